# Optimizing an MI355X kernel written in HIP

```python
import jax, jax.numpy as jnp
from jax import lax
import numpy as np

D_MODEL = 1024
BATCH = 16
SEQ = 2048
DEPTH = 2
DEC_BATCH = 32
DEC_SEQ = 8
PAST_LEN = 16384
PAGE_SIZE = 128

HEAD_DIM = 64
A_GROUPS = ((128, 1), (512, 4), (2048, 16))
N_A_GROUPS = 3
HEADS_PER_GROUP = 8
A_WIDTH = HEADS_PER_GROUP * HEAD_DIM
ROPE_THETA = 10000.0
BAND_BLOCK = 128
B_CHUNK = 128
B_WIDTH = 2 * D_MODEL
B_GROUPS = 16
B_GROUP_DIM = B_WIDTH // B_GROUPS
D_FF = 2816
N_MIXERS = 2
N_A_LAYERS = (DEPTH + 1) // 2
N_B_LAYERS = DEPTH // 2
EPS = 1e-6

kernel_name = "hybrid_dilated_attn_chunk_gmlp_macaron_step"


def rms_norm(x, g):
    xf = x.astype(jnp.float32)
    y = xf * lax.rsqrt(jnp.mean(xf * xf, axis=-1, keepdims=True) + EPS)
    return (y * g.astype(jnp.float32)).astype(x.dtype)


def rotary(x, pos):
    half = HEAD_DIM // 2
    inv = ROPE_THETA ** (-jnp.arange(half, dtype=jnp.float32) / half)
    ang = pos.astype(jnp.float32)[:, None] * inv[None, :]
    shape = (1, pos.shape[0]) + (1,) * (x.ndim - 3) + (half,)
    cos = jnp.cos(ang).reshape(shape)
    sin = jnp.sin(ang).reshape(shape)
    xf = x.astype(jnp.float32)
    x1, x2 = xf[..., :half], xf[..., half:]
    return jnp.concatenate([x1 * cos - x2 * sin, x2 * cos + x1 * sin], axis=-1).astype(x.dtype)


def swiglu_half_step(x, g, w_in, w_out):
    h = rms_norm(x, g) @ w_in
    gate, up = jnp.split(h, 2, axis=-1)
    return x + 0.5 * ((jax.nn.silu(gate) * up) @ w_out)


def masked_softmax_av(s, valid, v, eq):
    s = jnp.where(valid, s, -jnp.inf)
    m = jnp.max(s, axis=-1, keepdims=True)
    p = jnp.exp(s - m)
    l = jnp.sum(p, axis=-1, keepdims=True)
    o = jnp.einsum(eq, (p / l).astype(v.dtype), v)
    return o, (m + jnp.log(l))[..., 0]


def a_project(xn, w_qkv, qk_gain, pos):
    B, T, _ = xn.shape
    qkv = (xn @ w_qkv).reshape(B, T, 3, N_A_GROUPS, HEADS_PER_GROUP, HEAD_DIM)
    q = rotary(rms_norm(qkv[:, :, 0], qk_gain[0]), pos)
    k = rotary(rms_norm(qkv[:, :, 1], qk_gain[1]), pos)
    return q, k, qkv[:, :, 2]


def dilated_band_attention(q, k, v, window, dilation):
    B, S, H, Dh = q.shape
    n_back = window // dilation
    L = S // dilation
    nblk = -(-L // BAND_BLOCK)
    Lp = nblk * BAND_BLOCK

    def by_residue(a, front):
        a = a.reshape(B, L, dilation, H, Dh).transpose(0, 2, 1, 3, 4)
        return jnp.pad(a, ((0, 0), (0, 0), (front, Lp - L), (0, 0), (0, 0)))

    qb = by_residue(q, 0).reshape(B, dilation, nblk, BAND_BLOCK, H, Dh)
    kb = by_residue(k, BAND_BLOCK).reshape(B, dilation, nblk + 1, BAND_BLOCK, H, Dh)
    vb = by_residue(v, BAND_BLOCK).reshape(B, dilation, nblk + 1, BAND_BLOCK, H, Dh)
    kw = jnp.concatenate([kb[:, :, :-1], kb[:, :, 1:]], axis=3)
    vw = jnp.concatenate([vb[:, :, :-1], vb[:, :, 1:]], axis=3)
    s = jnp.einsum('brnqhd,brnkhd->brnhqk', qb, kw,
                   preferred_element_type=jnp.float32) * (HEAD_DIM ** -0.5)
    jq = jnp.arange(nblk)[:, None] * BAND_BLOCK + jnp.arange(BAND_BLOCK)[None, :]
    jk = (jnp.arange(nblk)[:, None] - 1) * BAND_BLOCK + jnp.arange(2 * BAND_BLOCK)[None, :]
    dist = jq[:, :, None] - jk[:, None, :]
    valid = (dist >= 0) & (dist <= n_back) & (jk[:, None, :] >= 0)
    o, lse = masked_softmax_av(s, valid[None, None, :, None], vw, 'brnhqk,brnkhd->brnqhd')
    o = o.reshape(B, dilation, Lp, H, Dh)[:, :, :L].transpose(0, 2, 1, 3, 4).reshape(B, S, H, Dh)
    lse = lse.transpose(0, 1, 2, 4, 3).reshape(B, dilation, Lp, H)[:, :, :L]
    lse = lse.transpose(0, 2, 1, 3).reshape(B, S, H)
    return o, lse


def dilated_gather_attention(q, k_all, v_all, window, dilation, L):
    T = q.shape[1]
    n_back = window // dilation
    idx = L + jnp.arange(T)[:, None] - dilation * jnp.arange(n_back + 1)[None, :]
    valid = idx >= 0
    idxc = jnp.maximum(idx, 0)
    kg = k_all[:, idxc]
    vg = v_all[:, idxc]
    s = jnp.einsum('bthd,btkhd->bthk', q, kg,
                   preferred_element_type=jnp.float32) * (HEAD_DIM ** -0.5)
    return masked_softmax_av(s, valid[None, :, None, :], vg, 'bthk,btkhd->bthd')


def merge_groups(outs, lses):
    o = jnp.stack(outs, axis=0)
    w = jax.nn.softmax(jnp.stack(lses, axis=0), axis=0)
    return jnp.sum(w[..., None] * o.astype(jnp.float32), axis=0).astype(o.dtype)


def mixer_a_prompt(xn, w_qkv, qk_gain, w_o):
    B, S, _ = xn.shape
    q, k, v = a_project(xn, w_qkv, qk_gain, jnp.arange(S))
    outs, lses, tails = [], [], []
    for g, (window, dilation) in enumerate(A_GROUPS):
        o, lse = dilated_band_attention(q[:, :, g], k[:, :, g], v[:, :, g], window, dilation)
        outs.append(o)
        lses.append(lse)
        keep = min(window, S)
        tails.append(jnp.stack([k[:, S - keep:, g], v[:, S - keep:, g]], axis=2))
    y = merge_groups(outs, lses).reshape(B, S, A_WIDTH) @ w_o
    return y, tails


def mixer_a_sample(xn, bufs, w_qkv, qk_gain, w_o):
    B, T, _ = xn.shape
    q, k, v = a_project(xn, w_qkv, qk_gain, PAST_LEN + jnp.arange(T))
    outs, lses, rows = [], [], []
    for g, (window, dilation) in enumerate(A_GROUPS):
        buf = bufs[g]
        L = buf.shape[1]
        k_all = jnp.concatenate([buf[:, :, 0], k[:, :, g]], axis=1)
        v_all = jnp.concatenate([buf[:, :, 1], v[:, :, g]], axis=1)
        o, lse = dilated_gather_attention(q[:, :, g], k_all, v_all, window, dilation, L)
        outs.append(o)
        lses.append(lse)
        rows.append(jnp.stack([k[:, :, g], v[:, :, g]], axis=2))
    y = merge_groups(outs, lses).reshape(B, T, A_WIDTH) @ w_o
    return y, rows


def chunk_spatial_gating(xn, w_uv, v_gain, w_sp, b_sp, w_o):
    B, T, _ = xn.shape
    u, v = jnp.split(jax.nn.gelu(xn @ w_uv), 2, axis=-1)
    v = rms_norm(v, v_gain)
    nch = -(-T // B_CHUNK)
    Tp = nch * B_CHUNK
    vc = jnp.pad(v, ((0, 0), (0, Tp - T), (0, 0))).reshape(B, nch, B_CHUNK, B_GROUPS, B_GROUP_DIM)
    causal = jnp.tril(jnp.ones((B_CHUNK, B_CHUNK), dtype=bool))
    w = jnp.where(causal[None], w_sp, jnp.zeros_like(w_sp))
    mixed = jnp.einsum('gts,bnsgc->bntgc', w, vc) + b_sp.T[None, None, :, :, None]
    mixed = mixed.reshape(B, Tp, B_WIDTH)[:, :T]
    return (u * mixed) @ w_o, v


def setup_inputs(seed: int = 0) -> dict:
    key = jax.random.key(seed)
    ks = jax.random.split(key, 18)
    f32 = jnp.float32
    d_qkv = 3 * N_A_GROUPS * HEADS_PER_GROUP * HEAD_DIM

    def cache(k, window):
        return jax.random.normal(k, (N_A_LAYERS, DEC_BATCH, min(window, PAST_LEN), 2,
                                     HEADS_PER_GROUP, HEAD_DIM), f32)

    return {
        "x_prompt": jax.random.normal(ks[0], (BATCH, SEQ, D_MODEL), f32),
        "x_sample": jax.random.normal(ks[1], (DEC_BATCH, DEC_SEQ, D_MODEL), f32),
        "cache_kv_w128": cache(ks[2], A_GROUPS[0][0]),
        "cache_kv_w512": cache(ks[3], A_GROUPS[1][0]),
        "cache_kv_w2048": cache(ks[4], A_GROUPS[2][0]),
        "norm_g": 1.0 + 0.02 * jax.random.normal(ks[5], (DEPTH, 3, D_MODEL), f32),
        "w_ffn_in": jax.random.normal(ks[6], (DEPTH, 2, D_MODEL, 2 * D_FF), f32) * D_MODEL ** -0.5,
        "w_ffn_out": jax.random.normal(ks[7], (DEPTH, 2, D_FF, D_MODEL), f32) * D_FF ** -0.5,
        "w_qkv_a": jax.random.normal(ks[8], (N_A_LAYERS, D_MODEL, d_qkv), f32) * D_MODEL ** -0.5,
        "qk_gain_a": 1.0 + 0.02 * jax.random.normal(ks[9], (N_A_LAYERS, 2, HEAD_DIM), f32),
        "w_o_a": jax.random.normal(ks[10], (N_A_LAYERS, A_WIDTH, D_MODEL), f32) * A_WIDTH ** -0.5,
        "w_uv_b": jax.random.normal(ks[11], (N_B_LAYERS, D_MODEL, 2 * B_WIDTH), f32) * D_MODEL ** -0.5,
        "v_gain_b": 1.0 + 0.02 * jax.random.normal(ks[12], (N_B_LAYERS, B_WIDTH), f32),
        "w_sp_b": jax.random.normal(ks[13], (N_B_LAYERS, B_GROUPS, B_CHUNK, B_CHUNK), f32) * B_CHUNK ** -0.5,
        "b_sp_b": 1.0 + 0.02 * jax.random.normal(ks[14], (N_B_LAYERS, B_GROUPS, B_CHUNK), f32),
        "w_o_b": jax.random.normal(ks[15], (N_B_LAYERS, B_WIDTH, D_MODEL), f32) * B_WIDTH ** -0.5,
    }


def reference(x_prompt, x_sample, cache_kv_w128, cache_kv_w512, cache_kv_w2048, norm_g,
              w_ffn_in, w_ffn_out, w_qkv_a, qk_gain_a, w_o_a, w_uv_b, v_gain_b, w_sp_b, b_sp_b, w_o_b):
    xp, xs = x_prompt, x_sample
    tails_p = [[], [], []]
    rows_s = [[], [], []]
    v_rows_s = []
    for i in range(DEPTH):
        j = i // N_MIXERS
        xp = swiglu_half_step(xp, norm_g[i, 0], w_ffn_in[i, 0], w_ffn_out[i, 0])
        xs = swiglu_half_step(xs, norm_g[i, 0], w_ffn_in[i, 0], w_ffn_out[i, 0])
        xpn = rms_norm(xp, norm_g[i, 1])
        xsn = rms_norm(xs, norm_g[i, 1])
        if i % N_MIXERS == 0:
            yp, tails = mixer_a_prompt(xpn, w_qkv_a[j], qk_gain_a[j], w_o_a[j])
            ys, rows = mixer_a_sample(xsn, (cache_kv_w128[j], cache_kv_w512[j], cache_kv_w2048[j]),
                                      w_qkv_a[j], qk_gain_a[j], w_o_a[j])
            for g in range(N_A_GROUPS):
                tails_p[g].append(tails[g])
                rows_s[g].append(rows[g])
        else:
            yp, _ = chunk_spatial_gating(xpn, w_uv_b[j], v_gain_b[j], w_sp_b[j], b_sp_b[j], w_o_b[j])
            ys, v_new = chunk_spatial_gating(xsn, w_uv_b[j], v_gain_b[j], w_sp_b[j], b_sp_b[j], w_o_b[j])
            v_rows_s.append(v_new)
        xp = xp + yp
        xs = xs + ys
        xp = swiglu_half_step(xp, norm_g[i, 2], w_ffn_in[i, 1], w_ffn_out[i, 1])
        xs = swiglu_half_step(xs, norm_g[i, 2], w_ffn_in[i, 1], w_ffn_out[i, 1])
    return (xp, xs,
            jnp.stack(tails_p[0], axis=0), jnp.stack(tails_p[1], axis=0), jnp.stack(tails_p[2], axis=0),
            jnp.stack(rows_s[0], axis=0), jnp.stack(rows_s[1], axis=0), jnp.stack(rows_s[2], axis=0),
            jnp.stack(v_rows_s, axis=0))
```

```cpp
#include <hip/hip_runtime.h>
#include <hip/hip_cooperative_groups.h>
#include <cstdio>
#include <cstdint>
namespace cg = cooperative_groups;

#ifndef ONE_LAUNCH
#define ONE_LAUNCH 1
#endif

#define LAS __attribute__((address_space(3)))
typedef unsigned short bf16_t;
typedef short bf16x8 __attribute__((ext_vector_type(8)));
typedef short s16x4 __attribute__((ext_vector_type(4)));
typedef float f32x2 __attribute__((ext_vector_type(2)));
typedef float f32x4 __attribute__((ext_vector_type(4)));
typedef float f32x16 __attribute__((ext_vector_type(16)));
typedef unsigned u32x2 __attribute__((ext_vector_type(2)));
typedef unsigned u32x4 __attribute__((ext_vector_type(4)));

constexpr int D = 1024, SEQ = 2048, NBATCH = 16, MP = NBATCH * SEQ, MS = 256, M = MP + MS;
constexpr int FF = 2816, NQKV = 4608, AW = 512, BW = 2048, NUV = 4096, PAST = 16384;
constexpr float EPS = 1e-6f;
constexpr int LDU = BW + 64;
constexpr int NPOS = SEQ + 8;
constexpr size_t O_YP = 0, O_YS = (size_t)MP * D, O_KP0 = O_YS + (size_t)MS * D, O_KP1 = O_KP0 + 2097152, O_KP2 = O_KP1 + 8388608,
                 O_KS0 = O_KP2 + 33554432, O_KS1 = O_KS0 + 262144, O_KS2 = O_KS1 + 262144, O_VS = O_KS2 + 262144;
constexpr size_t al256(size_t x) { return (x + 255) & ~(size_t)255; }
constexpr size_t WS_WIN = 1u << 20;
constexpr size_t SZ_WIN = (size_t)2 * FF * D * 2;
constexpr size_t WS_WOUT = WS_WIN + 4 * SZ_WIN;
constexpr size_t SZ_WOUT = (size_t)D * FF * 2;
constexpr size_t WS_WQKV = WS_WOUT + 4 * SZ_WOUT;
constexpr size_t WS_WOA = WS_WQKV + (size_t)NQKV * D * 2;
constexpr size_t WS_WUV = WS_WOA + (size_t)D * AW * 2;
constexpr size_t WS_WOB = WS_WUV + (size_t)NUV * D * 2;
constexpr size_t WS_WSP = WS_WOB + (size_t)D * LDU * 2;
constexpr size_t WS_ROPE = WS_WSP + (size_t)16 * 128 * 128 * 2;
constexpr size_t WS_XN = al256(WS_ROPE + (size_t)NPOS * 32 * 4 * 2);
constexpr size_t WS_BIG = al256(WS_XN + (size_t)M * D * 2);
constexpr size_t WS_OG = al256(WS_BIG + (size_t)M * NQKV * 2);
constexpr size_t WS_LSE = al256(WS_OG + (size_t)3 * M * AW * 2);
constexpr size_t WS_AO = al256(WS_LSE + (size_t)3 * M * 8 * 4);
constexpr size_t WS_UM = al256(WS_AO + (size_t)M * AW * 2);
constexpr size_t WS_RV = al256(WS_UM + (size_t)M * LDU * 2);
constexpr size_t WS_YB = al256(WS_RV + (size_t)M * 4);
constexpr size_t WS_END = al256(WS_YB + (size_t)M * D * 2);

constexpr int LDS_BYTES = 139264;
#ifdef DUMPSEL
constexpr int NPHASE = 21;
#else
constexpr int NPHASE = 24;
#endif

__device__ __forceinline__ float wave_sum(float v) {
#pragma unroll
    for (int o = 1; o < 64; o <<= 1) v += __shfl_xor(v, o);
    return v;
}
__device__ __forceinline__ float wave_max(float v) {
#pragma unroll
    for (int o = 1; o < 64; o <<= 1) v = fmaxf(v, __shfl_xor(v, o));
    return v;
}
typedef __bf16 bf16x2_t __attribute__((ext_vector_type(2)));
__device__ __forceinline__ unsigned cvt_pk_bf16(float lo, float hi) { const f32x2 v = {lo, hi}; return __builtin_bit_cast(unsigned, __builtin_convertvector(v, bf16x2_t)); }
__device__ __forceinline__ float bf_lo(unsigned w) { return __uint_as_float(w << 16); }
__device__ __forceinline__ float bf_hi(unsigned w) { return __uint_as_float(w & 0xffff0000u); }
__device__ __forceinline__ float silu_f(float x) { return x * __builtin_amdgcn_rcpf(1.0f + __expf(-x)); }
__device__ __forceinline__ float gelu_tanh_f(float x) { const float y = 0.7978845608028654f * (x + 0.044715f * x * x * x); return x * __builtin_amdgcn_rcpf(1.0f + __expf(-2.0f * y)); }

namespace pg8 {
constexpr int BM = 256, BK = 64, HALF = 128, HTB = HALF * BK * 2, STAGE_BYTES = 8 * HTB, NXCD = 8, WGM = 8;
__device__ __forceinline__ int lds_byte(int r, int c) { const int st = (r >> 4) * 2 + (c >> 5), rr = r & 15, cc = c & 31, ob = rr * 64 + cc * 2; return st * 1024 + (ob ^ (((ob >> 9) & 1) << 5)); }
__device__ __forceinline__ void stage_rc(int b, int& R, int& C) { const int st = b / 1024, sb = b % 1024, swz = sb ^ (((sb >> 9) & 1) << 5); R = (st >> 1) * 16 + swz / 64; C = (st & 1) * 32 + (swz % 64) / 2; }
__device__ __forceinline__ int perm32(int rho) { const int n = rho >> 4, i = rho & 15; return 8 * (i >> 2) + 4 * n + (i & 3); }
struct Unit { int pm, pn; };
struct StaticOrder {
    int nM, nN, nwg, G, c;
    __device__ void init(int M_, int N_, int G_, int c_) { nM = M_ / BM; nN = N_ / BM; nwg = nM * nN; G = G_; c = c_; }
    __device__ bool next(int i, Unit& u) const {
        const long L = (long)i * G + c; if (L >= nwg) return false;
        int wgid = (int)L; { const int q = nwg / NXCD, r = nwg % NXCD, xcd = wgid % NXCD, off = wgid / NXCD; wgid = (xcd < r ? xcd * (q + 1) : r * (q + 1) + (xcd - r) * q) + off; }
        const int nig = WGM * nN, gid = wgid / nig, fm = gid * WGM, gsz = (nM - fm) < WGM ? (nM - fm) : WGM;
        u.pm = fm + ((wgid % nig) % gsz); u.pn = (wgid % nig) / gsz; return true;
    }
};
template <class Epi>
__device__ __forceinline__ void gemm_phase(LAS unsigned char* lds, const bf16_t* gA, const bf16_t* gBt, int gM, int gN, int K, const Epi& E, const int tid, const int lda = 0, const int ldb = 0) {
    const int LA = lda ? lda : K, LB = ldb ? ldb : K;
    const int wid = __builtin_amdgcn_readfirstlane(tid >> 6), lane = tid & 63, wr = wid >> 2, wc = wid & 3, fr = lane & 15, fq = lane >> 4;
    const int nt = K / BK;
    StaticOrder S; S.init(gM, gN, (int)gridDim.x, (int)blockIdx.x);
    unsigned voffA[2], voffB[2];
#pragma unroll
    for (int i = 0; i < 2; ++i) { int R, C; stage_rc(tid * 16 + i * 8192, R, C); const int Rb = Epi::PERM ? ((R & ~31) + perm32(R & 31)) : R;
        voffA[i] = (unsigned)(R * LA + C) * 2u; voffB[i] = (unsigned)(Rb * LB + C) * 2u; }
    const size_t kstep = (size_t)(BK * 2);
    const size_t hstepA = (size_t)HALF * LA * 2, hstepB = (size_t)HALF * LB * 2;
    const size_t tstepA = 2 * hstepA, tstepB = 2 * hstepB;
    const unsigned ldsw = (unsigned)wid * 1024u;
    const int aoff = lds_byte(wr * 64 + fr, fq * 8), boff = lds_byte(wc * 32 + fr, fq * 8);
#define PG8_SA(b, h) (((b) * 2 + (h)) * HTB)
#define PG8_SB(b, h) ((4 + (b) * 2 + (h)) * HTB)
#define PG8_STAGE(bufoff, gbase, voff) do { _Pragma("unroll") for (int _i = 0; _i < 2; ++_i) \
        __builtin_amdgcn_global_load_lds((const unsigned*)((const char*)(gbase) + (voff)[_i]), (LAS unsigned*)(lds + (bufoff) + ldsw + _i * 8192), 16, 0, 0); } while (0)
#define PG8_LDA(dst, b, h) do { _Pragma("unroll") for (int m = 0; m < 4; ++m) _Pragma("unroll") for (int k = 0; k < 2; ++k) dst[m][k] = *(const LAS bf16x8*)(lds + PG8_SA(b, h) + aoff + m * 2048 + k * 1024); } while (0)
#define PG8_LDB(dst, b, h) do { _Pragma("unroll") for (int n = 0; n < 2; ++n) _Pragma("unroll") for (int k = 0; k < 2; ++k) dst[n][k] = *(const LAS bf16x8*)(lds + PG8_SB(b, h) + boff + n * 2048 + k * 1024); } while (0)
#define PG8_MMA(ai, bj, At, Bt) do { __builtin_amdgcn_s_setprio(1); _Pragma("unroll") for (int m = 0; m < 4; ++m) _Pragma("unroll") for (int n = 0; n < 2; ++n) _Pragma("unroll") for (int k = 0; k < 2; ++k) \
        acc[ai][bj][m][n] = __builtin_amdgcn_mfma_f32_16x16x32_bf16(Bt[n][k], At[m][k], acc[ai][bj][m][n], 0, 0, 0); __builtin_amdgcn_s_setprio(0); } while (0)
#define PG8_WAIT_V(n) asm volatile("s_waitcnt vmcnt(" #n ")" ::: "memory")
#define PG8_WAIT_L(n) asm volatile("s_waitcnt lgkmcnt(" #n ")" ::: "memory")
#define PG8_BAR __builtin_amdgcn_s_barrier()
#define PG8_SCHED __builtin_amdgcn_sched_barrier(0)
    Unit cur, nxt; int ui = 0;
    if (!S.next(0, cur)) return;
    f32x4 acc[2][2][4][2];
#pragma unroll
    for (int a = 0; a < 2; ++a)
#pragma unroll
        for (int b = 0; b < 2; ++b)
#pragma unroll
            for (int m = 0; m < 4; ++m)
#pragma unroll
                for (int n = 0; n < 2; ++n) acc[a][b][m][n] = (f32x4){0.f, 0.f, 0.f, 0.f};
    bf16x8 At[4][2], B0[2][2], B1[2][2];
    const char* cA = (const char*)gA + (size_t)cur.pm * tstepA; const char* cB = (const char*)gBt + (size_t)cur.pn * tstepB;
    PG8_STAGE(PG8_SB(0, 0), cB, voffB); PG8_STAGE(PG8_SA(0, 0), cA, voffA); PG8_STAGE(PG8_SB(0, 1), cB + hstepB, voffB); PG8_STAGE(PG8_SA(0, 1), cA + hstepA, voffA);
    if (wr == 1) PG8_BAR;
    PG8_WAIT_V(4); PG8_BAR;
    PG8_STAGE(PG8_SB(1, 0), cB + kstep, voffB); PG8_STAGE(PG8_SA(1, 0), cA + kstep, voffA); PG8_STAGE(PG8_SB(1, 1), cB + hstepB + kstep, voffB);
    PG8_WAIT_V(6); PG8_BAR;
    for (;;) {
        const bool has_next = S.next(ui + 1, nxt);
        const char* nA = has_next ? (const char*)gA + (size_t)nxt.pm * tstepA : cA; const char* nB = has_next ? (const char*)gBt + (size_t)nxt.pn * tstepB : cB;
        for (int t = 0; t < nt; t += 2) {
            const bool last = (t == nt - 2);
            const char* a1 = cA + (size_t)(t + 1) * kstep;
            const char* a2 = last ? nA : cA + (size_t)(t + 2) * kstep; const char* b2 = last ? nB : cB + (size_t)(t + 2) * kstep;
            const char* a3 = a2 + kstep; const char* b3 = b2 + kstep;
            PG8_LDB(B0, 0, 0); PG8_SCHED; PG8_LDA(At, 0, 0); PG8_STAGE(PG8_SA(1, 1), a1 + hstepA, voffA);
            PG8_WAIT_L(8); PG8_BAR; PG8_WAIT_L(0); PG8_MMA(0, 0, At, B0); PG8_BAR; PG8_SCHED;
            PG8_LDB(B1, 0, 1); PG8_STAGE(PG8_SB(0, 0), b2, voffB);
            PG8_BAR; PG8_WAIT_L(0); PG8_MMA(0, 1, At, B1); PG8_BAR;
            PG8_LDA(At, 0, 1); PG8_STAGE(PG8_SA(0, 0), a2, voffA);
            PG8_BAR; PG8_WAIT_L(0); PG8_MMA(1, 0, At, B0); PG8_BAR; PG8_SCHED;
            PG8_STAGE(PG8_SB(0, 1), b2 + hstepB, voffB);
            PG8_WAIT_V(6); PG8_BAR; PG8_MMA(1, 1, At, B1); PG8_BAR;
            PG8_LDB(B0, 1, 0); PG8_SCHED; PG8_LDA(At, 1, 0); PG8_STAGE(PG8_SA(0, 1), a2 + hstepA, voffA);
            PG8_WAIT_L(8); PG8_BAR; PG8_WAIT_L(0); PG8_MMA(0, 0, At, B0); PG8_BAR; PG8_SCHED;
            PG8_LDB(B1, 1, 1); PG8_STAGE(PG8_SB(1, 0), b3, voffB);
            PG8_BAR; PG8_WAIT_L(0); PG8_MMA(0, 1, At, B1); PG8_BAR;
            PG8_LDA(At, 1, 1); PG8_STAGE(PG8_SA(1, 0), a3, voffA);
            PG8_BAR; PG8_WAIT_L(0); PG8_MMA(1, 0, At, B0); PG8_BAR; PG8_SCHED;
            PG8_STAGE(PG8_SB(1, 1), b3 + hstepB, voffB);
            PG8_WAIT_V(6); PG8_BAR; PG8_MMA(1, 1, At, B1); PG8_BAR;
        }
        E(acc, cur, wr, wc, fr, fq);
        if (!has_next) break;
#pragma unroll
        for (int a = 0; a < 2; ++a)
#pragma unroll
            for (int b = 0; b < 2; ++b)
#pragma unroll
                for (int m = 0; m < 4; ++m)
#pragma unroll
                    for (int n = 0; n < 2; ++n) acc[a][b][m][n] = (f32x4){0.f, 0.f, 0.f, 0.f};
        cur = nxt; cA = nA; cB = nB; ++ui;
    }
    PG8_WAIT_V(0);
    if (wr == 0) PG8_BAR;
    PG8_BAR;
#undef PG8_SA
#undef PG8_SB
#undef PG8_STAGE
#undef PG8_LDA
#undef PG8_LDB
#undef PG8_MMA
#undef PG8_WAIT_V
#undef PG8_WAIT_L
#undef PG8_BAR
#undef PG8_SCHED
}

struct EpiSwiglu {
    static constexpr bool PERM = true;
    bf16_t* O;
    __device__ __forceinline__ void operator()(const f32x4 (&acc)[2][2][4][2], const Unit& u, int wr, int wc, int fr, int fq) const {
        const int row0 = u.pm * BM + wr * 64 + fr, col0 = u.pn * HALF + wc * 32 + 8 * fq;
#pragma unroll
        for (int ai = 0; ai < 2; ++ai)
#pragma unroll
            for (int m = 0; m < 4; ++m) {
                const f32x4 g0 = acc[ai][0][m][0], g1 = acc[ai][0][m][1], u0 = acc[ai][1][m][0], u1 = acc[ai][1][m][1];
                u32x4 w;
                w.x = cvt_pk_bf16(silu_f(g0[0]) * u0[0], silu_f(g0[1]) * u0[1]); w.y = cvt_pk_bf16(silu_f(g0[2]) * u0[2], silu_f(g0[3]) * u0[3]);
                w.z = cvt_pk_bf16(silu_f(g1[0]) * u1[0], silu_f(g1[1]) * u1[1]); w.w = cvt_pk_bf16(silu_f(g1[2]) * u1[2], silu_f(g1[3]) * u1[3]);
                *(u32x4*)(O + (size_t)(row0 + ai * HALF + m * 16) * FF + col0) = w;
            }
    }
};
struct EpiResid {
    static constexpr bool PERM = false;
    float* X; float s;
    __device__ __forceinline__ void operator()(const f32x4 (&acc)[2][2][4][2], const Unit& u, int wr, int wc, int fr, int fq) const {
        const int row0 = u.pm * BM + wr * 64 + fr, col0 = u.pn * BM + wc * 32 + 4 * fq;
#pragma unroll
        for (int ai = 0; ai < 2; ++ai)
#pragma unroll
            for (int m = 0; m < 4; ++m) { float* rowp = X + (size_t)(row0 + ai * HALF + m * 16) * D + col0;
#pragma unroll
                for (int bj = 0; bj < 2; ++bj)
#pragma unroll
                    for (int n = 0; n < 2; ++n) { f32x4* p = (f32x4*)(rowp + bj * HALF + n * 16); *p = *p + acc[ai][bj][m][n] * s; } }
    }
};
template <int ACT> struct EpiBf16 {
    static constexpr bool PERM = true;
    bf16_t* O; int ldc;
    __device__ __forceinline__ void operator()(const f32x4 (&acc)[2][2][4][2], const Unit& u, int wr, int wc, int fr, int fq) const {
        const int row0 = u.pm * BM + wr * 64 + fr, col0 = u.pn * BM + wc * 32 + 8 * fq;
#pragma unroll
        for (int ai = 0; ai < 2; ++ai)
#pragma unroll
            for (int m = 0; m < 4; ++m) { bf16_t* rowp = O + (size_t)(row0 + ai * HALF + m * 16) * ldc + col0;
#pragma unroll
                for (int bj = 0; bj < 2; ++bj) { f32x4 v0 = acc[ai][bj][m][0], v1 = acc[ai][bj][m][1];
                    if (ACT == 1) {
#pragma unroll
                        for (int j = 0; j < 4; ++j) { v0[j] = gelu_tanh_f(v0[j]); v1[j] = gelu_tanh_f(v1[j]); } }
                    u32x4 w; w.x = cvt_pk_bf16(v0[0], v0[1]); w.y = cvt_pk_bf16(v0[2], v0[3]); w.z = cvt_pk_bf16(v1[0], v1[1]); w.w = cvt_pk_bf16(v1[2], v1[3]);
                    *(u32x4*)(rowp + bj * HALF) = w; } }
    }
};
}

#define MFMA32S(a, b, c) __builtin_amdgcn_mfma_f32_32x32x16_bf16((a), (b), (c), 0, 0, 0)
template <int MODE>
__device__ __forceinline__ void sample_gemm(LAS unsigned char* lds, const bf16_t* A, int lda, const bf16_t* Bt, int ldb, int K, int N, bf16_t* O, int ldc, const int tid) {
    const int lane = tid & 63, wave = __builtin_amdgcn_readfirstlane(tid >> 6), hh = lane >> 5;
    const int ntiles = 8 * (N / 32), kw = K / 8;
    LAS float* red = (LAS float*)lds;
    for (int tile = blockIdx.x; tile < ntiles; tile += gridDim.x) {
        const int rt = tile & 7, ct = tile >> 3;
        const bf16_t* ap = A + (size_t)(32 * rt + (lane & 31)) * lda + wave * kw + 8 * hh;
        int brow = 32 * ct + (lane & 31);
        if (MODE == 2) { const int h0 = 32 * ct; brow = (h0 >> 7) * 256 + (h0 & 127) + (lane & 31); }
        const bf16_t* bp = Bt + (size_t)brow * ldb + wave * kw + 8 * hh;
        f32x16 c0, c1;
#pragma unroll
        for (int i = 0; i < 16; ++i) { c0[i] = 0.f; c1[i] = 0.f; }
#pragma unroll 4
        for (int k = 0; k < kw; k += 16) {
            const bf16x8 a = *(const bf16x8*)(ap + k), b = *(const bf16x8*)(bp + k);
            c0 = MFMA32S(a, b, c0);
            if (MODE == 2) { const bf16x8 b2 = *(const bf16x8*)(bp + (size_t)128 * ldb + k); c1 = MFMA32S(a, b2, c1); }
        }
        __syncthreads();
#pragma unroll
        for (int i = 0; i < 16; ++i) { red[((wave * 2 + 0) * 16 + i) * 64 + lane] = c0[i]; if (MODE == 2) red[((wave * 2 + 1) * 16 + i) * 64 + lane] = c1[i]; }
        __syncthreads();
#pragma unroll
        for (int r = 0; r < 2; ++r) {
            const int e = tid + 512 * r, i = e >> 6, l = e & 63;
            float s0 = 0.f, s1 = 0.f;
#pragma unroll
            for (int w = 0; w < 8; ++w) { s0 += red[((w * 2 + 0) * 16 + i) * 64 + l]; if (MODE == 2) s1 += red[((w * 2 + 1) * 16 + i) * 64 + l]; }
            const int row = 32 * rt + (i & 3) + 8 * (i >> 2) + 4 * (l >> 5), col = 32 * ct + (l & 31);
            const float v = MODE == 2 ? silu_f(s0) * s1 : (MODE == 1 ? gelu_tanh_f(s0) : s0);
            O[(size_t)row * ldc + col] = (bf16_t)(cvt_pk_bf16(v, 0.f) & 0xffffu);
        }
    }
    __syncthreads();
}

struct Params { const float* in[16]; float* out; unsigned char* ws; int ph_lo, ph_hi; };

__device__ __forceinline__ void transpose_item(const float* W, int K, int N, bf16_t* WT, int k0, int n0, int drow0, LAS float* scr, int lane, int ldw) {
#pragma unroll 8
    for (int i = 0; i < 32; ++i) { const int kk = 2 * i + (lane >> 5); scr[kk * 33 + (lane & 31)] = W[(size_t)(k0 + kk) * N + n0 + (lane & 31)]; }
    asm volatile("s_waitcnt lgkmcnt(0)" ::: "memory");
    const int c = lane & 7;
#pragma unroll
    for (int j = 0; j < 4; ++j) { const int n = (lane >> 3) + 8 * j; const LAS float* s = scr + (8 * c) * 33 + n;
        u32x4 o; o.x = cvt_pk_bf16(s[0 * 33], s[1 * 33]); o.y = cvt_pk_bf16(s[2 * 33], s[3 * 33]); o.z = cvt_pk_bf16(s[4 * 33], s[5 * 33]); o.w = cvt_pk_bf16(s[6 * 33], s[7 * 33]);
        *(u32x4*)(WT + (size_t)(drow0 + n) * ldw + k0 + 8 * c) = o; }
    asm volatile("s_waitcnt lgkmcnt(0)" ::: "memory");
}
__device__ __forceinline__ void transpose_mat(const float* W, int K, int N, bf16_t* WT, int item, bool swiglu, LAS float* scr, int lane, int ldw = 0) {
    const int nblk = N / 32, kb = item / nblk, nb = item % nblk, n0 = 32 * nb;
    int drow0 = n0;
    if (swiglu) { const int up = n0 >= FF, nn = up ? n0 - FF : n0; drow0 = (nn >> 7) * 256 + (up ? 128 : 0) + (nn & 127); }
    transpose_item(W, K, N, WT, 64 * kb, n0, drow0, scr, lane, ldw ? ldw : K);
}
__constant__ double ROPE_INV[32] = {
    1.0, 0.7498942093324559, 0.5623413251903491, 0.4216965034285822, 0.31622776601683794, 0.23713737056616552, 0.1778279410038923, 0.1333521432163324,
    0.1, 0.07498942093324558, 0.05623413251903491, 0.042169650342858224, 0.03162277660168379, 0.023713737056616554, 0.01778279410038923, 0.01333521432163324,
    0.01, 0.007498942093324558, 0.005623413251903491, 0.004216965034285823, 0.0031622776601683794, 0.0023713737056616554, 0.0017782794100389228, 0.001333521432163324,
    0.001, 0.0007498942093324559, 0.0005623413251903491, 0.00042169650342858224, 0.00031622776601683794, 0.00023713737056616554, 0.00017782794100389227, 0.0001333521432163324};

__device__ __forceinline__ void norm_row(const float* xrow, const bf16_t* yrow, float sy, const float* g, bf16_t* orow, float* xout, int lane) {
    const f32x4* xr = (const f32x4*)xrow + lane;
    f32x4 v[4]; float ss = 0.f;
#pragma unroll
    for (int j = 0; j < 4; ++j) v[j] = xr[64 * j];
    if (yrow) {
#pragma unroll
        for (int j = 0; j < 4; ++j) { const u32x2 y = ((const u32x2*)yrow)[lane + 64 * j];
            v[j].x += sy * bf_lo(y.x); v[j].y += sy * bf_hi(y.x); v[j].z += sy * bf_lo(y.y); v[j].w += sy * bf_hi(y.y); }
    }
#pragma unroll
    for (int j = 0; j < 4; ++j) ss += (v[j].x * v[j].x + v[j].y * v[j].y) + (v[j].z * v[j].z + v[j].w * v[j].w);
    if (xout) {
#pragma unroll
        for (int j = 0; j < 4; ++j) ((f32x4*)xout)[lane + 64 * j] = v[j];
    }
    if (g) {
        const float r = 1.0f / sqrtf(wave_sum(ss) * (1.0f / D) + EPS);
#pragma unroll
        for (int j = 0; j < 4; ++j) {
            const f32x4 gg = ((const f32x4*)g)[lane + 64 * j];
            u32x2 o; o.x = cvt_pk_bf16(v[j].x * r * gg.x, v[j].y * r * gg.y); o.y = cvt_pk_bf16(v[j].z * r * gg.z, v[j].w * r * gg.w);
            ((u32x2*)orow)[lane + 64 * j] = o;
        }
    }
}

__device__ __forceinline__ void phase_prologue(const Params& p, unsigned char* ws, float* out, LAS unsigned char* lds, const int tid) {
    const int lane = tid & 63, wave = tid >> 6;
    const int gw = blockIdx.x * 8 + wave, NGW = gridDim.x * 8;
    LAS float* scr = (LAS float*)(lds + wave * 8704);
    constexpr int I_IN = (D / 64) * (2 * FF / 32), I_OUT = (FF / 64) * (D / 32), I_QKV = (D / 64) * (NQKV / 32), I_OA = (AW / 64) * (D / 32), I_UV = (D / 64) * (NUV / 32), I_OB = (BW / 64) * (D / 32);
    constexpr int NITEMS = 4 * I_IN + 4 * I_OUT + I_QKV + I_OA + I_UV + I_OB;
    for (int it = gw; it < NITEMS; it += NGW) {
        int r = it;
        if (r < 4 * I_IN) { const int w = r / I_IN; transpose_mat(p.in[6] + (size_t)w * D * 2 * FF, D, 2 * FF, (bf16_t*)(ws + WS_WIN + w * SZ_WIN), r % I_IN, true, scr, lane); continue; } r -= 4 * I_IN;
        if (r < 4 * I_OUT) { const int w = r / I_OUT; transpose_mat(p.in[7] + (size_t)w * FF * D, FF, D, (bf16_t*)(ws + WS_WOUT + w * SZ_WOUT), r % I_OUT, false, scr, lane); continue; } r -= 4 * I_OUT;
        if (r < I_QKV) { transpose_mat(p.in[8], D, NQKV, (bf16_t*)(ws + WS_WQKV), r, false, scr, lane); continue; } r -= I_QKV;
        if (r < I_OA) { transpose_mat(p.in[10], AW, D, (bf16_t*)(ws + WS_WOA), r, false, scr, lane); continue; } r -= I_OA;
        if (r < I_UV) { transpose_mat(p.in[11], D, NUV, (bf16_t*)(ws + WS_WUV), r, false, scr, lane); continue; } r -= I_UV;
        transpose_mat(p.in[15], BW, D, (bf16_t*)(ws + WS_WOB), r, false, scr, lane, LDU);
    }
    { bf16_t* wsp = (bf16_t*)(ws + WS_WSP); const float* src = p.in[13];
      for (int i = blockIdx.x * 512 + tid; i < 16 * 128 * 128 / 2; i += gridDim.x * 512) {
          const int e = 2 * i, s = e & 127, t = (e >> 7) & 127; const f32x2 v = *(const f32x2*)(src + e);
          ((unsigned*)wsp)[i] = cvt_pk_bf16(s <= t ? v.x : 0.f, (s + 1) <= t ? v.y : 0.f); } }
    { float* ct = (float*)(ws + WS_ROPE); float* st = ct + NPOS * 32;
      for (int i = blockIdx.x * 512 + tid; i < NPOS * 32; i += gridDim.x * 512) {
          const int pi = i >> 5, fi = i & 31; const double pos = (double)(pi < SEQ ? pi : PAST + (pi - SEQ));
          const double a = pos * ROPE_INV[fi]; const double n = __builtin_rint(a * 0.15915494309189535);
          const double r = (a - n * 6.283185307179586) - n * 2.4492935982947064e-16; const double r2 = r * r;
          double sn = 1.0, cs = 1.0;
#pragma unroll 1
          for (int k = 14; k >= 1; --k) { const double k2 = (double)(2 * k); sn = 1.0 - sn * r2 / (k2 * (k2 + 1.0)); cs = 1.0 - cs * r2 / ((k2 - 1.0) * k2); }
          ct[i] = (float)cs; st[i] = (float)(sn * r); } }
#ifdef NANFILL
    { u32x4* f = (u32x4*)(ws + WS_BIG); const size_t n = (WS_END - WS_BIG) / 16; const u32x4 q = {0xffffffffu, 0xffffffffu, 0xffffffffu, 0xffffffffu};
      for (size_t i = (size_t)blockIdx.x * 512 + tid; i < n; i += (size_t)gridDim.x * 512) f[i] = q;
      u32x4* fo = (u32x4*)(out + O_KP0); const size_t no = (O_VS + 524288 - O_KP0) / 4;
      for (size_t i = (size_t)blockIdx.x * 512 + tid; i < no; i += (size_t)gridDim.x * 512) fo[i] = q; }
#endif
    for (int m = gw; m < M; m += NGW) {
        const float* src = m < MP ? p.in[0] + (size_t)m * D : p.in[1] + (size_t)(m - MP) * D;
        norm_row(src, nullptr, 0.f, p.in[5], (bf16_t*)(ws + WS_XN) + (size_t)m * D, out + (size_t)m * D, lane);
    }
}

__device__ __forceinline__ void phase_norm(unsigned char* ws, float* out, const float* g, float sy, const int tid) {
    const int lane = tid & 63, wave = tid >> 6;
    const int gw = blockIdx.x * 8 + wave, NGW = gridDim.x * 8;
    for (int m = gw; m < M; m += NGW) norm_row(out + (size_t)m * D, (const bf16_t*)(ws + WS_YB) + (size_t)m * D, sy, g, (bf16_t*)(ws + WS_XN) + (size_t)m * D, out + (size_t)m * D, lane);
}

__device__ __forceinline__ void tail_store(float* out, int g, int h, int kv, int row, int i0, f32x4 a, f32x4 b) {
    float* dst;
    if (row < MP) {
        const int bb = row >> 11, t = row & 2047, keep = 128 << (2 * g), tt = t - (SEQ - keep);
        if (tt < 0) return;
        const size_t base = g == 0 ? O_KP0 : (g == 1 ? O_KP1 : O_KP2);
        dst = out + base + ((((size_t)bb * keep + tt) * 2 + kv) * 8 + h) * 64;
    } else {
        const int s = row - MP; const size_t base = g == 0 ? O_KS0 : (g == 1 ? O_KS1 : O_KS2);
        dst = out + base + (((size_t)s * 2 + kv) * 8 + h) * 64;
    }
    *(f32x4*)(dst + i0) = a; *(f32x4*)(dst + 32 + i0) = b;
}
__device__ __forceinline__ void phase_qknorm(const Params& p, unsigned char* ws, float* out, const int tid) {
    const int lane = tid & 63, wave = tid >> 6;
    const int gw = blockIdx.x * 8 + wave, NGW = gridDim.x * 8;
    bf16_t* QKV = (bf16_t*)(ws + WS_BIG);
    const float* ct = (const float*)(ws + WS_ROPE); const float* st = ct + NPOS * 32;
    const int sub = lane & 7, i0 = 4 * sub;
    for (int it = gw; it < M * 9; it += NGW) {
        const int row = it / 9, s9 = it - row * 9;
        if (s9 < 6) {
            const int head = s9 * 8 + (lane >> 3), isk = head >= 24, gh = isk ? head - 24 : head, g = gh >> 3, h = gh & 7;
            bf16_t* ptr = QKV + (size_t)row * NQKV + head * 64;
            const u32x2 ra = *(const u32x2*)(ptr + i0), rb = *(const u32x2*)(ptr + 32 + i0);
            f32x4 x1 = {bf_lo(ra.x), bf_hi(ra.x), bf_lo(ra.y), bf_hi(ra.y)}, x2 = {bf_lo(rb.x), bf_hi(rb.x), bf_lo(rb.y), bf_hi(rb.y)};
            float ss = (x1.x * x1.x + x1.y * x1.y) + (x1.z * x1.z + x1.w * x1.w) + (x2.x * x2.x + x2.y * x2.y) + (x2.z * x2.z + x2.w * x2.w);
            ss += __shfl_xor(ss, 1); ss += __shfl_xor(ss, 2); ss += __shfl_xor(ss, 4);
            const float r = 1.0f / sqrtf(ss * (1.0f / 64) + EPS);
            const float* gain = p.in[9] + isk * 64;
            const f32x4 g1 = *(const f32x4*)(gain + i0), g2 = *(const f32x4*)(gain + 32 + i0);
            const int pi = row < MP ? (row & 2047) : SEQ + ((row - MP) & 7);
            const f32x4 c = *(const f32x4*)(ct + pi * 32 + i0), s = *(const f32x4*)(st + pi * 32 + i0);
            const f32x4 y1 = x1 * r * g1, y2 = x2 * r * g2;
            const f32x4 o1 = y1 * c - y2 * s, o2 = y2 * c + y1 * s;
            u32x2 wa, wb; wa.x = cvt_pk_bf16(o1.x, o1.y); wa.y = cvt_pk_bf16(o1.z, o1.w); wb.x = cvt_pk_bf16(o2.x, o2.y); wb.y = cvt_pk_bf16(o2.z, o2.w);
            *(u32x2*)(ptr + i0) = wa; *(u32x2*)(ptr + 32 + i0) = wb;
            if (isk) tail_store(out, g, h, 0, row, i0, o1, o2);
        } else {
            const int vh = (s9 - 6) * 8 + (lane >> 3), g = vh >> 3, h = vh & 7;
            const bf16_t* ptr = QKV + (size_t)row * NQKV + 3072 + vh * 64;
            const u32x2 ra = *(const u32x2*)(ptr + i0), rb = *(const u32x2*)(ptr + 32 + i0);
            const f32x4 x1 = {bf_lo(ra.x), bf_hi(ra.x), bf_lo(ra.y), bf_hi(ra.y)}, x2 = {bf_lo(rb.x), bf_hi(rb.x), bf_lo(rb.y), bf_hi(rb.y)};
            tail_store(out, g, h, 1, row, i0, x1, x2);
        }
    }
}

#define MFMA32(a, b, c) __builtin_amdgcn_mfma_f32_32x32x16_bf16((a), (b), (c), 0, 0, 0)
__device__ __forceinline__ s16x4 tr_read(unsigned lds_addr) { return __builtin_amdgcn_ds_read_tr16_b64_v4i16((LAS s16x4*)(uintptr_t)lds_addr); }
__device__ __forceinline__ bf16x8 pack8(const f32x16& x, int s) {
    u32x4 pk;
    pk.x = cvt_pk_bf16(x[8 * s + 0], x[8 * s + 1]); pk.y = cvt_pk_bf16(x[8 * s + 2], x[8 * s + 3]); pk.z = cvt_pk_bf16(x[8 * s + 4], x[8 * s + 5]); pk.w = cvt_pk_bf16(x[8 * s + 6], x[8 * s + 7]);
    return __builtin_bit_cast(bf16x8, pk);
}
__device__ __forceinline__ void attn_prompt_tile(const bf16_t* QKV, bf16_t* OG, float* LSE, LAS unsigned char* vl, int g, int b, int h, int w, int lane) {
    const int dsh = 2 * g, d = 1 << dsh;
    const int tpr_sh = 6 - dsh;
    const int r = w >> tpr_sh, jt = w & ((1 << tpr_sh) - 1), j0 = jt * 32;
    const int q = lane & 31, hh = lane >> 5;
    const size_t rowb = (size_t)b * SEQ;
    const int qcol = g * 512 + h * 64, kcol = 1536 + qcol, vcol = 3072 + qcol;
    const int tq = ((j0 + q) << dsh) + r;
    const bf16_t* qp = QKV + (rowb + tq) * NQKV + qcol + 8 * hh;
    bf16x8 qf[4];
#pragma unroll
    for (int s = 0; s < 4; ++s) qf[s] = *(const bf16x8*)(qp + 16 * s);
    const int kb0 = jt >= 4 ? 0 : 4 - jt;
    f32x16 S[5];
    float mx = -INFINITY;
    bf16x8 kfa[5][4];
#pragma unroll
    for (int kb = 0; kb < 5; ++kb) {
        int jk = j0 - 128 + kb * 32 + q; jk = jk < 0 ? 0 : jk;
        const bf16_t* kp = QKV + (rowb + (size_t)((jk << dsh) + r)) * NQKV + kcol + 8 * hh;
#pragma unroll
        for (int s = 0; s < 4; ++s) kfa[kb][s] = *(const bf16x8*)(kp + 16 * s);
    }
#pragma unroll
    for (int kb = 0; kb < 5; ++kb) {
        f32x16 c;
#pragma unroll
        for (int i = 0; i < 16; ++i) c[i] = 0.f;
#pragma unroll
        for (int s = 0; s < 4; ++s) c = MFMA32(kfa[kb][s], qf[s], c);
#pragma unroll
        for (int i = 0; i < 16; ++i) {
            const int ki = (i & 3) + 8 * (i >> 2) + 4 * hh;
            bool valid = kb >= kb0;
            if (kb == 0) valid = valid && (ki >= q);
            if (kb == 4) valid = valid && (ki <= q);
            const float sv = valid ? c[i] * 0.125f : -INFINITY;
            c[i] = sv; mx = fmaxf(mx, sv);
        }
        S[kb] = c;
    }
    bf16x8 vva[5][4];
#pragma unroll
    for (int kb = 0; kb < 5; ++kb)
#pragma unroll
        for (int c4 = 0; c4 < 4; ++c4) {
            const int i = c4 * 8 + (lane >> 3); int jk = j0 - 128 + kb * 32 + i; jk = jk < 0 ? 0 : jk;
            vva[kb][c4] = *(const bf16x8*)(QKV + (rowb + (size_t)((jk << dsh) + r)) * NQKV + vcol + (lane & 7) * 8);
        }
    mx = fmaxf(mx, __shfl_xor(mx, 32));
    float l = 0.f;
#pragma unroll
    for (int kb = 0; kb < 5; ++kb)
#pragma unroll
        for (int i = 0; i < 16; ++i) { const float e = __expf(S[kb][i] - mx); S[kb][i] = e; l += e; }
    l += __shfl_xor(l, 32);
    const float inv = 1.0f / l;
    f32x16 o0, o1;
#pragma unroll
    for (int i = 0; i < 16; ++i) { o0[i] = 0.f; o1[i] = 0.f; }
    const unsigned vbase = (unsigned)(uintptr_t)vl;
    const unsigned tr_off = (unsigned)((4 * hh + ((lane & 15) >> 2)) * 144 + ((lane >> 4) & 1) * 32 + 8 * (lane & 3));
#pragma unroll
    for (int kb = 0; kb < 5; ++kb) {
        {
#pragma unroll
            for (int c4 = 0; c4 < 4; ++c4) *(LAS bf16x8*)(vl + (c4 * 8 + (lane >> 3)) * 144 + (lane & 7) * 16) = vva[kb][c4];
#pragma unroll
            for (int s2 = 0; s2 < 2; ++s2) {
                f32x16 pn = S[kb];
#pragma unroll
                for (int i = 0; i < 16; ++i) pn[i] *= inv;
                const bf16x8 pb = pack8(pn, s2);
#pragma unroll
                for (int nb = 0; nb < 2; ++nb) {
                    const unsigned a0 = vbase + tr_off + (unsigned)(16 * s2 * 144 + nb * 64);
                    const s16x4 lo = tr_read(a0), hi = tr_read(a0 + 8 * 144);
                    const bf16x8 va = __builtin_shufflevector(lo, hi, 0, 1, 2, 3, 4, 5, 6, 7);
                    if (nb == 0) o0 = MFMA32(va, pb, o0); else o1 = MFMA32(va, pb, o1);
                }
            }
        }
    }
    const size_t orow = (size_t)g * M + rowb + tq;
    bf16_t* op = OG + orow * AW + h * 64 + 4 * hh;
#pragma unroll
    for (int g4 = 0; g4 < 4; ++g4) {
        u32x2 w0, w1;
        w0.x = cvt_pk_bf16(o0[4 * g4], o0[4 * g4 + 1]); w0.y = cvt_pk_bf16(o0[4 * g4 + 2], o0[4 * g4 + 3]);
        w1.x = cvt_pk_bf16(o1[4 * g4], o1[4 * g4 + 1]); w1.y = cvt_pk_bf16(o1[4 * g4 + 2], o1[4 * g4 + 3]);
        *(u32x2*)(op + 8 * g4) = w0; *(u32x2*)(op + 32 + 8 * g4) = w1;
    }
    if (hh == 0) LSE[orow * 8 + h] = mx + __logf(l);
}
__device__ __forceinline__ void attn_sample_item(const Params& p, unsigned char* ws, int item, LAS float* sc, int lane) {
    const int j = item & 7, h = (item >> 3) & 7, gb = item >> 6, g = gb % 3, b = gb / 3;
    const int dsh = 2 * g, L = 128 << dsh;
    const float* cache = (g == 0 ? p.in[2] : (g == 1 ? p.in[3] : p.in[4])) + (size_t)b * L * 1024;
    const bf16_t* QKV = (const bf16_t*)(ws + WS_BIG);
    const int row = MP + b * 8 + j;
    const int sub = lane & 15, ks = lane >> 4;
    const int qcol = g * 512 + h * 64 + 4 * sub;
    const u32x2 qr = *(const u32x2*)(QKV + (size_t)row * NQKV + qcol);
    const f32x4 qv = {bf_lo(qr.x), bf_hi(qr.x), bf_lo(qr.y), bf_hi(qr.y)};
#pragma unroll 11
    for (int it = 0; it < 33; ++it) {
        const int i = it * 4 + ks;
        float dot = 0.f;
        if (i <= 128) {
            const int idx = L + j - (i << dsh);
            f32x4 kv;
            if (idx >= L) { const u32x2 kr = *(const u32x2*)(QKV + (size_t)(MP + b * 8 + (idx - L)) * NQKV + 1536 + qcol); kv = (f32x4){bf_lo(kr.x), bf_hi(kr.x), bf_lo(kr.y), bf_hi(kr.y)}; }
            else kv = *(const f32x4*)(cache + (size_t)idx * 1024 + h * 64 + 4 * sub);
            dot = (qv.x * kv.x + qv.y * kv.y) + (qv.z * kv.z + qv.w * kv.w);
        }
        dot += __shfl_xor(dot, 1); dot += __shfl_xor(dot, 2); dot += __shfl_xor(dot, 4); dot += __shfl_xor(dot, 8);
        if (sub == 0 && i <= 128) sc[i] = dot * 0.125f;
    }
    asm volatile("s_waitcnt lgkmcnt(0)" ::: "memory");
    float mx = fmaxf(sc[lane], sc[lane + 64]); if (lane == 0) mx = fmaxf(mx, sc[128]);
    mx = wave_max(mx);
    float l = __expf(sc[lane] - mx) + __expf(sc[lane + 64] - mx); if (lane == 0) l += __expf(sc[128] - mx);
    l = wave_sum(l);
    const float inv = 1.0f / l;
    f32x4 acc = {0.f, 0.f, 0.f, 0.f};
#pragma unroll 11
    for (int it = 0; it < 33; ++it) {
        const int i = it * 4 + ks;
        if (i <= 128) {
            const float pw = __expf(sc[i] - mx) * inv;
            const int idx = L + j - (i << dsh);
            f32x4 vv;
            if (idx >= L) { const u32x2 vr = *(const u32x2*)(QKV + (size_t)(MP + b * 8 + (idx - L)) * NQKV + 3072 + qcol); vv = (f32x4){bf_lo(vr.x), bf_hi(vr.x), bf_lo(vr.y), bf_hi(vr.y)}; }
            else vv = *(const f32x4*)(cache + (size_t)idx * 1024 + 512 + h * 64 + 4 * sub);
            acc += vv * pw;
        }
    }
#pragma unroll
    for (int k = 0; k < 4; ++k) { acc[k] += __shfl_xor(acc[k], 16); acc[k] += __shfl_xor(acc[k], 32); }
    const size_t orow = (size_t)g * M + row;
    if (ks == 0) { u32x2 w; w.x = cvt_pk_bf16(acc.x, acc.y); w.y = cvt_pk_bf16(acc.z, acc.w); *(u32x2*)((bf16_t*)(ws + WS_OG) + orow * AW + h * 64 + 4 * sub) = w; }
    if (lane == 0) ((float*)(ws + WS_LSE))[orow * 8 + h] = mx + __logf(l);
    asm volatile("s_waitcnt lgkmcnt(0)" ::: "memory");
}
__device__ __forceinline__ void phase_attn(const Params& p, unsigned char* ws, LAS unsigned char* lds, const int tid) {
    const int lane = tid & 63, wave = __builtin_amdgcn_readfirstlane(tid >> 6);
    LAS unsigned char* vl = lds + wave * 4608;
    constexpr int NS = 768, NP = 3072;
    for (int bi = blockIdx.x; bi < NS + NP; bi += gridDim.x) {
        if (bi < NS) attn_sample_item(p, ws, bi * 8 + wave, (LAS float*)vl, lane);
        else {
            const int x = bi - NS, w8 = x & 7, h = (x >> 3) & 7, b = (x >> 6) & 15, g = x >> 10;
            attn_prompt_tile((const bf16_t*)(ws + WS_BIG), (bf16_t*)(ws + WS_OG), (float*)(ws + WS_LSE), vl, g, b, h, w8 * 8 + wave, lane);
        }
    }
}
__device__ __forceinline__ void phase_merge(unsigned char* ws, const int tid) {
    const bf16_t* OG = (const bf16_t*)(ws + WS_OG); const float* LSE = (const float*)(ws + WS_LSE); bf16_t* AO = (bf16_t*)(ws + WS_AO);
    for (int e = blockIdx.x * 512 + tid; e < M * 64; e += gridDim.x * 512) {
        const int rh = e >> 3, c8 = e & 7;
        const float l0 = LSE[rh], l1 = LSE[(size_t)M * 8 + rh], l2 = LSE[(size_t)2 * M * 8 + rh];
        const float mx = fmaxf(l0, fmaxf(l1, l2));
        float w0 = __expf(l0 - mx), w1 = __expf(l1 - mx), w2 = __expf(l2 - mx); const float inv = 1.0f / (w0 + w1 + w2); w0 *= inv; w1 *= inv; w2 *= inv;
        const size_t off = (size_t)rh * 64 + c8 * 8;
        const u32x4 a = *(const u32x4*)(OG + off), b = *(const u32x4*)(OG + (size_t)M * AW + off), c = *(const u32x4*)(OG + (size_t)2 * M * AW + off);
        u32x4 o;
#pragma unroll
        for (int k = 0; k < 4; ++k) o[k] = cvt_pk_bf16(w0 * bf_lo(a[k]) + w1 * bf_lo(b[k]) + w2 * bf_lo(c[k]), w0 * bf_hi(a[k]) + w1 * bf_hi(b[k]) + w2 * bf_hi(c[k]));
        *(u32x4*)(AO + off) = o;
    }
}

__device__ __forceinline__ void phase_vnorm(const Params& p, unsigned char* ws, float* out, const int tid) {
    const int lane = tid & 63, wave = tid >> 6;
    const int gw = blockIdx.x * 8 + wave, NGW = gridDim.x * 8;
    const bf16_t* UV = (const bf16_t*)(ws + WS_BIG); float* RV = (float*)(ws + WS_RV);
    for (int m = gw; m < M; m += NGW) {
        const u32x4* vr = (const u32x4*)(UV + (size_t)m * NUV + BW) + lane;
        u32x4 v[4]; float ss = 0.f;
#pragma unroll
        for (int j = 0; j < 4; ++j) { v[j] = vr[64 * j];
#pragma unroll
            for (int k = 0; k < 4; ++k) { const float a = bf_lo(v[j][k]), b = bf_hi(v[j][k]); ss += a * a + b * b; } }
        const float r = 1.0f / sqrtf(wave_sum(ss) * (1.0f / BW) + EPS);
        if (lane == 0) RV[m] = r;
        if (m >= MP) {
            float* dst = out + O_VS + (size_t)(m - MP) * BW;
#pragma unroll
            for (int j = 0; j < 4; ++j) { const int c0 = 8 * (lane + 64 * j); const f32x4 ga = *(const f32x4*)(p.in[12] + c0), gb = *(const f32x4*)(p.in[12] + c0 + 4);
                *(f32x4*)(dst + c0) = (f32x4){bf_lo(v[j][0]) * r * ga.x, bf_hi(v[j][0]) * r * ga.y, bf_lo(v[j][1]) * r * ga.z, bf_hi(v[j][1]) * r * ga.w};
                *(f32x4*)(dst + c0 + 4) = (f32x4){bf_lo(v[j][2]) * r * gb.x, bf_hi(v[j][2]) * r * gb.y, bf_lo(v[j][3]) * r * gb.z, bf_hi(v[j][3]) * r * gb.w}; }
        }
    }
}
__device__ __forceinline__ void spatial_tile(const Params& p, unsigned char* ws, LAS unsigned char* vl, int chunk, int gi, int tb, int ch, int lane) {
    const bf16_t* UV = (const bf16_t*)(ws + WS_BIG); const float* RV = (const float*)(ws + WS_RV); bf16_t* UM = (bf16_t*)(ws + WS_UM);
    const bf16_t* WSP = (const bf16_t*)(ws + WS_WSP);
    const int hh = lane >> 5;
    const int colb = gi * 128 + 64 * ch;
    const f32x4 ga = *(const f32x4*)(p.in[12] + colb + (lane & 7) * 8), gb = *(const f32x4*)(p.in[12] + colb + (lane & 7) * 8 + 4);
    f32x16 a0, a1;
#pragma unroll
    for (int i = 0; i < 16; ++i) { a0[i] = 0.f; a1[i] = 0.f; }
    const int t = 32 * tb + (lane & 31);
    const bf16_t* wp = WSP + ((size_t)gi * 128 + t) * 128 + 8 * hh;
    const unsigned vbase = (unsigned)(uintptr_t)vl;
    const unsigned tr_off = (unsigned)((8 * hh + ((lane & 15) >> 2)) * 144 + ((lane >> 4) & 1) * 32 + 8 * (lane & 3));
    bf16x8 wfa[8];
#pragma unroll
    for (int ks = 0; ks < 8; ++ks) wfa[ks] = *(const bf16x8*)(wp + 16 * ks);
    u32x4 rawa[4][4]; float rva[4][4];
#pragma unroll
    for (int sb = 0; sb < 4; ++sb)
#pragma unroll
        for (int c4 = 0; c4 < 4; ++c4) {
            const int srow = chunk * 128 + 32 * sb + c4 * 8 + (lane >> 3);
            rawa[sb][c4] = *(const u32x4*)(UV + (size_t)srow * NUV + BW + colb + (lane & 7) * 8);
            rva[sb][c4] = RV[srow];
        }
#pragma unroll
    for (int sb = 0; sb < 4; ++sb) {
        if (sb <= tb) {
        u32x4 raw[4]; float rv[4];
#pragma unroll
        for (int c4 = 0; c4 < 4; ++c4) { raw[c4] = rawa[sb][c4]; rv[c4] = rva[sb][c4]; }
#pragma unroll
        for (int c4 = 0; c4 < 4; ++c4) {
            const float r = rv[c4]; u32x4 o;
            o.x = cvt_pk_bf16(bf_lo(raw[c4].x) * r * ga.x, bf_hi(raw[c4].x) * r * ga.y); o.y = cvt_pk_bf16(bf_lo(raw[c4].y) * r * ga.z, bf_hi(raw[c4].y) * r * ga.w);
            o.z = cvt_pk_bf16(bf_lo(raw[c4].z) * r * gb.x, bf_hi(raw[c4].z) * r * gb.y); o.w = cvt_pk_bf16(bf_lo(raw[c4].w) * r * gb.z, bf_hi(raw[c4].w) * r * gb.w);
            *(LAS u32x4*)(vl + (c4 * 8 + (lane >> 3)) * 144 + (lane & 7) * 16) = o;
        }
#pragma unroll
        for (int s2 = 0; s2 < 2; ++s2) {
            const bf16x8 wf = wfa[2 * sb + s2];
#pragma unroll
            for (int cb = 0; cb < 2; ++cb) {
                const unsigned a = vbase + tr_off + (unsigned)(16 * s2 * 144 + cb * 64);
                const s16x4 lo = tr_read(a), hi = tr_read(a + 4 * 144);
                const bf16x8 va = __builtin_shufflevector(lo, hi, 0, 1, 2, 3, 4, 5, 6, 7);
                if (cb == 0) a0 = MFMA32(va, wf, a0); else a1 = MFMA32(va, wf, a1);
            }
        }
        }
    }
    const size_t row = (size_t)chunk * 128 + t;
    const float bias = p.in[14][gi * 128 + t];
    const bf16_t* up = UV + row * NUV + colb + 4 * hh;
    bf16_t* op = UM + row * LDU + colb + 4 * hh;
#pragma unroll
    for (int cb = 0; cb < 2; ++cb)
#pragma unroll
        for (int g4 = 0; g4 < 4; ++g4) {
            const u32x2 ur = *(const u32x2*)(up + 32 * cb + 8 * g4);
            const f32x16& a = cb == 0 ? a0 : a1;
            u32x2 w;
            w.x = cvt_pk_bf16(bf_lo(ur.x) * (a[4 * g4] + bias), bf_hi(ur.x) * (a[4 * g4 + 1] + bias));
            w.y = cvt_pk_bf16(bf_lo(ur.y) * (a[4 * g4 + 2] + bias), bf_hi(ur.y) * (a[4 * g4 + 3] + bias));
            *(u32x2*)(op + 32 * cb + 8 * g4) = w;
        }
}
__device__ __forceinline__ void phase_spatial(const Params& p, unsigned char* ws, LAS unsigned char* lds, const int tid) {
    const int lane = tid & 63, wave = __builtin_amdgcn_readfirstlane(tid >> 6);
    const bf16_t* UV = (const bf16_t*)(ws + WS_BIG); const float* RV = (const float*)(ws + WS_RV); bf16_t* UM = (bf16_t*)(ws + WS_UM);
    const float* vgain = p.in[12]; const float* bsp = p.in[14];
    constexpr int NPI = 256 * 16, NSI = 256;
    LAS unsigned char* vl = lds + wave * 4608;
    for (int it = blockIdx.x; it < NPI + NSI; it += gridDim.x) {
        if (it < NPI) spatial_tile(p, ws, vl, it >> 4, it & 15, wave & 3, wave >> 2, lane);
        else {
            const int e = (it - NPI) * 512 + tid;
            const int c4 = e & 511, bt = e >> 9, t = bt & 7, b = bt >> 3, c0 = 4 * c4, gi = c0 >> 7;
            f32x4 acc = {0.f, 0.f, 0.f, 0.f};
            const f32x4 vg = *(const f32x4*)(vgain + c0);
            for (int s = 0; s <= t; ++s) {
                const size_t r = (size_t)MP + b * 8 + s;
                const u32x2 vr = *(const u32x2*)(UV + r * NUV + BW + c0);
                const float wv = p.in[13][((size_t)gi * 128 + t) * 128 + s] * RV[r];
                acc += (f32x4){bf_lo(vr.x), bf_hi(vr.x), bf_lo(vr.y), bf_hi(vr.y)} * wv;
            }
            const float bias = bsp[gi * 128 + t];
            const size_t r = (size_t)MP + b * 8 + t;
            const u32x2 ur = *(const u32x2*)(UV + r * NUV + c0);
            u32x2 w;
            w.x = cvt_pk_bf16(bf_lo(ur.x) * (acc.x * vg.x + bias), bf_hi(ur.x) * (acc.y * vg.y + bias));
            w.y = cvt_pk_bf16(bf_lo(ur.y) * (acc.z * vg.z + bias), bf_hi(ur.y) * (acc.w * vg.w + bias));
            *(u32x2*)(UM + r * LDU + c0) = w;
        }
    }
}

__device__ __forceinline__ void grid_barrier(unsigned* ctr, const unsigned nblocks, const int tid) {
    asm volatile("s_waitcnt vmcnt(0) lgkmcnt(0)" ::: "memory");
    __syncthreads();
    if (tid == 0) {
        __builtin_amdgcn_fence(__ATOMIC_RELEASE, "agent");
        asm volatile("s_waitcnt vmcnt(0)" ::: "memory");
        __hip_atomic_fetch_add(ctr, 1u, __ATOMIC_RELAXED, __HIP_MEMORY_SCOPE_AGENT);
        while (__hip_atomic_load(ctr, __ATOMIC_RELAXED, __HIP_MEMORY_SCOPE_AGENT) < nblocks) __builtin_amdgcn_s_sleep(1);
        __builtin_amdgcn_fence(__ATOMIC_ACQUIRE, "agent");
        asm volatile("s_waitcnt vmcnt(0)" ::: "memory");
    }
    __syncthreads();
}

__global__ void __launch_bounds__(512, 2) mega(Params p) {
    extern __shared__ __attribute__((aligned(16))) unsigned char lds_raw[];
    LAS unsigned char* lds = (LAS unsigned char*)lds_raw;
    for (int ph = p.ph_lo; ph < p.ph_hi; ++ph) {
        int tid = threadIdx.x; asm volatile("" : "+v"(tid));
        unsigned z; asm volatile("s_mov_b32 %0, 0" : "=s"(z));
        unsigned char* ws = p.ws + z; float* out = p.out + z;
        bf16_t* XN = (bf16_t*)(ws + WS_XN); bf16_t* BIG = (bf16_t*)(ws + WS_BIG);
        bf16_t* YB = (bf16_t*)(ws + WS_YB);
        int fi = -1, fo = -1, ni = -1; float sy = 0.5f;
        switch (ph) {
            case 1: fi = 0; break; case 10: fi = 1; break; case 13: fi = 2; break; case 21: fi = 3; break;
            case 2: fo = 0; break; case 11: fo = 1; break; case 14: fo = 2; break; case 22: fo = 3; break;
            case 3: ni = 1; break; case 9: ni = 2; sy = 1.0f; break; case 12: ni = 3; break; case 15: ni = 4; break; case 20: ni = 5; sy = 1.0f; break; case 23: ni = 6; break;
            default: break;
        }
#ifndef PMASK
#define PMASK 0xFFFF
#endif
        if ((PMASK & 1) && ph == 0) phase_prologue(p, ws, out, lds, tid);
        else if ((PMASK & 2) && fi >= 0) { const bf16_t* W = (const bf16_t*)(ws + WS_WIN + fi * SZ_WIN); sample_gemm<2>(lds, XN + (size_t)MP * D, D, W, D, D, FF, BIG + (size_t)MP * FF, FF, tid);
            pg8::EpiSwiglu E{BIG}; pg8::gemm_phase(lds, XN, W, MP, 2 * FF, D, E, tid); }
        else if ((PMASK & 4) && (fo >= 0 || ph == 8 || ph == 19)) {
            const bf16_t* A = BIG; const bf16_t* B = (const bf16_t*)(ws + WS_WOUT + (fo < 0 ? 0 : fo) * SZ_WOUT); int K = FF, ld = FF;
            if (ph == 8) { A = (const bf16_t*)(ws + WS_AO); B = (const bf16_t*)(ws + WS_WOA); K = AW; ld = AW; }
            if (ph == 19) { A = (const bf16_t*)(ws + WS_UM); B = (const bf16_t*)(ws + WS_WOB); K = BW; ld = LDU; }
            sample_gemm<0>(lds, A + (size_t)MP * ld, ld, B, ld, K, D, YB + (size_t)MP * D, D, tid);
            pg8::EpiBf16<0> E{YB, D}; pg8::gemm_phase(lds, A, B, MP, D, K, E, tid, ld, ld); }
#ifdef DUMPSEL
        else if (ph == 20) {
            const bf16_t* wsp = (const bf16_t*)(ws + WS_WSP); const float* rvp = (const float*)(ws + WS_RV);
            for (size_t e = (size_t)blockIdx.x * 512 + tid; e < (size_t)M * D; e += (size_t)gridDim.x * 512) { const size_t r = e / D, c = e % D;
                out[e] = (DUMPSEL == 10) ? p.in[12][(c + r) % 2048] * p.in[14][(c * 3 + r) % 2048] * (1.0f + p.in[13][(r * 1024 + c) % 262144]) : (DUMPSEL == 2) ? (r >= (size_t)MP ? 0.f : 1.f) * __uint_as_float((unsigned)((const bf16_t*)(ws + WS_UM))[r * LDU + c] << 16) : (DUMPSEL == 8) ? (r < 256 ? __uint_as_float((unsigned)wsp[r * 1024 + c] << 16) : 0.f) : rvp[r]; }
        }
#endif
        else if ((PMASK & 8) && ni >= 0) phase_norm(ws, out, ni < 6 ? p.in[5] + ni * D : nullptr, sy, tid);
        else if ((PMASK & 16) && ph == 4) { sample_gemm<0>(lds, XN + (size_t)MP * D, D, (const bf16_t*)(ws + WS_WQKV), D, D, NQKV, BIG + (size_t)MP * NQKV, NQKV, tid);
            pg8::EpiBf16<0> E{BIG, NQKV}; pg8::gemm_phase(lds, XN, (const bf16_t*)(ws + WS_WQKV), MP, NQKV, D, E, tid); }
        else if ((PMASK & 32) && ph == 5) phase_qknorm(p, ws, out, tid);
        else if ((PMASK & 64) && ph == 6) phase_attn(p, ws, lds, tid);
        else if ((PMASK & 128) && ph == 7) phase_merge(ws, tid);
        else if ((PMASK & 512) && ph == 16) { sample_gemm<1>(lds, XN + (size_t)MP * D, D, (const bf16_t*)(ws + WS_WUV), D, D, NUV, BIG + (size_t)MP * NUV, NUV, tid);
            pg8::EpiBf16<1> E{BIG, NUV}; pg8::gemm_phase(lds, XN, (const bf16_t*)(ws + WS_WUV), MP, NUV, D, E, tid); }
        else if ((PMASK & 1024) && ph == 17) phase_vnorm(p, ws, out, tid);
        else if ((PMASK & 2048) && ph == 18) phase_spatial(p, ws, lds, tid);
        if (ph + 1 < p.ph_hi) { __syncthreads(); cg::this_grid().sync(); }
    }
}

extern "C" void kernel_launch(void* const* d_in, const int* in_sizes, int n_in, void* d_out, int out_size, void* d_ws, size_t ws_size, hipStream_t stream) {
    static int grid = 0;
    if (grid == 0) {
        if (n_in != 16 || ws_size < WS_END) { fprintf(stderr, "kernel_launch: unexpected inputs (n_in %d, ws %zu < %zu)\n", n_in, ws_size, (size_t)WS_END); grid = -1; return; }
        int dev = 0, cus = 0, per_cu = 0;
        (void)hipGetDevice(&dev);
        (void)hipDeviceGetAttribute(&cus, hipDeviceAttributeMultiprocessorCount, dev);
        if (hipFuncSetAttribute((const void*)mega, hipFuncAttributeMaxDynamicSharedMemorySize, LDS_BYTES) != hipSuccess) { fprintf(stderr, "kernel_launch: hipFuncSetAttribute failed\n"); grid = -1; return; }
        if (hipOccupancyMaxActiveBlocksPerMultiprocessor(&per_cu, (const void*)mega, 512, LDS_BYTES) != hipSuccess || per_cu < 1) { fprintf(stderr, "kernel_launch: occupancy query says %d\n", per_cu); per_cu = 1; }
        (void)hipGetLastError();
        grid = cus * 1;
    }
    if (grid < 0) return;
    if (hipMemsetAsync(d_ws, 0, 16384, stream) != hipSuccess) { fprintf(stderr, "kernel_launch: memset failed\n"); return; }
    Params p{};
    for (int i = 0; i < 16; ++i) p.in[i] = (const float*)d_in[i];
    p.out = (float*)d_out; p.ws = (unsigned char*)d_ws;
#if ONE_LAUNCH
    p.ph_lo = 0; p.ph_hi = NPHASE;
    void* args[] = {&p};
    hipError_t e = hipLaunchCooperativeKernel((const void*)mega, dim3(grid), dim3(512), args, LDS_BYTES, stream);
    if (e != hipSuccess) fprintf(stderr, "cooperative launch failed: %s (grid %d)\n", hipGetErrorString(e), grid);
#else
    for (int ph = 0; ph < NPHASE; ++ph) {
        p.ph_lo = ph; p.ph_hi = ph + 1;
        hipLaunchKernelGGL(mega, dim3(grid), dim3(512), LDS_BYTES, stream, p);
    }
#endif
}
```

```cpp
#include <hip/hip_runtime.h>
#include <hip/hip_cooperative_groups.h>
#include <cstdio>
#include <cstdint>
namespace cg = cooperative_groups;

#ifndef ONE_LAUNCH
#define ONE_LAUNCH 1
#endif

#define LAS __attribute__((address_space(3)))
typedef unsigned short bf16_t;
typedef short bf16x8 __attribute__((ext_vector_type(8)));
typedef short s16x4 __attribute__((ext_vector_type(4)));
typedef float f32x2 __attribute__((ext_vector_type(2)));
typedef float f32x4 __attribute__((ext_vector_type(4)));
typedef float f32x16 __attribute__((ext_vector_type(16)));
typedef unsigned u32x2 __attribute__((ext_vector_type(2)));
typedef unsigned u32x4 __attribute__((ext_vector_type(4)));

constexpr int D = 1024, SEQ = 2048, NBATCH = 16, MP = NBATCH * SEQ, MS = 256, M = MP + MS;
constexpr int FF = 2816, NQKV = 4608, AW = 512, BW = 2048, NUV = 4096, PAST = 16384;
constexpr float EPS = 1e-6f;
constexpr int LDU = BW + 64;
constexpr int NPOS = SEQ + 8;
constexpr size_t O_YP = 0, O_YS = (size_t)MP * D, O_KP0 = O_YS + (size_t)MS * D, O_KP1 = O_KP0 + 2097152, O_KP2 = O_KP1 + 8388608,
                 O_KS0 = O_KP2 + 33554432, O_KS1 = O_KS0 + 262144, O_KS2 = O_KS1 + 262144, O_VS = O_KS2 + 262144;
constexpr size_t al256(size_t x) { return (x + 255) & ~(size_t)255; }
constexpr size_t WS_WIN = 1u << 20;
constexpr size_t SZ_WIN = (size_t)2 * FF * D * 2;
constexpr size_t WS_WOUT = WS_WIN + 4 * SZ_WIN;
constexpr size_t SZ_WOUT = (size_t)D * FF * 2;
constexpr size_t WS_WQKV = WS_WOUT + 4 * SZ_WOUT;
constexpr size_t WS_WOA = WS_WQKV + (size_t)NQKV * D * 2;
constexpr size_t WS_WUV = WS_WOA + (size_t)D * AW * 2;
constexpr size_t WS_WOB = WS_WUV + (size_t)NUV * D * 2;
constexpr size_t WS_WSP = WS_WOB + (size_t)D * LDU * 2;
constexpr size_t WS_ROPE = WS_WSP + (size_t)16 * 128 * 128 * 2;
constexpr size_t WS_XN = al256(WS_ROPE + (size_t)NPOS * 32 * 4 * 2);
constexpr size_t WS_BIG = al256(WS_XN + (size_t)M * D * 2);
constexpr size_t WS_OG = al256(WS_BIG + (size_t)M * NQKV * 2);
constexpr size_t WS_LSE = al256(WS_OG + (size_t)3 * M * AW * 2);
constexpr size_t WS_AO = al256(WS_LSE + (size_t)3 * M * 8 * 4);
constexpr size_t WS_UM = al256(WS_AO + (size_t)M * AW * 2);
constexpr size_t WS_RV = al256(WS_UM + (size_t)M * LDU * 2);
constexpr size_t WS_YB = al256(WS_RV + (size_t)M * 4);
constexpr size_t WS_END = al256(WS_YB + (size_t)M * D * 2);

constexpr int LDS_BYTES = 139264;
#ifdef DUMPSEL
constexpr int NPHASE = 21;
#else
constexpr int NPHASE = 23;
#endif

__device__ __forceinline__ float wave_sum(float v) {
#pragma unroll
    for (int o = 1; o < 64; o <<= 1) v += __shfl_xor(v, o);
    return v;
}
__device__ __forceinline__ float wave_max(float v) {
#pragma unroll
    for (int o = 1; o < 64; o <<= 1) v = fmaxf(v, __shfl_xor(v, o));
    return v;
}
typedef __bf16 bf16x2_t __attribute__((ext_vector_type(2)));
__device__ __forceinline__ unsigned cvt_pk_bf16(float lo, float hi) { const f32x2 v = {lo, hi}; return __builtin_bit_cast(unsigned, __builtin_convertvector(v, bf16x2_t)); }
__device__ __forceinline__ float bf_lo(unsigned w) { return __uint_as_float(w << 16); }
__device__ __forceinline__ float bf_hi(unsigned w) { return __uint_as_float(w & 0xffff0000u); }
__device__ __forceinline__ float silu_f(float x) { return x * __builtin_amdgcn_rcpf(1.0f + __expf(-x)); }
__device__ __forceinline__ float gelu_tanh_f(float x) { const float y = 0.7978845608028654f * (x + 0.044715f * x * x * x); return x * __builtin_amdgcn_rcpf(1.0f + __expf(-2.0f * y)); }

namespace pg8 {
constexpr int BM = 256, BK = 64, HALF = 128, HTB = HALF * BK * 2, STAGE_BYTES = 8 * HTB, NXCD = 8, WGM = 8;
__device__ __forceinline__ int lds_byte(int r, int c) { const int st = (r >> 4) * 2 + (c >> 5), rr = r & 15, cc = c & 31, ob = rr * 64 + cc * 2; return st * 1024 + (ob ^ (((ob >> 9) & 1) << 5)); }
__device__ __forceinline__ void stage_rc(int b, int& R, int& C) { const int st = b / 1024, sb = b % 1024, swz = sb ^ (((sb >> 9) & 1) << 5); R = (st >> 1) * 16 + swz / 64; C = (st & 1) * 32 + (swz % 64) / 2; }
__device__ __forceinline__ int perm32(int rho) { const int n = rho >> 4, i = rho & 15; return 8 * (i >> 2) + 4 * n + (i & 3); }
struct Unit { int pm, pn; };
struct StaticOrder {
    int nM, nN, nwg, G, c;
    __device__ void init(int M_, int N_, int G_, int c_) { nM = M_ / BM; nN = N_ / BM; nwg = nM * nN; G = G_; c = c_; }
    __device__ bool next(int i, Unit& u) const {
        const long L = (long)i * G + c; if (L >= nwg) return false;
        int wgid = (int)L; { const int q = nwg / NXCD, r = nwg % NXCD, xcd = wgid % NXCD, off = wgid / NXCD; wgid = (xcd < r ? xcd * (q + 1) : r * (q + 1) + (xcd - r) * q) + off; }
        const int nig = WGM * nN, gid = wgid / nig, fm = gid * WGM, gsz = (nM - fm) < WGM ? (nM - fm) : WGM;
        u.pm = fm + ((wgid % nig) % gsz); u.pn = (wgid % nig) / gsz; return true;
    }
};
template <class Epi>
__device__ __forceinline__ void gemm_phase(LAS unsigned char* lds, const bf16_t* gA, const bf16_t* gBt, int gM, int gN, int K, const Epi& E, const int tid, const int lda = 0, const int ldb = 0) {
    const int LA = lda ? lda : K, LB = ldb ? ldb : K;
    const int wid = __builtin_amdgcn_readfirstlane(tid >> 6), lane = tid & 63, wr = wid >> 2, wc = wid & 3, fr = lane & 15, fq = lane >> 4;
    const int nt = K / BK;
    StaticOrder S; S.init(gM, gN, (int)gridDim.x, (int)blockIdx.x);
    unsigned voffA[2], voffB[2];
#pragma unroll
    for (int i = 0; i < 2; ++i) { int R, C; stage_rc(tid * 16 + i * 8192, R, C); const int Rb = Epi::PERM ? ((R & ~31) + perm32(R & 31)) : R;
        voffA[i] = (unsigned)(R * LA + C) * 2u; voffB[i] = (unsigned)(Rb * LB + C) * 2u; }
    const size_t kstep = (size_t)(BK * 2);
    const size_t hstepA = (size_t)HALF * LA * 2, hstepB = (size_t)HALF * LB * 2;
    const size_t tstepA = 2 * hstepA, tstepB = 2 * hstepB;
    const unsigned ldsw = (unsigned)wid * 1024u;
    const int aoff = lds_byte(wr * 64 + fr, fq * 8), boff = lds_byte(wc * 32 + fr, fq * 8);
#define PG8_SA(b, h) (((b) * 2 + (h)) * HTB)
#define PG8_SB(b, h) ((4 + (b) * 2 + (h)) * HTB)
#define PG8_STAGE(bufoff, gbase, voff) do { _Pragma("unroll") for (int _i = 0; _i < 2; ++_i) \
        __builtin_amdgcn_global_load_lds((const unsigned*)((const char*)(gbase) + (voff)[_i]), (LAS unsigned*)(lds + (bufoff) + ldsw + _i * 8192), 16, 0, 0); } while (0)
#define PG8_LDA(dst, b, h) do { _Pragma("unroll") for (int m = 0; m < 4; ++m) _Pragma("unroll") for (int k = 0; k < 2; ++k) dst[m][k] = *(const LAS bf16x8*)(lds + PG8_SA(b, h) + aoff + m * 2048 + k * 1024); } while (0)
#define PG8_LDB(dst, b, h) do { _Pragma("unroll") for (int n = 0; n < 2; ++n) _Pragma("unroll") for (int k = 0; k < 2; ++k) dst[n][k] = *(const LAS bf16x8*)(lds + PG8_SB(b, h) + boff + n * 2048 + k * 1024); } while (0)
#define PG8_MMA(ai, bj, At, Bt) do { __builtin_amdgcn_s_setprio(1); _Pragma("unroll") for (int m = 0; m < 4; ++m) _Pragma("unroll") for (int n = 0; n < 2; ++n) _Pragma("unroll") for (int k = 0; k < 2; ++k) \
        acc[ai][bj][m][n] = __builtin_amdgcn_mfma_f32_16x16x32_bf16(Bt[n][k], At[m][k], acc[ai][bj][m][n], 0, 0, 0); __builtin_amdgcn_s_setprio(0); } while (0)
#define PG8_WAIT_V(n) asm volatile("s_waitcnt vmcnt(" #n ")" ::: "memory")
#define PG8_WAIT_L(n) asm volatile("s_waitcnt lgkmcnt(" #n ")" ::: "memory")
#define PG8_BAR __builtin_amdgcn_s_barrier()
#define PG8_SCHED __builtin_amdgcn_sched_barrier(0)
    Unit cur, nxt; int ui = 0;
    if (!S.next(0, cur)) return;
    f32x4 acc[2][2][4][2];
#pragma unroll
    for (int a = 0; a < 2; ++a)
#pragma unroll
        for (int b = 0; b < 2; ++b)
#pragma unroll
            for (int m = 0; m < 4; ++m)
#pragma unroll
                for (int n = 0; n < 2; ++n) acc[a][b][m][n] = (f32x4){0.f, 0.f, 0.f, 0.f};
    bf16x8 At[4][2], B0[2][2], B1[2][2];
    const char* cA = (const char*)gA + (size_t)cur.pm * tstepA; const char* cB = (const char*)gBt + (size_t)cur.pn * tstepB;
    PG8_STAGE(PG8_SB(0, 0), cB, voffB); PG8_STAGE(PG8_SA(0, 0), cA, voffA); PG8_STAGE(PG8_SB(0, 1), cB + hstepB, voffB); PG8_STAGE(PG8_SA(0, 1), cA + hstepA, voffA);
    if (wr == 1) PG8_BAR;
    PG8_WAIT_V(4); PG8_BAR;
    PG8_STAGE(PG8_SB(1, 0), cB + kstep, voffB); PG8_STAGE(PG8_SA(1, 0), cA + kstep, voffA); PG8_STAGE(PG8_SB(1, 1), cB + hstepB + kstep, voffB);
    PG8_WAIT_V(6); PG8_BAR;
    for (;;) {
        const bool has_next = S.next(ui + 1, nxt);
        const char* nA = has_next ? (const char*)gA + (size_t)nxt.pm * tstepA : cA; const char* nB = has_next ? (const char*)gBt + (size_t)nxt.pn * tstepB : cB;
        for (int t = 0; t < nt; t += 2) {
            const bool last = (t == nt - 2);
            const char* a1 = cA + (size_t)(t + 1) * kstep;
            const char* a2 = last ? nA : cA + (size_t)(t + 2) * kstep; const char* b2 = last ? nB : cB + (size_t)(t + 2) * kstep;
            const char* a3 = a2 + kstep; const char* b3 = b2 + kstep;
            PG8_LDB(B0, 0, 0); PG8_SCHED; PG8_LDA(At, 0, 0); PG8_STAGE(PG8_SA(1, 1), a1 + hstepA, voffA);
            PG8_WAIT_L(8); PG8_BAR; PG8_WAIT_L(0); PG8_MMA(0, 0, At, B0); PG8_BAR; PG8_SCHED;
            PG8_LDB(B1, 0, 1); PG8_STAGE(PG8_SB(0, 0), b2, voffB);
            PG8_BAR; PG8_WAIT_L(0); PG8_MMA(0, 1, At, B1); PG8_BAR;
            PG8_LDA(At, 0, 1); PG8_STAGE(PG8_SA(0, 0), a2, voffA);
            PG8_BAR; PG8_WAIT_L(0); PG8_MMA(1, 0, At, B0); PG8_BAR; PG8_SCHED;
            PG8_STAGE(PG8_SB(0, 1), b2 + hstepB, voffB);
            PG8_WAIT_V(6); PG8_BAR; PG8_MMA(1, 1, At, B1); PG8_BAR;
            PG8_LDB(B0, 1, 0); PG8_SCHED; PG8_LDA(At, 1, 0); PG8_STAGE(PG8_SA(0, 1), a2 + hstepA, voffA);
            PG8_WAIT_L(8); PG8_BAR; PG8_WAIT_L(0); PG8_MMA(0, 0, At, B0); PG8_BAR; PG8_SCHED;
            PG8_LDB(B1, 1, 1); PG8_STAGE(PG8_SB(1, 0), b3, voffB);
            PG8_BAR; PG8_WAIT_L(0); PG8_MMA(0, 1, At, B1); PG8_BAR;
            PG8_LDA(At, 1, 1); PG8_STAGE(PG8_SA(1, 0), a3, voffA);
            PG8_BAR; PG8_WAIT_L(0); PG8_MMA(1, 0, At, B0); PG8_BAR; PG8_SCHED;
            PG8_STAGE(PG8_SB(1, 1), b3 + hstepB, voffB);
            PG8_WAIT_V(6); PG8_BAR; PG8_MMA(1, 1, At, B1); PG8_BAR;
        }
        E(acc, cur, wr, wc, fr, fq);
        if (!has_next) break;
#pragma unroll
        for (int a = 0; a < 2; ++a)
#pragma unroll
            for (int b = 0; b < 2; ++b)
#pragma unroll
                for (int m = 0; m < 4; ++m)
#pragma unroll
                    for (int n = 0; n < 2; ++n) acc[a][b][m][n] = (f32x4){0.f, 0.f, 0.f, 0.f};
        cur = nxt; cA = nA; cB = nB; ++ui;
    }
    PG8_WAIT_V(0);
    if (wr == 0) PG8_BAR;
    PG8_BAR;
#undef PG8_SA
#undef PG8_SB
#undef PG8_STAGE
#undef PG8_LDA
#undef PG8_LDB
#undef PG8_MMA
#undef PG8_WAIT_V
#undef PG8_WAIT_L
#undef PG8_BAR
#undef PG8_SCHED
}

struct EpiSwiglu {
    static constexpr bool PERM = true;
    bf16_t* O;
    __device__ __forceinline__ void operator()(const f32x4 (&acc)[2][2][4][2], const Unit& u, int wr, int wc, int fr, int fq) const {
        const int row0 = u.pm * BM + wr * 64 + fr, col0 = u.pn * HALF + wc * 32 + 8 * fq;
#pragma unroll
        for (int ai = 0; ai < 2; ++ai)
#pragma unroll
            for (int m = 0; m < 4; ++m) {
                const f32x4 g0 = acc[ai][0][m][0], g1 = acc[ai][0][m][1], u0 = acc[ai][1][m][0], u1 = acc[ai][1][m][1];
                u32x4 w;
                w.x = cvt_pk_bf16(silu_f(g0[0]) * u0[0], silu_f(g0[1]) * u0[1]); w.y = cvt_pk_bf16(silu_f(g0[2]) * u0[2], silu_f(g0[3]) * u0[3]);
                w.z = cvt_pk_bf16(silu_f(g1[0]) * u1[0], silu_f(g1[1]) * u1[1]); w.w = cvt_pk_bf16(silu_f(g1[2]) * u1[2], silu_f(g1[3]) * u1[3]);
                *(u32x4*)(O + (size_t)(row0 + ai * HALF + m * 16) * FF + col0) = w;
            }
    }
};
struct EpiResid {
    static constexpr bool PERM = false;
    float* X; float s;
    __device__ __forceinline__ void operator()(const f32x4 (&acc)[2][2][4][2], const Unit& u, int wr, int wc, int fr, int fq) const {
        const int row0 = u.pm * BM + wr * 64 + fr, col0 = u.pn * BM + wc * 32 + 4 * fq;
#pragma unroll
        for (int ai = 0; ai < 2; ++ai)
#pragma unroll
            for (int m = 0; m < 4; ++m) { float* rowp = X + (size_t)(row0 + ai * HALF + m * 16) * D + col0;
#pragma unroll
                for (int bj = 0; bj < 2; ++bj)
#pragma unroll
                    for (int n = 0; n < 2; ++n) { f32x4* p = (f32x4*)(rowp + bj * HALF + n * 16); *p = *p + acc[ai][bj][m][n] * s; } }
    }
};
struct EpiFinal {
    static constexpr bool PERM = false;
    float* X; float s;
    __device__ __forceinline__ void operator()(const f32x4 (&acc)[2][2][4][2], const Unit& u, int wr, int wc, int fr, int fq) const {
        float* base = X + (size_t)(u.pm * BM + wr * 64 + fr) * D + u.pn * BM + wc * 32 + 4 * fq;
        f32x4 x[2][4];
#pragma unroll
        for (int q = 0; q < 4; ++q) x[0][q] = *(const f32x4*)(base + (q >> 1) * HALF + (q & 1) * 16);
#pragma unroll
        for (int g = 0; g < 8; ++g) {
            const int ai = g >> 2, m = g & 3;
            float* rowp = base + (size_t)(ai * HALF + m * 16) * D;
            if (g < 7) { const float* nx = base + (size_t)(((g + 1) >> 2) * HALF + ((g + 1) & 3) * 16) * D;
#pragma unroll
                for (int q = 0; q < 4; ++q) x[(g + 1) & 1][q] = *(const f32x4*)(nx + (q >> 1) * HALF + (q & 1) * 16); }
#pragma unroll
            for (int q = 0; q < 4; ++q) *(f32x4*)(rowp + (q >> 1) * HALF + (q & 1) * 16) = x[g & 1][q] + acc[ai][q >> 1][m][q & 1] * s;
        }
    }
};
template <int ACT> struct EpiBf16 {
    static constexpr bool PERM = true;
    bf16_t* O; int ldc;
    __device__ __forceinline__ void operator()(const f32x4 (&acc)[2][2][4][2], const Unit& u, int wr, int wc, int fr, int fq) const {
        const int row0 = u.pm * BM + wr * 64 + fr, col0 = u.pn * BM + wc * 32 + 8 * fq;
#pragma unroll
        for (int ai = 0; ai < 2; ++ai)
#pragma unroll
            for (int m = 0; m < 4; ++m) { bf16_t* rowp = O + (size_t)(row0 + ai * HALF + m * 16) * ldc + col0;
#pragma unroll
                for (int bj = 0; bj < 2; ++bj) { f32x4 v0 = acc[ai][bj][m][0], v1 = acc[ai][bj][m][1];
                    if (ACT == 1) {
#pragma unroll
                        for (int j = 0; j < 4; ++j) { v0[j] = gelu_tanh_f(v0[j]); v1[j] = gelu_tanh_f(v1[j]); } }
                    u32x4 w; w.x = cvt_pk_bf16(v0[0], v0[1]); w.y = cvt_pk_bf16(v0[2], v0[3]); w.z = cvt_pk_bf16(v1[0], v1[1]); w.w = cvt_pk_bf16(v1[2], v1[3]);
                    *(u32x4*)(rowp + bj * HALF) = w; } }
    }
};
}

#define MFMA32S(a, b, c) __builtin_amdgcn_mfma_f32_32x32x16_bf16((a), (b), (c), 0, 0, 0)
template <int MODE>
__device__ __forceinline__ void sample_gemm(LAS unsigned char* lds, const bf16_t* A, int lda, const bf16_t* Bt, int ldb, int K, int N, bf16_t* O, int ldc, const int tid, float* Xs = nullptr) {
    const int lane = tid & 63, wave = __builtin_amdgcn_readfirstlane(tid >> 6), hh = lane >> 5;
    const int ntiles = 8 * (N / 32), kw = K / 8;
    LAS float* red = (LAS float*)lds;
    for (int tile = blockIdx.x; tile < ntiles; tile += gridDim.x) {
        const int rt = tile & 7, ct = tile >> 3;
        const bf16_t* ap = A + (size_t)(32 * rt + (lane & 31)) * lda + wave * kw + 8 * hh;
        int brow = 32 * ct + (lane & 31);
        if (MODE == 2) { const int h0 = 32 * ct; brow = (h0 >> 7) * 256 + (h0 & 127) + (lane & 31); }
        const bf16_t* bp = Bt + (size_t)brow * ldb + wave * kw + 8 * hh;
        f32x16 c0, c1;
#pragma unroll
        for (int i = 0; i < 16; ++i) { c0[i] = 0.f; c1[i] = 0.f; }
#pragma unroll 4
        for (int k = 0; k < kw; k += 16) {
            const bf16x8 a = *(const bf16x8*)(ap + k), b = *(const bf16x8*)(bp + k);
            c0 = MFMA32S(a, b, c0);
            if (MODE == 2) { const bf16x8 b2 = *(const bf16x8*)(bp + (size_t)128 * ldb + k); c1 = MFMA32S(a, b2, c1); }
        }
        __syncthreads();
#pragma unroll
        for (int i = 0; i < 16; ++i) { red[((wave * 2 + 0) * 16 + i) * 64 + lane] = c0[i]; if (MODE == 2) red[((wave * 2 + 1) * 16 + i) * 64 + lane] = c1[i]; }
        __syncthreads();
#pragma unroll
        for (int r = 0; r < 2; ++r) {
            const int e = tid + 512 * r, i = e >> 6, l = e & 63;
            float s0 = 0.f, s1 = 0.f;
#pragma unroll
            for (int w = 0; w < 8; ++w) { s0 += red[((w * 2 + 0) * 16 + i) * 64 + l]; if (MODE == 2) s1 += red[((w * 2 + 1) * 16 + i) * 64 + l]; }
            const int row = 32 * rt + (i & 3) + 8 * (i >> 2) + 4 * (l >> 5), col = 32 * ct + (l & 31);
            const float v = MODE == 2 ? silu_f(s0) * s1 : (MODE == 1 ? gelu_tanh_f(s0) : s0);
            if (MODE == 4) Xs[(size_t)row * ldc + col] += 0.5f * s0;
            else O[(size_t)row * ldc + col] = (bf16_t)(cvt_pk_bf16(v, 0.f) & 0xffffu);
        }
    }
    __syncthreads();
}

struct Params { const float* in[16]; float* out; unsigned char* ws; int ph_lo, ph_hi; };

__device__ __forceinline__ void transpose_item(const float* W, int K, int N, bf16_t* WT, int k0, int n0, int drow0, LAS float* scr, int lane, int ldw) {
#pragma unroll 8
    for (int i = 0; i < 32; ++i) { const int kk = 2 * i + (lane >> 5); scr[kk * 33 + (lane & 31)] = W[(size_t)(k0 + kk) * N + n0 + (lane & 31)]; }
    asm volatile("s_waitcnt lgkmcnt(0)" ::: "memory");
    const int c = lane & 7;
#pragma unroll
    for (int j = 0; j < 4; ++j) { const int n = (lane >> 3) + 8 * j; const LAS float* s = scr + (8 * c) * 33 + n;
        u32x4 o; o.x = cvt_pk_bf16(s[0 * 33], s[1 * 33]); o.y = cvt_pk_bf16(s[2 * 33], s[3 * 33]); o.z = cvt_pk_bf16(s[4 * 33], s[5 * 33]); o.w = cvt_pk_bf16(s[6 * 33], s[7 * 33]);
        *(u32x4*)(WT + (size_t)(drow0 + n) * ldw + k0 + 8 * c) = o; }
    asm volatile("s_waitcnt lgkmcnt(0)" ::: "memory");
}
__device__ __forceinline__ void transpose_mat(const float* W, int K, int N, bf16_t* WT, int item, bool swiglu, LAS float* scr, int lane, int ldw = 0) {
    const int nblk = N / 32, kb = item / nblk, nb = item % nblk, n0 = 32 * nb;
    int drow0 = n0;
    if (swiglu) { const int up = n0 >= FF, nn = up ? n0 - FF : n0; drow0 = (nn >> 7) * 256 + (up ? 128 : 0) + (nn & 127); }
    transpose_item(W, K, N, WT, 64 * kb, n0, drow0, scr, lane, ldw ? ldw : K);
}
__constant__ double ROPE_INV[32] = {
    1.0, 0.7498942093324559, 0.5623413251903491, 0.4216965034285822, 0.31622776601683794, 0.23713737056616552, 0.1778279410038923, 0.1333521432163324,
    0.1, 0.07498942093324558, 0.05623413251903491, 0.042169650342858224, 0.03162277660168379, 0.023713737056616554, 0.01778279410038923, 0.01333521432163324,
    0.01, 0.007498942093324558, 0.005623413251903491, 0.004216965034285823, 0.0031622776601683794, 0.0023713737056616554, 0.0017782794100389228, 0.001333521432163324,
    0.001, 0.0007498942093324559, 0.0005623413251903491, 0.00042169650342858224, 0.00031622776601683794, 0.00023713737056616554, 0.00017782794100389227, 0.0001333521432163324};

__device__ __forceinline__ void norm_row(const float* xrow, const bf16_t* yrow, float sy, const float* g, bf16_t* orow, float* xout, int lane) {
    const f32x4* xr = (const f32x4*)xrow + lane;
    f32x4 v[4]; float ss = 0.f;
#pragma unroll
    for (int j = 0; j < 4; ++j) v[j] = xr[64 * j];
    if (yrow) {
#pragma unroll
        for (int j = 0; j < 4; ++j) { const u32x2 y = ((const u32x2*)yrow)[lane + 64 * j];
            v[j].x += sy * bf_lo(y.x); v[j].y += sy * bf_hi(y.x); v[j].z += sy * bf_lo(y.y); v[j].w += sy * bf_hi(y.y); }
    }
#pragma unroll
    for (int j = 0; j < 4; ++j) ss += (v[j].x * v[j].x + v[j].y * v[j].y) + (v[j].z * v[j].z + v[j].w * v[j].w);
    if (xout) {
#pragma unroll
        for (int j = 0; j < 4; ++j) ((f32x4*)xout)[lane + 64 * j] = v[j];
    }
    if (g) {
        const float r = 1.0f / sqrtf(wave_sum(ss) * (1.0f / D) + EPS);
#pragma unroll
        for (int j = 0; j < 4; ++j) {
            const f32x4 gg = ((const f32x4*)g)[lane + 64 * j];
            u32x2 o; o.x = cvt_pk_bf16(v[j].x * r * gg.x, v[j].y * r * gg.y); o.y = cvt_pk_bf16(v[j].z * r * gg.z, v[j].w * r * gg.w);
            ((u32x2*)orow)[lane + 64 * j] = o;
        }
    }
}

__device__ __forceinline__ void phase_prologue(const Params& p, unsigned char* ws, float* out, LAS unsigned char* lds, const int tid) {
    const int lane = tid & 63, wave = tid >> 6;
    const int gw = blockIdx.x * 8 + wave, NGW = gridDim.x * 8;
    LAS float* scr = (LAS float*)(lds + wave * 8704);
    constexpr int I_IN = (D / 64) * (2 * FF / 32), I_OUT = (FF / 64) * (D / 32), I_QKV = (D / 64) * (NQKV / 32), I_OA = (AW / 64) * (D / 32), I_UV = (D / 64) * (NUV / 32), I_OB = (BW / 64) * (D / 32);
    constexpr int NITEMS = 4 * I_IN + 4 * I_OUT + I_QKV + I_OA + I_UV + I_OB;
    for (int it = gw; it < NITEMS; it += NGW) {
        int r = it;
        if (r < 4 * I_IN) { const int w = r / I_IN; transpose_mat(p.in[6] + (size_t)w * D * 2 * FF, D, 2 * FF, (bf16_t*)(ws + WS_WIN + w * SZ_WIN), r % I_IN, true, scr, lane); continue; } r -= 4 * I_IN;
        if (r < 4 * I_OUT) { const int w = r / I_OUT; transpose_mat(p.in[7] + (size_t)w * FF * D, FF, D, (bf16_t*)(ws + WS_WOUT + w * SZ_WOUT), r % I_OUT, false, scr, lane); continue; } r -= 4 * I_OUT;
        if (r < I_QKV) { transpose_mat(p.in[8], D, NQKV, (bf16_t*)(ws + WS_WQKV), r, false, scr, lane); continue; } r -= I_QKV;
        if (r < I_OA) { transpose_mat(p.in[10], AW, D, (bf16_t*)(ws + WS_WOA), r, false, scr, lane); continue; } r -= I_OA;
        if (r < I_UV) { transpose_mat(p.in[11], D, NUV, (bf16_t*)(ws + WS_WUV), r, false, scr, lane); continue; } r -= I_UV;
        transpose_mat(p.in[15], BW, D, (bf16_t*)(ws + WS_WOB), r, false, scr, lane, LDU);
    }
    { bf16_t* wsp = (bf16_t*)(ws + WS_WSP); const float* src = p.in[13];
      for (int i = blockIdx.x * 512 + tid; i < 16 * 128 * 128 / 2; i += gridDim.x * 512) {
          const int e = 2 * i, s = e & 127, t = (e >> 7) & 127; const f32x2 v = *(const f32x2*)(src + e);
          ((unsigned*)wsp)[i] = cvt_pk_bf16(s <= t ? v.x : 0.f, (s + 1) <= t ? v.y : 0.f); } }
    { float* ct = (float*)(ws + WS_ROPE); float* st = ct + NPOS * 32;
      for (int i = blockIdx.x * 512 + tid; i < NPOS * 32; i += gridDim.x * 512) {
          const int pi = i >> 5, fi = i & 31; const double pos = (double)(pi < SEQ ? pi : PAST + (pi - SEQ));
          const double a = pos * ROPE_INV[fi]; const double n = __builtin_rint(a * 0.15915494309189535);
          const double r = (a - n * 6.283185307179586) - n * 2.4492935982947064e-16; const double r2 = r * r;
          double sn = 1.0, cs = 1.0;
#pragma unroll 1
          for (int k = 14; k >= 1; --k) { const double k2 = (double)(2 * k); sn = 1.0 - sn * r2 / (k2 * (k2 + 1.0)); cs = 1.0 - cs * r2 / ((k2 - 1.0) * k2); }
          ct[i] = (float)cs; st[i] = (float)(sn * r); } }
#ifdef NANFILL
    { u32x4* f = (u32x4*)(ws + WS_BIG); const size_t n = (WS_END - WS_BIG) / 16; const u32x4 q = {0xffffffffu, 0xffffffffu, 0xffffffffu, 0xffffffffu};
      for (size_t i = (size_t)blockIdx.x * 512 + tid; i < n; i += (size_t)gridDim.x * 512) f[i] = q;
      u32x4* fo = (u32x4*)(out + O_KP0); const size_t no = (O_VS + 524288 - O_KP0) / 4;
      for (size_t i = (size_t)blockIdx.x * 512 + tid; i < no; i += (size_t)gridDim.x * 512) fo[i] = q; }
#endif
    for (int m = gw; m < M; m += NGW) {
        const float* src = m < MP ? p.in[0] + (size_t)m * D : p.in[1] + (size_t)(m - MP) * D;
        norm_row(src, nullptr, 0.f, p.in[5], (bf16_t*)(ws + WS_XN) + (size_t)m * D, out + (size_t)m * D, lane);
    }
}

__device__ __forceinline__ void phase_norm(unsigned char* ws, float* out, const float* g, float sy, const int tid) {
    const int lane = tid & 63, wave = tid >> 6;
    const int gw = blockIdx.x * 8 + wave, NGW = gridDim.x * 8;
    for (int m = gw; m < M; m += NGW) norm_row(out + (size_t)m * D, (const bf16_t*)(ws + WS_YB) + (size_t)m * D, sy, g, (bf16_t*)(ws + WS_XN) + (size_t)m * D, out + (size_t)m * D, lane);
}

__device__ __forceinline__ void tail_store(float* out, int g, int h, int kv, int row, int i0, f32x4 a, f32x4 b) {
    float* dst;
    if (row < MP) {
        const int bb = row >> 11, t = row & 2047, keep = 128 << (2 * g), tt = t - (SEQ - keep);
        if (tt < 0) return;
        const size_t base = g == 0 ? O_KP0 : (g == 1 ? O_KP1 : O_KP2);
        dst = out + base + ((((size_t)bb * keep + tt) * 2 + kv) * 8 + h) * 64;
    } else {
        const int s = row - MP; const size_t base = g == 0 ? O_KS0 : (g == 1 ? O_KS1 : O_KS2);
        dst = out + base + (((size_t)s * 2 + kv) * 8 + h) * 64;
    }
    *(f32x4*)(dst + i0) = a; *(f32x4*)(dst + 32 + i0) = b;
}
__device__ __forceinline__ void phase_qknorm(const Params& p, unsigned char* ws, float* out, const int tid) {
    const int lane = tid & 63, wave = tid >> 6;
    const int gw = blockIdx.x * 8 + wave, NGW = gridDim.x * 8;
    bf16_t* QKV = (bf16_t*)(ws + WS_BIG);
    const float* ct = (const float*)(ws + WS_ROPE); const float* st = ct + NPOS * 32;
    const int sub = lane & 7, i0 = 4 * sub;
    for (int it = gw; it < M * 9; it += NGW) {
        const int row = it / 9, s9 = it - row * 9;
        if (s9 < 6) {
            const int head = s9 * 8 + (lane >> 3), isk = head >= 24, gh = isk ? head - 24 : head, g = gh >> 3, h = gh & 7;
            bf16_t* ptr = QKV + (size_t)row * NQKV + head * 64;
            const u32x2 ra = *(const u32x2*)(ptr + i0), rb = *(const u32x2*)(ptr + 32 + i0);
            f32x4 x1 = {bf_lo(ra.x), bf_hi(ra.x), bf_lo(ra.y), bf_hi(ra.y)}, x2 = {bf_lo(rb.x), bf_hi(rb.x), bf_lo(rb.y), bf_hi(rb.y)};
            float ss = (x1.x * x1.x + x1.y * x1.y) + (x1.z * x1.z + x1.w * x1.w) + (x2.x * x2.x + x2.y * x2.y) + (x2.z * x2.z + x2.w * x2.w);
            ss += __shfl_xor(ss, 1); ss += __shfl_xor(ss, 2); ss += __shfl_xor(ss, 4);
            const float r = 1.0f / sqrtf(ss * (1.0f / 64) + EPS);
            const float* gain = p.in[9] + isk * 64;
            const f32x4 g1 = *(const f32x4*)(gain + i0), g2 = *(const f32x4*)(gain + 32 + i0);
            const int pi = row < MP ? (row & 2047) : SEQ + ((row - MP) & 7);
            const f32x4 c = *(const f32x4*)(ct + pi * 32 + i0), s = *(const f32x4*)(st + pi * 32 + i0);
            const f32x4 y1 = x1 * r * g1, y2 = x2 * r * g2;
            const f32x4 o1 = y1 * c - y2 * s, o2 = y2 * c + y1 * s;
            u32x2 wa, wb; wa.x = cvt_pk_bf16(o1.x, o1.y); wa.y = cvt_pk_bf16(o1.z, o1.w); wb.x = cvt_pk_bf16(o2.x, o2.y); wb.y = cvt_pk_bf16(o2.z, o2.w);
            *(u32x2*)(ptr + i0) = wa; *(u32x2*)(ptr + 32 + i0) = wb;
            if (isk) tail_store(out, g, h, 0, row, i0, o1, o2);
        } else {
            const int vh = (s9 - 6) * 8 + (lane >> 3), g = vh >> 3, h = vh & 7;
            const bf16_t* ptr = QKV + (size_t)row * NQKV + 3072 + vh * 64;
            const u32x2 ra = *(const u32x2*)(ptr + i0), rb = *(const u32x2*)(ptr + 32 + i0);
            const f32x4 x1 = {bf_lo(ra.x), bf_hi(ra.x), bf_lo(ra.y), bf_hi(ra.y)}, x2 = {bf_lo(rb.x), bf_hi(rb.x), bf_lo(rb.y), bf_hi(rb.y)};
            tail_store(out, g, h, 1, row, i0, x1, x2);
        }
    }
}

#define MFMA32(a, b, c) __builtin_amdgcn_mfma_f32_32x32x16_bf16((a), (b), (c), 0, 0, 0)
__device__ __forceinline__ s16x4 tr_read(unsigned lds_addr) { return __builtin_amdgcn_ds_read_tr16_b64_v4i16((LAS s16x4*)(uintptr_t)lds_addr); }
__device__ __forceinline__ bf16x8 pack8(const f32x16& x, int s) {
    u32x4 pk;
    pk.x = cvt_pk_bf16(x[8 * s + 0], x[8 * s + 1]); pk.y = cvt_pk_bf16(x[8 * s + 2], x[8 * s + 3]); pk.z = cvt_pk_bf16(x[8 * s + 4], x[8 * s + 5]); pk.w = cvt_pk_bf16(x[8 * s + 6], x[8 * s + 7]);
    return __builtin_bit_cast(bf16x8, pk);
}
__device__ __forceinline__ void attn_prompt_tile(const bf16_t* QKV, bf16_t* OG, float* LSE, LAS unsigned char* vl, int g, int b, int h, int w, int lane) {
    const int dsh = 2 * g, d = 1 << dsh;
    const int tpr_sh = 6 - dsh;
    const int r = w >> tpr_sh, jt = w & ((1 << tpr_sh) - 1), j0 = jt * 32;
    const int q = lane & 31, hh = lane >> 5;
    const size_t rowb = (size_t)b * SEQ;
    const int qcol = g * 512 + h * 64, kcol = 1536 + qcol, vcol = 3072 + qcol;
    const int tq = ((j0 + q) << dsh) + r;
    const bf16_t* qp = QKV + (rowb + tq) * NQKV + qcol + 8 * hh;
    bf16x8 qf[4];
#pragma unroll
    for (int s = 0; s < 4; ++s) qf[s] = *(const bf16x8*)(qp + 16 * s);
    const int kb0 = jt >= 4 ? 0 : 4 - jt;
    f32x16 S[5];
    float mx = -INFINITY;
    bf16x8 kfa[5][4];
#pragma unroll
    for (int kb = 0; kb < 5; ++kb) {
        int jk = j0 - 128 + kb * 32 + q; jk = jk < 0 ? 0 : jk;
        const bf16_t* kp = QKV + (rowb + (size_t)((jk << dsh) + r)) * NQKV + kcol + 8 * hh;
#pragma unroll
        for (int s = 0; s < 4; ++s) kfa[kb][s] = *(const bf16x8*)(kp + 16 * s);
    }
#pragma unroll
    for (int kb = 0; kb < 5; ++kb) {
        f32x16 c;
#pragma unroll
        for (int i = 0; i < 16; ++i) c[i] = 0.f;
#pragma unroll
        for (int s = 0; s < 4; ++s) c = MFMA32(kfa[kb][s], qf[s], c);
#pragma unroll
        for (int i = 0; i < 16; ++i) {
            const int ki = (i & 3) + 8 * (i >> 2) + 4 * hh;
            bool valid = kb >= kb0;
            if (kb == 0) valid = valid && (ki >= q);
            if (kb == 4) valid = valid && (ki <= q);
            const float sv = valid ? c[i] * 0.125f : -INFINITY;
            c[i] = sv; mx = fmaxf(mx, sv);
        }
        S[kb] = c;
    }
    bf16x8 vva[5][4];
#pragma unroll
    for (int kb = 0; kb < 5; ++kb)
#pragma unroll
        for (int c4 = 0; c4 < 4; ++c4) {
            const int i = c4 * 8 + (lane >> 3); int jk = j0 - 128 + kb * 32 + i; jk = jk < 0 ? 0 : jk;
            vva[kb][c4] = *(const bf16x8*)(QKV + (rowb + (size_t)((jk << dsh) + r)) * NQKV + vcol + (lane & 7) * 8);
        }
    mx = fmaxf(mx, __shfl_xor(mx, 32));
    float l = 0.f;
#pragma unroll
    for (int kb = 0; kb < 5; ++kb)
#pragma unroll
        for (int i = 0; i < 16; ++i) { const float e = __expf(S[kb][i] - mx); S[kb][i] = e; l += e; }
    l += __shfl_xor(l, 32);
    const float inv = 1.0f / l;
    f32x16 o0, o1;
#pragma unroll
    for (int i = 0; i < 16; ++i) { o0[i] = 0.f; o1[i] = 0.f; }
    const unsigned vbase = (unsigned)(uintptr_t)vl;
    const unsigned tr_off = (unsigned)((4 * hh + ((lane & 15) >> 2)) * 144 + ((lane >> 4) & 1) * 32 + 8 * (lane & 3));
#pragma unroll
    for (int kb = 0; kb < 5; ++kb) {
        {
#pragma unroll
            for (int c4 = 0; c4 < 4; ++c4) *(LAS bf16x8*)(vl + (c4 * 8 + (lane >> 3)) * 144 + (lane & 7) * 16) = vva[kb][c4];
#pragma unroll
            for (int s2 = 0; s2 < 2; ++s2) {
                f32x16 pn = S[kb];
#pragma unroll
                for (int i = 0; i < 16; ++i) pn[i] *= inv;
                const bf16x8 pb = pack8(pn, s2);
#pragma unroll
                for (int nb = 0; nb < 2; ++nb) {
                    const unsigned a0 = vbase + tr_off + (unsigned)(16 * s2 * 144 + nb * 64);
                    const s16x4 lo = tr_read(a0), hi = tr_read(a0 + 8 * 144);
                    const bf16x8 va = __builtin_shufflevector(lo, hi, 0, 1, 2, 3, 4, 5, 6, 7);
                    if (nb == 0) o0 = MFMA32(va, pb, o0); else o1 = MFMA32(va, pb, o1);
                }
            }
        }
    }
    const size_t orow = (size_t)g * M + rowb + tq;
    bf16_t* op = OG + orow * AW + h * 64 + 4 * hh;
#pragma unroll
    for (int g4 = 0; g4 < 4; ++g4) {
        u32x2 w0, w1;
        w0.x = cvt_pk_bf16(o0[4 * g4], o0[4 * g4 + 1]); w0.y = cvt_pk_bf16(o0[4 * g4 + 2], o0[4 * g4 + 3]);
        w1.x = cvt_pk_bf16(o1[4 * g4], o1[4 * g4 + 1]); w1.y = cvt_pk_bf16(o1[4 * g4 + 2], o1[4 * g4 + 3]);
        *(u32x2*)(op + 8 * g4) = w0; *(u32x2*)(op + 32 + 8 * g4) = w1;
    }
    if (hh == 0) LSE[orow * 8 + h] = mx + __logf(l);
}
__device__ __forceinline__ void attn_sample_item(const Params& p, unsigned char* ws, int item, LAS float* sc, int lane) {
    const int j = item & 7, h = (item >> 3) & 7, gb = item >> 6, g = gb % 3, b = gb / 3;
    const int dsh = 2 * g, L = 128 << dsh;
    const float* cache = (g == 0 ? p.in[2] : (g == 1 ? p.in[3] : p.in[4])) + (size_t)b * L * 1024;
    const bf16_t* QKV = (const bf16_t*)(ws + WS_BIG);
    const int row = MP + b * 8 + j;
    const int sub = lane & 15, ks = lane >> 4;
    const int qcol = g * 512 + h * 64 + 4 * sub;
    const u32x2 qr = *(const u32x2*)(QKV + (size_t)row * NQKV + qcol);
    const f32x4 qv = {bf_lo(qr.x), bf_hi(qr.x), bf_lo(qr.y), bf_hi(qr.y)};
#pragma unroll 11
    for (int it = 0; it < 33; ++it) {
        const int i = it * 4 + ks;
        float dot = 0.f;
        if (i <= 128) {
            const int idx = L + j - (i << dsh);
            f32x4 kv;
            if (idx >= L) { const u32x2 kr = *(const u32x2*)(QKV + (size_t)(MP + b * 8 + (idx - L)) * NQKV + 1536 + qcol); kv = (f32x4){bf_lo(kr.x), bf_hi(kr.x), bf_lo(kr.y), bf_hi(kr.y)}; }
            else kv = *(const f32x4*)(cache + (size_t)idx * 1024 + h * 64 + 4 * sub);
            dot = (qv.x * kv.x + qv.y * kv.y) + (qv.z * kv.z + qv.w * kv.w);
        }
        dot += __shfl_xor(dot, 1); dot += __shfl_xor(dot, 2); dot += __shfl_xor(dot, 4); dot += __shfl_xor(dot, 8);
        if (sub == 0 && i <= 128) sc[i] = dot * 0.125f;
    }
    asm volatile("s_waitcnt lgkmcnt(0)" ::: "memory");
    float mx = fmaxf(sc[lane], sc[lane + 64]); if (lane == 0) mx = fmaxf(mx, sc[128]);
    mx = wave_max(mx);
    float l = __expf(sc[lane] - mx) + __expf(sc[lane + 64] - mx); if (lane == 0) l += __expf(sc[128] - mx);
    l = wave_sum(l);
    const float inv = 1.0f / l;
    f32x4 acc = {0.f, 0.f, 0.f, 0.f};
#pragma unroll 11
    for (int it = 0; it < 33; ++it) {
        const int i = it * 4 + ks;
        if (i <= 128) {
            const float pw = __expf(sc[i] - mx) * inv;
            const int idx = L + j - (i << dsh);
            f32x4 vv;
            if (idx >= L) { const u32x2 vr = *(const u32x2*)(QKV + (size_t)(MP + b * 8 + (idx - L)) * NQKV + 3072 + qcol); vv = (f32x4){bf_lo(vr.x), bf_hi(vr.x), bf_lo(vr.y), bf_hi(vr.y)}; }
            else vv = *(const f32x4*)(cache + (size_t)idx * 1024 + 512 + h * 64 + 4 * sub);
            acc += vv * pw;
        }
    }
#pragma unroll
    for (int k = 0; k < 4; ++k) { acc[k] += __shfl_xor(acc[k], 16); acc[k] += __shfl_xor(acc[k], 32); }
    const size_t orow = (size_t)g * M + row;
    if (ks == 0) { u32x2 w; w.x = cvt_pk_bf16(acc.x, acc.y); w.y = cvt_pk_bf16(acc.z, acc.w); *(u32x2*)((bf16_t*)(ws + WS_OG) + orow * AW + h * 64 + 4 * sub) = w; }
    if (lane == 0) ((float*)(ws + WS_LSE))[orow * 8 + h] = mx + __logf(l);
    asm volatile("s_waitcnt lgkmcnt(0)" ::: "memory");
}
__device__ __forceinline__ void phase_attn(const Params& p, unsigned char* ws, LAS unsigned char* lds, const int tid) {
    const int lane = tid & 63, wave = __builtin_amdgcn_readfirstlane(tid >> 6);
    LAS unsigned char* vl = lds + wave * 4608;
    constexpr int NS = 768, NP = 3072;
    for (int bi = blockIdx.x; bi < NS + NP; bi += gridDim.x) {
        if (bi < NS) attn_sample_item(p, ws, bi * 8 + wave, (LAS float*)vl, lane);
        else {
            const int x = bi - NS, w8 = x & 7, h = (x >> 3) & 7, b = (x >> 6) & 15, g = x >> 10;
            attn_prompt_tile((const bf16_t*)(ws + WS_BIG), (bf16_t*)(ws + WS_OG), (float*)(ws + WS_LSE), vl, g, b, h, w8 * 8 + wave, lane);
        }
    }
}
__device__ __forceinline__ void phase_merge(unsigned char* ws, const int tid) {
    const bf16_t* OG = (const bf16_t*)(ws + WS_OG); const float* LSE = (const float*)(ws + WS_LSE); bf16_t* AO = (bf16_t*)(ws + WS_AO);
    for (int e = blockIdx.x * 512 + tid; e < M * 64; e += gridDim.x * 512) {
        const int rh = e >> 3, c8 = e & 7;
        const float l0 = LSE[rh], l1 = LSE[(size_t)M * 8 + rh], l2 = LSE[(size_t)2 * M * 8 + rh];
        const float mx = fmaxf(l0, fmaxf(l1, l2));
        float w0 = __expf(l0 - mx), w1 = __expf(l1 - mx), w2 = __expf(l2 - mx); const float inv = 1.0f / (w0 + w1 + w2); w0 *= inv; w1 *= inv; w2 *= inv;
        const size_t off = (size_t)rh * 64 + c8 * 8;
        const u32x4 a = *(const u32x4*)(OG + off), b = *(const u32x4*)(OG + (size_t)M * AW + off), c = *(const u32x4*)(OG + (size_t)2 * M * AW + off);
        u32x4 o;
#pragma unroll
        for (int k = 0; k < 4; ++k) o[k] = cvt_pk_bf16(w0 * bf_lo(a[k]) + w1 * bf_lo(b[k]) + w2 * bf_lo(c[k]), w0 * bf_hi(a[k]) + w1 * bf_hi(b[k]) + w2 * bf_hi(c[k]));
        *(u32x4*)(AO + off) = o;
    }
}

__device__ __forceinline__ void phase_vnorm(const Params& p, unsigned char* ws, float* out, const int tid) {
    const int lane = tid & 63, wave = tid >> 6;
    const int gw = blockIdx.x * 8 + wave, NGW = gridDim.x * 8;
    const bf16_t* UV = (const bf16_t*)(ws + WS_BIG); float* RV = (float*)(ws + WS_RV);
    for (int m = gw; m < M; m += NGW) {
        const u32x4* vr = (const u32x4*)(UV + (size_t)m * NUV + BW) + lane;
        u32x4 v[4]; float ss = 0.f;
#pragma unroll
        for (int j = 0; j < 4; ++j) { v[j] = vr[64 * j];
#pragma unroll
            for (int k = 0; k < 4; ++k) { const float a = bf_lo(v[j][k]), b = bf_hi(v[j][k]); ss += a * a + b * b; } }
        const float r = 1.0f / sqrtf(wave_sum(ss) * (1.0f / BW) + EPS);
        if (lane == 0) RV[m] = r;
        if (m >= MP) {
            float* dst = out + O_VS + (size_t)(m - MP) * BW;
#pragma unroll
            for (int j = 0; j < 4; ++j) { const int c0 = 8 * (lane + 64 * j); const f32x4 ga = *(const f32x4*)(p.in[12] + c0), gb = *(const f32x4*)(p.in[12] + c0 + 4);
                *(f32x4*)(dst + c0) = (f32x4){bf_lo(v[j][0]) * r * ga.x, bf_hi(v[j][0]) * r * ga.y, bf_lo(v[j][1]) * r * ga.z, bf_hi(v[j][1]) * r * ga.w};
                *(f32x4*)(dst + c0 + 4) = (f32x4){bf_lo(v[j][2]) * r * gb.x, bf_hi(v[j][2]) * r * gb.y, bf_lo(v[j][3]) * r * gb.z, bf_hi(v[j][3]) * r * gb.w}; }
        }
    }
}
__device__ __forceinline__ void spatial_tile(const Params& p, unsigned char* ws, LAS unsigned char* vl, int chunk, int gi, int tb, int ch, int lane) {
    const bf16_t* UV = (const bf16_t*)(ws + WS_BIG); const float* RV = (const float*)(ws + WS_RV); bf16_t* UM = (bf16_t*)(ws + WS_UM);
    const bf16_t* WSP = (const bf16_t*)(ws + WS_WSP);
    const int hh = lane >> 5;
    const int colb = gi * 128 + 64 * ch;
    const f32x4 ga = *(const f32x4*)(p.in[12] + colb + (lane & 7) * 8), gb = *(const f32x4*)(p.in[12] + colb + (lane & 7) * 8 + 4);
    f32x16 a0, a1;
#pragma unroll
    for (int i = 0; i < 16; ++i) { a0[i] = 0.f; a1[i] = 0.f; }
    const int t = 32 * tb + (lane & 31);
    const bf16_t* wp = WSP + ((size_t)gi * 128 + t) * 128 + 8 * hh;
    const unsigned vbase = (unsigned)(uintptr_t)vl;
    const unsigned tr_off = (unsigned)((8 * hh + ((lane & 15) >> 2)) * 144 + ((lane >> 4) & 1) * 32 + 8 * (lane & 3));
    bf16x8 wfa[8];
#pragma unroll
    for (int ks = 0; ks < 8; ++ks) wfa[ks] = *(const bf16x8*)(wp + 16 * ks);
    u32x4 rawa[4][4]; float rva[4][4];
#pragma unroll
    for (int sb = 0; sb < 4; ++sb)
#pragma unroll
        for (int c4 = 0; c4 < 4; ++c4) {
            const int srow = chunk * 128 + 32 * sb + c4 * 8 + (lane >> 3);
            rawa[sb][c4] = *(const u32x4*)(UV + (size_t)srow * NUV + BW + colb + (lane & 7) * 8);
            rva[sb][c4] = RV[srow];
        }
#pragma unroll
    for (int sb = 0; sb < 4; ++sb) {
        if (sb <= tb) {
        u32x4 raw[4]; float rv[4];
#pragma unroll
        for (int c4 = 0; c4 < 4; ++c4) { raw[c4] = rawa[sb][c4]; rv[c4] = rva[sb][c4]; }
#pragma unroll
        for (int c4 = 0; c4 < 4; ++c4) {
            const float r = rv[c4]; u32x4 o;
            o.x = cvt_pk_bf16(bf_lo(raw[c4].x) * r * ga.x, bf_hi(raw[c4].x) * r * ga.y); o.y = cvt_pk_bf16(bf_lo(raw[c4].y) * r * ga.z, bf_hi(raw[c4].y) * r * ga.w);
            o.z = cvt_pk_bf16(bf_lo(raw[c4].z) * r * gb.x, bf_hi(raw[c4].z) * r * gb.y); o.w = cvt_pk_bf16(bf_lo(raw[c4].w) * r * gb.z, bf_hi(raw[c4].w) * r * gb.w);
            *(LAS u32x4*)(vl + (c4 * 8 + (lane >> 3)) * 144 + (lane & 7) * 16) = o;
        }
#pragma unroll
        for (int s2 = 0; s2 < 2; ++s2) {
            const bf16x8 wf = wfa[2 * sb + s2];
#pragma unroll
            for (int cb = 0; cb < 2; ++cb) {
                const unsigned a = vbase + tr_off + (unsigned)(16 * s2 * 144 + cb * 64);
                const s16x4 lo = tr_read(a), hi = tr_read(a + 4 * 144);
                const bf16x8 va = __builtin_shufflevector(lo, hi, 0, 1, 2, 3, 4, 5, 6, 7);
                if (cb == 0) a0 = MFMA32(va, wf, a0); else a1 = MFMA32(va, wf, a1);
            }
        }
        }
    }
    const size_t row = (size_t)chunk * 128 + t;
    const float bias = p.in[14][gi * 128 + t];
    const bf16_t* up = UV + row * NUV + colb + 4 * hh;
    bf16_t* op = UM + row * LDU + colb + 4 * hh;
#pragma unroll
    for (int cb = 0; cb < 2; ++cb)
#pragma unroll
        for (int g4 = 0; g4 < 4; ++g4) {
            const u32x2 ur = *(const u32x2*)(up + 32 * cb + 8 * g4);
            const f32x16& a = cb == 0 ? a0 : a1;
            u32x2 w;
            w.x = cvt_pk_bf16(bf_lo(ur.x) * (a[4 * g4] + bias), bf_hi(ur.x) * (a[4 * g4 + 1] + bias));
            w.y = cvt_pk_bf16(bf_lo(ur.y) * (a[4 * g4 + 2] + bias), bf_hi(ur.y) * (a[4 * g4 + 3] + bias));
            *(u32x2*)(op + 32 * cb + 8 * g4) = w;
        }
}
__device__ __forceinline__ void phase_spatial(const Params& p, unsigned char* ws, LAS unsigned char* lds, const int tid) {
    const int lane = tid & 63, wave = __builtin_amdgcn_readfirstlane(tid >> 6);
    const bf16_t* UV = (const bf16_t*)(ws + WS_BIG); const float* RV = (const float*)(ws + WS_RV); bf16_t* UM = (bf16_t*)(ws + WS_UM);
    const float* vgain = p.in[12]; const float* bsp = p.in[14];
    constexpr int NPI = 256 * 16, NSI = 256;
    LAS unsigned char* vl = lds + wave * 4608;
    for (int it = blockIdx.x; it < NPI + NSI; it += gridDim.x) {
        if (it < NPI) spatial_tile(p, ws, vl, it >> 4, it & 15, wave & 3, wave >> 2, lane);
        else {
            const int e = (it - NPI) * 512 + tid;
            const int c4 = e & 511, bt = e >> 9, t = bt & 7, b = bt >> 3, c0 = 4 * c4, gi = c0 >> 7;
            f32x4 acc = {0.f, 0.f, 0.f, 0.f};
            const f32x4 vg = *(const f32x4*)(vgain + c0);
            for (int s = 0; s <= t; ++s) {
                const size_t r = (size_t)MP + b * 8 + s;
                const u32x2 vr = *(const u32x2*)(UV + r * NUV + BW + c0);
                const float wv = p.in[13][((size_t)gi * 128 + t) * 128 + s] * RV[r];
                acc += (f32x4){bf_lo(vr.x), bf_hi(vr.x), bf_lo(vr.y), bf_hi(vr.y)} * wv;
            }
            const float bias = bsp[gi * 128 + t];
            const size_t r = (size_t)MP + b * 8 + t;
            const u32x2 ur = *(const u32x2*)(UV + r * NUV + c0);
            u32x2 w;
            w.x = cvt_pk_bf16(bf_lo(ur.x) * (acc.x * vg.x + bias), bf_hi(ur.x) * (acc.y * vg.y + bias));
            w.y = cvt_pk_bf16(bf_lo(ur.y) * (acc.z * vg.z + bias), bf_hi(ur.y) * (acc.w * vg.w + bias));
            *(u32x2*)(UM + r * LDU + c0) = w;
        }
    }
}

__device__ __forceinline__ void grid_barrier(unsigned* ctr, const unsigned nblocks, const int tid) {
    asm volatile("s_waitcnt vmcnt(0) lgkmcnt(0)" ::: "memory");
    __syncthreads();
    if (tid == 0) {
        __builtin_amdgcn_fence(__ATOMIC_RELEASE, "agent");
        asm volatile("s_waitcnt vmcnt(0)" ::: "memory");
        __hip_atomic_fetch_add(ctr, 1u, __ATOMIC_RELAXED, __HIP_MEMORY_SCOPE_AGENT);
        while (__hip_atomic_load(ctr, __ATOMIC_RELAXED, __HIP_MEMORY_SCOPE_AGENT) < nblocks) __builtin_amdgcn_s_sleep(1);
        __builtin_amdgcn_fence(__ATOMIC_ACQUIRE, "agent");
        asm volatile("s_waitcnt vmcnt(0)" ::: "memory");
    }
    __syncthreads();
}

__global__ void __launch_bounds__(512, 2) mega(Params p) {
    extern __shared__ __attribute__((aligned(16))) unsigned char lds_raw[];
    LAS unsigned char* lds = (LAS unsigned char*)lds_raw;
    for (int ph = p.ph_lo; ph < p.ph_hi; ++ph) {
        int tid = threadIdx.x; asm volatile("" : "+v"(tid));
        unsigned z; asm volatile("s_mov_b32 %0, 0" : "=s"(z));
        unsigned char* ws = p.ws + z; float* out = p.out + z;
        bf16_t* XN = (bf16_t*)(ws + WS_XN); bf16_t* BIG = (bf16_t*)(ws + WS_BIG);
        bf16_t* YB = (bf16_t*)(ws + WS_YB);
        int fi = -1, fo = -1, ni = -1; float sy = 0.5f;
        switch (ph) {
            case 1: fi = 0; break; case 10: fi = 1; break; case 13: fi = 2; break; case 21: fi = 3; break;
            case 2: fo = 0; break; case 11: fo = 1; break; case 14: fo = 2; break; case 22: fo = 3; break;
            case 3: ni = 1; break; case 9: ni = 2; sy = 1.0f; break; case 12: ni = 3; break; case 15: ni = 4; break; case 20: ni = 5; sy = 1.0f; break; case 23: ni = 6; break;
            default: break;
        }
#ifndef PMASK
#define PMASK 0xFFFF
#endif
        if ((PMASK & 1) && ph == 0) phase_prologue(p, ws, out, lds, tid);
        else if ((PMASK & 2) && fi >= 0) { const bf16_t* W = (const bf16_t*)(ws + WS_WIN + fi * SZ_WIN); sample_gemm<2>(lds, XN + (size_t)MP * D, D, W, D, D, FF, BIG + (size_t)MP * FF, FF, tid);
            pg8::EpiSwiglu E{BIG}; pg8::gemm_phase(lds, XN, W, MP, 2 * FF, D, E, tid); }
        else if (ph == 22) {
            const bf16_t* B = (const bf16_t*)(ws + WS_WOUT + 3 * SZ_WOUT);
            sample_gemm<4>(lds, BIG + (size_t)MP * FF, FF, B, FF, FF, D, nullptr, D, tid, out + (size_t)MP * D);
            pg8::EpiFinal E{out, 0.5f}; pg8::gemm_phase(lds, BIG, B, MP, D, FF, E, tid); }
        else if ((PMASK & 4) && (fo >= 0 || ph == 8 || ph == 19)) {
            const bf16_t* A = BIG; const bf16_t* B = (const bf16_t*)(ws + WS_WOUT + (fo < 0 ? 0 : fo) * SZ_WOUT); int K = FF, ld = FF;
            if (ph == 8) { A = (const bf16_t*)(ws + WS_AO); B = (const bf16_t*)(ws + WS_WOA); K = AW; ld = AW; }
            if (ph == 19) { A = (const bf16_t*)(ws + WS_UM); B = (const bf16_t*)(ws + WS_WOB); K = BW; ld = LDU; }
            sample_gemm<0>(lds, A + (size_t)MP * ld, ld, B, ld, K, D, YB + (size_t)MP * D, D, tid);
            pg8::EpiBf16<0> E{YB, D}; pg8::gemm_phase(lds, A, B, MP, D, K, E, tid, ld, ld); }
#ifdef DUMPSEL
        else if (ph == 20) {
            const bf16_t* wsp = (const bf16_t*)(ws + WS_WSP); const float* rvp = (const float*)(ws + WS_RV);
            for (size_t e = (size_t)blockIdx.x * 512 + tid; e < (size_t)M * D; e += (size_t)gridDim.x * 512) { const size_t r = e / D, c = e % D;
                out[e] = (DUMPSEL == 10) ? p.in[12][(c + r) % 2048] * p.in[14][(c * 3 + r) % 2048] * (1.0f + p.in[13][(r * 1024 + c) % 262144]) : (DUMPSEL == 2) ? (r >= (size_t)MP ? 0.f : 1.f) * __uint_as_float((unsigned)((const bf16_t*)(ws + WS_UM))[r * LDU + c] << 16) : (DUMPSEL == 8) ? (r < 256 ? __uint_as_float((unsigned)wsp[r * 1024 + c] << 16) : 0.f) : rvp[r]; }
        }
#endif
        else if ((PMASK & 8) && ni >= 0) phase_norm(ws, out, ni < 6 ? p.in[5] + ni * D : nullptr, sy, tid);
        else if ((PMASK & 16) && ph == 4) { sample_gemm<0>(lds, XN + (size_t)MP * D, D, (const bf16_t*)(ws + WS_WQKV), D, D, NQKV, BIG + (size_t)MP * NQKV, NQKV, tid);
            pg8::EpiBf16<0> E{BIG, NQKV}; pg8::gemm_phase(lds, XN, (const bf16_t*)(ws + WS_WQKV), MP, NQKV, D, E, tid); }
        else if ((PMASK & 32) && ph == 5) phase_qknorm(p, ws, out, tid);
        else if ((PMASK & 64) && ph == 6) phase_attn(p, ws, lds, tid);
        else if ((PMASK & 128) && ph == 7) phase_merge(ws, tid);
        else if ((PMASK & 512) && ph == 16) { sample_gemm<1>(lds, XN + (size_t)MP * D, D, (const bf16_t*)(ws + WS_WUV), D, D, NUV, BIG + (size_t)MP * NUV, NUV, tid);
            pg8::EpiBf16<1> E{BIG, NUV}; pg8::gemm_phase(lds, XN, (const bf16_t*)(ws + WS_WUV), MP, NUV, D, E, tid); }
        else if ((PMASK & 1024) && ph == 17) phase_vnorm(p, ws, out, tid);
        else if ((PMASK & 2048) && ph == 18) phase_spatial(p, ws, lds, tid);
        if (ph + 1 < p.ph_hi) { __syncthreads(); cg::this_grid().sync(); }
    }
}

extern "C" void kernel_launch(void* const* d_in, const int* in_sizes, int n_in, void* d_out, int out_size, void* d_ws, size_t ws_size, hipStream_t stream) {
    static int grid = 0;
    if (grid == 0) {
        if (n_in != 16 || ws_size < WS_END) { fprintf(stderr, "kernel_launch: unexpected inputs (n_in %d, ws %zu < %zu)\n", n_in, ws_size, (size_t)WS_END); grid = -1; return; }
        int dev = 0, cus = 0, per_cu = 0;
        (void)hipGetDevice(&dev);
        (void)hipDeviceGetAttribute(&cus, hipDeviceAttributeMultiprocessorCount, dev);
        if (hipFuncSetAttribute((const void*)mega, hipFuncAttributeMaxDynamicSharedMemorySize, LDS_BYTES) != hipSuccess) { fprintf(stderr, "kernel_launch: hipFuncSetAttribute failed\n"); grid = -1; return; }
        if (hipOccupancyMaxActiveBlocksPerMultiprocessor(&per_cu, (const void*)mega, 512, LDS_BYTES) != hipSuccess || per_cu < 1) { fprintf(stderr, "kernel_launch: occupancy query says %d\n", per_cu); per_cu = 1; }
        (void)hipGetLastError();
        grid = cus * 1;
    }
    if (grid < 0) return;
    if (hipMemsetAsync(d_ws, 0, 16384, stream) != hipSuccess) { fprintf(stderr, "kernel_launch: memset failed\n"); return; }
    Params p{};
    for (int i = 0; i < 16; ++i) p.in[i] = (const float*)d_in[i];
    p.out = (float*)d_out; p.ws = (unsigned char*)d_ws;
#if ONE_LAUNCH
    p.ph_lo = 0; p.ph_hi = NPHASE;
    void* args[] = {&p};
    hipError_t e = hipLaunchCooperativeKernel((const void*)mega, dim3(grid), dim3(512), args, LDS_BYTES, stream);
    if (e != hipSuccess) fprintf(stderr, "cooperative launch failed: %s (grid %d)\n", hipGetErrorString(e), grid);
#else
    for (int ph = 0; ph < NPHASE; ++ph) {
        p.ph_lo = ph; p.ph_hi = ph + 1;
        hipLaunchKernelGGL(mega, dim3(grid), dim3(512), LDS_BYTES, stream, p);
    }
#endif
}
```

```cpp
#include <hip/hip_runtime.h>
#include <hip/hip_cooperative_groups.h>
#include <cstdio>
#include <cstdint>
namespace cg = cooperative_groups;

#ifndef ONE_LAUNCH
#define ONE_LAUNCH 1
#endif

#define LAS __attribute__((address_space(3)))
typedef unsigned short bf16_t;
typedef short bf16x8 __attribute__((ext_vector_type(8)));
typedef short s16x4 __attribute__((ext_vector_type(4)));
typedef float f32x2 __attribute__((ext_vector_type(2)));
typedef float f32x4 __attribute__((ext_vector_type(4)));
typedef float f32x16 __attribute__((ext_vector_type(16)));
typedef unsigned u32x2 __attribute__((ext_vector_type(2)));
typedef unsigned u32x4 __attribute__((ext_vector_type(4)));

constexpr int D = 1024, SEQ = 2048, NBATCH = 16, MP = NBATCH * SEQ, MS = 256, M = MP + MS;
constexpr int FF = 2816, NQKV = 4608, AW = 512, BW = 2048, NUV = 4096, PAST = 16384;
constexpr float EPS = 1e-6f;
constexpr int LDU = BW + 64;
constexpr int NPOS = SEQ + 8;
constexpr size_t O_YP = 0, O_YS = (size_t)MP * D, O_KP0 = O_YS + (size_t)MS * D, O_KP1 = O_KP0 + 2097152, O_KP2 = O_KP1 + 8388608,
                 O_KS0 = O_KP2 + 33554432, O_KS1 = O_KS0 + 262144, O_KS2 = O_KS1 + 262144, O_VS = O_KS2 + 262144;
constexpr size_t al256(size_t x) { return (x + 255) & ~(size_t)255; }
constexpr size_t WS_WIN = 1u << 20;
constexpr size_t SZ_WIN = (size_t)2 * FF * D * 2;
constexpr size_t WS_WOUT = WS_WIN + 4 * SZ_WIN;
constexpr size_t SZ_WOUT = (size_t)D * FF * 2;
constexpr size_t WS_WQKV = WS_WOUT + 4 * SZ_WOUT;
constexpr size_t WS_WOA = WS_WQKV + (size_t)NQKV * D * 2;
constexpr size_t WS_WUV = WS_WOA + (size_t)D * AW * 2;
constexpr size_t WS_WOB = WS_WUV + (size_t)NUV * D * 2;
constexpr size_t WS_WSP = WS_WOB + (size_t)D * LDU * 2;
constexpr size_t WS_ROPE = WS_WSP + (size_t)16 * 128 * 128 * 2;
constexpr size_t WS_XN = al256(WS_ROPE + (size_t)NPOS * 32 * 4 * 2);
constexpr size_t WS_BIG = al256(WS_XN + (size_t)M * D * 2);
constexpr size_t WS_OG = al256(WS_BIG + (size_t)M * NQKV * 2);
constexpr size_t WS_LSE = al256(WS_OG + (size_t)3 * M * AW * 2);
constexpr size_t WS_AO = al256(WS_LSE + (size_t)3 * M * 8 * 4);
constexpr size_t WS_UM = al256(WS_AO + (size_t)M * AW * 2);
constexpr size_t WS_RV = al256(WS_UM + (size_t)M * LDU * 2);
constexpr size_t WS_YB = al256(WS_RV + (size_t)M * 4);
constexpr size_t WS_END = al256(WS_YB + (size_t)M * D * 2);

constexpr int LDS_BYTES = 139264;
#ifdef DUMPSEL
constexpr int NPHASE = 21;
#else
constexpr int NPHASE = 23;
#endif

__device__ __forceinline__ float wave_sum(float v) {
#pragma unroll
    for (int o = 1; o < 64; o <<= 1) v += __shfl_xor(v, o);
    return v;
}
__device__ __forceinline__ float wave_max(float v) {
#pragma unroll
    for (int o = 1; o < 64; o <<= 1) v = fmaxf(v, __shfl_xor(v, o));
    return v;
}
typedef __bf16 bf16x2_t __attribute__((ext_vector_type(2)));
__device__ __forceinline__ unsigned cvt_pk_bf16(float lo, float hi) { const f32x2 v = {lo, hi}; return __builtin_bit_cast(unsigned, __builtin_convertvector(v, bf16x2_t)); }
__device__ __forceinline__ float bf_lo(unsigned w) { return __uint_as_float(w << 16); }
__device__ __forceinline__ float bf_hi(unsigned w) { return __uint_as_float(w & 0xffff0000u); }
__device__ __forceinline__ float silu_f(float x) { return x * __builtin_amdgcn_rcpf(1.0f + __expf(-x)); }
__device__ __forceinline__ float gelu_tanh_f(float x) { const float y = 0.7978845608028654f * (x + 0.044715f * x * x * x); return x * __builtin_amdgcn_rcpf(1.0f + __expf(-2.0f * y)); }

namespace pg8 {
constexpr int BM = 256, BK = 64, HALF = 128, HTB = HALF * BK * 2, STAGE_BYTES = 8 * HTB, NXCD = 8, WGM = 8;
__device__ __forceinline__ int lds_byte(int r, int c) { const int st = (r >> 4) * 2 + (c >> 5), rr = r & 15, cc = c & 31, ob = rr * 64 + cc * 2; return st * 1024 + (ob ^ (((ob >> 9) & 1) << 5)); }
__device__ __forceinline__ void stage_rc(int b, int& R, int& C) { const int st = b / 1024, sb = b % 1024, swz = sb ^ (((sb >> 9) & 1) << 5); R = (st >> 1) * 16 + swz / 64; C = (st & 1) * 32 + (swz % 64) / 2; }
__device__ __forceinline__ int perm32(int rho) { const int n = rho >> 4, i = rho & 15; return 8 * (i >> 2) + 4 * n + (i & 3); }
struct Unit { int pm, pn; };
struct StaticOrder {
    int nM, nN, nwg, G, c;
    __device__ void init(int M_, int N_, int G_, int c_) { nM = M_ / BM; nN = N_ / BM; nwg = nM * nN; G = G_; c = c_; }
    __device__ bool next(int i, Unit& u) const {
        const long L = (long)i * G + c; if (L >= nwg) return false;
        int wgid = (int)L; { const int q = nwg / NXCD, r = nwg % NXCD, xcd = wgid % NXCD, off = wgid / NXCD; wgid = (xcd < r ? xcd * (q + 1) : r * (q + 1) + (xcd - r) * q) + off; }
        const int nig = WGM * nN, gid = wgid / nig, fm = gid * WGM, gsz = (nM - fm) < WGM ? (nM - fm) : WGM;
        u.pm = fm + ((wgid % nig) % gsz); u.pn = (wgid % nig) / gsz; return true;
    }
};
template <class Epi>
__device__ __forceinline__ void gemm_phase(LAS unsigned char* lds, const bf16_t* gA, const bf16_t* gBt, int gM, int gN, int K, const Epi& E, const int tid, const int lda = 0, const int ldb = 0) {
    const int LA = lda ? lda : K, LB = ldb ? ldb : K;
    const int wid = __builtin_amdgcn_readfirstlane(tid >> 6), lane = tid & 63, wr = wid >> 2, wc = wid & 3, fr = lane & 15, fq = lane >> 4;
    const int nt = K / BK;
    StaticOrder S; S.init(gM, gN, (int)gridDim.x, (int)blockIdx.x);
    unsigned voffA[2], voffB[2];
#pragma unroll
    for (int i = 0; i < 2; ++i) { int R, C; stage_rc(tid * 16 + i * 8192, R, C); const int Rb = Epi::PERM ? ((R & ~31) + perm32(R & 31)) : R;
        voffA[i] = (unsigned)(R * LA + C) * 2u; voffB[i] = (unsigned)(Rb * LB + C) * 2u; }
    const size_t kstep = (size_t)(BK * 2);
    const size_t hstepA = (size_t)HALF * LA * 2, hstepB = (size_t)HALF * LB * 2;
    const size_t tstepA = 2 * hstepA, tstepB = 2 * hstepB;
    const unsigned ldsw = (unsigned)wid * 1024u;
    const int aoff = lds_byte(wr * 64 + fr, fq * 8), boff = lds_byte(wc * 32 + fr, fq * 8);
#define PG8_SA(b, h) (((b) * 2 + (h)) * HTB)
#define PG8_SB(b, h) ((4 + (b) * 2 + (h)) * HTB)
#define PG8_STAGE(bufoff, gbase, voff) do { _Pragma("unroll") for (int _i = 0; _i < 2; ++_i) \
        __builtin_amdgcn_global_load_lds((const unsigned*)((const char*)(gbase) + (voff)[_i]), (LAS unsigned*)(lds + (bufoff) + ldsw + _i * 8192), 16, 0, 0); } while (0)
#define PG8_LDA(dst, b, h) do { _Pragma("unroll") for (int m = 0; m < 4; ++m) _Pragma("unroll") for (int k = 0; k < 2; ++k) dst[m][k] = *(const LAS bf16x8*)(lds + PG8_SA(b, h) + aoff + m * 2048 + k * 1024); } while (0)
#define PG8_LDB(dst, b, h) do { _Pragma("unroll") for (int n = 0; n < 2; ++n) _Pragma("unroll") for (int k = 0; k < 2; ++k) dst[n][k] = *(const LAS bf16x8*)(lds + PG8_SB(b, h) + boff + n * 2048 + k * 1024); } while (0)
#define PG8_MMA(ai, bj, At, Bt) do { __builtin_amdgcn_s_setprio(1); _Pragma("unroll") for (int m = 0; m < 4; ++m) _Pragma("unroll") for (int n = 0; n < 2; ++n) _Pragma("unroll") for (int k = 0; k < 2; ++k) \
        acc[ai][bj][m][n] = __builtin_amdgcn_mfma_f32_16x16x32_bf16(Bt[n][k], At[m][k], acc[ai][bj][m][n], 0, 0, 0); __builtin_amdgcn_s_setprio(0); } while (0)
#define PG8_WAIT_V(n) asm volatile("s_waitcnt vmcnt(" #n ")" ::: "memory")
#define PG8_WAIT_L(n) asm volatile("s_waitcnt lgkmcnt(" #n ")" ::: "memory")
#define PG8_BAR __builtin_amdgcn_s_barrier()
#define PG8_SCHED __builtin_amdgcn_sched_barrier(0)
    Unit cur, nxt; int ui = 0;
    if (!S.next(0, cur)) return;
    f32x4 acc[2][2][4][2];
#pragma unroll
    for (int a = 0; a < 2; ++a)
#pragma unroll
        for (int b = 0; b < 2; ++b)
#pragma unroll
            for (int m = 0; m < 4; ++m)
#pragma unroll
                for (int n = 0; n < 2; ++n) acc[a][b][m][n] = (f32x4){0.f, 0.f, 0.f, 0.f};
    bf16x8 At[4][2], B0[2][2], B1[2][2];
    const char* cA = (const char*)gA + (size_t)cur.pm * tstepA; const char* cB = (const char*)gBt + (size_t)cur.pn * tstepB;
    PG8_STAGE(PG8_SB(0, 0), cB, voffB); PG8_STAGE(PG8_SA(0, 0), cA, voffA); PG8_STAGE(PG8_SB(0, 1), cB + hstepB, voffB); PG8_STAGE(PG8_SA(0, 1), cA + hstepA, voffA);
    if (wr == 1) PG8_BAR;
    PG8_WAIT_V(4); PG8_BAR;
    PG8_STAGE(PG8_SB(1, 0), cB + kstep, voffB); PG8_STAGE(PG8_SA(1, 0), cA + kstep, voffA); PG8_STAGE(PG8_SB(1, 1), cB + hstepB + kstep, voffB);
    PG8_WAIT_V(6); PG8_BAR;
    for (;;) {
        const bool has_next = S.next(ui + 1, nxt);
        const char* nA = has_next ? (const char*)gA + (size_t)nxt.pm * tstepA : cA; const char* nB = has_next ? (const char*)gBt + (size_t)nxt.pn * tstepB : cB;
        for (int t = 0; t < nt; t += 2) {
            const bool last = (t == nt - 2);
            const char* a1 = cA + (size_t)(t + 1) * kstep;
            const char* a2 = last ? nA : cA + (size_t)(t + 2) * kstep; const char* b2 = last ? nB : cB + (size_t)(t + 2) * kstep;
            const char* a3 = a2 + kstep; const char* b3 = b2 + kstep;
            PG8_LDB(B0, 0, 0); PG8_SCHED; PG8_LDA(At, 0, 0); PG8_STAGE(PG8_SA(1, 1), a1 + hstepA, voffA);
            PG8_WAIT_L(8); PG8_BAR; PG8_WAIT_L(0); PG8_MMA(0, 0, At, B0); PG8_BAR; PG8_SCHED;
            PG8_LDB(B1, 0, 1); PG8_STAGE(PG8_SB(0, 0), b2, voffB);
            PG8_BAR; PG8_WAIT_L(0); PG8_MMA(0, 1, At, B1); PG8_BAR;
            PG8_LDA(At, 0, 1); PG8_STAGE(PG8_SA(0, 0), a2, voffA);
            PG8_BAR; PG8_WAIT_L(0); PG8_MMA(1, 0, At, B0); PG8_BAR; PG8_SCHED;
            PG8_STAGE(PG8_SB(0, 1), b2 + hstepB, voffB);
            PG8_WAIT_V(6); PG8_BAR; PG8_MMA(1, 1, At, B1); PG8_BAR;
            PG8_LDB(B0, 1, 0); PG8_SCHED; PG8_LDA(At, 1, 0); PG8_STAGE(PG8_SA(0, 1), a2 + hstepA, voffA);
            PG8_WAIT_L(8); PG8_BAR; PG8_WAIT_L(0); PG8_MMA(0, 0, At, B0); PG8_BAR; PG8_SCHED;
            PG8_LDB(B1, 1, 1); PG8_STAGE(PG8_SB(1, 0), b3, voffB);
            PG8_BAR; PG8_WAIT_L(0); PG8_MMA(0, 1, At, B1); PG8_BAR;
            PG8_LDA(At, 1, 1); PG8_STAGE(PG8_SA(1, 0), a3, voffA);
            PG8_BAR; PG8_WAIT_L(0); PG8_MMA(1, 0, At, B0); PG8_BAR; PG8_SCHED;
            PG8_STAGE(PG8_SB(1, 1), b3 + hstepB, voffB);
            PG8_WAIT_V(6); PG8_BAR; PG8_MMA(1, 1, At, B1); PG8_BAR;
        }
        E(acc, cur, wr, wc, fr, fq);
        if (!has_next) break;
#pragma unroll
        for (int a = 0; a < 2; ++a)
#pragma unroll
            for (int b = 0; b < 2; ++b)
#pragma unroll
                for (int m = 0; m < 4; ++m)
#pragma unroll
                    for (int n = 0; n < 2; ++n) acc[a][b][m][n] = (f32x4){0.f, 0.f, 0.f, 0.f};
        cur = nxt; cA = nA; cB = nB; ++ui;
    }
    PG8_WAIT_V(0);
    if (wr == 0) PG8_BAR;
    PG8_BAR;
#undef PG8_SA
#undef PG8_SB
#undef PG8_STAGE
#undef PG8_LDA
#undef PG8_LDB
#undef PG8_MMA
#undef PG8_WAIT_V
#undef PG8_WAIT_L
#undef PG8_BAR
#undef PG8_SCHED
}

struct EpiSwiglu {
    static constexpr bool PERM = true;
    bf16_t* O;
    __device__ __forceinline__ void operator()(const f32x4 (&acc)[2][2][4][2], const Unit& u, int wr, int wc, int fr, int fq) const {
        const int row0 = u.pm * BM + wr * 64 + fr, col0 = u.pn * HALF + wc * 32 + 8 * fq;
#pragma unroll
        for (int ai = 0; ai < 2; ++ai)
#pragma unroll
            for (int m = 0; m < 4; ++m) {
                const f32x4 g0 = acc[ai][0][m][0], g1 = acc[ai][0][m][1], u0 = acc[ai][1][m][0], u1 = acc[ai][1][m][1];
                u32x4 w;
                w.x = cvt_pk_bf16(silu_f(g0[0]) * u0[0], silu_f(g0[1]) * u0[1]); w.y = cvt_pk_bf16(silu_f(g0[2]) * u0[2], silu_f(g0[3]) * u0[3]);
                w.z = cvt_pk_bf16(silu_f(g1[0]) * u1[0], silu_f(g1[1]) * u1[1]); w.w = cvt_pk_bf16(silu_f(g1[2]) * u1[2], silu_f(g1[3]) * u1[3]);
                *(u32x4*)(O + (size_t)(row0 + ai * HALF + m * 16) * FF + col0) = w;
            }
    }
};
struct EpiResid {
    static constexpr bool PERM = false;
    float* X; float s;
    __device__ __forceinline__ void operator()(const f32x4 (&acc)[2][2][4][2], const Unit& u, int wr, int wc, int fr, int fq) const {
        const int row0 = u.pm * BM + wr * 64 + fr, col0 = u.pn * BM + wc * 32 + 4 * fq;
#pragma unroll
        for (int ai = 0; ai < 2; ++ai)
#pragma unroll
            for (int m = 0; m < 4; ++m) { float* rowp = X + (size_t)(row0 + ai * HALF + m * 16) * D + col0;
#pragma unroll
                for (int bj = 0; bj < 2; ++bj)
#pragma unroll
                    for (int n = 0; n < 2; ++n) { f32x4* p = (f32x4*)(rowp + bj * HALF + n * 16); *p = *p + acc[ai][bj][m][n] * s; } }
    }
};
struct EpiFinal {
    static constexpr bool PERM = false;
    float* X; float s;
    __device__ __forceinline__ void operator()(const f32x4 (&acc)[2][2][4][2], const Unit& u, int wr, int wc, int fr, int fq) const {
        float* base = X + (size_t)(u.pm * BM + wr * 64 + fr) * D + u.pn * BM + wc * 32 + 4 * fq;
        f32x4 x[2][4];
#pragma unroll
        for (int q = 0; q < 4; ++q) x[0][q] = *(const f32x4*)(base + (q >> 1) * HALF + (q & 1) * 16);
#pragma unroll
        for (int g = 0; g < 8; ++g) {
            const int ai = g >> 2, m = g & 3;
            float* rowp = base + (size_t)(ai * HALF + m * 16) * D;
            if (g < 7) { const float* nx = base + (size_t)(((g + 1) >> 2) * HALF + ((g + 1) & 3) * 16) * D;
#pragma unroll
                for (int q = 0; q < 4; ++q) x[(g + 1) & 1][q] = *(const f32x4*)(nx + (q >> 1) * HALF + (q & 1) * 16); }
#pragma unroll
            for (int q = 0; q < 4; ++q) *(f32x4*)(rowp + (q >> 1) * HALF + (q & 1) * 16) = x[g & 1][q] + acc[ai][q >> 1][m][q & 1] * s;
        }
    }
};
template <int ACT> struct EpiBf16 {
    static constexpr bool PERM = true;
    bf16_t* O; int ldc;
    __device__ __forceinline__ void operator()(const f32x4 (&acc)[2][2][4][2], const Unit& u, int wr, int wc, int fr, int fq) const {
        const int row0 = u.pm * BM + wr * 64 + fr, col0 = u.pn * BM + wc * 32 + 8 * fq;
#pragma unroll
        for (int ai = 0; ai < 2; ++ai)
#pragma unroll
            for (int m = 0; m < 4; ++m) { bf16_t* rowp = O + (size_t)(row0 + ai * HALF + m * 16) * ldc + col0;
#pragma unroll
                for (int bj = 0; bj < 2; ++bj) { f32x4 v0 = acc[ai][bj][m][0], v1 = acc[ai][bj][m][1];
                    if (ACT == 1) {
#pragma unroll
                        for (int j = 0; j < 4; ++j) { v0[j] = gelu_tanh_f(v0[j]); v1[j] = gelu_tanh_f(v1[j]); } }
                    u32x4 w; w.x = cvt_pk_bf16(v0[0], v0[1]); w.y = cvt_pk_bf16(v0[2], v0[3]); w.z = cvt_pk_bf16(v1[0], v1[1]); w.w = cvt_pk_bf16(v1[2], v1[3]);
                    *(u32x4*)(rowp + bj * HALF) = w; } }
    }
};
}

#define MFMA32S(a, b, c) __builtin_amdgcn_mfma_f32_32x32x16_bf16((a), (b), (c), 0, 0, 0)
template <int MODE>
__device__ __forceinline__ void sample_gemm(LAS unsigned char* lds, const bf16_t* A, int lda, const bf16_t* Bt, int ldb, int K, int N, bf16_t* O, int ldc, const int tid, float* Xs = nullptr) {
    const int lane = tid & 63, wave = __builtin_amdgcn_readfirstlane(tid >> 6), hh = lane >> 5;
    const int ntiles = 8 * (N / 32), kw = K / 8;
    LAS float* red = (LAS float*)lds;
    for (int tile = blockIdx.x; tile < ntiles; tile += gridDim.x) {
        const int rt = tile & 7, ct = tile >> 3;
        const bf16_t* ap = A + (size_t)(32 * rt + (lane & 31)) * lda + wave * kw + 8 * hh;
        int brow = 32 * ct + (lane & 31);
        if (MODE == 2) { const int h0 = 32 * ct; brow = (h0 >> 7) * 256 + (h0 & 127) + (lane & 31); }
        const bf16_t* bp = Bt + (size_t)brow * ldb + wave * kw + 8 * hh;
        f32x16 c0, c1;
#pragma unroll
        for (int i = 0; i < 16; ++i) { c0[i] = 0.f; c1[i] = 0.f; }
#pragma unroll 4
        for (int k = 0; k < kw; k += 16) {
            const bf16x8 a = *(const bf16x8*)(ap + k), b = *(const bf16x8*)(bp + k);
            c0 = MFMA32S(a, b, c0);
            if (MODE == 2) { const bf16x8 b2 = *(const bf16x8*)(bp + (size_t)128 * ldb + k); c1 = MFMA32S(a, b2, c1); }
        }
        __syncthreads();
#pragma unroll
        for (int i = 0; i < 16; ++i) { red[((wave * 2 + 0) * 16 + i) * 64 + lane] = c0[i]; if (MODE == 2) red[((wave * 2 + 1) * 16 + i) * 64 + lane] = c1[i]; }
        __syncthreads();
#pragma unroll
        for (int r = 0; r < 2; ++r) {
            const int e = tid + 512 * r, i = e >> 6, l = e & 63;
            float s0 = 0.f, s1 = 0.f;
#pragma unroll
            for (int w = 0; w < 8; ++w) { s0 += red[((w * 2 + 0) * 16 + i) * 64 + l]; if (MODE == 2) s1 += red[((w * 2 + 1) * 16 + i) * 64 + l]; }
            const int row = 32 * rt + (i & 3) + 8 * (i >> 2) + 4 * (l >> 5), col = 32 * ct + (l & 31);
            const float v = MODE == 2 ? silu_f(s0) * s1 : (MODE == 1 ? gelu_tanh_f(s0) : s0);
            if (MODE == 4) Xs[(size_t)row * ldc + col] += 0.5f * s0;
            else O[(size_t)row * ldc + col] = (bf16_t)(cvt_pk_bf16(v, 0.f) & 0xffffu);
        }
    }
    __syncthreads();
}

struct Params { const float* in[16]; float* out; unsigned char* ws; int ph_lo, ph_hi; };

__device__ __forceinline__ void transpose_item(const float* W, int K, int N, bf16_t* WT, int k0, int n0, int drow0, LAS float* scr, int lane, int ldw) {
#pragma unroll 8
    for (int i = 0; i < 32; ++i) { const int kk = 2 * i + (lane >> 5); scr[kk * 33 + (lane & 31)] = W[(size_t)(k0 + kk) * N + n0 + (lane & 31)]; }
    asm volatile("s_waitcnt lgkmcnt(0)" ::: "memory");
    const int c = lane & 7;
#pragma unroll
    for (int j = 0; j < 4; ++j) { const int n = (lane >> 3) + 8 * j; const LAS float* s = scr + (8 * c) * 33 + n;
        u32x4 o; o.x = cvt_pk_bf16(s[0 * 33], s[1 * 33]); o.y = cvt_pk_bf16(s[2 * 33], s[3 * 33]); o.z = cvt_pk_bf16(s[4 * 33], s[5 * 33]); o.w = cvt_pk_bf16(s[6 * 33], s[7 * 33]);
        *(u32x4*)(WT + (size_t)(drow0 + n) * ldw + k0 + 8 * c) = o; }
    asm volatile("s_waitcnt lgkmcnt(0)" ::: "memory");
}
__device__ __forceinline__ void transpose_mat(const float* W, int K, int N, bf16_t* WT, int item, bool swiglu, LAS float* scr, int lane, int ldw = 0) {
    const int nblk = N / 32, kb = item / nblk, nb = item % nblk, n0 = 32 * nb;
    int drow0 = n0;
    if (swiglu) { const int up = n0 >= FF, nn = up ? n0 - FF : n0; drow0 = (nn >> 7) * 256 + (up ? 128 : 0) + (nn & 127); }
    transpose_item(W, K, N, WT, 64 * kb, n0, drow0, scr, lane, ldw ? ldw : K);
}
__constant__ double ROPE_INV[32] = {
    1.0, 0.7498942093324559, 0.5623413251903491, 0.4216965034285822, 0.31622776601683794, 0.23713737056616552, 0.1778279410038923, 0.1333521432163324,
    0.1, 0.07498942093324558, 0.05623413251903491, 0.042169650342858224, 0.03162277660168379, 0.023713737056616554, 0.01778279410038923, 0.01333521432163324,
    0.01, 0.007498942093324558, 0.005623413251903491, 0.004216965034285823, 0.0031622776601683794, 0.0023713737056616554, 0.0017782794100389228, 0.001333521432163324,
    0.001, 0.0007498942093324559, 0.0005623413251903491, 0.00042169650342858224, 0.00031622776601683794, 0.00023713737056616554, 0.00017782794100389227, 0.0001333521432163324};

__device__ __forceinline__ void norm_row(const float* xrow, const bf16_t* yrow, float sy, const float* g, bf16_t* orow, float* xout, int lane) {
    const f32x4* xr = (const f32x4*)xrow + lane;
    f32x4 v[4]; float ss = 0.f;
#pragma unroll
    for (int j = 0; j < 4; ++j) v[j] = xr[64 * j];
    if (yrow) {
#pragma unroll
        for (int j = 0; j < 4; ++j) { const u32x2 y = ((const u32x2*)yrow)[lane + 64 * j];
            v[j].x += sy * bf_lo(y.x); v[j].y += sy * bf_hi(y.x); v[j].z += sy * bf_lo(y.y); v[j].w += sy * bf_hi(y.y); }
    }
#pragma unroll
    for (int j = 0; j < 4; ++j) ss += (v[j].x * v[j].x + v[j].y * v[j].y) + (v[j].z * v[j].z + v[j].w * v[j].w);
    if (xout) {
#pragma unroll
        for (int j = 0; j < 4; ++j) ((f32x4*)xout)[lane + 64 * j] = v[j];
    }
    if (g) {
        const float r = 1.0f / sqrtf(wave_sum(ss) * (1.0f / D) + EPS);
#pragma unroll
        for (int j = 0; j < 4; ++j) {
            const f32x4 gg = ((const f32x4*)g)[lane + 64 * j];
            u32x2 o; o.x = cvt_pk_bf16(v[j].x * r * gg.x, v[j].y * r * gg.y); o.y = cvt_pk_bf16(v[j].z * r * gg.z, v[j].w * r * gg.w);
            ((u32x2*)orow)[lane + 64 * j] = o;
        }
    }
}

__device__ __forceinline__ void phase_prologue(const Params& p, unsigned char* ws, float* out, LAS unsigned char* lds, const int tid) {
    const int lane = tid & 63, wave = tid >> 6;
    const int gw = blockIdx.x * 8 + wave, NGW = gridDim.x * 8;
    LAS float* scr = (LAS float*)(lds + wave * 8704);
    constexpr int I_IN = (D / 64) * (2 * FF / 32), I_OUT = (FF / 64) * (D / 32), I_QKV = (D / 64) * (NQKV / 32), I_OA = (AW / 64) * (D / 32), I_UV = (D / 64) * (NUV / 32), I_OB = (BW / 64) * (D / 32);
    constexpr int NITEMS = 4 * I_IN + 4 * I_OUT + I_QKV + I_OA + I_UV + I_OB;
    for (int it = gw; it < NITEMS; it += NGW) {
        int r = it;
        if (r < 4 * I_IN) { const int w = r / I_IN; transpose_mat(p.in[6] + (size_t)w * D * 2 * FF, D, 2 * FF, (bf16_t*)(ws + WS_WIN + w * SZ_WIN), r % I_IN, true, scr, lane); continue; } r -= 4 * I_IN;
        if (r < 4 * I_OUT) { const int w = r / I_OUT; transpose_mat(p.in[7] + (size_t)w * FF * D, FF, D, (bf16_t*)(ws + WS_WOUT + w * SZ_WOUT), r % I_OUT, false, scr, lane); continue; } r -= 4 * I_OUT;
        if (r < I_QKV) { transpose_mat(p.in[8], D, NQKV, (bf16_t*)(ws + WS_WQKV), r, false, scr, lane); continue; } r -= I_QKV;
        if (r < I_OA) { transpose_mat(p.in[10], AW, D, (bf16_t*)(ws + WS_WOA), r, false, scr, lane); continue; } r -= I_OA;
        if (r < I_UV) { transpose_mat(p.in[11], D, NUV, (bf16_t*)(ws + WS_WUV), r, false, scr, lane); continue; } r -= I_UV;
        transpose_mat(p.in[15], BW, D, (bf16_t*)(ws + WS_WOB), r, false, scr, lane, LDU);
    }
    { bf16_t* wsp = (bf16_t*)(ws + WS_WSP); const float* src = p.in[13];
      for (int i = blockIdx.x * 512 + tid; i < 16 * 128 * 128 / 2; i += gridDim.x * 512) {
          const int e = 2 * i, s = e & 127, t = (e >> 7) & 127; const f32x2 v = *(const f32x2*)(src + e);
          ((unsigned*)wsp)[i] = cvt_pk_bf16(s <= t ? v.x : 0.f, (s + 1) <= t ? v.y : 0.f); } }
    { float* ct = (float*)(ws + WS_ROPE); float* st = ct + NPOS * 32;
      for (int i = blockIdx.x * 512 + tid; i < NPOS * 32; i += gridDim.x * 512) {
          const int pi = i >> 5, fi = i & 31; const double pos = (double)(pi < SEQ ? pi : PAST + (pi - SEQ));
          const double a = pos * ROPE_INV[fi]; const double n = __builtin_rint(a * 0.15915494309189535);
          const double r = (a - n * 6.283185307179586) - n * 2.4492935982947064e-16; const double r2 = r * r;
          double sn = 1.0, cs = 1.0;
#pragma unroll 1
          for (int k = 14; k >= 1; --k) { const double k2 = (double)(2 * k); sn = 1.0 - sn * r2 / (k2 * (k2 + 1.0)); cs = 1.0 - cs * r2 / ((k2 - 1.0) * k2); }
          ct[i] = (float)cs; st[i] = (float)(sn * r); } }
#ifdef NANFILL
    { u32x4* f = (u32x4*)(ws + WS_BIG); const size_t n = (WS_END - WS_BIG) / 16; const u32x4 q = {0xffffffffu, 0xffffffffu, 0xffffffffu, 0xffffffffu};
      for (size_t i = (size_t)blockIdx.x * 512 + tid; i < n; i += (size_t)gridDim.x * 512) f[i] = q;
      u32x4* fo = (u32x4*)(out + O_KP0); const size_t no = (O_VS + 524288 - O_KP0) / 4;
      for (size_t i = (size_t)blockIdx.x * 512 + tid; i < no; i += (size_t)gridDim.x * 512) fo[i] = q; }
#endif
    for (int m = gw; m < M; m += NGW) {
        const float* src = m < MP ? p.in[0] + (size_t)m * D : p.in[1] + (size_t)(m - MP) * D;
        norm_row(src, nullptr, 0.f, p.in[5], (bf16_t*)(ws + WS_XN) + (size_t)m * D, out + (size_t)m * D, lane);
    }
}

__device__ __forceinline__ void phase_norm(unsigned char* ws, float* out, const float* g, float sy, const int tid) {
    const int lane = tid & 63, wave = tid >> 6;
    const int gw = blockIdx.x * 8 + wave, NGW = gridDim.x * 8;
    for (int m = gw; m < M; m += NGW) norm_row(out + (size_t)m * D, (const bf16_t*)(ws + WS_YB) + (size_t)m * D, sy, g, (bf16_t*)(ws + WS_XN) + (size_t)m * D, out + (size_t)m * D, lane);
}

__device__ __forceinline__ void tail_store(float* out, int g, int h, int kv, int row, int i0, f32x4 a, f32x4 b) {
    float* dst;
    if (row < MP) {
        const int bb = row >> 11, t = row & 2047, keep = 128 << (2 * g), tt = t - (SEQ - keep);
        if (tt < 0) return;
        const size_t base = g == 0 ? O_KP0 : (g == 1 ? O_KP1 : O_KP2);
        dst = out + base + ((((size_t)bb * keep + tt) * 2 + kv) * 8 + h) * 64;
    } else {
        const int s = row - MP; const size_t base = g == 0 ? O_KS0 : (g == 1 ? O_KS1 : O_KS2);
        dst = out + base + (((size_t)s * 2 + kv) * 8 + h) * 64;
    }
    *(f32x4*)(dst + i0) = a; *(f32x4*)(dst + 32 + i0) = b;
}
__device__ __forceinline__ void phase_qknorm(const Params& p, unsigned char* ws, float* out, const int tid) {
    const int lane = tid & 63, wave = tid >> 6;
    const int gw = blockIdx.x * 8 + wave, NGW = gridDim.x * 8;
    bf16_t* QKV = (bf16_t*)(ws + WS_BIG);
    const float* ct = (const float*)(ws + WS_ROPE); const float* st = ct + NPOS * 32;
    const int sub = lane & 7, i0 = 4 * sub;
    for (int it = gw; it < M * 9; it += NGW) {
        const int row = it / 9, s9 = it - row * 9;
        if (s9 < 6) {
            const int head = s9 * 8 + (lane >> 3), isk = head >= 24, gh = isk ? head - 24 : head, g = gh >> 3, h = gh & 7;
            bf16_t* ptr = QKV + (size_t)row * NQKV + head * 64;
            const u32x2 ra = *(const u32x2*)(ptr + i0), rb = *(const u32x2*)(ptr + 32 + i0);
            f32x4 x1 = {bf_lo(ra.x), bf_hi(ra.x), bf_lo(ra.y), bf_hi(ra.y)}, x2 = {bf_lo(rb.x), bf_hi(rb.x), bf_lo(rb.y), bf_hi(rb.y)};
            float ss = (x1.x * x1.x + x1.y * x1.y) + (x1.z * x1.z + x1.w * x1.w) + (x2.x * x2.x + x2.y * x2.y) + (x2.z * x2.z + x2.w * x2.w);
            ss += __shfl_xor(ss, 1); ss += __shfl_xor(ss, 2); ss += __shfl_xor(ss, 4);
            const float r = 1.0f / sqrtf(ss * (1.0f / 64) + EPS);
            const float* gain = p.in[9] + isk * 64;
            const f32x4 g1 = *(const f32x4*)(gain + i0), g2 = *(const f32x4*)(gain + 32 + i0);
            const int pi = row < MP ? (row & 2047) : SEQ + ((row - MP) & 7);
            const f32x4 c = *(const f32x4*)(ct + pi * 32 + i0), s = *(const f32x4*)(st + pi * 32 + i0);
            const f32x4 y1 = x1 * r * g1, y2 = x2 * r * g2;
            const f32x4 o1 = y1 * c - y2 * s, o2 = y2 * c + y1 * s;
            u32x2 wa, wb; wa.x = cvt_pk_bf16(o1.x, o1.y); wa.y = cvt_pk_bf16(o1.z, o1.w); wb.x = cvt_pk_bf16(o2.x, o2.y); wb.y = cvt_pk_bf16(o2.z, o2.w);
            *(u32x2*)(ptr + i0) = wa; *(u32x2*)(ptr + 32 + i0) = wb;
            if (isk) tail_store(out, g, h, 0, row, i0, o1, o2);
        } else {
            const int vh = (s9 - 6) * 8 + (lane >> 3), g = vh >> 3, h = vh & 7;
            const bf16_t* ptr = QKV + (size_t)row * NQKV + 3072 + vh * 64;
            const u32x2 ra = *(const u32x2*)(ptr + i0), rb = *(const u32x2*)(ptr + 32 + i0);
            const f32x4 x1 = {bf_lo(ra.x), bf_hi(ra.x), bf_lo(ra.y), bf_hi(ra.y)}, x2 = {bf_lo(rb.x), bf_hi(rb.x), bf_lo(rb.y), bf_hi(rb.y)};
            tail_store(out, g, h, 1, row, i0, x1, x2);
        }
    }
}

#define MFMA32(a, b, c) __builtin_amdgcn_mfma_f32_32x32x16_bf16((a), (b), (c), 0, 0, 0)
__device__ __forceinline__ s16x4 tr_read(unsigned lds_addr) { return __builtin_amdgcn_ds_read_tr16_b64_v4i16((LAS s16x4*)(uintptr_t)lds_addr); }
__device__ __forceinline__ bf16x8 pack8(const f32x16& x, int s) {
    u32x4 pk;
    pk.x = cvt_pk_bf16(x[8 * s + 0], x[8 * s + 1]); pk.y = cvt_pk_bf16(x[8 * s + 2], x[8 * s + 3]); pk.z = cvt_pk_bf16(x[8 * s + 4], x[8 * s + 5]); pk.w = cvt_pk_bf16(x[8 * s + 6], x[8 * s + 7]);
    return __builtin_bit_cast(bf16x8, pk);
}
__device__ __forceinline__ void attn_prompt_tile(const bf16_t* QKV, bf16_t* OG, float* LSE, LAS unsigned char* vl, int g, int b, int h, int w, int lane) {
    const int dsh = 2 * g, d = 1 << dsh;
    const int tpr_sh = 6 - dsh;
    const int r = w >> tpr_sh, jt = w & ((1 << tpr_sh) - 1), j0 = jt * 32;
    const int q = lane & 31, hh = lane >> 5;
    const size_t rowb = (size_t)b * SEQ;
    const int qcol = g * 512 + h * 64, kcol = 1536 + qcol, vcol = 3072 + qcol;
    const int tq = ((j0 + q) << dsh) + r;
    const bf16_t* qp = QKV + (rowb + tq) * NQKV + qcol + 8 * hh;
    bf16x8 qf[4];
#pragma unroll
    for (int s = 0; s < 4; ++s) qf[s] = *(const bf16x8*)(qp + 16 * s);
    const int kb0 = jt >= 4 ? 0 : 4 - jt;
    f32x16 S[5];
    float mx = -INFINITY;
    bf16x8 kfa[5][4];
#pragma unroll
    for (int kb = 0; kb < 5; ++kb) {
        int jk = j0 - 128 + kb * 32 + q; jk = jk < 0 ? 0 : jk;
        const bf16_t* kp = QKV + (rowb + (size_t)((jk << dsh) + r)) * NQKV + kcol + 8 * hh;
#pragma unroll
        for (int s = 0; s < 4; ++s) kfa[kb][s] = *(const bf16x8*)(kp + 16 * s);
    }
#pragma unroll
    for (int kb = 0; kb < 5; ++kb) {
        f32x16 c;
#pragma unroll
        for (int i = 0; i < 16; ++i) c[i] = 0.f;
#pragma unroll
        for (int s = 0; s < 4; ++s) c = MFMA32(kfa[kb][s], qf[s], c);
#pragma unroll
        for (int i = 0; i < 16; ++i) {
            const int ki = (i & 3) + 8 * (i >> 2) + 4 * hh;
            bool valid = kb >= kb0;
            if (kb == 0) valid = valid && (ki >= q);
            if (kb == 4) valid = valid && (ki <= q);
            const float sv = valid ? c[i] * 0.125f : -INFINITY;
            c[i] = sv; mx = fmaxf(mx, sv);
        }
        S[kb] = c;
    }
    bf16x8 vva[5][4];
#pragma unroll
    for (int kb = 0; kb < 5; ++kb)
#pragma unroll
        for (int c4 = 0; c4 < 4; ++c4) {
            const int i = c4 * 8 + (lane >> 3); int jk = j0 - 128 + kb * 32 + i; jk = jk < 0 ? 0 : jk;
            vva[kb][c4] = *(const bf16x8*)(QKV + (rowb + (size_t)((jk << dsh) + r)) * NQKV + vcol + (lane & 7) * 8);
        }
    mx = fmaxf(mx, __shfl_xor(mx, 32));
    float l = 0.f;
#pragma unroll
    for (int kb = 0; kb < 5; ++kb)
#pragma unroll
        for (int i = 0; i < 16; ++i) { const float e = __expf(S[kb][i] - mx); S[kb][i] = e; l += e; }
    l += __shfl_xor(l, 32);
    const float inv = 1.0f / l;
    f32x16 o0, o1;
#pragma unroll
    for (int i = 0; i < 16; ++i) { o0[i] = 0.f; o1[i] = 0.f; }
    const unsigned vbase = (unsigned)(uintptr_t)vl;
    const unsigned tr_off = (unsigned)((4 * hh + ((lane & 15) >> 2)) * 144 + ((lane >> 4) & 1) * 32 + 8 * (lane & 3));
#pragma unroll
    for (int kb = 0; kb < 5; ++kb) {
        {
#pragma unroll
            for (int c4 = 0; c4 < 4; ++c4) *(LAS bf16x8*)(vl + (c4 * 8 + (lane >> 3)) * 144 + (lane & 7) * 16) = vva[kb][c4];
#pragma unroll
            for (int s2 = 0; s2 < 2; ++s2) {
                f32x16 pn = S[kb];
#pragma unroll
                for (int i = 0; i < 16; ++i) pn[i] *= inv;
                const bf16x8 pb = pack8(pn, s2);
#pragma unroll
                for (int nb = 0; nb < 2; ++nb) {
                    const unsigned a0 = vbase + tr_off + (unsigned)(16 * s2 * 144 + nb * 64);
                    const s16x4 lo = tr_read(a0), hi = tr_read(a0 + 8 * 144);
                    const bf16x8 va = __builtin_shufflevector(lo, hi, 0, 1, 2, 3, 4, 5, 6, 7);
                    if (nb == 0) o0 = MFMA32(va, pb, o0); else o1 = MFMA32(va, pb, o1);
                }
            }
        }
    }
    const size_t orow = (size_t)g * M + rowb + tq;
    bf16_t* op = OG + orow * AW + h * 64 + 4 * hh;
#pragma unroll
    for (int g4 = 0; g4 < 4; ++g4) {
        u32x2 w0, w1;
        w0.x = cvt_pk_bf16(o0[4 * g4], o0[4 * g4 + 1]); w0.y = cvt_pk_bf16(o0[4 * g4 + 2], o0[4 * g4 + 3]);
        w1.x = cvt_pk_bf16(o1[4 * g4], o1[4 * g4 + 1]); w1.y = cvt_pk_bf16(o1[4 * g4 + 2], o1[4 * g4 + 3]);
        *(u32x2*)(op + 8 * g4) = w0; *(u32x2*)(op + 32 + 8 * g4) = w1;
    }
    if (hh == 0) LSE[orow * 8 + h] = mx + __logf(l);
}
__device__ __forceinline__ void attn_sample_item(const Params& p, unsigned char* ws, int item, LAS float* sc, int lane) {
    const int j = item & 7, h = (item >> 3) & 7, gb = item >> 6, g = gb % 3, b = gb / 3;
    const int dsh = 2 * g, L = 128 << dsh;
    const float* cache = (g == 0 ? p.in[2] : (g == 1 ? p.in[3] : p.in[4])) + (size_t)b * L * 1024;
    const bf16_t* QKV = (const bf16_t*)(ws + WS_BIG);
    const int row = MP + b * 8 + j;
    const int sub = lane & 15, ks = lane >> 4;
    const int qcol = g * 512 + h * 64 + 4 * sub;
    const u32x2 qr = *(const u32x2*)(QKV + (size_t)row * NQKV + qcol);
    const f32x4 qv = {bf_lo(qr.x), bf_hi(qr.x), bf_lo(qr.y), bf_hi(qr.y)};
#pragma unroll 11
    for (int it = 0; it < 33; ++it) {
        const int i = it * 4 + ks;
        float dot = 0.f;
        if (i <= 128) {
            const int idx = L + j - (i << dsh);
            f32x4 kv;
            if (idx >= L) { const u32x2 kr = *(const u32x2*)(QKV + (size_t)(MP + b * 8 + (idx - L)) * NQKV + 1536 + qcol); kv = (f32x4){bf_lo(kr.x), bf_hi(kr.x), bf_lo(kr.y), bf_hi(kr.y)}; }
            else kv = *(const f32x4*)(cache + (size_t)idx * 1024 + h * 64 + 4 * sub);
            dot = (qv.x * kv.x + qv.y * kv.y) + (qv.z * kv.z + qv.w * kv.w);
        }
        dot += __shfl_xor(dot, 1); dot += __shfl_xor(dot, 2); dot += __shfl_xor(dot, 4); dot += __shfl_xor(dot, 8);
        if (sub == 0 && i <= 128) sc[i] = dot * 0.125f;
    }
    asm volatile("s_waitcnt lgkmcnt(0)" ::: "memory");
    float mx = fmaxf(sc[lane], sc[lane + 64]); if (lane == 0) mx = fmaxf(mx, sc[128]);
    mx = wave_max(mx);
    float l = __expf(sc[lane] - mx) + __expf(sc[lane + 64] - mx); if (lane == 0) l += __expf(sc[128] - mx);
    l = wave_sum(l);
    const float inv = 1.0f / l;
    f32x4 acc = {0.f, 0.f, 0.f, 0.f};
#pragma unroll 11
    for (int it = 0; it < 33; ++it) {
        const int i = it * 4 + ks;
        if (i <= 128) {
            const float pw = __expf(sc[i] - mx) * inv;
            const int idx = L + j - (i << dsh);
            f32x4 vv;
            if (idx >= L) { const u32x2 vr = *(const u32x2*)(QKV + (size_t)(MP + b * 8 + (idx - L)) * NQKV + 3072 + qcol); vv = (f32x4){bf_lo(vr.x), bf_hi(vr.x), bf_lo(vr.y), bf_hi(vr.y)}; }
            else vv = *(const f32x4*)(cache + (size_t)idx * 1024 + 512 + h * 64 + 4 * sub);
            acc += vv * pw;
        }
    }
#pragma unroll
    for (int k = 0; k < 4; ++k) { acc[k] += __shfl_xor(acc[k], 16); acc[k] += __shfl_xor(acc[k], 32); }
    const size_t orow = (size_t)g * M + row;
    if (ks == 0) { u32x2 w; w.x = cvt_pk_bf16(acc.x, acc.y); w.y = cvt_pk_bf16(acc.z, acc.w); *(u32x2*)((bf16_t*)(ws + WS_OG) + orow * AW + h * 64 + 4 * sub) = w; }
    if (lane == 0) ((float*)(ws + WS_LSE))[orow * 8 + h] = mx + __logf(l);
    asm volatile("s_waitcnt lgkmcnt(0)" ::: "memory");
}
__device__ __forceinline__ void phase_attn(const Params& p, unsigned char* ws, LAS unsigned char* lds, const int tid) {
    const int lane = tid & 63, wave = __builtin_amdgcn_readfirstlane(tid >> 6);
    LAS unsigned char* vl = lds + wave * 4608;
    constexpr int NS = 768, NP = 3072;
    for (int bi = blockIdx.x; bi < NS + NP; bi += gridDim.x) {
        if (bi < NS) attn_sample_item(p, ws, bi * 8 + wave, (LAS float*)vl, lane);
        else {
            const int x = bi - NS, w8 = x & 7, h = (x >> 3) & 7, b = (x >> 6) & 15, g = x >> 10;
            attn_prompt_tile((const bf16_t*)(ws + WS_BIG), (bf16_t*)(ws + WS_OG), (float*)(ws + WS_LSE), vl, g, b, h, w8 * 8 + wave, lane);
        }
    }
}
__device__ __forceinline__ void phase_merge(unsigned char* ws, const int tid) {
    const bf16_t* OG = (const bf16_t*)(ws + WS_OG); const float* LSE = (const float*)(ws + WS_LSE); bf16_t* AO = (bf16_t*)(ws + WS_AO);
    for (int e = blockIdx.x * 512 + tid; e < M * 64; e += gridDim.x * 512) {
        const int rh = e >> 3, c8 = e & 7;
        const float l0 = LSE[rh], l1 = LSE[(size_t)M * 8 + rh], l2 = LSE[(size_t)2 * M * 8 + rh];
        const float mx = fmaxf(l0, fmaxf(l1, l2));
        float w0 = __expf(l0 - mx), w1 = __expf(l1 - mx), w2 = __expf(l2 - mx); const float inv = 1.0f / (w0 + w1 + w2); w0 *= inv; w1 *= inv; w2 *= inv;
        const size_t off = (size_t)rh * 64 + c8 * 8;
        const u32x4 a = *(const u32x4*)(OG + off), b = *(const u32x4*)(OG + (size_t)M * AW + off), c = *(const u32x4*)(OG + (size_t)2 * M * AW + off);
        u32x4 o;
#pragma unroll
        for (int k = 0; k < 4; ++k) o[k] = cvt_pk_bf16(w0 * bf_lo(a[k]) + w1 * bf_lo(b[k]) + w2 * bf_lo(c[k]), w0 * bf_hi(a[k]) + w1 * bf_hi(b[k]) + w2 * bf_hi(c[k]));
        *(u32x4*)(AO + off) = o;
    }
}

__device__ __forceinline__ void phase_vnorm(const Params& p, unsigned char* ws, float* out, const int tid) {
    const int lane = tid & 63, wave = tid >> 6;
    const int gw = blockIdx.x * 8 + wave, NGW = gridDim.x * 8;
    const bf16_t* UV = (const bf16_t*)(ws + WS_BIG); float* RV = (float*)(ws + WS_RV);
    for (int m = gw; m < M; m += NGW) {
        const u32x4* vr = (const u32x4*)(UV + (size_t)m * NUV + BW) + lane;
        u32x4 v[4]; float ss = 0.f;
#pragma unroll
        for (int j = 0; j < 4; ++j) { v[j] = vr[64 * j];
#pragma unroll
            for (int k = 0; k < 4; ++k) { const float a = bf_lo(v[j][k]), b = bf_hi(v[j][k]); ss += a * a + b * b; } }
        const float r = 1.0f / sqrtf(wave_sum(ss) * (1.0f / BW) + EPS);
        if (lane == 0) RV[m] = r;
        if (m >= MP) {
            float* dst = out + O_VS + (size_t)(m - MP) * BW;
#pragma unroll
            for (int j = 0; j < 4; ++j) { const int c0 = 8 * (lane + 64 * j); const f32x4 ga = *(const f32x4*)(p.in[12] + c0), gb = *(const f32x4*)(p.in[12] + c0 + 4);
                *(f32x4*)(dst + c0) = (f32x4){bf_lo(v[j][0]) * r * ga.x, bf_hi(v[j][0]) * r * ga.y, bf_lo(v[j][1]) * r * ga.z, bf_hi(v[j][1]) * r * ga.w};
                *(f32x4*)(dst + c0 + 4) = (f32x4){bf_lo(v[j][2]) * r * gb.x, bf_hi(v[j][2]) * r * gb.y, bf_lo(v[j][3]) * r * gb.z, bf_hi(v[j][3]) * r * gb.w}; }
        }
    }
}
__device__ __forceinline__ void spatial_tile(const Params& p, unsigned char* ws, LAS unsigned char* vl, int chunk, int gi, int tb, int ch, int lane) {
    const bf16_t* UV = (const bf16_t*)(ws + WS_BIG); const float* RV = (const float*)(ws + WS_RV); bf16_t* UM = (bf16_t*)(ws + WS_UM);
    const bf16_t* WSP = (const bf16_t*)(ws + WS_WSP);
    const int hh = lane >> 5;
    const int colb = gi * 128 + 64 * ch;
    const f32x4 ga = *(const f32x4*)(p.in[12] + colb + (lane & 7) * 8), gb = *(const f32x4*)(p.in[12] + colb + (lane & 7) * 8 + 4);
    f32x16 a0, a1;
#pragma unroll
    for (int i = 0; i < 16; ++i) { a0[i] = 0.f; a1[i] = 0.f; }
    const int t = 32 * tb + (lane & 31);
    const bf16_t* wp = WSP + ((size_t)gi * 128 + t) * 128 + 8 * hh;
    const unsigned vbase = (unsigned)(uintptr_t)vl;
    const unsigned tr_off = (unsigned)((8 * hh + ((lane & 15) >> 2)) * 144 + ((lane >> 4) & 1) * 32 + 8 * (lane & 3));
    bf16x8 wfa[8];
#pragma unroll
    for (int ks = 0; ks < 8; ++ks) wfa[ks] = *(const bf16x8*)(wp + 16 * ks);
    u32x4 rawa[4][4]; float rva[4][4];
#pragma unroll
    for (int sb = 0; sb < 4; ++sb)
#pragma unroll
        for (int c4 = 0; c4 < 4; ++c4) {
            const int srow = chunk * 128 + 32 * sb + c4 * 8 + (lane >> 3);
            rawa[sb][c4] = *(const u32x4*)(UV + (size_t)srow * NUV + BW + colb + (lane & 7) * 8);
            rva[sb][c4] = RV[srow];
        }
#pragma unroll
    for (int sb = 0; sb < 4; ++sb) {
        if (sb <= tb) {
        u32x4 raw[4]; float rv[4];
#pragma unroll
        for (int c4 = 0; c4 < 4; ++c4) { raw[c4] = rawa[sb][c4]; rv[c4] = rva[sb][c4]; }
#pragma unroll
        for (int c4 = 0; c4 < 4; ++c4) {
            const float r = rv[c4]; u32x4 o;
            o.x = cvt_pk_bf16(bf_lo(raw[c4].x) * r * ga.x, bf_hi(raw[c4].x) * r * ga.y); o.y = cvt_pk_bf16(bf_lo(raw[c4].y) * r * ga.z, bf_hi(raw[c4].y) * r * ga.w);
            o.z = cvt_pk_bf16(bf_lo(raw[c4].z) * r * gb.x, bf_hi(raw[c4].z) * r * gb.y); o.w = cvt_pk_bf16(bf_lo(raw[c4].w) * r * gb.z, bf_hi(raw[c4].w) * r * gb.w);
            *(LAS u32x4*)(vl + (c4 * 8 + (lane >> 3)) * 144 + (lane & 7) * 16) = o;
        }
#pragma unroll
        for (int s2 = 0; s2 < 2; ++s2) {
            const bf16x8 wf = wfa[2 * sb + s2];
#pragma unroll
            for (int cb = 0; cb < 2; ++cb) {
                const unsigned a = vbase + tr_off + (unsigned)(16 * s2 * 144 + cb * 64);
                const s16x4 lo = tr_read(a), hi = tr_read(a + 4 * 144);
                const bf16x8 va = __builtin_shufflevector(lo, hi, 0, 1, 2, 3, 4, 5, 6, 7);
                if (cb == 0) a0 = MFMA32(va, wf, a0); else a1 = MFMA32(va, wf, a1);
            }
        }
        }
    }
    const size_t row = (size_t)chunk * 128 + t;
    const float bias = p.in[14][gi * 128 + t];
    const bf16_t* up = UV + row * NUV + colb + 4 * hh;
    bf16_t* op = UM + row * LDU + colb + 4 * hh;
#pragma unroll
    for (int cb = 0; cb < 2; ++cb)
#pragma unroll
        for (int g4 = 0; g4 < 4; ++g4) {
            const u32x2 ur = *(const u32x2*)(up + 32 * cb + 8 * g4);
            const f32x16& a = cb == 0 ? a0 : a1;
            u32x2 w;
            w.x = cvt_pk_bf16(bf_lo(ur.x) * (a[4 * g4] + bias), bf_hi(ur.x) * (a[4 * g4 + 1] + bias));
            w.y = cvt_pk_bf16(bf_lo(ur.y) * (a[4 * g4 + 2] + bias), bf_hi(ur.y) * (a[4 * g4 + 3] + bias));
            *(u32x2*)(op + 32 * cb + 8 * g4) = w;
        }
}
__device__ __forceinline__ void phase_spatial(const Params& p, unsigned char* ws, LAS unsigned char* lds, const int tid) {
    const int lane = tid & 63, wave = __builtin_amdgcn_readfirstlane(tid >> 6);
    const bf16_t* UV = (const bf16_t*)(ws + WS_BIG); const float* RV = (const float*)(ws + WS_RV); bf16_t* UM = (bf16_t*)(ws + WS_UM);
    const float* vgain = p.in[12]; const float* bsp = p.in[14];
    constexpr int NPI = 256 * 16, NSI = 256;
    LAS unsigned char* vl = lds + wave * 4608;
    for (int it = blockIdx.x; it < NPI + NSI; it += gridDim.x) {
        if (it < NPI) spatial_tile(p, ws, vl, it >> 4, it & 15, wave & 3, wave >> 2, lane);
        else {
            const int e = (it - NPI) * 512 + tid;
            const int c4 = e & 511, bt = e >> 9, t = bt & 7, b = bt >> 3, c0 = 4 * c4, gi = c0 >> 7;
            f32x4 acc = {0.f, 0.f, 0.f, 0.f};
            const f32x4 vg = *(const f32x4*)(vgain + c0);
            for (int s = 0; s <= t; ++s) {
                const size_t r = (size_t)MP + b * 8 + s;
                const u32x2 vr = *(const u32x2*)(UV + r * NUV + BW + c0);
                const float wv = p.in[13][((size_t)gi * 128 + t) * 128 + s] * RV[r];
                acc += (f32x4){bf_lo(vr.x), bf_hi(vr.x), bf_lo(vr.y), bf_hi(vr.y)} * wv;
            }
            const float bias = bsp[gi * 128 + t];
            const size_t r = (size_t)MP + b * 8 + t;
            const u32x2 ur = *(const u32x2*)(UV + r * NUV + c0);
            u32x2 w;
            w.x = cvt_pk_bf16(bf_lo(ur.x) * (acc.x * vg.x + bias), bf_hi(ur.x) * (acc.y * vg.y + bias));
            w.y = cvt_pk_bf16(bf_lo(ur.y) * (acc.z * vg.z + bias), bf_hi(ur.y) * (acc.w * vg.w + bias));
            *(u32x2*)(UM + r * LDU + c0) = w;
        }
    }
}

constexpr int BAR_WORDS = 64 * 18;
__device__ __forceinline__ void grid_barrier(unsigned* bar, const int tid, volatile LAS unsigned* ctl) {
    asm volatile("s_waitcnt vmcnt(0) lgkmcnt(0)" ::: "memory");
    __syncthreads();
    if (tid == 0) {
        const unsigned x = (unsigned)__builtin_amdgcn_s_getreg((3 << 11) | 20) & 7u, nloc = ctl[0], nx = ctl[1];
        if (__hip_atomic_fetch_add(bar + 64 * x, 1u, __ATOMIC_RELAXED, __HIP_MEMORY_SCOPE_AGENT) == nloc - 1u) {
            __builtin_amdgcn_fence(__ATOMIC_RELEASE, "agent");
            asm volatile("s_waitcnt vmcnt(0)" ::: "memory");
            if (__hip_atomic_fetch_add(bar + 64 * 8, 1u, __ATOMIC_RELAXED, __HIP_MEMORY_SCOPE_AGENT) == nx - 1u) __hip_atomic_store(bar + 64 * 9, 1u, __ATOMIC_RELAXED, __HIP_MEMORY_SCOPE_AGENT);
            else while (__hip_atomic_load(bar + 64 * 9, __ATOMIC_RELAXED, __HIP_MEMORY_SCOPE_AGENT) == 0u) __builtin_amdgcn_s_sleep(1);
            __builtin_amdgcn_fence(__ATOMIC_ACQUIRE, "agent");
            __hip_atomic_store(bar + 64 * (10 + x), 1u, __ATOMIC_RELAXED, __HIP_MEMORY_SCOPE_AGENT);
            asm volatile("s_waitcnt vmcnt(0)" ::: "memory");
        } else {
            while (__hip_atomic_load(bar + 64 * (10 + x), __ATOMIC_RELAXED, __HIP_MEMORY_SCOPE_AGENT) == 0u) __builtin_amdgcn_s_sleep(1);
            __builtin_amdgcn_fence(__ATOMIC_ACQUIRE, "agent");
            asm volatile("s_waitcnt vmcnt(0)" ::: "memory");
        }
    }
    __syncthreads();
}

__global__ void __launch_bounds__(512, 2) mega(Params p) {
    extern __shared__ __attribute__((aligned(16))) unsigned char lds_raw[];
    LAS unsigned char* lds = (LAS unsigned char*)lds_raw;
    for (int ph = p.ph_lo; ph < p.ph_hi; ++ph) {
        int tid = threadIdx.x; asm volatile("" : "+v"(tid));
        unsigned z; asm volatile("s_mov_b32 %0, 0" : "=s"(z));
        unsigned char* ws = p.ws + z; float* out = p.out + z;
        bf16_t* XN = (bf16_t*)(ws + WS_XN); bf16_t* BIG = (bf16_t*)(ws + WS_BIG);
        bf16_t* YB = (bf16_t*)(ws + WS_YB);
        int fi = -1, fo = -1, ni = -1; float sy = 0.5f;
        switch (ph) {
            case 1: fi = 0; break; case 10: fi = 1; break; case 13: fi = 2; break; case 21: fi = 3; break;
            case 2: fo = 0; break; case 11: fo = 1; break; case 14: fo = 2; break; case 22: fo = 3; break;
            case 3: ni = 1; break; case 9: ni = 2; sy = 1.0f; break; case 12: ni = 3; break; case 15: ni = 4; break; case 20: ni = 5; sy = 1.0f; break; case 23: ni = 6; break;
            default: break;
        }
#ifndef PMASK
#define PMASK 0xFFFF
#endif
        if ((PMASK & 1) && ph == 0) phase_prologue(p, ws, out, lds, tid);
        else if ((PMASK & 2) && fi >= 0) { const bf16_t* W = (const bf16_t*)(ws + WS_WIN + fi * SZ_WIN); sample_gemm<2>(lds, XN + (size_t)MP * D, D, W, D, D, FF, BIG + (size_t)MP * FF, FF, tid);
            pg8::EpiSwiglu E{BIG}; pg8::gemm_phase(lds, XN, W, MP, 2 * FF, D, E, tid); }
        else if (ph == 22) {
            const bf16_t* B = (const bf16_t*)(ws + WS_WOUT + 3 * SZ_WOUT);
            sample_gemm<4>(lds, BIG + (size_t)MP * FF, FF, B, FF, FF, D, nullptr, D, tid, out + (size_t)MP * D);
            pg8::EpiFinal E{out, 0.5f}; pg8::gemm_phase(lds, BIG, B, MP, D, FF, E, tid); }
        else if ((PMASK & 4) && (fo >= 0 || ph == 8 || ph == 19)) {
            const bf16_t* A = BIG; const bf16_t* B = (const bf16_t*)(ws + WS_WOUT + (fo < 0 ? 0 : fo) * SZ_WOUT); int K = FF, ld = FF;
            if (ph == 8) { A = (const bf16_t*)(ws + WS_AO); B = (const bf16_t*)(ws + WS_WOA); K = AW; ld = AW; }
            if (ph == 19) { A = (const bf16_t*)(ws + WS_UM); B = (const bf16_t*)(ws + WS_WOB); K = BW; ld = LDU; }
            sample_gemm<0>(lds, A + (size_t)MP * ld, ld, B, ld, K, D, YB + (size_t)MP * D, D, tid);
            pg8::EpiBf16<0> E{YB, D}; pg8::gemm_phase(lds, A, B, MP, D, K, E, tid, ld, ld); }
#ifdef DUMPSEL
        else if (ph == 20) {
            const bf16_t* wsp = (const bf16_t*)(ws + WS_WSP); const float* rvp = (const float*)(ws + WS_RV);
            for (size_t e = (size_t)blockIdx.x * 512 + tid; e < (size_t)M * D; e += (size_t)gridDim.x * 512) { const size_t r = e / D, c = e % D;
                out[e] = (DUMPSEL == 10) ? p.in[12][(c + r) % 2048] * p.in[14][(c * 3 + r) % 2048] * (1.0f + p.in[13][(r * 1024 + c) % 262144]) : (DUMPSEL == 2) ? (r >= (size_t)MP ? 0.f : 1.f) * __uint_as_float((unsigned)((const bf16_t*)(ws + WS_UM))[r * LDU + c] << 16) : (DUMPSEL == 8) ? (r < 256 ? __uint_as_float((unsigned)wsp[r * 1024 + c] << 16) : 0.f) : rvp[r]; }
        }
#endif
        else if ((PMASK & 8) && ni >= 0) phase_norm(ws, out, ni < 6 ? p.in[5] + ni * D : nullptr, sy, tid);
        else if ((PMASK & 16) && ph == 4) { sample_gemm<0>(lds, XN + (size_t)MP * D, D, (const bf16_t*)(ws + WS_WQKV), D, D, NQKV, BIG + (size_t)MP * NQKV, NQKV, tid);
            pg8::EpiBf16<0> E{BIG, NQKV}; pg8::gemm_phase(lds, XN, (const bf16_t*)(ws + WS_WQKV), MP, NQKV, D, E, tid); }
        else if ((PMASK & 32) && ph == 5) phase_qknorm(p, ws, out, tid);
        else if ((PMASK & 64) && ph == 6) phase_attn(p, ws, lds, tid);
        else if ((PMASK & 128) && ph == 7) phase_merge(ws, tid);
        else if ((PMASK & 512) && ph == 16) { sample_gemm<1>(lds, XN + (size_t)MP * D, D, (const bf16_t*)(ws + WS_WUV), D, D, NUV, BIG + (size_t)MP * NUV, NUV, tid);
            pg8::EpiBf16<1> E{BIG, NUV}; pg8::gemm_phase(lds, XN, (const bf16_t*)(ws + WS_WUV), MP, NUV, D, E, tid); }
        else if ((PMASK & 1024) && ph == 17) phase_vnorm(p, ws, out, tid);
        else if ((PMASK & 2048) && ph == 18) phase_spatial(p, ws, lds, tid);
        if (ph + 1 < p.ph_hi) {
            volatile LAS unsigned* ctl = (volatile LAS unsigned*)(lds + 135168);
            if (ph == 0) {
                const unsigned x = (unsigned)__builtin_amdgcn_s_getreg((3 << 11) | 20) & 7u;
                if (tid == 0) __hip_atomic_fetch_add((unsigned*)p.ws + 64 * x, 1u, __ATOMIC_RELAXED, __HIP_MEMORY_SCOPE_AGENT);
                __syncthreads(); cg::this_grid().sync();
                if (tid == 0) { unsigned nx = 0;
                    for (int j = 0; j < 8; ++j) nx += __hip_atomic_load((unsigned*)p.ws + 64 * j, __ATOMIC_RELAXED, __HIP_MEMORY_SCOPE_AGENT) != 0u;
                    ctl[0] = __hip_atomic_load((unsigned*)p.ws + 64 * x, __ATOMIC_RELAXED, __HIP_MEMORY_SCOPE_AGENT); ctl[1] = nx; }
                __syncthreads();
            }
            else grid_barrier((unsigned*)p.ws + (size_t)BAR_WORDS * ph, tid, ctl);
        }
    }
}

extern "C" void kernel_launch(void* const* d_in, const int* in_sizes, int n_in, void* d_out, int out_size, void* d_ws, size_t ws_size, hipStream_t stream) {
    static int grid = 0;
    if (grid == 0) {
        if (n_in != 16 || ws_size < WS_END) { fprintf(stderr, "kernel_launch: unexpected inputs (n_in %d, ws %zu < %zu)\n", n_in, ws_size, (size_t)WS_END); grid = -1; return; }
        int dev = 0, cus = 0, per_cu = 0;
        (void)hipGetDevice(&dev);
        (void)hipDeviceGetAttribute(&cus, hipDeviceAttributeMultiprocessorCount, dev);
        if (hipFuncSetAttribute((const void*)mega, hipFuncAttributeMaxDynamicSharedMemorySize, LDS_BYTES) != hipSuccess) { fprintf(stderr, "kernel_launch: hipFuncSetAttribute failed\n"); grid = -1; return; }
        if (hipOccupancyMaxActiveBlocksPerMultiprocessor(&per_cu, (const void*)mega, 512, LDS_BYTES) != hipSuccess || per_cu < 1) { fprintf(stderr, "kernel_launch: occupancy query says %d\n", per_cu); per_cu = 1; }
        (void)hipGetLastError();
        grid = cus * 1;
    }
    if (grid < 0) return;
    if (hipMemsetAsync(d_ws, 0, 262144, stream) != hipSuccess) { fprintf(stderr, "kernel_launch: memset failed\n"); return; }
    Params p{};
    for (int i = 0; i < 16; ++i) p.in[i] = (const float*)d_in[i];
    p.out = (float*)d_out; p.ws = (unsigned char*)d_ws;
#if ONE_LAUNCH
    p.ph_lo = 0; p.ph_hi = NPHASE;
    void* args[] = {&p};
    hipError_t e = hipLaunchCooperativeKernel((const void*)mega, dim3(grid), dim3(512), args, LDS_BYTES, stream);
    if (e != hipSuccess) fprintf(stderr, "cooperative launch failed: %s (grid %d)\n", hipGetErrorString(e), grid);
#else
    for (int ph = 0; ph < NPHASE; ++ph) {
        p.ph_lo = ph; p.ph_hi = ph + 1;
        hipLaunchKernelGGL(mega, dim3(grid), dim3(512), LDS_BYTES, stream, p);
    }
#endif
}
```

```cpp
#include <hip/hip_runtime.h>
#include <hip/hip_cooperative_groups.h>
#include <cstdio>
#include <cstdint>
namespace cg = cooperative_groups;

#ifndef ONE_LAUNCH
#define ONE_LAUNCH 1
#endif

#define LAS __attribute__((address_space(3)))
typedef unsigned short bf16_t;
typedef short bf16x8 __attribute__((ext_vector_type(8)));
typedef short s16x4 __attribute__((ext_vector_type(4)));
typedef float f32x2 __attribute__((ext_vector_type(2)));
typedef float f32x4 __attribute__((ext_vector_type(4)));
typedef float f32x16 __attribute__((ext_vector_type(16)));
typedef unsigned u32x2 __attribute__((ext_vector_type(2)));
typedef unsigned u32x4 __attribute__((ext_vector_type(4)));

constexpr int D = 1024, SEQ = 2048, NBATCH = 16, MP = NBATCH * SEQ, MS = 256, M = MP + MS;
constexpr int FF = 2816, NQKV = 4608, AW = 512, BW = 2048, NUV = 4096, PAST = 16384;
constexpr float EPS = 1e-6f;
constexpr int LDU = BW + 64;
constexpr int NPOS = SEQ + 8;
constexpr size_t O_YP = 0, O_YS = (size_t)MP * D, O_KP0 = O_YS + (size_t)MS * D, O_KP1 = O_KP0 + 2097152, O_KP2 = O_KP1 + 8388608,
                 O_KS0 = O_KP2 + 33554432, O_KS1 = O_KS0 + 262144, O_KS2 = O_KS1 + 262144, O_VS = O_KS2 + 262144;
constexpr size_t al256(size_t x) { return (x + 255) & ~(size_t)255; }
constexpr size_t WS_WIN = 1u << 20;
constexpr size_t SZ_WIN = (size_t)2 * FF * D * 2;
constexpr size_t WS_WOUT = WS_WIN + 4 * SZ_WIN;
constexpr size_t SZ_WOUT = (size_t)D * FF * 2;
constexpr size_t WS_WQKV = WS_WOUT + 4 * SZ_WOUT;
constexpr size_t WS_WOA = WS_WQKV + (size_t)NQKV * D * 2;
constexpr size_t WS_WUV = WS_WOA + (size_t)D * AW * 2;
constexpr size_t WS_WOB = WS_WUV + (size_t)NUV * D * 2;
constexpr size_t WS_WSP = WS_WOB + (size_t)D * LDU * 2;
constexpr size_t WS_ROPE = WS_WSP + (size_t)16 * 128 * 128 * 2;
constexpr size_t WS_XN = al256(WS_ROPE + (size_t)NPOS * 32 * 4 * 2);
constexpr size_t WS_BIG = al256(WS_XN + (size_t)M * D * 2);
constexpr size_t WS_OG = al256(WS_BIG + (size_t)M * NQKV * 2);
constexpr size_t WS_LSE = al256(WS_OG + (size_t)3 * M * AW * 2);
constexpr size_t WS_AO = al256(WS_LSE + (size_t)3 * M * 8 * 4);
constexpr size_t WS_UM = al256(WS_AO + (size_t)M * AW * 2);
constexpr size_t WS_RV = al256(WS_UM + (size_t)M * LDU * 2);
constexpr size_t WS_YB = al256(WS_RV + (size_t)M * 4);
constexpr size_t WS_END = al256(WS_YB + (size_t)M * D * 2);

constexpr int LDS_BYTES = 139264;
#ifdef DUMPSEL
constexpr int NPHASE = 21;
#else
constexpr int NPHASE = 23;
#endif

__device__ __forceinline__ float wave_sum(float v) {
#pragma unroll
    for (int o = 1; o < 64; o <<= 1) v += __shfl_xor(v, o);
    return v;
}
__device__ __forceinline__ float wave_max(float v) {
#pragma unroll
    for (int o = 1; o < 64; o <<= 1) v = fmaxf(v, __shfl_xor(v, o));
    return v;
}
typedef __bf16 bf16x2_t __attribute__((ext_vector_type(2)));
__device__ __forceinline__ unsigned cvt_pk_bf16(float lo, float hi) { const f32x2 v = {lo, hi}; return __builtin_bit_cast(unsigned, __builtin_convertvector(v, bf16x2_t)); }
__device__ __forceinline__ float bf_lo(unsigned w) { return __uint_as_float(w << 16); }
__device__ __forceinline__ float bf_hi(unsigned w) { return __uint_as_float(w & 0xffff0000u); }
__device__ __forceinline__ float silu_f(float x) { return x * __builtin_amdgcn_rcpf(1.0f + __expf(-x)); }
__device__ __forceinline__ float gelu_tanh_f(float x) { const float y = 0.7978845608028654f * (x + 0.044715f * x * x * x); return x * __builtin_amdgcn_rcpf(1.0f + __expf(-2.0f * y)); }

namespace pg8 {
constexpr int BM = 256, BK = 64, HALF = 128, HTB = HALF * BK * 2, STAGE_BYTES = 8 * HTB, NXCD = 8, WGM = 8;
__device__ __forceinline__ int lds_byte(int r, int c) { const int st = (r >> 4) * 2 + (c >> 5), rr = r & 15, cc = c & 31, ob = rr * 64 + cc * 2; return st * 1024 + (ob ^ (((ob >> 9) & 1) << 5)); }
__device__ __forceinline__ void stage_rc(int b, int& R, int& C) { const int st = b / 1024, sb = b % 1024, swz = sb ^ (((sb >> 9) & 1) << 5); R = (st >> 1) * 16 + swz / 64; C = (st & 1) * 32 + (swz % 64) / 2; }
__device__ __forceinline__ int perm32(int rho) { const int n = rho >> 4, i = rho & 15; return 8 * (i >> 2) + 4 * n + (i & 3); }
struct Unit { int pm, pn; };
struct StaticOrder {
    int nM, nN, nwg, G, c;
    __device__ void init(int M_, int N_, int G_, int c_) { nM = M_ / BM; nN = N_ / BM; nwg = nM * nN; G = G_; c = c_; }
    __device__ bool next(int i, Unit& u) const {
        const long L = (long)i * G + c; if (L >= nwg) return false;
        int wgid = (int)L; { const int q = nwg / NXCD, r = nwg % NXCD, xcd = wgid % NXCD, off = wgid / NXCD; wgid = (xcd < r ? xcd * (q + 1) : r * (q + 1) + (xcd - r) * q) + off; }
        const int nig = WGM * nN, gid = wgid / nig, fm = gid * WGM, gsz = (nM - fm) < WGM ? (nM - fm) : WGM;
        u.pm = fm + ((wgid % nig) % gsz); u.pn = (wgid % nig) / gsz; return true;
    }
};
template <class Epi>
__device__ __forceinline__ void gemm_phase(LAS unsigned char* lds, const bf16_t* gA, const bf16_t* gBt, int gM, int gN, int K, const Epi& E, const int tid, const int lda = 0, const int ldb = 0) {
    const int LA = lda ? lda : K, LB = ldb ? ldb : K;
    const int wid = __builtin_amdgcn_readfirstlane(tid >> 6), lane = tid & 63, wr = wid >> 2, wc = wid & 3, fr = lane & 15, fq = lane >> 4;
    const int nt = K / BK;
    StaticOrder S; S.init(gM, gN, (int)gridDim.x, (int)blockIdx.x);
    unsigned voffA[2], voffB[2];
#pragma unroll
    for (int i = 0; i < 2; ++i) { int R, C; stage_rc(tid * 16 + i * 8192, R, C); const int Rb = Epi::PERM ? ((R & ~31) + perm32(R & 31)) : R;
        voffA[i] = (unsigned)(R * LA + C) * 2u; voffB[i] = (unsigned)(Rb * LB + C) * 2u; }
    const size_t kstep = (size_t)(BK * 2);
    const size_t hstepA = (size_t)HALF * LA * 2, hstepB = (size_t)HALF * LB * 2;
    const size_t tstepA = 2 * hstepA, tstepB = 2 * hstepB;
    const unsigned ldsw = (unsigned)wid * 1024u;
    const int aoff = lds_byte(wr * 64 + fr, fq * 8), boff = lds_byte(wc * 32 + fr, fq * 8);
#define PG8_SA(b, h) (((b) * 2 + (h)) * HTB)
#define PG8_SB(b, h) ((4 + (b) * 2 + (h)) * HTB)
#define PG8_STAGE(bufoff, gbase, voff) do { _Pragma("unroll") for (int _i = 0; _i < 2; ++_i) \
        __builtin_amdgcn_global_load_lds((const unsigned*)((const char*)(gbase) + (voff)[_i]), (LAS unsigned*)(lds + (bufoff) + ldsw + _i * 8192), 16, 0, 0); } while (0)
#define PG8_LDA(dst, b, h) do { _Pragma("unroll") for (int m = 0; m < 4; ++m) _Pragma("unroll") for (int k = 0; k < 2; ++k) dst[m][k] = *(const LAS bf16x8*)(lds + PG8_SA(b, h) + aoff + m * 2048 + k * 1024); } while (0)
#define PG8_LDB(dst, b, h) do { _Pragma("unroll") for (int n = 0; n < 2; ++n) _Pragma("unroll") for (int k = 0; k < 2; ++k) dst[n][k] = *(const LAS bf16x8*)(lds + PG8_SB(b, h) + boff + n * 2048 + k * 1024); } while (0)
#define PG8_MMA(ai, bj, At, Bt) do { __builtin_amdgcn_s_setprio(1); _Pragma("unroll") for (int m = 0; m < 4; ++m) _Pragma("unroll") for (int n = 0; n < 2; ++n) _Pragma("unroll") for (int k = 0; k < 2; ++k) \
        acc[ai][bj][m][n] = __builtin_amdgcn_mfma_f32_16x16x32_bf16(Bt[n][k], At[m][k], acc[ai][bj][m][n], 0, 0, 0); __builtin_amdgcn_s_setprio(0); } while (0)
#define PG8_WAIT_V(n) asm volatile("s_waitcnt vmcnt(" #n ")" ::: "memory")
#define PG8_WAIT_L(n) asm volatile("s_waitcnt lgkmcnt(" #n ")" ::: "memory")
#define PG8_BAR __builtin_amdgcn_s_barrier()
#define PG8_SCHED __builtin_amdgcn_sched_barrier(0)
    Unit cur, nxt; int ui = 0;
    if (!S.next(0, cur)) return;
    f32x4 acc[2][2][4][2];
#pragma unroll
    for (int a = 0; a < 2; ++a)
#pragma unroll
        for (int b = 0; b < 2; ++b)
#pragma unroll
            for (int m = 0; m < 4; ++m)
#pragma unroll
                for (int n = 0; n < 2; ++n) acc[a][b][m][n] = (f32x4){0.f, 0.f, 0.f, 0.f};
    bf16x8 At[4][2], B0[2][2], B1[2][2];
    const char* cA = (const char*)gA + (size_t)cur.pm * tstepA; const char* cB = (const char*)gBt + (size_t)cur.pn * tstepB;
    PG8_STAGE(PG8_SB(0, 0), cB, voffB); PG8_STAGE(PG8_SB(0, 1), cB + hstepB, voffB); PG8_STAGE(PG8_SA(0, 0), cA, voffA); PG8_STAGE(PG8_SA(0, 1), cA + hstepA, voffA);
    if (wr == 1) PG8_BAR;
    PG8_WAIT_V(2); PG8_BAR;
    PG8_STAGE(PG8_SB(1, 0), cB + kstep, voffB); PG8_STAGE(PG8_SA(1, 0), cA + kstep, voffA); PG8_STAGE(PG8_SB(1, 1), cB + hstepB + kstep, voffB);
    PG8_WAIT_V(6); PG8_BAR;
    for (;;) {
        const bool has_next = S.next(ui + 1, nxt);
        const char* nA = has_next ? (const char*)gA + (size_t)nxt.pm * tstepA : cA; const char* nB = has_next ? (const char*)gBt + (size_t)nxt.pn * tstepB : cB;
        for (int t = 0; t < nt; t += 2) {
            const bool last = (t == nt - 2);
            const char* a1 = cA + (size_t)(t + 1) * kstep;
            const char* a2 = last ? nA : cA + (size_t)(t + 2) * kstep; const char* b2 = last ? nB : cB + (size_t)(t + 2) * kstep;
            const char* a3 = a2 + kstep; const char* b3 = b2 + kstep;
            PG8_LDB(B0, 0, 0); PG8_LDB(B1, 0, 1); PG8_SCHED; PG8_LDA(At, 0, 0); PG8_STAGE(PG8_SA(1, 1), a1 + hstepA, voffA);
            PG8_WAIT_V(8); PG8_WAIT_L(0); PG8_BAR; PG8_MMA(0, 0, At, B0); PG8_MMA(0, 1, At, B1); PG8_BAR; PG8_SCHED;
            PG8_LDA(At, 0, 1); PG8_STAGE(PG8_SB(0, 0), b2, voffB); PG8_STAGE(PG8_SB(0, 1), b2 + hstepB, voffB); PG8_STAGE(PG8_SA(0, 0), a2, voffA);
            PG8_WAIT_V(8); PG8_WAIT_L(0); PG8_BAR; PG8_MMA(1, 0, At, B0); PG8_MMA(1, 1, At, B1); PG8_BAR; PG8_SCHED;
            PG8_LDB(B0, 1, 0); PG8_LDB(B1, 1, 1); PG8_SCHED; PG8_LDA(At, 1, 0); PG8_STAGE(PG8_SA(0, 1), a2 + hstepA, voffA);
            PG8_WAIT_V(8); PG8_WAIT_L(0); PG8_BAR; PG8_MMA(0, 0, At, B0); PG8_MMA(0, 1, At, B1); PG8_BAR; PG8_SCHED;
            PG8_LDA(At, 1, 1); PG8_STAGE(PG8_SB(1, 0), b3, voffB); PG8_STAGE(PG8_SB(1, 1), b3 + hstepB, voffB); PG8_STAGE(PG8_SA(1, 0), a3, voffA);
            PG8_WAIT_V(8); PG8_WAIT_L(0); PG8_BAR; PG8_MMA(1, 0, At, B0); PG8_MMA(1, 1, At, B1); PG8_BAR; PG8_SCHED;
        }
        if (wr == 0) PG8_BAR;
        E(acc, cur, wr, wc, fr, fq);
        if (!has_next) break;
#pragma unroll
        for (int a = 0; a < 2; ++a)
#pragma unroll
            for (int b = 0; b < 2; ++b)
#pragma unroll
                for (int m = 0; m < 4; ++m)
#pragma unroll
                    for (int n = 0; n < 2; ++n) acc[a][b][m][n] = (f32x4){0.f, 0.f, 0.f, 0.f};
        cur = nxt; cA = nA; cB = nB; ++ui;
        if (wr == 1) PG8_BAR;
    }
    PG8_WAIT_V(0);
    PG8_BAR;
#undef PG8_SA
#undef PG8_SB
#undef PG8_STAGE
#undef PG8_LDA
#undef PG8_LDB
#undef PG8_MMA
#undef PG8_WAIT_V
#undef PG8_WAIT_L
#undef PG8_BAR
#undef PG8_SCHED
}

struct EpiSwiglu {
    static constexpr bool PERM = true;
    bf16_t* O;
    __device__ __forceinline__ void operator()(const f32x4 (&acc)[2][2][4][2], const Unit& u, int wr, int wc, int fr, int fq) const {
        const int row0 = u.pm * BM + wr * 64 + fr, col0 = u.pn * HALF + wc * 32 + 8 * fq;
#pragma unroll
        for (int ai = 0; ai < 2; ++ai)
#pragma unroll
            for (int m = 0; m < 4; ++m) {
                const f32x4 g0 = acc[ai][0][m][0], g1 = acc[ai][0][m][1], u0 = acc[ai][1][m][0], u1 = acc[ai][1][m][1];
                u32x4 w;
                w.x = cvt_pk_bf16(silu_f(g0[0]) * u0[0], silu_f(g0[1]) * u0[1]); w.y = cvt_pk_bf16(silu_f(g0[2]) * u0[2], silu_f(g0[3]) * u0[3]);
                w.z = cvt_pk_bf16(silu_f(g1[0]) * u1[0], silu_f(g1[1]) * u1[1]); w.w = cvt_pk_bf16(silu_f(g1[2]) * u1[2], silu_f(g1[3]) * u1[3]);
                *(u32x4*)(O + (size_t)(row0 + ai * HALF + m * 16) * FF + col0) = w;
            }
    }
};
struct EpiResid {
    static constexpr bool PERM = false;
    float* X; float s;
    __device__ __forceinline__ void operator()(const f32x4 (&acc)[2][2][4][2], const Unit& u, int wr, int wc, int fr, int fq) const {
        const int row0 = u.pm * BM + wr * 64 + fr, col0 = u.pn * BM + wc * 32 + 4 * fq;
#pragma unroll
        for (int ai = 0; ai < 2; ++ai)
#pragma unroll
            for (int m = 0; m < 4; ++m) { float* rowp = X + (size_t)(row0 + ai * HALF + m * 16) * D + col0;
#pragma unroll
                for (int bj = 0; bj < 2; ++bj)
#pragma unroll
                    for (int n = 0; n < 2; ++n) { f32x4* p = (f32x4*)(rowp + bj * HALF + n * 16); *p = *p + acc[ai][bj][m][n] * s; } }
    }
};
struct EpiFinal {
    static constexpr bool PERM = false;
    float* X; float s;
    __device__ __forceinline__ void operator()(const f32x4 (&acc)[2][2][4][2], const Unit& u, int wr, int wc, int fr, int fq) const {
        float* base = X + (size_t)(u.pm * BM + wr * 64 + fr) * D + u.pn * BM + wc * 32 + 4 * fq;
        f32x4 x[2][4];
#pragma unroll
        for (int q = 0; q < 4; ++q) x[0][q] = *(const f32x4*)(base + (q >> 1) * HALF + (q & 1) * 16);
#pragma unroll
        for (int g = 0; g < 8; ++g) {
            const int ai = g >> 2, m = g & 3;
            float* rowp = base + (size_t)(ai * HALF + m * 16) * D;
            if (g < 7) { const float* nx = base + (size_t)(((g + 1) >> 2) * HALF + ((g + 1) & 3) * 16) * D;
#pragma unroll
                for (int q = 0; q < 4; ++q) x[(g + 1) & 1][q] = *(const f32x4*)(nx + (q >> 1) * HALF + (q & 1) * 16); }
#pragma unroll
            for (int q = 0; q < 4; ++q) *(f32x4*)(rowp + (q >> 1) * HALF + (q & 1) * 16) = x[g & 1][q] + acc[ai][q >> 1][m][q & 1] * s;
        }
    }
};
template <int ACT> struct EpiBf16 {
    static constexpr bool PERM = true;
    bf16_t* O; int ldc;
    __device__ __forceinline__ void operator()(const f32x4 (&acc)[2][2][4][2], const Unit& u, int wr, int wc, int fr, int fq) const {
        const int row0 = u.pm * BM + wr * 64 + fr, col0 = u.pn * BM + wc * 32 + 8 * fq;
#pragma unroll
        for (int ai = 0; ai < 2; ++ai)
#pragma unroll
            for (int m = 0; m < 4; ++m) { bf16_t* rowp = O + (size_t)(row0 + ai * HALF + m * 16) * ldc + col0;
#pragma unroll
                for (int bj = 0; bj < 2; ++bj) { f32x4 v0 = acc[ai][bj][m][0], v1 = acc[ai][bj][m][1];
                    if (ACT == 1) {
#pragma unroll
                        for (int j = 0; j < 4; ++j) { v0[j] = gelu_tanh_f(v0[j]); v1[j] = gelu_tanh_f(v1[j]); } }
                    u32x4 w; w.x = cvt_pk_bf16(v0[0], v0[1]); w.y = cvt_pk_bf16(v0[2], v0[3]); w.z = cvt_pk_bf16(v1[0], v1[1]); w.w = cvt_pk_bf16(v1[2], v1[3]);
                    *(u32x4*)(rowp + bj * HALF) = w; } }
    }
};
}

#define MFMA32S(a, b, c) __builtin_amdgcn_mfma_f32_32x32x16_bf16((a), (b), (c), 0, 0, 0)
template <int MODE>
__device__ __forceinline__ void sample_gemm(LAS unsigned char* lds, const bf16_t* A, int lda, const bf16_t* Bt, int ldb, int K, int N, bf16_t* O, int ldc, const int tid, float* Xs = nullptr) {
    const int lane = tid & 63, wave = __builtin_amdgcn_readfirstlane(tid >> 6), hh = lane >> 5;
    const int ntiles = 8 * (N / 32), kw = K / 8;
    LAS float* red = (LAS float*)lds;
    for (int tile = blockIdx.x; tile < ntiles; tile += gridDim.x) {
        const int rt = tile & 7, ct = tile >> 3;
        const bf16_t* ap = A + (size_t)(32 * rt + (lane & 31)) * lda + wave * kw + 8 * hh;
        int brow = 32 * ct + (lane & 31);
        if (MODE == 2) { const int h0 = 32 * ct; brow = (h0 >> 7) * 256 + (h0 & 127) + (lane & 31); }
        const bf16_t* bp = Bt + (size_t)brow * ldb + wave * kw + 8 * hh;
        f32x16 c0, c1;
#pragma unroll
        for (int i = 0; i < 16; ++i) { c0[i] = 0.f; c1[i] = 0.f; }
#pragma unroll 4
        for (int k = 0; k < kw; k += 16) {
            const bf16x8 a = *(const bf16x8*)(ap + k), b = *(const bf16x8*)(bp + k);
            c0 = MFMA32S(a, b, c0);
            if (MODE == 2) { const bf16x8 b2 = *(const bf16x8*)(bp + (size_t)128 * ldb + k); c1 = MFMA32S(a, b2, c1); }
        }
        __syncthreads();
#pragma unroll
        for (int i = 0; i < 16; ++i) { red[((wave * 2 + 0) * 16 + i) * 64 + lane] = c0[i]; if (MODE == 2) red[((wave * 2 + 1) * 16 + i) * 64 + lane] = c1[i]; }
        __syncthreads();
#pragma unroll
        for (int r = 0; r < 2; ++r) {
            const int e = tid + 512 * r, i = e >> 6, l = e & 63;
            float s0 = 0.f, s1 = 0.f;
#pragma unroll
            for (int w = 0; w < 8; ++w) { s0 += red[((w * 2 + 0) * 16 + i) * 64 + l]; if (MODE == 2) s1 += red[((w * 2 + 1) * 16 + i) * 64 + l]; }
            const int row = 32 * rt + (i & 3) + 8 * (i >> 2) + 4 * (l >> 5), col = 32 * ct + (l & 31);
            const float v = MODE == 2 ? silu_f(s0) * s1 : (MODE == 1 ? gelu_tanh_f(s0) : s0);
            if (MODE == 4) Xs[(size_t)row * ldc + col] += 0.5f * s0;
            else O[(size_t)row * ldc + col] = (bf16_t)(cvt_pk_bf16(v, 0.f) & 0xffffu);
        }
    }
    __syncthreads();
}

struct Params { const float* in[16]; float* out; unsigned char* ws; int ph_lo, ph_hi; };

__device__ __forceinline__ void transpose_item(const float* W, int K, int N, bf16_t* WT, int k0, int n0, int drow0, LAS float* scr, int lane, int ldw) {
#pragma unroll 8
    for (int i = 0; i < 32; ++i) { const int kk = 2 * i + (lane >> 5); scr[kk * 33 + (lane & 31)] = W[(size_t)(k0 + kk) * N + n0 + (lane & 31)]; }
    asm volatile("s_waitcnt lgkmcnt(0)" ::: "memory");
    const int c = lane & 7;
#pragma unroll
    for (int j = 0; j < 4; ++j) { const int n = (lane >> 3) + 8 * j; const LAS float* s = scr + (8 * c) * 33 + n;
        u32x4 o; o.x = cvt_pk_bf16(s[0 * 33], s[1 * 33]); o.y = cvt_pk_bf16(s[2 * 33], s[3 * 33]); o.z = cvt_pk_bf16(s[4 * 33], s[5 * 33]); o.w = cvt_pk_bf16(s[6 * 33], s[7 * 33]);
        *(u32x4*)(WT + (size_t)(drow0 + n) * ldw + k0 + 8 * c) = o; }
    asm volatile("s_waitcnt lgkmcnt(0)" ::: "memory");
}
__device__ __forceinline__ void transpose_mat(const float* W, int K, int N, bf16_t* WT, int item, bool swiglu, LAS float* scr, int lane, int ldw = 0) {
    const int nblk = N / 32, kb = item / nblk, nb = item % nblk, n0 = 32 * nb;
    int drow0 = n0;
    if (swiglu) { const int up = n0 >= FF, nn = up ? n0 - FF : n0; drow0 = (nn >> 7) * 256 + (up ? 128 : 0) + (nn & 127); }
    transpose_item(W, K, N, WT, 64 * kb, n0, drow0, scr, lane, ldw ? ldw : K);
}
__constant__ double ROPE_INV[32] = {
    1.0, 0.7498942093324559, 0.5623413251903491, 0.4216965034285822, 0.31622776601683794, 0.23713737056616552, 0.1778279410038923, 0.1333521432163324,
    0.1, 0.07498942093324558, 0.05623413251903491, 0.042169650342858224, 0.03162277660168379, 0.023713737056616554, 0.01778279410038923, 0.01333521432163324,
    0.01, 0.007498942093324558, 0.005623413251903491, 0.004216965034285823, 0.0031622776601683794, 0.0023713737056616554, 0.0017782794100389228, 0.001333521432163324,
    0.001, 0.0007498942093324559, 0.0005623413251903491, 0.00042169650342858224, 0.00031622776601683794, 0.00023713737056616554, 0.00017782794100389227, 0.0001333521432163324};

__device__ __forceinline__ void norm_row(const float* xrow, const bf16_t* yrow, float sy, const float* g, bf16_t* orow, float* xout, int lane) {
    const f32x4* xr = (const f32x4*)xrow + lane;
    f32x4 v[4]; float ss = 0.f;
#pragma unroll
    for (int j = 0; j < 4; ++j) v[j] = xr[64 * j];
    if (yrow) {
#pragma unroll
        for (int j = 0; j < 4; ++j) { const u32x2 y = ((const u32x2*)yrow)[lane + 64 * j];
            v[j].x += sy * bf_lo(y.x); v[j].y += sy * bf_hi(y.x); v[j].z += sy * bf_lo(y.y); v[j].w += sy * bf_hi(y.y); }
    }
#pragma unroll
    for (int j = 0; j < 4; ++j) ss += (v[j].x * v[j].x + v[j].y * v[j].y) + (v[j].z * v[j].z + v[j].w * v[j].w);
    if (xout) {
#pragma unroll
        for (int j = 0; j < 4; ++j) ((f32x4*)xout)[lane + 64 * j] = v[j];
    }
    if (g) {
        const float r = 1.0f / sqrtf(wave_sum(ss) * (1.0f / D) + EPS);
#pragma unroll
        for (int j = 0; j < 4; ++j) {
            const f32x4 gg = ((const f32x4*)g)[lane + 64 * j];
            u32x2 o; o.x = cvt_pk_bf16(v[j].x * r * gg.x, v[j].y * r * gg.y); o.y = cvt_pk_bf16(v[j].z * r * gg.z, v[j].w * r * gg.w);
            ((u32x2*)orow)[lane + 64 * j] = o;
        }
    }
}

__device__ __forceinline__ void phase_prologue(const Params& p, unsigned char* ws, float* out, LAS unsigned char* lds, const int tid) {
    const int lane = tid & 63, wave = tid >> 6;
    const int gw = blockIdx.x * 8 + wave, NGW = gridDim.x * 8;
    LAS float* scr = (LAS float*)(lds + wave * 8704);
    constexpr int I_IN = (D / 64) * (2 * FF / 32), I_OUT = (FF / 64) * (D / 32), I_QKV = (D / 64) * (NQKV / 32), I_OA = (AW / 64) * (D / 32), I_UV = (D / 64) * (NUV / 32), I_OB = (BW / 64) * (D / 32);
    constexpr int NITEMS = 4 * I_IN + 4 * I_OUT + I_QKV + I_OA + I_UV + I_OB;
    for (int it = gw; it < NITEMS; it += NGW) {
        int r = it;
        if (r < 4 * I_IN) { const int w = r / I_IN; transpose_mat(p.in[6] + (size_t)w * D * 2 * FF, D, 2 * FF, (bf16_t*)(ws + WS_WIN + w * SZ_WIN), r % I_IN, true, scr, lane); continue; } r -= 4 * I_IN;
        if (r < 4 * I_OUT) { const int w = r / I_OUT; transpose_mat(p.in[7] + (size_t)w * FF * D, FF, D, (bf16_t*)(ws + WS_WOUT + w * SZ_WOUT), r % I_OUT, false, scr, lane); continue; } r -= 4 * I_OUT;
        if (r < I_QKV) { transpose_mat(p.in[8], D, NQKV, (bf16_t*)(ws + WS_WQKV), r, false, scr, lane); continue; } r -= I_QKV;
        if (r < I_OA) { transpose_mat(p.in[10], AW, D, (bf16_t*)(ws + WS_WOA), r, false, scr, lane); continue; } r -= I_OA;
        if (r < I_UV) { transpose_mat(p.in[11], D, NUV, (bf16_t*)(ws + WS_WUV), r, false, scr, lane); continue; } r -= I_UV;
        transpose_mat(p.in[15], BW, D, (bf16_t*)(ws + WS_WOB), r, false, scr, lane, LDU);
    }
    { bf16_t* wsp = (bf16_t*)(ws + WS_WSP); const float* src = p.in[13];
      for (int i = blockIdx.x * 512 + tid; i < 16 * 128 * 128 / 2; i += gridDim.x * 512) {
          const int e = 2 * i, s = e & 127, t = (e >> 7) & 127; const f32x2 v = *(const f32x2*)(src + e);
          ((unsigned*)wsp)[i] = cvt_pk_bf16(s <= t ? v.x : 0.f, (s + 1) <= t ? v.y : 0.f); } }
    { float* ct = (float*)(ws + WS_ROPE); float* st = ct + NPOS * 32;
      for (int i = blockIdx.x * 512 + tid; i < NPOS * 32; i += gridDim.x * 512) {
          const int pi = i >> 5, fi = i & 31; const double pos = (double)(pi < SEQ ? pi : PAST + (pi - SEQ));
          const double a = pos * ROPE_INV[fi]; const double n = __builtin_rint(a * 0.15915494309189535);
          const double r = (a - n * 6.283185307179586) - n * 2.4492935982947064e-16; const double r2 = r * r;
          double sn = 1.0, cs = 1.0;
#pragma unroll 1
          for (int k = 14; k >= 1; --k) { const double k2 = (double)(2 * k); sn = 1.0 - sn * r2 / (k2 * (k2 + 1.0)); cs = 1.0 - cs * r2 / ((k2 - 1.0) * k2); }
          ct[i] = (float)cs; st[i] = (float)(sn * r); } }
#ifdef NANFILL
    { u32x4* f = (u32x4*)(ws + WS_BIG); const size_t n = (WS_END - WS_BIG) / 16; const u32x4 q = {0xffffffffu, 0xffffffffu, 0xffffffffu, 0xffffffffu};
      for (size_t i = (size_t)blockIdx.x * 512 + tid; i < n; i += (size_t)gridDim.x * 512) f[i] = q;
      u32x4* fo = (u32x4*)(out + O_KP0); const size_t no = (O_VS + 524288 - O_KP0) / 4;
      for (size_t i = (size_t)blockIdx.x * 512 + tid; i < no; i += (size_t)gridDim.x * 512) fo[i] = q; }
#endif
    for (int m = gw; m < M; m += NGW) {
        const float* src = m < MP ? p.in[0] + (size_t)m * D : p.in[1] + (size_t)(m - MP) * D;
        norm_row(src, nullptr, 0.f, p.in[5], (bf16_t*)(ws + WS_XN) + (size_t)m * D, out + (size_t)m * D, lane);
    }
}

__device__ __forceinline__ void phase_norm(unsigned char* ws, float* out, const float* g, float sy, const int tid) {
    const int lane = tid & 63, wave = tid >> 6;
    const int gw = blockIdx.x * 8 + wave, NGW = gridDim.x * 8;
    const bf16_t* YB = (const bf16_t*)(ws + WS_YB); bf16_t* XN = (bf16_t*)(ws + WS_XN);
    for (int m0 = gw; m0 < M; m0 += 2 * NGW) {
        const int m1 = m0 + NGW; const bool two = m1 < M; const int mb = two ? m1 : m0;
        f32x4 va[4], vb[4]; u32x2 ya[4], yb[4];
#pragma unroll
        for (int j = 0; j < 4; ++j) { va[j] = ((const f32x4*)(out + (size_t)m0 * D))[lane + 64 * j]; vb[j] = ((const f32x4*)(out + (size_t)mb * D))[lane + 64 * j]; }
#pragma unroll
        for (int j = 0; j < 4; ++j) { ya[j] = ((const u32x2*)(YB + (size_t)m0 * D))[lane + 64 * j]; yb[j] = ((const u32x2*)(YB + (size_t)mb * D))[lane + 64 * j]; }
        float sa = 0.f, sb = 0.f;
#pragma unroll
        for (int j = 0; j < 4; ++j) {
            va[j].x += sy * bf_lo(ya[j].x); va[j].y += sy * bf_hi(ya[j].x); va[j].z += sy * bf_lo(ya[j].y); va[j].w += sy * bf_hi(ya[j].y);
            vb[j].x += sy * bf_lo(yb[j].x); vb[j].y += sy * bf_hi(yb[j].x); vb[j].z += sy * bf_lo(yb[j].y); vb[j].w += sy * bf_hi(yb[j].y);
            sa += (va[j].x * va[j].x + va[j].y * va[j].y) + (va[j].z * va[j].z + va[j].w * va[j].w);
            sb += (vb[j].x * vb[j].x + vb[j].y * vb[j].y) + (vb[j].z * vb[j].z + vb[j].w * vb[j].w);
        }
#pragma unroll
        for (int j = 0; j < 4; ++j) { ((f32x4*)(out + (size_t)m0 * D))[lane + 64 * j] = va[j]; if (two) ((f32x4*)(out + (size_t)m1 * D))[lane + 64 * j] = vb[j]; }
        if (g) {
            const float ra = 1.0f / sqrtf(wave_sum(sa) * (1.0f / D) + EPS), rb = 1.0f / sqrtf(wave_sum(sb) * (1.0f / D) + EPS);
#pragma unroll
            for (int j = 0; j < 4; ++j) {
                const f32x4 gg = ((const f32x4*)g)[lane + 64 * j];
                u32x2 o; o.x = cvt_pk_bf16(va[j].x * ra * gg.x, va[j].y * ra * gg.y); o.y = cvt_pk_bf16(va[j].z * ra * gg.z, va[j].w * ra * gg.w);
                ((u32x2*)(XN + (size_t)m0 * D))[lane + 64 * j] = o;
                if (two) { u32x2 o2; o2.x = cvt_pk_bf16(vb[j].x * rb * gg.x, vb[j].y * rb * gg.y); o2.y = cvt_pk_bf16(vb[j].z * rb * gg.z, vb[j].w * rb * gg.w);
                    ((u32x2*)(XN + (size_t)m1 * D))[lane + 64 * j] = o2; }
            }
        }
    }
}

__device__ __forceinline__ void tail_store(float* out, int g, int h, int kv, int row, int i0, f32x4 a, f32x4 b) {
    float* dst;
    if (row < MP) {
        const int bb = row >> 11, t = row & 2047, keep = 128 << (2 * g), tt = t - (SEQ - keep);
        if (tt < 0) return;
        const size_t base = g == 0 ? O_KP0 : (g == 1 ? O_KP1 : O_KP2);
        dst = out + base + ((((size_t)bb * keep + tt) * 2 + kv) * 8 + h) * 64;
    } else {
        const int s = row - MP; const size_t base = g == 0 ? O_KS0 : (g == 1 ? O_KS1 : O_KS2);
        dst = out + base + (((size_t)s * 2 + kv) * 8 + h) * 64;
    }
    *(f32x4*)(dst + i0) = a; *(f32x4*)(dst + 32 + i0) = b;
}
__device__ __forceinline__ void phase_qknorm(const Params& p, unsigned char* ws, float* out, const int tid) {
    const int lane = tid & 63, wave = tid >> 6;
    const int gw = blockIdx.x * 8 + wave, NGW = gridDim.x * 8;
    bf16_t* QKV = (bf16_t*)(ws + WS_BIG);
    const float* ct = (const float*)(ws + WS_ROPE); const float* st = ct + NPOS * 32;
    const int sub = lane & 7, i0 = 4 * sub;
    for (int it = gw; it < M * 9; it += NGW) {
        const int row = it / 9, s9 = it - row * 9;
        if (s9 < 6) {
            const int head = s9 * 8 + (lane >> 3), isk = head >= 24, gh = isk ? head - 24 : head, g = gh >> 3, h = gh & 7;
            bf16_t* ptr = QKV + (size_t)row * NQKV + head * 64;
            const u32x2 ra = *(const u32x2*)(ptr + i0), rb = *(const u32x2*)(ptr + 32 + i0);
            f32x4 x1 = {bf_lo(ra.x), bf_hi(ra.x), bf_lo(ra.y), bf_hi(ra.y)}, x2 = {bf_lo(rb.x), bf_hi(rb.x), bf_lo(rb.y), bf_hi(rb.y)};
            float ss = (x1.x * x1.x + x1.y * x1.y) + (x1.z * x1.z + x1.w * x1.w) + (x2.x * x2.x + x2.y * x2.y) + (x2.z * x2.z + x2.w * x2.w);
            ss += __shfl_xor(ss, 1); ss += __shfl_xor(ss, 2); ss += __shfl_xor(ss, 4);
            const float r = 1.0f / sqrtf(ss * (1.0f / 64) + EPS);
            const float* gain = p.in[9] + isk * 64;
            const f32x4 g1 = *(const f32x4*)(gain + i0), g2 = *(const f32x4*)(gain + 32 + i0);
            const int pi = row < MP ? (row & 2047) : SEQ + ((row - MP) & 7);
            const f32x4 c = *(const f32x4*)(ct + pi * 32 + i0), s = *(const f32x4*)(st + pi * 32 + i0);
            const f32x4 y1 = x1 * r * g1, y2 = x2 * r * g2;
            const f32x4 o1 = y1 * c - y2 * s, o2 = y2 * c + y1 * s;
            u32x2 wa, wb; wa.x = cvt_pk_bf16(o1.x, o1.y); wa.y = cvt_pk_bf16(o1.z, o1.w); wb.x = cvt_pk_bf16(o2.x, o2.y); wb.y = cvt_pk_bf16(o2.z, o2.w);
            *(u32x2*)(ptr + i0) = wa; *(u32x2*)(ptr + 32 + i0) = wb;
            if (isk) tail_store(out, g, h, 0, row, i0, o1, o2);
        } else {
            const int vh = (s9 - 6) * 8 + (lane >> 3), g = vh >> 3, h = vh & 7;
            const bf16_t* ptr = QKV + (size_t)row * NQKV + 3072 + vh * 64;
            const u32x2 ra = *(const u32x2*)(ptr + i0), rb = *(const u32x2*)(ptr + 32 + i0);
            const f32x4 x1 = {bf_lo(ra.x), bf_hi(ra.x), bf_lo(ra.y), bf_hi(ra.y)}, x2 = {bf_lo(rb.x), bf_hi(rb.x), bf_lo(rb.y), bf_hi(rb.y)};
            tail_store(out, g, h, 1, row, i0, x1, x2);
        }
    }
}

#define MFMA32(a, b, c) __builtin_amdgcn_mfma_f32_32x32x16_bf16((a), (b), (c), 0, 0, 0)
__device__ __forceinline__ s16x4 tr_read(unsigned lds_addr) { return __builtin_amdgcn_ds_read_tr16_b64_v4i16((LAS s16x4*)(uintptr_t)lds_addr); }
__device__ __forceinline__ bf16x8 pack8(const f32x16& x, int s) {
    u32x4 pk;
    pk.x = cvt_pk_bf16(x[8 * s + 0], x[8 * s + 1]); pk.y = cvt_pk_bf16(x[8 * s + 2], x[8 * s + 3]); pk.z = cvt_pk_bf16(x[8 * s + 4], x[8 * s + 5]); pk.w = cvt_pk_bf16(x[8 * s + 6], x[8 * s + 7]);
    return __builtin_bit_cast(bf16x8, pk);
}
__device__ __forceinline__ void attn_prompt_tile(const bf16_t* QKV, bf16_t* OG, float* LSE, LAS unsigned char* vl, int g, int b, int h, int w, int lane) {
    const int dsh = 2 * g, d = 1 << dsh;
    const int tpr_sh = 6 - dsh;
    const int r = w >> tpr_sh, jt = w & ((1 << tpr_sh) - 1), j0 = jt * 32;
    const int q = lane & 31, hh = lane >> 5;
    const size_t rowb = (size_t)b * SEQ;
    const int qcol = g * 512 + h * 64, kcol = 1536 + qcol, vcol = 3072 + qcol;
    const int tq = ((j0 + q) << dsh) + r;
    const bf16_t* qp = QKV + (rowb + tq) * NQKV + qcol + 8 * hh;
    bf16x8 qf[4];
#pragma unroll
    for (int s = 0; s < 4; ++s) qf[s] = *(const bf16x8*)(qp + 16 * s);
    const int kb0 = jt >= 4 ? 0 : 4 - jt;
    f32x16 S[5];
    float mx = -INFINITY;
    bf16x8 kfa[5][4];
#pragma unroll
    for (int kb = 0; kb < 5; ++kb) {
        int jk = j0 - 128 + kb * 32 + q; jk = jk < 0 ? 0 : jk;
        const bf16_t* kp = QKV + (rowb + (size_t)((jk << dsh) + r)) * NQKV + kcol + 8 * hh;
#pragma unroll
        for (int s = 0; s < 4; ++s) kfa[kb][s] = *(const bf16x8*)(kp + 16 * s);
    }
#pragma unroll
    for (int kb = 0; kb < 5; ++kb) {
        f32x16 c;
#pragma unroll
        for (int i = 0; i < 16; ++i) c[i] = 0.f;
#pragma unroll
        for (int s = 0; s < 4; ++s) c = MFMA32(kfa[kb][s], qf[s], c);
#pragma unroll
        for (int i = 0; i < 16; ++i) {
            const int ki = (i & 3) + 8 * (i >> 2) + 4 * hh;
            bool valid = kb >= kb0;
            if (kb == 0) valid = valid && (ki >= q);
            if (kb == 4) valid = valid && (ki <= q);
            const float sv = valid ? c[i] * 0.125f : -INFINITY;
            c[i] = sv; mx = fmaxf(mx, sv);
        }
        S[kb] = c;
    }
    bf16x8 vva[5][4];
#pragma unroll
    for (int kb = 0; kb < 5; ++kb)
#pragma unroll
        for (int c4 = 0; c4 < 4; ++c4) {
            const int i = c4 * 8 + (lane >> 3); int jk = j0 - 128 + kb * 32 + i; jk = jk < 0 ? 0 : jk;
            vva[kb][c4] = *(const bf16x8*)(QKV + (rowb + (size_t)((jk << dsh) + r)) * NQKV + vcol + (lane & 7) * 8);
        }
    mx = fmaxf(mx, __shfl_xor(mx, 32));
    float l = 0.f;
#pragma unroll
    for (int kb = 0; kb < 5; ++kb)
#pragma unroll
        for (int i = 0; i < 16; ++i) { const float e = __expf(S[kb][i] - mx); S[kb][i] = e; l += e; }
    l += __shfl_xor(l, 32);
    const float inv = 1.0f / l;
    f32x16 o0, o1;
#pragma unroll
    for (int i = 0; i < 16; ++i) { o0[i] = 0.f; o1[i] = 0.f; }
    const unsigned vbase = (unsigned)(uintptr_t)vl;
    const unsigned tr_off = (unsigned)((4 * hh + ((lane & 15) >> 2)) * 144 + ((lane >> 4) & 1) * 32 + 8 * (lane & 3));
#pragma unroll
    for (int kb = 0; kb < 5; ++kb) {
        {
#pragma unroll
            for (int c4 = 0; c4 < 4; ++c4) *(LAS bf16x8*)(vl + (c4 * 8 + (lane >> 3)) * 144 + (lane & 7) * 16) = vva[kb][c4];
#pragma unroll
            for (int s2 = 0; s2 < 2; ++s2) {
                f32x16 pn = S[kb];
#pragma unroll
                for (int i = 0; i < 16; ++i) pn[i] *= inv;
                const bf16x8 pb = pack8(pn, s2);
#pragma unroll
                for (int nb = 0; nb < 2; ++nb) {
                    const unsigned a0 = vbase + tr_off + (unsigned)(16 * s2 * 144 + nb * 64);
                    const s16x4 lo = tr_read(a0), hi = tr_read(a0 + 8 * 144);
                    const bf16x8 va = __builtin_shufflevector(lo, hi, 0, 1, 2, 3, 4, 5, 6, 7);
                    if (nb == 0) o0 = MFMA32(va, pb, o0); else o1 = MFMA32(va, pb, o1);
                }
            }
        }
    }
    const size_t orow = (size_t)g * M + rowb + tq;
    bf16_t* op = OG + orow * AW + h * 64 + 4 * hh;
#pragma unroll
    for (int g4 = 0; g4 < 4; ++g4) {
        u32x2 w0, w1;
        w0.x = cvt_pk_bf16(o0[4 * g4], o0[4 * g4 + 1]); w0.y = cvt_pk_bf16(o0[4 * g4 + 2], o0[4 * g4 + 3]);
        w1.x = cvt_pk_bf16(o1[4 * g4], o1[4 * g4 + 1]); w1.y = cvt_pk_bf16(o1[4 * g4 + 2], o1[4 * g4 + 3]);
        *(u32x2*)(op + 8 * g4) = w0; *(u32x2*)(op + 32 + 8 * g4) = w1;
    }
    if (hh == 0) LSE[orow * 8 + h] = mx + __logf(l);
}
__device__ __forceinline__ void attn_sample_item(const Params& p, unsigned char* ws, int item, LAS float* sc, int lane) {
    const int j = item & 7, h = (item >> 3) & 7, gb = item >> 6, g = gb % 3, b = gb / 3;
    const int dsh = 2 * g, L = 128 << dsh;
    const float* cache = (g == 0 ? p.in[2] : (g == 1 ? p.in[3] : p.in[4])) + (size_t)b * L * 1024;
    const bf16_t* QKV = (const bf16_t*)(ws + WS_BIG);
    const int row = MP + b * 8 + j;
    const int sub = lane & 15, ks = lane >> 4;
    const int qcol = g * 512 + h * 64 + 4 * sub;
    const u32x2 qr = *(const u32x2*)(QKV + (size_t)row * NQKV + qcol);
    const f32x4 qv = {bf_lo(qr.x), bf_hi(qr.x), bf_lo(qr.y), bf_hi(qr.y)};
#pragma unroll 11
    for (int it = 0; it < 33; ++it) {
        const int i = it * 4 + ks;
        float dot = 0.f;
        if (i <= 128) {
            const int idx = L + j - (i << dsh);
            f32x4 kv;
            if (idx >= L) { const u32x2 kr = *(const u32x2*)(QKV + (size_t)(MP + b * 8 + (idx - L)) * NQKV + 1536 + qcol); kv = (f32x4){bf_lo(kr.x), bf_hi(kr.x), bf_lo(kr.y), bf_hi(kr.y)}; }
            else kv = *(const f32x4*)(cache + (size_t)idx * 1024 + h * 64 + 4 * sub);
            dot = (qv.x * kv.x + qv.y * kv.y) + (qv.z * kv.z + qv.w * kv.w);
        }
        dot += __shfl_xor(dot, 1); dot += __shfl_xor(dot, 2); dot += __shfl_xor(dot, 4); dot += __shfl_xor(dot, 8);
        if (sub == 0 && i <= 128) sc[i] = dot * 0.125f;
    }
    asm volatile("s_waitcnt lgkmcnt(0)" ::: "memory");
    float mx = fmaxf(sc[lane], sc[lane + 64]); if (lane == 0) mx = fmaxf(mx, sc[128]);
    mx = wave_max(mx);
    float l = __expf(sc[lane] - mx) + __expf(sc[lane + 64] - mx); if (lane == 0) l += __expf(sc[128] - mx);
    l = wave_sum(l);
    const float inv = 1.0f / l;
    f32x4 acc = {0.f, 0.f, 0.f, 0.f};
#pragma unroll 11
    for (int it = 0; it < 33; ++it) {
        const int i = it * 4 + ks;
        if (i <= 128) {
            const float pw = __expf(sc[i] - mx) * inv;
            const int idx = L + j - (i << dsh);
            f32x4 vv;
            if (idx >= L) { const u32x2 vr = *(const u32x2*)(QKV + (size_t)(MP + b * 8 + (idx - L)) * NQKV + 3072 + qcol); vv = (f32x4){bf_lo(vr.x), bf_hi(vr.x), bf_lo(vr.y), bf_hi(vr.y)}; }
            else vv = *(const f32x4*)(cache + (size_t)idx * 1024 + 512 + h * 64 + 4 * sub);
            acc += vv * pw;
        }
    }
#pragma unroll
    for (int k = 0; k < 4; ++k) { acc[k] += __shfl_xor(acc[k], 16); acc[k] += __shfl_xor(acc[k], 32); }
    const size_t orow = (size_t)g * M + row;
    if (ks == 0) { u32x2 w; w.x = cvt_pk_bf16(acc.x, acc.y); w.y = cvt_pk_bf16(acc.z, acc.w); *(u32x2*)((bf16_t*)(ws + WS_OG) + orow * AW + h * 64 + 4 * sub) = w; }
    if (lane == 0) ((float*)(ws + WS_LSE))[orow * 8 + h] = mx + __logf(l);
    asm volatile("s_waitcnt lgkmcnt(0)" ::: "memory");
}
__device__ __forceinline__ void phase_attn(const Params& p, unsigned char* ws, LAS unsigned char* lds, const int tid) {
    const int lane = tid & 63, wave = __builtin_amdgcn_readfirstlane(tid >> 6);
    LAS unsigned char* vl = lds + wave * 4608;
    constexpr int NS = 768, NP = 3072;
    for (int bi = blockIdx.x; bi < NS + NP; bi += gridDim.x) {
        if (bi < NS) attn_sample_item(p, ws, bi * 8 + wave, (LAS float*)vl, lane);
        else {
            const int x = bi - NS, w8 = x & 7, h = (x >> 3) & 7, b = (x >> 6) & 15, g = x >> 10;
            attn_prompt_tile((const bf16_t*)(ws + WS_BIG), (bf16_t*)(ws + WS_OG), (float*)(ws + WS_LSE), vl, g, b, h, w8 * 8 + wave, lane);
        }
    }
}
__device__ __forceinline__ void phase_merge(unsigned char* ws, const int tid) {
    const bf16_t* OG = (const bf16_t*)(ws + WS_OG); const float* LSE = (const float*)(ws + WS_LSE); bf16_t* AO = (bf16_t*)(ws + WS_AO);
    for (int e = blockIdx.x * 512 + tid; e < M * 64; e += gridDim.x * 512) {
        const int rh = e >> 3, c8 = e & 7;
        const float l0 = LSE[rh], l1 = LSE[(size_t)M * 8 + rh], l2 = LSE[(size_t)2 * M * 8 + rh];
        const float mx = fmaxf(l0, fmaxf(l1, l2));
        float w0 = __expf(l0 - mx), w1 = __expf(l1 - mx), w2 = __expf(l2 - mx); const float inv = 1.0f / (w0 + w1 + w2); w0 *= inv; w1 *= inv; w2 *= inv;
        const size_t off = (size_t)rh * 64 + c8 * 8;
        const u32x4 a = *(const u32x4*)(OG + off), b = *(const u32x4*)(OG + (size_t)M * AW + off), c = *(const u32x4*)(OG + (size_t)2 * M * AW + off);
        u32x4 o;
#pragma unroll
        for (int k = 0; k < 4; ++k) o[k] = cvt_pk_bf16(w0 * bf_lo(a[k]) + w1 * bf_lo(b[k]) + w2 * bf_lo(c[k]), w0 * bf_hi(a[k]) + w1 * bf_hi(b[k]) + w2 * bf_hi(c[k]));
        *(u32x4*)(AO + off) = o;
    }
}

__device__ __forceinline__ void phase_vnorm(const Params& p, unsigned char* ws, float* out, const int tid) {
    const int lane = tid & 63, wave = tid >> 6;
    const int gw = blockIdx.x * 8 + wave, NGW = gridDim.x * 8;
    const bf16_t* UV = (const bf16_t*)(ws + WS_BIG); float* RV = (float*)(ws + WS_RV);
    for (int m = gw; m < M; m += NGW) {
        const u32x4* vr = (const u32x4*)(UV + (size_t)m * NUV + BW) + lane;
        u32x4 v[4]; float ss = 0.f;
#pragma unroll
        for (int j = 0; j < 4; ++j) { v[j] = vr[64 * j];
#pragma unroll
            for (int k = 0; k < 4; ++k) { const float a = bf_lo(v[j][k]), b = bf_hi(v[j][k]); ss += a * a + b * b; } }
        const float r = 1.0f / sqrtf(wave_sum(ss) * (1.0f / BW) + EPS);
        if (lane == 0) RV[m] = r;
        if (m >= MP) {
            float* dst = out + O_VS + (size_t)(m - MP) * BW;
#pragma unroll
            for (int j = 0; j < 4; ++j) { const int c0 = 8 * (lane + 64 * j); const f32x4 ga = *(const f32x4*)(p.in[12] + c0), gb = *(const f32x4*)(p.in[12] + c0 + 4);
                *(f32x4*)(dst + c0) = (f32x4){bf_lo(v[j][0]) * r * ga.x, bf_hi(v[j][0]) * r * ga.y, bf_lo(v[j][1]) * r * ga.z, bf_hi(v[j][1]) * r * ga.w};
                *(f32x4*)(dst + c0 + 4) = (f32x4){bf_lo(v[j][2]) * r * gb.x, bf_hi(v[j][2]) * r * gb.y, bf_lo(v[j][3]) * r * gb.z, bf_hi(v[j][3]) * r * gb.w}; }
        }
    }
}
__device__ __forceinline__ void spatial_tile(const Params& p, unsigned char* ws, LAS unsigned char* vl, int chunk, int gi, int tb, int ch, int lane) {
    const bf16_t* UV = (const bf16_t*)(ws + WS_BIG); const float* RV = (const float*)(ws + WS_RV); bf16_t* UM = (bf16_t*)(ws + WS_UM);
    const bf16_t* WSP = (const bf16_t*)(ws + WS_WSP);
    const int hh = lane >> 5;
    const int colb = gi * 128 + 64 * ch;
    const f32x4 ga = *(const f32x4*)(p.in[12] + colb + (lane & 7) * 8), gb = *(const f32x4*)(p.in[12] + colb + (lane & 7) * 8 + 4);
    f32x16 a0, a1;
#pragma unroll
    for (int i = 0; i < 16; ++i) { a0[i] = 0.f; a1[i] = 0.f; }
    const int t = 32 * tb + (lane & 31);
    const bf16_t* wp = WSP + ((size_t)gi * 128 + t) * 128 + 8 * hh;
    const unsigned vbase = (unsigned)(uintptr_t)vl;
    const unsigned tr_off = (unsigned)((8 * hh + ((lane & 15) >> 2)) * 144 + ((lane >> 4) & 1) * 32 + 8 * (lane & 3));
    bf16x8 wfa[8];
#pragma unroll
    for (int ks = 0; ks < 8; ++ks) wfa[ks] = *(const bf16x8*)(wp + 16 * ks);
    u32x4 rawa[4][4]; float rva[4][4];
#pragma unroll
    for (int sb = 0; sb < 4; ++sb)
#pragma unroll
        for (int c4 = 0; c4 < 4; ++c4) {
            const int srow = chunk * 128 + 32 * sb + c4 * 8 + (lane >> 3);
            rawa[sb][c4] = *(const u32x4*)(UV + (size_t)srow * NUV + BW + colb + (lane & 7) * 8);
            rva[sb][c4] = RV[srow];
        }
#pragma unroll
    for (int sb = 0; sb < 4; ++sb) {
        if (sb <= tb) {
        u32x4 raw[4]; float rv[4];
#pragma unroll
        for (int c4 = 0; c4 < 4; ++c4) { raw[c4] = rawa[sb][c4]; rv[c4] = rva[sb][c4]; }
#pragma unroll
        for (int c4 = 0; c4 < 4; ++c4) {
            const float r = rv[c4]; u32x4 o;
            o.x = cvt_pk_bf16(bf_lo(raw[c4].x) * r * ga.x, bf_hi(raw[c4].x) * r * ga.y); o.y = cvt_pk_bf16(bf_lo(raw[c4].y) * r * ga.z, bf_hi(raw[c4].y) * r * ga.w);
            o.z = cvt_pk_bf16(bf_lo(raw[c4].z) * r * gb.x, bf_hi(raw[c4].z) * r * gb.y); o.w = cvt_pk_bf16(bf_lo(raw[c4].w) * r * gb.z, bf_hi(raw[c4].w) * r * gb.w);
            *(LAS u32x4*)(vl + (c4 * 8 + (lane >> 3)) * 144 + (lane & 7) * 16) = o;
        }
#pragma unroll
        for (int s2 = 0; s2 < 2; ++s2) {
            const bf16x8 wf = wfa[2 * sb + s2];
#pragma unroll
            for (int cb = 0; cb < 2; ++cb) {
                const unsigned a = vbase + tr_off + (unsigned)(16 * s2 * 144 + cb * 64);
                const s16x4 lo = tr_read(a), hi = tr_read(a + 4 * 144);
                const bf16x8 va = __builtin_shufflevector(lo, hi, 0, 1, 2, 3, 4, 5, 6, 7);
                if (cb == 0) a0 = MFMA32(va, wf, a0); else a1 = MFMA32(va, wf, a1);
            }
        }
        }
    }
    const size_t row = (size_t)chunk * 128 + t;
    const float bias = p.in[14][gi * 128 + t];
    const bf16_t* up = UV + row * NUV + colb + 4 * hh;
    bf16_t* op = UM + row * LDU + colb + 4 * hh;
#pragma unroll
    for (int cb = 0; cb < 2; ++cb)
#pragma unroll
        for (int g4 = 0; g4 < 4; ++g4) {
            const u32x2 ur = *(const u32x2*)(up + 32 * cb + 8 * g4);
            const f32x16& a = cb == 0 ? a0 : a1;
            u32x2 w;
            w.x = cvt_pk_bf16(bf_lo(ur.x) * (a[4 * g4] + bias), bf_hi(ur.x) * (a[4 * g4 + 1] + bias));
            w.y = cvt_pk_bf16(bf_lo(ur.y) * (a[4 * g4 + 2] + bias), bf_hi(ur.y) * (a[4 * g4 + 3] + bias));
            *(u32x2*)(op + 32 * cb + 8 * g4) = w;
        }
}
__device__ __forceinline__ void phase_spatial(const Params& p, unsigned char* ws, LAS unsigned char* lds, const int tid) {
    const int lane = tid & 63, wave = __builtin_amdgcn_readfirstlane(tid >> 6);
    const bf16_t* UV = (const bf16_t*)(ws + WS_BIG); const float* RV = (const float*)(ws + WS_RV); bf16_t* UM = (bf16_t*)(ws + WS_UM);
    const float* vgain = p.in[12]; const float* bsp = p.in[14];
    constexpr int NPI = 256 * 16, NSI = 256;
    LAS unsigned char* vl = lds + wave * 4608;
    for (int it = blockIdx.x; it < NPI + NSI; it += gridDim.x) {
        if (it < NPI) spatial_tile(p, ws, vl, it >> 4, it & 15, wave & 3, wave >> 2, lane);
        else {
            const int e = (it - NPI) * 512 + tid;
            const int c4 = e & 511, bt = e >> 9, t = bt & 7, b = bt >> 3, c0 = 4 * c4, gi = c0 >> 7;
            f32x4 acc = {0.f, 0.f, 0.f, 0.f};
            const f32x4 vg = *(const f32x4*)(vgain + c0);
            for (int s = 0; s <= t; ++s) {
                const size_t r = (size_t)MP + b * 8 + s;
                const u32x2 vr = *(const u32x2*)(UV + r * NUV + BW + c0);
                const float wv = p.in[13][((size_t)gi * 128 + t) * 128 + s] * RV[r];
                acc += (f32x4){bf_lo(vr.x), bf_hi(vr.x), bf_lo(vr.y), bf_hi(vr.y)} * wv;
            }
            const float bias = bsp[gi * 128 + t];
            const size_t r = (size_t)MP + b * 8 + t;
            const u32x2 ur = *(const u32x2*)(UV + r * NUV + c0);
            u32x2 w;
            w.x = cvt_pk_bf16(bf_lo(ur.x) * (acc.x * vg.x + bias), bf_hi(ur.x) * (acc.y * vg.y + bias));
            w.y = cvt_pk_bf16(bf_lo(ur.y) * (acc.z * vg.z + bias), bf_hi(ur.y) * (acc.w * vg.w + bias));
            *(u32x2*)(UM + r * LDU + c0) = w;
        }
    }
}

constexpr int BAR_WORDS = 64 * 18;
__device__ __forceinline__ void grid_barrier(unsigned* bar, const int tid, volatile LAS unsigned* ctl) {
    asm volatile("s_waitcnt vmcnt(0) lgkmcnt(0)" ::: "memory");
    __syncthreads();
    if (tid == 0) {
        const unsigned x = (unsigned)__builtin_amdgcn_s_getreg((3 << 11) | 20) & 7u, nloc = ctl[0], nx = ctl[1];
        if (__hip_atomic_fetch_add(bar + 64 * x, 1u, __ATOMIC_RELAXED, __HIP_MEMORY_SCOPE_AGENT) == nloc - 1u) {
            __builtin_amdgcn_fence(__ATOMIC_RELEASE, "agent");
            asm volatile("s_waitcnt vmcnt(0)" ::: "memory");
            if (__hip_atomic_fetch_add(bar + 64 * 8, 1u, __ATOMIC_RELAXED, __HIP_MEMORY_SCOPE_AGENT) == nx - 1u) __hip_atomic_store(bar + 64 * 9, 1u, __ATOMIC_RELAXED, __HIP_MEMORY_SCOPE_AGENT);
            else while (__hip_atomic_load(bar + 64 * 9, __ATOMIC_RELAXED, __HIP_MEMORY_SCOPE_AGENT) == 0u) __builtin_amdgcn_s_sleep(1);
            __builtin_amdgcn_fence(__ATOMIC_ACQUIRE, "agent");
            __hip_atomic_store(bar + 64 * (10 + x), 1u, __ATOMIC_RELAXED, __HIP_MEMORY_SCOPE_AGENT);
            asm volatile("s_waitcnt vmcnt(0)" ::: "memory");
        } else {
            while (__hip_atomic_load(bar + 64 * (10 + x), __ATOMIC_RELAXED, __HIP_MEMORY_SCOPE_AGENT) == 0u) __builtin_amdgcn_s_sleep(1);
            __builtin_amdgcn_fence(__ATOMIC_ACQUIRE, "agent");
            asm volatile("s_waitcnt vmcnt(0)" ::: "memory");
        }
    }
    __syncthreads();
}

__global__ void __launch_bounds__(512, 2) mega(Params p) {
    extern __shared__ __attribute__((aligned(16))) unsigned char lds_raw[];
    LAS unsigned char* lds = (LAS unsigned char*)lds_raw;
    for (int ph = p.ph_lo; ph < p.ph_hi; ++ph) {
        int tid = threadIdx.x; asm volatile("" : "+v"(tid));
        unsigned z; asm volatile("s_mov_b32 %0, 0" : "=s"(z));
        unsigned char* ws = p.ws + z; float* out = p.out + z;
        bf16_t* XN = (bf16_t*)(ws + WS_XN); bf16_t* BIG = (bf16_t*)(ws + WS_BIG);
        bf16_t* YB = (bf16_t*)(ws + WS_YB);
        int fi = -1, fo = -1, ni = -1; float sy = 0.5f;
        switch (ph) {
            case 1: fi = 0; break; case 10: fi = 1; break; case 13: fi = 2; break; case 21: fi = 3; break;
            case 2: fo = 0; break; case 11: fo = 1; break; case 14: fo = 2; break; case 22: fo = 3; break;
            case 3: ni = 1; break; case 9: ni = 2; sy = 1.0f; break; case 12: ni = 3; break; case 15: ni = 4; break; case 20: ni = 5; sy = 1.0f; break; case 23: ni = 6; break;
            default: break;
        }
#ifndef PMASK
#define PMASK 0xFFFF
#endif
        if ((PMASK & 1) && ph == 0) phase_prologue(p, ws, out, lds, tid);
        else if ((PMASK & 2) && fi >= 0) { const bf16_t* W = (const bf16_t*)(ws + WS_WIN + fi * SZ_WIN); sample_gemm<2>(lds, XN + (size_t)MP * D, D, W, D, D, FF, BIG + (size_t)MP * FF, FF, tid);
            pg8::EpiSwiglu E{BIG}; pg8::gemm_phase(lds, XN, W, MP, 2 * FF, D, E, tid); }
        else if (ph == 22) {
            const bf16_t* B = (const bf16_t*)(ws + WS_WOUT + 3 * SZ_WOUT);
            sample_gemm<4>(lds, BIG + (size_t)MP * FF, FF, B, FF, FF, D, nullptr, D, tid, out + (size_t)MP * D);
            pg8::EpiFinal E{out, 0.5f}; pg8::gemm_phase(lds, BIG, B, MP, D, FF, E, tid); }
        else if ((PMASK & 4) && (fo >= 0 || ph == 8 || ph == 19)) {
            const bf16_t* A = BIG; const bf16_t* B = (const bf16_t*)(ws + WS_WOUT + (fo < 0 ? 0 : fo) * SZ_WOUT); int K = FF, ld = FF;
            if (ph == 8) { A = (const bf16_t*)(ws + WS_AO); B = (const bf16_t*)(ws + WS_WOA); K = AW; ld = AW; }
            if (ph == 19) { A = (const bf16_t*)(ws + WS_UM); B = (const bf16_t*)(ws + WS_WOB); K = BW; ld = LDU; }
            sample_gemm<0>(lds, A + (size_t)MP * ld, ld, B, ld, K, D, YB + (size_t)MP * D, D, tid);
            pg8::EpiBf16<0> E{YB, D}; pg8::gemm_phase(lds, A, B, MP, D, K, E, tid, ld, ld); }
#ifdef DUMPSEL
        else if (ph == 20) {
            const bf16_t* wsp = (const bf16_t*)(ws + WS_WSP); const float* rvp = (const float*)(ws + WS_RV);
            for (size_t e = (size_t)blockIdx.x * 512 + tid; e < (size_t)M * D; e += (size_t)gridDim.x * 512) { const size_t r = e / D, c = e % D;
                out[e] = (DUMPSEL == 10) ? p.in[12][(c + r) % 2048] * p.in[14][(c * 3 + r) % 2048] * (1.0f + p.in[13][(r * 1024 + c) % 262144]) : (DUMPSEL == 2) ? (r >= (size_t)MP ? 0.f : 1.f) * __uint_as_float((unsigned)((const bf16_t*)(ws + WS_UM))[r * LDU + c] << 16) : (DUMPSEL == 8) ? (r < 256 ? __uint_as_float((unsigned)wsp[r * 1024 + c] << 16) : 0.f) : rvp[r]; }
        }
#endif
        else if ((PMASK & 8) && ni >= 0) phase_norm(ws, out, ni < 6 ? p.in[5] + ni * D : nullptr, sy, tid);
        else if ((PMASK & 16) && ph == 4) { sample_gemm<0>(lds, XN + (size_t)MP * D, D, (const bf16_t*)(ws + WS_WQKV), D, D, NQKV, BIG + (size_t)MP * NQKV, NQKV, tid);
            pg8::EpiBf16<0> E{BIG, NQKV}; pg8::gemm_phase(lds, XN, (const bf16_t*)(ws + WS_WQKV), MP, NQKV, D, E, tid); }
        else if ((PMASK & 32) && ph == 5) phase_qknorm(p, ws, out, tid);
        else if ((PMASK & 64) && ph == 6) phase_attn(p, ws, lds, tid);
        else if ((PMASK & 128) && ph == 7) phase_merge(ws, tid);
        else if ((PMASK & 512) && ph == 16) { sample_gemm<1>(lds, XN + (size_t)MP * D, D, (const bf16_t*)(ws + WS_WUV), D, D, NUV, BIG + (size_t)MP * NUV, NUV, tid);
            pg8::EpiBf16<1> E{BIG, NUV}; pg8::gemm_phase(lds, XN, (const bf16_t*)(ws + WS_WUV), MP, NUV, D, E, tid); }
        else if ((PMASK & 1024) && ph == 17) phase_vnorm(p, ws, out, tid);
        else if ((PMASK & 2048) && ph == 18) phase_spatial(p, ws, lds, tid);
        if (ph + 1 < p.ph_hi) {
            volatile LAS unsigned* ctl = (volatile LAS unsigned*)(lds + 135168);
            if (ph == 0) {
                const unsigned x = (unsigned)__builtin_amdgcn_s_getreg((3 << 11) | 20) & 7u;
                if (tid == 0) __hip_atomic_fetch_add((unsigned*)p.ws + 64 * x, 1u, __ATOMIC_RELAXED, __HIP_MEMORY_SCOPE_AGENT);
                __syncthreads(); cg::this_grid().sync();
                if (tid == 0) { unsigned nx = 0;
                    for (int j = 0; j < 8; ++j) nx += __hip_atomic_load((unsigned*)p.ws + 64 * j, __ATOMIC_RELAXED, __HIP_MEMORY_SCOPE_AGENT) != 0u;
                    ctl[0] = __hip_atomic_load((unsigned*)p.ws + 64 * x, __ATOMIC_RELAXED, __HIP_MEMORY_SCOPE_AGENT); ctl[1] = nx; }
                __syncthreads();
            }
            else grid_barrier((unsigned*)p.ws + (size_t)BAR_WORDS * ph, tid, ctl);
        }
    }
}

extern "C" void kernel_launch(void* const* d_in, const int* in_sizes, int n_in, void* d_out, int out_size, void* d_ws, size_t ws_size, hipStream_t stream) {
    static int grid = 0;
    if (grid == 0) {
        if (n_in != 16 || ws_size < WS_END) { fprintf(stderr, "kernel_launch: unexpected inputs (n_in %d, ws %zu < %zu)\n", n_in, ws_size, (size_t)WS_END); grid = -1; return; }
        int dev = 0, cus = 0, per_cu = 0;
        (void)hipGetDevice(&dev);
        (void)hipDeviceGetAttribute(&cus, hipDeviceAttributeMultiprocessorCount, dev);
        if (hipFuncSetAttribute((const void*)mega, hipFuncAttributeMaxDynamicSharedMemorySize, LDS_BYTES) != hipSuccess) { fprintf(stderr, "kernel_launch: hipFuncSetAttribute failed\n"); grid = -1; return; }
        if (hipOccupancyMaxActiveBlocksPerMultiprocessor(&per_cu, (const void*)mega, 512, LDS_BYTES) != hipSuccess || per_cu < 1) { fprintf(stderr, "kernel_launch: occupancy query says %d\n", per_cu); per_cu = 1; }
        (void)hipGetLastError();
        grid = cus * 1;
    }
    if (grid < 0) return;
    if (hipMemsetAsync(d_ws, 0, 262144, stream) != hipSuccess) { fprintf(stderr, "kernel_launch: memset failed\n"); return; }
    Params p{};
    for (int i = 0; i < 16; ++i) p.in[i] = (const float*)d_in[i];
    p.out = (float*)d_out; p.ws = (unsigned char*)d_ws;
#if ONE_LAUNCH
    p.ph_lo = 0; p.ph_hi = NPHASE;
    void* args[] = {&p};
    hipError_t e = hipLaunchCooperativeKernel((const void*)mega, dim3(grid), dim3(512), args, LDS_BYTES, stream);
    if (e != hipSuccess) fprintf(stderr, "cooperative launch failed: %s (grid %d)\n", hipGetErrorString(e), grid);
#else
    for (int ph = 0; ph < NPHASE; ++ph) {
        p.ph_lo = ph; p.ph_hi = ph + 1;
        hipLaunchKernelGGL(mega, dim3(grid), dim3(512), LDS_BYTES, stream, p);
    }
#endif
}
```

```cpp
#include <hip/hip_runtime.h>
#include <hip/hip_cooperative_groups.h>
#include <cstdio>
#include <cstdint>
namespace cg = cooperative_groups;

#ifndef ONE_LAUNCH
#define ONE_LAUNCH 1
#endif

#define LAS __attribute__((address_space(3)))
typedef unsigned short bf16_t;
typedef short bf16x8 __attribute__((ext_vector_type(8)));
typedef short s16x4 __attribute__((ext_vector_type(4)));
typedef float f32x2 __attribute__((ext_vector_type(2)));
typedef float f32x4 __attribute__((ext_vector_type(4)));
typedef float f32x16 __attribute__((ext_vector_type(16)));
typedef unsigned u32x2 __attribute__((ext_vector_type(2)));
typedef unsigned u32x4 __attribute__((ext_vector_type(4)));

constexpr int D = 1024, SEQ = 2048, NBATCH = 16, MP = NBATCH * SEQ, MS = 256, M = MP + MS;
constexpr int FF = 2816, NQKV = 4608, AW = 512, BW = 2048, NUV = 4096, PAST = 16384;
constexpr float EPS = 1e-6f;
constexpr int LDU = BW + 64;
constexpr int NPOS = SEQ + 8;
constexpr size_t O_YP = 0, O_YS = (size_t)MP * D, O_KP0 = O_YS + (size_t)MS * D, O_KP1 = O_KP0 + 2097152, O_KP2 = O_KP1 + 8388608,
                 O_KS0 = O_KP2 + 33554432, O_KS1 = O_KS0 + 262144, O_KS2 = O_KS1 + 262144, O_VS = O_KS2 + 262144;
constexpr size_t al256(size_t x) { return (x + 255) & ~(size_t)255; }
constexpr size_t WS_WIN = 1u << 20;
constexpr size_t SZ_WIN = (size_t)2 * FF * D * 2;
constexpr size_t WS_WOUT = WS_WIN + 4 * SZ_WIN;
constexpr size_t SZ_WOUT = (size_t)D * FF * 2;
constexpr size_t WS_WQKV = WS_WOUT + 4 * SZ_WOUT;
constexpr size_t WS_WOA = WS_WQKV + (size_t)NQKV * D * 2;
constexpr size_t WS_WUV = WS_WOA + (size_t)D * AW * 2;
constexpr size_t WS_WOB = WS_WUV + (size_t)NUV * D * 2;
constexpr size_t WS_WSP = WS_WOB + (size_t)D * LDU * 2;
constexpr size_t WS_ROPE = WS_WSP + (size_t)16 * 128 * 128 * 2;
constexpr size_t WS_XN = al256(WS_ROPE + (size_t)NPOS * 32 * 4 * 2);
constexpr size_t WS_BIG = al256(WS_XN + (size_t)M * D * 2);
constexpr size_t WS_OG = al256(WS_BIG + (size_t)M * NQKV * 2);
constexpr size_t WS_LSE = al256(WS_OG + (size_t)3 * M * AW * 2);
constexpr size_t WS_AO = al256(WS_LSE + (size_t)3 * M * 8 * 4);
constexpr size_t WS_UM = al256(WS_AO + (size_t)M * AW * 2);
constexpr size_t WS_RV = al256(WS_UM + (size_t)M * LDU * 2);
constexpr size_t WS_YB = al256(WS_RV + (size_t)M * 4);
constexpr size_t WS_END = al256(WS_YB + (size_t)M * D * 2);

constexpr int LDS_BYTES = 139264;
#ifdef DUMPSEL
constexpr int NPHASE = 21;
#else
constexpr int NPHASE = 23;
#endif

__device__ __forceinline__ float wave_sum(float v) {
#pragma unroll
    for (int o = 1; o < 64; o <<= 1) v += __shfl_xor(v, o);
    return v;
}
__device__ __forceinline__ float wave_max(float v) {
#pragma unroll
    for (int o = 1; o < 64; o <<= 1) v = fmaxf(v, __shfl_xor(v, o));
    return v;
}
typedef __bf16 bf16x2_t __attribute__((ext_vector_type(2)));
__device__ __forceinline__ unsigned cvt_pk_bf16(float lo, float hi) { const f32x2 v = {lo, hi}; return __builtin_bit_cast(unsigned, __builtin_convertvector(v, bf16x2_t)); }
__device__ __forceinline__ float bf_lo(unsigned w) { return __uint_as_float(w << 16); }
__device__ __forceinline__ float bf_hi(unsigned w) { return __uint_as_float(w & 0xffff0000u); }
__device__ __forceinline__ float silu_f(float x) { return x * __builtin_amdgcn_rcpf(1.0f + __expf(-x)); }
__device__ __forceinline__ float gelu_tanh_f(float x) { const float y = 0.7978845608028654f * (x + 0.044715f * x * x * x); return x * __builtin_amdgcn_rcpf(1.0f + __expf(-2.0f * y)); }

namespace pg8 {
constexpr int BM = 256, BK = 64, HALF = 128, HTB = HALF * BK * 2, STAGE_BYTES = 8 * HTB, NXCD = 8, WGM = 8;
__device__ __forceinline__ int lds_byte(int r, int c) { const int st = (r >> 4) * 2 + (c >> 5), rr = r & 15, cc = c & 31, ob = rr * 64 + cc * 2; return st * 1024 + (ob ^ (((ob >> 9) & 1) << 5)); }
__device__ __forceinline__ void stage_rc(int b, int& R, int& C) { const int st = b / 1024, sb = b % 1024, swz = sb ^ (((sb >> 9) & 1) << 5); R = (st >> 1) * 16 + swz / 64; C = (st & 1) * 32 + (swz % 64) / 2; }
__device__ __forceinline__ int perm32(int rho) { const int n = rho >> 4, i = rho & 15; return 8 * (i >> 2) + 4 * n + (i & 3); }
struct Unit { int pm, pn; };
struct StaticOrder {
    int nM, nN, nwg, G, c;
    __device__ void init(int M_, int N_, int G_, int c_) { nM = M_ / BM; nN = N_ / BM; nwg = nM * nN; G = G_; c = c_; }
    __device__ bool next(int i, Unit& u) const {
        const long L = (long)i * G + c; if (L >= nwg) return false;
        int wgid = (int)L; { const int q = nwg / NXCD, r = nwg % NXCD, xcd = wgid % NXCD, off = wgid / NXCD; wgid = (xcd < r ? xcd * (q + 1) : r * (q + 1) + (xcd - r) * q) + off; }
        const int nig = WGM * nN, gid = wgid / nig, fm = gid * WGM, gsz = (nM - fm) < WGM ? (nM - fm) : WGM;
        u.pm = fm + ((wgid % nig) % gsz); u.pn = (wgid % nig) / gsz; return true;
    }
};
template <class Epi>
__device__ __forceinline__ void gemm_phase(LAS unsigned char* lds, const bf16_t* gA, const bf16_t* gBt, int gM, int gN, int K, const Epi& E, const int tid, const int lda = 0, const int ldb = 0) {
    const int LA = lda ? lda : K, LB = ldb ? ldb : K;
    const int wid = __builtin_amdgcn_readfirstlane(tid >> 6), lane = tid & 63, wr = wid >> 2, wc = wid & 3, fr = lane & 15, fq = lane >> 4;
    const int nt = K / BK;
    StaticOrder S; S.init(gM, gN, (int)gridDim.x, (int)blockIdx.x);
    unsigned voffA[2], voffB[2];
#pragma unroll
    for (int i = 0; i < 2; ++i) { int R, C; stage_rc(tid * 16 + i * 8192, R, C); const int Rb = Epi::PERM ? ((R & ~31) + perm32(R & 31)) : R;
        voffA[i] = (unsigned)(R * LA + C) * 2u; voffB[i] = (unsigned)(Rb * LB + C) * 2u; }
    const size_t kstep = (size_t)(BK * 2);
    const size_t hstepA = (size_t)HALF * LA * 2, hstepB = (size_t)HALF * LB * 2;
    const size_t tstepA = 2 * hstepA, tstepB = 2 * hstepB;
    const unsigned ldsw = (unsigned)wid * 1024u;
    const int aoff = lds_byte(wr * 64 + fr, fq * 8), boff = lds_byte(wc * 32 + fr, fq * 8);
#define PG8_SA(b, h) (((b) * 2 + (h)) * HTB)
#define PG8_SB(b, h) ((4 + (b) * 2 + (h)) * HTB)
#define PG8_STAGE(bufoff, gbase, voff) do { _Pragma("unroll") for (int _i = 0; _i < 2; ++_i) \
        __builtin_amdgcn_global_load_lds((const unsigned*)((const char*)(gbase) + (voff)[_i]), (LAS unsigned*)(lds + (bufoff) + ldsw + _i * 8192), 16, 0, 0); } while (0)
#define PG8_LDA(dst, b, h) do { _Pragma("unroll") for (int m = 0; m < 4; ++m) _Pragma("unroll") for (int k = 0; k < 2; ++k) dst[m][k] = *(const LAS bf16x8*)(lds + PG8_SA(b, h) + aoff + m * 2048 + k * 1024); } while (0)
#define PG8_LDB(dst, b, h) do { _Pragma("unroll") for (int n = 0; n < 2; ++n) _Pragma("unroll") for (int k = 0; k < 2; ++k) dst[n][k] = *(const LAS bf16x8*)(lds + PG8_SB(b, h) + boff + n * 2048 + k * 1024); } while (0)
#define PG8_MMA(ai, bj, At, Bt) do { __builtin_amdgcn_s_setprio(1); _Pragma("unroll") for (int m = 0; m < 4; ++m) _Pragma("unroll") for (int n = 0; n < 2; ++n) _Pragma("unroll") for (int k = 0; k < 2; ++k) \
        acc[ai][bj][m][n] = __builtin_amdgcn_mfma_f32_16x16x32_bf16(Bt[n][k], At[m][k], acc[ai][bj][m][n], 0, 0, 0); __builtin_amdgcn_s_setprio(0); } while (0)
#define PG8_WAIT_V(n) asm volatile("s_waitcnt vmcnt(" #n ")" ::: "memory")
#define PG8_WAIT_L(n) asm volatile("s_waitcnt lgkmcnt(" #n ")" ::: "memory")
#define PG8_BAR __builtin_amdgcn_s_barrier()
#define PG8_SCHED __builtin_amdgcn_sched_barrier(0)
    Unit cur, nxt; int ui = 0;
    if (!S.next(0, cur)) return;
    f32x4 acc[2][2][4][2];
#pragma unroll
    for (int a = 0; a < 2; ++a)
#pragma unroll
        for (int b = 0; b < 2; ++b)
#pragma unroll
            for (int m = 0; m < 4; ++m)
#pragma unroll
                for (int n = 0; n < 2; ++n) acc[a][b][m][n] = (f32x4){0.f, 0.f, 0.f, 0.f};
    bf16x8 At[4][2], B0[2][2], B1[2][2];
    const char* cA = (const char*)gA + (size_t)cur.pm * tstepA; const char* cB = (const char*)gBt + (size_t)cur.pn * tstepB;
    PG8_STAGE(PG8_SB(0, 0), cB, voffB); PG8_STAGE(PG8_SB(0, 1), cB + hstepB, voffB); PG8_STAGE(PG8_SA(0, 0), cA, voffA); PG8_STAGE(PG8_SA(0, 1), cA + hstepA, voffA);
    if (wr == 1) PG8_BAR;
    PG8_WAIT_V(2); PG8_BAR;
    PG8_STAGE(PG8_SB(1, 0), cB + kstep, voffB); PG8_STAGE(PG8_SA(1, 0), cA + kstep, voffA); PG8_STAGE(PG8_SB(1, 1), cB + hstepB + kstep, voffB);
    PG8_WAIT_V(6); PG8_BAR;
    for (;;) {
        const bool has_next = S.next(ui + 1, nxt);
        const char* nA = has_next ? (const char*)gA + (size_t)nxt.pm * tstepA : cA; const char* nB = has_next ? (const char*)gBt + (size_t)nxt.pn * tstepB : cB;
        for (int t = 0; t < nt; t += 2) {
            const bool last = (t == nt - 2);
            const char* a1 = cA + (size_t)(t + 1) * kstep;
            const char* a2 = last ? nA : cA + (size_t)(t + 2) * kstep; const char* b2 = last ? nB : cB + (size_t)(t + 2) * kstep;
            const char* a3 = a2 + kstep; const char* b3 = b2 + kstep;
            PG8_LDB(B0, 0, 0); PG8_LDB(B1, 0, 1); PG8_SCHED; PG8_LDA(At, 0, 0); PG8_STAGE(PG8_SA(1, 1), a1 + hstepA, voffA);
            PG8_WAIT_V(8); PG8_WAIT_L(0); PG8_BAR; PG8_MMA(0, 0, At, B0); PG8_MMA(0, 1, At, B1); PG8_BAR; PG8_SCHED;
            PG8_LDA(At, 0, 1); PG8_STAGE(PG8_SB(0, 0), b2, voffB); PG8_STAGE(PG8_SB(0, 1), b2 + hstepB, voffB); PG8_STAGE(PG8_SA(0, 0), a2, voffA);
            PG8_WAIT_V(8); PG8_WAIT_L(0); PG8_BAR; PG8_MMA(1, 0, At, B0); PG8_MMA(1, 1, At, B1); PG8_BAR; PG8_SCHED;
            PG8_LDB(B0, 1, 0); PG8_LDB(B1, 1, 1); PG8_SCHED; PG8_LDA(At, 1, 0); PG8_STAGE(PG8_SA(0, 1), a2 + hstepA, voffA);
            PG8_WAIT_V(8); PG8_WAIT_L(0); PG8_BAR; PG8_MMA(0, 0, At, B0); PG8_MMA(0, 1, At, B1); PG8_BAR; PG8_SCHED;
            PG8_LDA(At, 1, 1); PG8_STAGE(PG8_SB(1, 0), b3, voffB); PG8_STAGE(PG8_SB(1, 1), b3 + hstepB, voffB); PG8_STAGE(PG8_SA(1, 0), a3, voffA);
            PG8_WAIT_V(8); PG8_WAIT_L(0); PG8_BAR; PG8_MMA(1, 0, At, B0); PG8_MMA(1, 1, At, B1); PG8_BAR; PG8_SCHED;
        }
        if (wr == 0) PG8_BAR;
        E(acc, cur, wr, wc, fr, fq);
        if (!has_next) break;
#pragma unroll
        for (int a = 0; a < 2; ++a)
#pragma unroll
            for (int b = 0; b < 2; ++b)
#pragma unroll
                for (int m = 0; m < 4; ++m)
#pragma unroll
                    for (int n = 0; n < 2; ++n) acc[a][b][m][n] = (f32x4){0.f, 0.f, 0.f, 0.f};
        cur = nxt; cA = nA; cB = nB; ++ui;
        if (wr == 1) PG8_BAR;
    }
    PG8_WAIT_V(0);
    PG8_BAR;
#undef PG8_SA
#undef PG8_SB
#undef PG8_STAGE
#undef PG8_LDA
#undef PG8_LDB
#undef PG8_MMA
#undef PG8_WAIT_V
#undef PG8_WAIT_L
#undef PG8_BAR
#undef PG8_SCHED
}

struct EpiSwiglu {
    static constexpr bool PERM = true;
    bf16_t* O;
    __device__ __forceinline__ void operator()(const f32x4 (&acc)[2][2][4][2], const Unit& u, int wr, int wc, int fr, int fq) const {
        const int row0 = u.pm * BM + wr * 64 + fr, col0 = u.pn * HALF + wc * 32 + 8 * fq;
#pragma unroll
        for (int ai = 0; ai < 2; ++ai)
#pragma unroll
            for (int m = 0; m < 4; ++m) {
                const f32x4 g0 = acc[ai][0][m][0], g1 = acc[ai][0][m][1], u0 = acc[ai][1][m][0], u1 = acc[ai][1][m][1];
                u32x4 w;
                w.x = cvt_pk_bf16(silu_f(g0[0]) * u0[0], silu_f(g0[1]) * u0[1]); w.y = cvt_pk_bf16(silu_f(g0[2]) * u0[2], silu_f(g0[3]) * u0[3]);
                w.z = cvt_pk_bf16(silu_f(g1[0]) * u1[0], silu_f(g1[1]) * u1[1]); w.w = cvt_pk_bf16(silu_f(g1[2]) * u1[2], silu_f(g1[3]) * u1[3]);
                *(u32x4*)(O + (size_t)(row0 + ai * HALF + m * 16) * FF + col0) = w;
            }
    }
};
struct EpiResid {
    static constexpr bool PERM = false;
    float* X; float s;
    __device__ __forceinline__ void operator()(const f32x4 (&acc)[2][2][4][2], const Unit& u, int wr, int wc, int fr, int fq) const {
        const int row0 = u.pm * BM + wr * 64 + fr, col0 = u.pn * BM + wc * 32 + 4 * fq;
#pragma unroll
        for (int ai = 0; ai < 2; ++ai)
#pragma unroll
            for (int m = 0; m < 4; ++m) { float* rowp = X + (size_t)(row0 + ai * HALF + m * 16) * D + col0;
#pragma unroll
                for (int bj = 0; bj < 2; ++bj)
#pragma unroll
                    for (int n = 0; n < 2; ++n) { f32x4* p = (f32x4*)(rowp + bj * HALF + n * 16); *p = *p + acc[ai][bj][m][n] * s; } }
    }
};
struct EpiFinal {
    static constexpr bool PERM = false;
    float* X; float s;
    __device__ __forceinline__ void operator()(const f32x4 (&acc)[2][2][4][2], const Unit& u, int wr, int wc, int fr, int fq) const {
        float* base = X + (size_t)(u.pm * BM + wr * 64 + fr) * D + u.pn * BM + wc * 32 + 4 * fq;
        f32x4 x[2][4];
#pragma unroll
        for (int q = 0; q < 4; ++q) x[0][q] = *(const f32x4*)(base + (q >> 1) * HALF + (q & 1) * 16);
#pragma unroll
        for (int g = 0; g < 8; ++g) {
            const int ai = g >> 2, m = g & 3;
            float* rowp = base + (size_t)(ai * HALF + m * 16) * D;
            if (g < 7) { const float* nx = base + (size_t)(((g + 1) >> 2) * HALF + ((g + 1) & 3) * 16) * D;
#pragma unroll
                for (int q = 0; q < 4; ++q) x[(g + 1) & 1][q] = *(const f32x4*)(nx + (q >> 1) * HALF + (q & 1) * 16); }
#pragma unroll
            for (int q = 0; q < 4; ++q) *(f32x4*)(rowp + (q >> 1) * HALF + (q & 1) * 16) = x[g & 1][q] + acc[ai][q >> 1][m][q & 1] * s;
        }
    }
};
template <int ACT> struct EpiBf16 {
    static constexpr bool PERM = true;
    bf16_t* O; int ldc;
    __device__ __forceinline__ void operator()(const f32x4 (&acc)[2][2][4][2], const Unit& u, int wr, int wc, int fr, int fq) const {
        const int row0 = u.pm * BM + wr * 64 + fr, col0 = u.pn * BM + wc * 32 + 8 * fq;
#pragma unroll
        for (int ai = 0; ai < 2; ++ai)
#pragma unroll
            for (int m = 0; m < 4; ++m) { bf16_t* rowp = O + (size_t)(row0 + ai * HALF + m * 16) * ldc + col0;
#pragma unroll
                for (int bj = 0; bj < 2; ++bj) { f32x4 v0 = acc[ai][bj][m][0], v1 = acc[ai][bj][m][1];
                    if (ACT == 1) {
#pragma unroll
                        for (int j = 0; j < 4; ++j) { v0[j] = gelu_tanh_f(v0[j]); v1[j] = gelu_tanh_f(v1[j]); } }
                    u32x4 w; w.x = cvt_pk_bf16(v0[0], v0[1]); w.y = cvt_pk_bf16(v0[2], v0[3]); w.z = cvt_pk_bf16(v1[0], v1[1]); w.w = cvt_pk_bf16(v1[2], v1[3]);
                    *(u32x4*)(rowp + bj * HALF) = w; } }
    }
};
}

#define MFMA32S(a, b, c) __builtin_amdgcn_mfma_f32_32x32x16_bf16((a), (b), (c), 0, 0, 0)
template <int MODE>
__device__ __forceinline__ void sample_gemm(LAS unsigned char* lds, const bf16_t* A, int lda, const bf16_t* Bt, int ldb, int K, int N, bf16_t* O, int ldc, const int tid, float* Xs = nullptr) {
    const int lane = tid & 63, wave = __builtin_amdgcn_readfirstlane(tid >> 6), hh = lane >> 5;
    const int ntiles = 8 * (N / 32), kw = K / 8;
    LAS float* red = (LAS float*)lds;
    for (int tile = blockIdx.x; tile < ntiles; tile += gridDim.x) {
        const int rt = tile & 7, ct = tile >> 3;
        const bf16_t* ap = A + (size_t)(32 * rt + (lane & 31)) * lda + wave * kw + 8 * hh;
        int brow = 32 * ct + (lane & 31);
        if (MODE == 2) { const int h0 = 32 * ct; brow = (h0 >> 7) * 256 + (h0 & 127) + (lane & 31); }
        const bf16_t* bp = Bt + (size_t)brow * ldb + wave * kw + 8 * hh;
        f32x16 c0, c1;
#pragma unroll
        for (int i = 0; i < 16; ++i) { c0[i] = 0.f; c1[i] = 0.f; }
#pragma unroll 4
        for (int k = 0; k < kw; k += 16) {
            const bf16x8 a = *(const bf16x8*)(ap + k), b = *(const bf16x8*)(bp + k);
            c0 = MFMA32S(a, b, c0);
            if (MODE == 2) { const bf16x8 b2 = *(const bf16x8*)(bp + (size_t)128 * ldb + k); c1 = MFMA32S(a, b2, c1); }
        }
        __syncthreads();
#pragma unroll
        for (int i = 0; i < 16; ++i) { red[((wave * 2 + 0) * 16 + i) * 64 + lane] = c0[i]; if (MODE == 2) red[((wave * 2 + 1) * 16 + i) * 64 + lane] = c1[i]; }
        __syncthreads();
#pragma unroll
        for (int r = 0; r < 2; ++r) {
            const int e = tid + 512 * r, i = e >> 6, l = e & 63;
            float s0 = 0.f, s1 = 0.f;
#pragma unroll
            for (int w = 0; w < 8; ++w) { s0 += red[((w * 2 + 0) * 16 + i) * 64 + l]; if (MODE == 2) s1 += red[((w * 2 + 1) * 16 + i) * 64 + l]; }
            const int row = 32 * rt + (i & 3) + 8 * (i >> 2) + 4 * (l >> 5), col = 32 * ct + (l & 31);
            const float v = MODE == 2 ? silu_f(s0) * s1 : (MODE == 1 ? gelu_tanh_f(s0) : s0);
            if (MODE == 4) Xs[(size_t)row * ldc + col] += 0.5f * s0;
            else O[(size_t)row * ldc + col] = (bf16_t)(cvt_pk_bf16(v, 0.f) & 0xffffu);
        }
    }
    __syncthreads();
}

struct Params { const float* in[16]; float* out; unsigned char* ws; int ph_lo, ph_hi; };

__device__ __forceinline__ void transpose_item(const float* W, int K, int N, bf16_t* WT, int k0, int n0, int drow0, LAS float* scr, int lane, int ldw) {
#pragma unroll 8
    for (int i = 0; i < 32; ++i) { const int kk = 2 * i + (lane >> 5); scr[kk * 33 + (lane & 31)] = W[(size_t)(k0 + kk) * N + n0 + (lane & 31)]; }
    asm volatile("s_waitcnt lgkmcnt(0)" ::: "memory");
    const int c = lane & 7;
#pragma unroll
    for (int j = 0; j < 4; ++j) { const int n = (lane >> 3) + 8 * j; const LAS float* s = scr + (8 * c) * 33 + n;
        u32x4 o; o.x = cvt_pk_bf16(s[0 * 33], s[1 * 33]); o.y = cvt_pk_bf16(s[2 * 33], s[3 * 33]); o.z = cvt_pk_bf16(s[4 * 33], s[5 * 33]); o.w = cvt_pk_bf16(s[6 * 33], s[7 * 33]);
        *(u32x4*)(WT + (size_t)(drow0 + n) * ldw + k0 + 8 * c) = o; }
    asm volatile("s_waitcnt lgkmcnt(0)" ::: "memory");
}
__device__ __forceinline__ void transpose_mat(const float* W, int K, int N, bf16_t* WT, int item, bool swiglu, LAS float* scr, int lane, int ldw = 0) {
    const int nblk = N / 32, kb = item / nblk, nb = item % nblk, n0 = 32 * nb;
    int drow0 = n0;
    if (swiglu) { const int up = n0 >= FF, nn = up ? n0 - FF : n0; drow0 = (nn >> 7) * 256 + (up ? 128 : 0) + (nn & 127); }
    transpose_item(W, K, N, WT, 64 * kb, n0, drow0, scr, lane, ldw ? ldw : K);
}
__constant__ double ROPE_INV[32] = {
    1.0, 0.7498942093324559, 0.5623413251903491, 0.4216965034285822, 0.31622776601683794, 0.23713737056616552, 0.1778279410038923, 0.1333521432163324,
    0.1, 0.07498942093324558, 0.05623413251903491, 0.042169650342858224, 0.03162277660168379, 0.023713737056616554, 0.01778279410038923, 0.01333521432163324,
    0.01, 0.007498942093324558, 0.005623413251903491, 0.004216965034285823, 0.0031622776601683794, 0.0023713737056616554, 0.0017782794100389228, 0.001333521432163324,
    0.001, 0.0007498942093324559, 0.0005623413251903491, 0.00042169650342858224, 0.00031622776601683794, 0.00023713737056616554, 0.00017782794100389227, 0.0001333521432163324};

__device__ __forceinline__ void norm_row(const float* xrow, const bf16_t* yrow, float sy, const float* g, bf16_t* orow, float* xout, int lane) {
    const f32x4* xr = (const f32x4*)xrow + lane;
    f32x4 v[4]; float ss = 0.f;
#pragma unroll
    for (int j = 0; j < 4; ++j) v[j] = xr[64 * j];
    if (yrow) {
#pragma unroll
        for (int j = 0; j < 4; ++j) { const u32x2 y = ((const u32x2*)yrow)[lane + 64 * j];
            v[j].x += sy * bf_lo(y.x); v[j].y += sy * bf_hi(y.x); v[j].z += sy * bf_lo(y.y); v[j].w += sy * bf_hi(y.y); }
    }
#pragma unroll
    for (int j = 0; j < 4; ++j) ss += (v[j].x * v[j].x + v[j].y * v[j].y) + (v[j].z * v[j].z + v[j].w * v[j].w);
    if (xout) {
#pragma unroll
        for (int j = 0; j < 4; ++j) ((f32x4*)xout)[lane + 64 * j] = v[j];
    }
    if (g) {
        const float r = 1.0f / sqrtf(wave_sum(ss) * (1.0f / D) + EPS);
#pragma unroll
        for (int j = 0; j < 4; ++j) {
            const f32x4 gg = ((const f32x4*)g)[lane + 64 * j];
            u32x2 o; o.x = cvt_pk_bf16(v[j].x * r * gg.x, v[j].y * r * gg.y); o.y = cvt_pk_bf16(v[j].z * r * gg.z, v[j].w * r * gg.w);
            ((u32x2*)orow)[lane + 64 * j] = o;
        }
    }
}

__device__ __forceinline__ void phase_prologue(const Params& p, unsigned char* ws, float* out, LAS unsigned char* lds, const int tid) {
    const int lane = tid & 63, wave = tid >> 6;
    const int gw = blockIdx.x * 8 + wave, NGW = gridDim.x * 8;
    LAS float* scr = (LAS float*)(lds + wave * 8704);
    constexpr int I_IN = (D / 64) * (2 * FF / 32), I_OUT = (FF / 64) * (D / 32), I_QKV = (D / 64) * (NQKV / 32), I_OA = (AW / 64) * (D / 32), I_UV = (D / 64) * (NUV / 32), I_OB = (BW / 64) * (D / 32);
    constexpr int NITEMS = 4 * I_IN + 4 * I_OUT + I_QKV + I_OA + I_UV + I_OB;
    for (int it = gw; it < NITEMS; it += NGW) {
        int r = it;
        if (r < 4 * I_IN) { const int w = r / I_IN; transpose_mat(p.in[6] + (size_t)w * D * 2 * FF, D, 2 * FF, (bf16_t*)(ws + WS_WIN + w * SZ_WIN), r % I_IN, true, scr, lane); continue; } r -= 4 * I_IN;
        if (r < 4 * I_OUT) { const int w = r / I_OUT; transpose_mat(p.in[7] + (size_t)w * FF * D, FF, D, (bf16_t*)(ws + WS_WOUT + w * SZ_WOUT), r % I_OUT, false, scr, lane); continue; } r -= 4 * I_OUT;
        if (r < I_QKV) { transpose_mat(p.in[8], D, NQKV, (bf16_t*)(ws + WS_WQKV), r, false, scr, lane); continue; } r -= I_QKV;
        if (r < I_OA) { transpose_mat(p.in[10], AW, D, (bf16_t*)(ws + WS_WOA), r, false, scr, lane); continue; } r -= I_OA;
        if (r < I_UV) { transpose_mat(p.in[11], D, NUV, (bf16_t*)(ws + WS_WUV), r, false, scr, lane); continue; } r -= I_UV;
        transpose_mat(p.in[15], BW, D, (bf16_t*)(ws + WS_WOB), r, false, scr, lane, LDU);
    }
    { bf16_t* wsp = (bf16_t*)(ws + WS_WSP); const float* src = p.in[13];
      for (int i = blockIdx.x * 512 + tid; i < 16 * 128 * 128 / 2; i += gridDim.x * 512) {
          const int e = 2 * i, s = e & 127, t = (e >> 7) & 127; const f32x2 v = *(const f32x2*)(src + e);
          ((unsigned*)wsp)[i] = cvt_pk_bf16(s <= t ? v.x : 0.f, (s + 1) <= t ? v.y : 0.f); } }
    { float* ct = (float*)(ws + WS_ROPE); float* st = ct + NPOS * 32;
      for (int i = blockIdx.x * 512 + tid; i < NPOS * 32; i += gridDim.x * 512) {
          const int pi = i >> 5, fi = i & 31; const double pos = (double)(pi < SEQ ? pi : PAST + (pi - SEQ));
          const double a = pos * ROPE_INV[fi]; const double n = __builtin_rint(a * 0.15915494309189535);
          const double r = (a - n * 6.283185307179586) - n * 2.4492935982947064e-16; const double r2 = r * r;
          double sn = 1.0, cs = 1.0;
#pragma unroll 1
          for (int k = 14; k >= 1; --k) { const double k2 = (double)(2 * k); sn = 1.0 - sn * r2 / (k2 * (k2 + 1.0)); cs = 1.0 - cs * r2 / ((k2 - 1.0) * k2); }
          ct[i] = (float)cs; st[i] = (float)(sn * r); } }
#ifdef NANFILL
    { u32x4* f = (u32x4*)(ws + WS_BIG); const size_t n = (WS_END - WS_BIG) / 16; const u32x4 q = {0xffffffffu, 0xffffffffu, 0xffffffffu, 0xffffffffu};
      for (size_t i = (size_t)blockIdx.x * 512 + tid; i < n; i += (size_t)gridDim.x * 512) f[i] = q;
      u32x4* fo = (u32x4*)(out + O_KP0); const size_t no = (O_VS + 524288 - O_KP0) / 4;
      for (size_t i = (size_t)blockIdx.x * 512 + tid; i < no; i += (size_t)gridDim.x * 512) fo[i] = q; }
#endif
    for (int m = gw; m < M; m += NGW) {
        const float* src = m < MP ? p.in[0] + (size_t)m * D : p.in[1] + (size_t)(m - MP) * D;
        norm_row(src, nullptr, 0.f, p.in[5], (bf16_t*)(ws + WS_XN) + (size_t)m * D, out + (size_t)m * D, lane);
    }
}

__device__ __forceinline__ void phase_norm(unsigned char* ws, float* out, const float* g, float sy, const int tid) {
    const int lane = tid & 63, wave = tid >> 6;
    const int gw = blockIdx.x * 8 + wave, NGW = gridDim.x * 8;
    const bf16_t* YB = (const bf16_t*)(ws + WS_YB); bf16_t* XN = (bf16_t*)(ws + WS_XN);
    for (int m0 = gw; m0 < M; m0 += 2 * NGW) {
        const int m1 = m0 + NGW; const bool two = m1 < M; const int mb = two ? m1 : m0;
        f32x4 va[4], vb[4]; u32x2 ya[4], yb[4];
#pragma unroll
        for (int j = 0; j < 4; ++j) { va[j] = ((const f32x4*)(out + (size_t)m0 * D))[lane + 64 * j]; vb[j] = ((const f32x4*)(out + (size_t)mb * D))[lane + 64 * j]; }
#pragma unroll
        for (int j = 0; j < 4; ++j) { ya[j] = ((const u32x2*)(YB + (size_t)m0 * D))[lane + 64 * j]; yb[j] = ((const u32x2*)(YB + (size_t)mb * D))[lane + 64 * j]; }
        float sa = 0.f, sb = 0.f;
#pragma unroll
        for (int j = 0; j < 4; ++j) {
            va[j].x += sy * bf_lo(ya[j].x); va[j].y += sy * bf_hi(ya[j].x); va[j].z += sy * bf_lo(ya[j].y); va[j].w += sy * bf_hi(ya[j].y);
            vb[j].x += sy * bf_lo(yb[j].x); vb[j].y += sy * bf_hi(yb[j].x); vb[j].z += sy * bf_lo(yb[j].y); vb[j].w += sy * bf_hi(yb[j].y);
            sa += (va[j].x * va[j].x + va[j].y * va[j].y) + (va[j].z * va[j].z + va[j].w * va[j].w);
            sb += (vb[j].x * vb[j].x + vb[j].y * vb[j].y) + (vb[j].z * vb[j].z + vb[j].w * vb[j].w);
        }
#pragma unroll
        for (int j = 0; j < 4; ++j) { ((f32x4*)(out + (size_t)m0 * D))[lane + 64 * j] = va[j]; if (two) ((f32x4*)(out + (size_t)m1 * D))[lane + 64 * j] = vb[j]; }
        if (g) {
            const float ra = 1.0f / sqrtf(wave_sum(sa) * (1.0f / D) + EPS), rb = 1.0f / sqrtf(wave_sum(sb) * (1.0f / D) + EPS);
#pragma unroll
            for (int j = 0; j < 4; ++j) {
                const f32x4 gg = ((const f32x4*)g)[lane + 64 * j];
                u32x2 o; o.x = cvt_pk_bf16(va[j].x * ra * gg.x, va[j].y * ra * gg.y); o.y = cvt_pk_bf16(va[j].z * ra * gg.z, va[j].w * ra * gg.w);
                ((u32x2*)(XN + (size_t)m0 * D))[lane + 64 * j] = o;
                if (two) { u32x2 o2; o2.x = cvt_pk_bf16(vb[j].x * rb * gg.x, vb[j].y * rb * gg.y); o2.y = cvt_pk_bf16(vb[j].z * rb * gg.z, vb[j].w * rb * gg.w);
                    ((u32x2*)(XN + (size_t)m1 * D))[lane + 64 * j] = o2; }
            }
        }
    }
}

__device__ __forceinline__ void tail_store(float* out, int g, int h, int kv, int row, int i0, f32x4 a, f32x4 b) {
    float* dst;
    if (row < MP) {
        const int bb = row >> 11, t = row & 2047, keep = 128 << (2 * g), tt = t - (SEQ - keep);
        if (tt < 0) return;
        const size_t base = g == 0 ? O_KP0 : (g == 1 ? O_KP1 : O_KP2);
        dst = out + base + ((((size_t)bb * keep + tt) * 2 + kv) * 8 + h) * 64;
    } else {
        const int s = row - MP; const size_t base = g == 0 ? O_KS0 : (g == 1 ? O_KS1 : O_KS2);
        dst = out + base + (((size_t)s * 2 + kv) * 8 + h) * 64;
    }
    *(f32x4*)(dst + i0) = a; *(f32x4*)(dst + 32 + i0) = b;
}
__device__ __forceinline__ void phase_qknorm(const Params& p, unsigned char* ws, float* out, const int tid) {
    const int lane = tid & 63, wave = tid >> 6;
    const int gw = blockIdx.x * 8 + wave, NGW = gridDim.x * 8;
    bf16_t* QKV = (bf16_t*)(ws + WS_BIG);
    const float* ct = (const float*)(ws + WS_ROPE); const float* st = ct + NPOS * 32;
    const int sub = lane & 7, i0 = 4 * sub;
    for (int it = gw; it < M * 9; it += NGW) {
        const int row = it / 9, s9 = it - row * 9;
        if (s9 < 6) {
            const int head = s9 * 8 + (lane >> 3), isk = head >= 24, gh = isk ? head - 24 : head, g = gh >> 3, h = gh & 7;
            bf16_t* ptr = QKV + (size_t)row * NQKV + head * 64;
            const u32x2 ra = *(const u32x2*)(ptr + i0), rb = *(const u32x2*)(ptr + 32 + i0);
            f32x4 x1 = {bf_lo(ra.x), bf_hi(ra.x), bf_lo(ra.y), bf_hi(ra.y)}, x2 = {bf_lo(rb.x), bf_hi(rb.x), bf_lo(rb.y), bf_hi(rb.y)};
            float ss = (x1.x * x1.x + x1.y * x1.y) + (x1.z * x1.z + x1.w * x1.w) + (x2.x * x2.x + x2.y * x2.y) + (x2.z * x2.z + x2.w * x2.w);
            ss += __shfl_xor(ss, 1); ss += __shfl_xor(ss, 2); ss += __shfl_xor(ss, 4);
            const float r = 1.0f / sqrtf(ss * (1.0f / 64) + EPS);
            const float* gain = p.in[9] + isk * 64;
            const f32x4 g1 = *(const f32x4*)(gain + i0), g2 = *(const f32x4*)(gain + 32 + i0);
            const int pi = row < MP ? (row & 2047) : SEQ + ((row - MP) & 7);
            const f32x4 c = *(const f32x4*)(ct + pi * 32 + i0), s = *(const f32x4*)(st + pi * 32 + i0);
            const f32x4 y1 = x1 * r * g1, y2 = x2 * r * g2;
            const f32x4 o1 = y1 * c - y2 * s, o2 = y2 * c + y1 * s;
            u32x2 wa, wb; wa.x = cvt_pk_bf16(o1.x, o1.y); wa.y = cvt_pk_bf16(o1.z, o1.w); wb.x = cvt_pk_bf16(o2.x, o2.y); wb.y = cvt_pk_bf16(o2.z, o2.w);
            *(u32x2*)(ptr + i0) = wa; *(u32x2*)(ptr + 32 + i0) = wb;
            if (isk) tail_store(out, g, h, 0, row, i0, o1, o2);
        } else {
            const int vh = (s9 - 6) * 8 + (lane >> 3), g = vh >> 3, h = vh & 7;
            const bf16_t* ptr = QKV + (size_t)row * NQKV + 3072 + vh * 64;
            const u32x2 ra = *(const u32x2*)(ptr + i0), rb = *(const u32x2*)(ptr + 32 + i0);
            const f32x4 x1 = {bf_lo(ra.x), bf_hi(ra.x), bf_lo(ra.y), bf_hi(ra.y)}, x2 = {bf_lo(rb.x), bf_hi(rb.x), bf_lo(rb.y), bf_hi(rb.y)};
            tail_store(out, g, h, 1, row, i0, x1, x2);
        }
    }
}

#define MFMA32(a, b, c) __builtin_amdgcn_mfma_f32_32x32x16_bf16((a), (b), (c), 0, 0, 0)
__device__ __forceinline__ s16x4 tr_read(unsigned lds_addr) { return __builtin_amdgcn_ds_read_tr16_b64_v4i16((LAS s16x4*)(uintptr_t)lds_addr); }
__device__ __forceinline__ bf16x8 pack8(const f32x16& x, int s) {
    u32x4 pk;
    pk.x = cvt_pk_bf16(x[8 * s + 0], x[8 * s + 1]); pk.y = cvt_pk_bf16(x[8 * s + 2], x[8 * s + 3]); pk.z = cvt_pk_bf16(x[8 * s + 4], x[8 * s + 5]); pk.w = cvt_pk_bf16(x[8 * s + 6], x[8 * s + 7]);
    return __builtin_bit_cast(bf16x8, pk);
}
__device__ __forceinline__ void attn_prompt_tile(const bf16_t* QKV, bf16_t* OG, float* LSE, LAS unsigned char* vl, int g, int b, int h, int w, int lane) {
    const int dsh = 2 * g, d = 1 << dsh;
    const int tpr_sh = 6 - dsh;
    const int r = w >> tpr_sh, jt = w & ((1 << tpr_sh) - 1), j0 = jt * 32;
    const int q = lane & 31, hh = lane >> 5;
    const size_t rowb = (size_t)b * SEQ;
    const int qcol = g * 512 + h * 64, kcol = 1536 + qcol, vcol = 3072 + qcol;
    const int tq = ((j0 + q) << dsh) + r;
    const bf16_t* qp = QKV + (rowb + tq) * NQKV + qcol + 8 * hh;
    bf16x8 qf[4];
#pragma unroll
    for (int s = 0; s < 4; ++s) qf[s] = *(const bf16x8*)(qp + 16 * s);
    const int kb0 = jt >= 4 ? 0 : 4 - jt;
    f32x16 S[5];
    float mx = -INFINITY;
    bf16x8 kfa[5][4];
#pragma unroll
    for (int kb = 0; kb < 5; ++kb) {
        int jk = j0 - 128 + kb * 32 + q; jk = jk < 0 ? 0 : jk;
        const bf16_t* kp = QKV + (rowb + (size_t)((jk << dsh) + r)) * NQKV + kcol + 8 * hh;
#pragma unroll
        for (int s = 0; s < 4; ++s) kfa[kb][s] = *(const bf16x8*)(kp + 16 * s);
    }
#pragma unroll
    for (int kb = 0; kb < 5; ++kb) {
        f32x16 c;
#pragma unroll
        for (int i = 0; i < 16; ++i) c[i] = 0.f;
#pragma unroll
        for (int s = 0; s < 4; ++s) c = MFMA32(kfa[kb][s], qf[s], c);
#pragma unroll
        for (int i = 0; i < 16; ++i) {
            const int ki = (i & 3) + 8 * (i >> 2) + 4 * hh;
            bool valid = kb >= kb0;
            if (kb == 0) valid = valid && (ki >= q);
            if (kb == 4) valid = valid && (ki <= q);
            const float sv = valid ? c[i] * 0.125f : -INFINITY;
            c[i] = sv; mx = fmaxf(mx, sv);
        }
        S[kb] = c;
    }
    bf16x8 vva[5][4];
#pragma unroll
    for (int kb = 0; kb < 5; ++kb)
#pragma unroll
        for (int c4 = 0; c4 < 4; ++c4) {
            const int i = c4 * 8 + (lane >> 3); int jk = j0 - 128 + kb * 32 + i; jk = jk < 0 ? 0 : jk;
            vva[kb][c4] = *(const bf16x8*)(QKV + (rowb + (size_t)((jk << dsh) + r)) * NQKV + vcol + (lane & 7) * 8);
        }
    mx = fmaxf(mx, __shfl_xor(mx, 32));
    float l = 0.f;
#pragma unroll
    for (int kb = 0; kb < 5; ++kb)
#pragma unroll
        for (int i = 0; i < 16; ++i) { const float e = __expf(S[kb][i] - mx); S[kb][i] = e; l += e; }
    l += __shfl_xor(l, 32);
    const float inv = 1.0f / l;
    f32x16 o0, o1;
#pragma unroll
    for (int i = 0; i < 16; ++i) { o0[i] = 0.f; o1[i] = 0.f; }
    const unsigned vbase = (unsigned)(uintptr_t)vl;
    const unsigned tr_off = (unsigned)((4 * hh + ((lane & 15) >> 2)) * 144 + ((lane >> 4) & 1) * 32 + 8 * (lane & 3));
#pragma unroll
    for (int kb = 0; kb < 5; ++kb) {
        {
#pragma unroll
            for (int c4 = 0; c4 < 4; ++c4) *(LAS bf16x8*)(vl + (c4 * 8 + (lane >> 3)) * 144 + (lane & 7) * 16) = vva[kb][c4];
#pragma unroll
            for (int s2 = 0; s2 < 2; ++s2) {
                f32x16 pn = S[kb];
#pragma unroll
                for (int i = 0; i < 16; ++i) pn[i] *= inv;
                const bf16x8 pb = pack8(pn, s2);
#pragma unroll
                for (int nb = 0; nb < 2; ++nb) {
                    const unsigned a0 = vbase + tr_off + (unsigned)(16 * s2 * 144 + nb * 64);
                    const s16x4 lo = tr_read(a0), hi = tr_read(a0 + 8 * 144);
                    const bf16x8 va = __builtin_shufflevector(lo, hi, 0, 1, 2, 3, 4, 5, 6, 7);
                    if (nb == 0) o0 = MFMA32(va, pb, o0); else o1 = MFMA32(va, pb, o1);
                }
            }
        }
    }
    const size_t orow = (size_t)g * M + rowb + tq;
    bf16_t* op = OG + orow * AW + h * 64 + 4 * hh;
#pragma unroll
    for (int g4 = 0; g4 < 4; ++g4) {
        u32x2 w0, w1;
        w0.x = cvt_pk_bf16(o0[4 * g4], o0[4 * g4 + 1]); w0.y = cvt_pk_bf16(o0[4 * g4 + 2], o0[4 * g4 + 3]);
        w1.x = cvt_pk_bf16(o1[4 * g4], o1[4 * g4 + 1]); w1.y = cvt_pk_bf16(o1[4 * g4 + 2], o1[4 * g4 + 3]);
        *(u32x2*)(op + 8 * g4) = w0; *(u32x2*)(op + 32 + 8 * g4) = w1;
    }
    if (hh == 0) LSE[orow * 8 + h] = mx + __logf(l);
}
__device__ __forceinline__ void attn_sample_item(const Params& p, unsigned char* ws, int item, LAS float* sc, int lane) {
    const int j = item & 7, h = (item >> 3) & 7, gb = item >> 6, g = gb % 3, b = gb / 3;
    const int dsh = 2 * g, L = 128 << dsh;
    const float* cache = (g == 0 ? p.in[2] : (g == 1 ? p.in[3] : p.in[4])) + (size_t)b * L * 1024;
    const bf16_t* QKV = (const bf16_t*)(ws + WS_BIG);
    const int row = MP + b * 8 + j;
    const int sub = lane & 15, ks = lane >> 4;
    const int qcol = g * 512 + h * 64 + 4 * sub;
    const u32x2 qr = *(const u32x2*)(QKV + (size_t)row * NQKV + qcol);
    const f32x4 qv = {bf_lo(qr.x), bf_hi(qr.x), bf_lo(qr.y), bf_hi(qr.y)};
#pragma unroll 11
    for (int it = 0; it < 33; ++it) {
        const int i = it * 4 + ks;
        float dot = 0.f;
        if (i <= 128) {
            const int idx = L + j - (i << dsh);
            f32x4 kv;
            if (idx >= L) { const u32x2 kr = *(const u32x2*)(QKV + (size_t)(MP + b * 8 + (idx - L)) * NQKV + 1536 + qcol); kv = (f32x4){bf_lo(kr.x), bf_hi(kr.x), bf_lo(kr.y), bf_hi(kr.y)}; }
            else kv = *(const f32x4*)(cache + (size_t)idx * 1024 + h * 64 + 4 * sub);
            dot = (qv.x * kv.x + qv.y * kv.y) + (qv.z * kv.z + qv.w * kv.w);
        }
        dot += __shfl_xor(dot, 1); dot += __shfl_xor(dot, 2); dot += __shfl_xor(dot, 4); dot += __shfl_xor(dot, 8);
        if (sub == 0 && i <= 128) sc[i] = dot * 0.125f;
    }
    asm volatile("s_waitcnt lgkmcnt(0)" ::: "memory");
    float mx = fmaxf(sc[lane], sc[lane + 64]); if (lane == 0) mx = fmaxf(mx, sc[128]);
    mx = wave_max(mx);
    float l = __expf(sc[lane] - mx) + __expf(sc[lane + 64] - mx); if (lane == 0) l += __expf(sc[128] - mx);
    l = wave_sum(l);
    const float inv = 1.0f / l;
    f32x4 acc = {0.f, 0.f, 0.f, 0.f};
#pragma unroll 11
    for (int it = 0; it < 33; ++it) {
        const int i = it * 4 + ks;
        if (i <= 128) {
            const float pw = __expf(sc[i] - mx) * inv;
            const int idx = L + j - (i << dsh);
            f32x4 vv;
            if (idx >= L) { const u32x2 vr = *(const u32x2*)(QKV + (size_t)(MP + b * 8 + (idx - L)) * NQKV + 3072 + qcol); vv = (f32x4){bf_lo(vr.x), bf_hi(vr.x), bf_lo(vr.y), bf_hi(vr.y)}; }
            else vv = *(const f32x4*)(cache + (size_t)idx * 1024 + 512 + h * 64 + 4 * sub);
            acc += vv * pw;
        }
    }
#pragma unroll
    for (int k = 0; k < 4; ++k) { acc[k] += __shfl_xor(acc[k], 16); acc[k] += __shfl_xor(acc[k], 32); }
    const size_t orow = (size_t)g * M + row;
    if (ks == 0) { u32x2 w; w.x = cvt_pk_bf16(acc.x, acc.y); w.y = cvt_pk_bf16(acc.z, acc.w); *(u32x2*)((bf16_t*)(ws + WS_OG) + orow * AW + h * 64 + 4 * sub) = w; }
    if (lane == 0) ((float*)(ws + WS_LSE))[orow * 8 + h] = mx + __logf(l);
    asm volatile("s_waitcnt lgkmcnt(0)" ::: "memory");
}
__device__ __forceinline__ void attn_prompt_block(const bf16_t* QKV, bf16_t* OG, float* LSE, LAS unsigned char* lds, int g, int b, int h, int w8, const int tid) {
    const int lane = tid & 63, wave = __builtin_amdgcn_readfirstlane(tid >> 6);
    const int dsh = 2 * g, tpr_sh = 6 - dsh;
    const size_t rowb = (size_t)b * SEQ;
    const int qcol = g * 512 + h * 64, kcol = 1536 + qcol, vcol = 3072 + qcol;
    LAS unsigned char* Kl = lds; LAS unsigned char* Vl = lds + 55296;
    const int w = w8 * 8 + wave, r = w >> tpr_sh, jt = w & ((1 << tpr_sh) - 1), j0 = jt * 32;
    const int q = lane & 31, hh = lane >> 5;
    const int tq = ((j0 + q) << dsh) + r;
    const bf16_t* qp = QKV + (rowb + tq) * NQKV + qcol + 8 * hh;
    bf16x8 qf[4];
#pragma unroll
    for (int s = 0; s < 4; ++s) qf[s] = *(const bf16x8*)(qp + 16 * s);
    __syncthreads();
    {
        bf16x8 kr[6], vr[6];
#pragma unroll
        for (int i = 0; i < 6; ++i) {
            const int p = tid + 512 * i, sl = p >> 3, c = p & 7;
            int j, rr; bool valid;
            if (g == 2) { valid = sl < 256; j = sl & 127; rr = 2 * w8 + (sl >> 7); }
            else if (g == 1) { j = 256 * (w8 & 1) - 128 + sl; rr = w8 >> 1; valid = j >= 0; }
            else { j = 256 * w8 - 128 + sl; rr = 0; valid = j >= 0; }
            j = valid ? j : 0;
            const bf16_t* src = QKV + (rowb + (size_t)((j << dsh) + rr)) * NQKV + c * 8;
            kr[i] = *(const bf16x8*)(src + kcol); vr[i] = *(const bf16x8*)(src + vcol);
        }
#pragma unroll
        for (int i = 0; i < 6; ++i) {
            const int p = tid + 512 * i, sl = p >> 3, c = p & 7;
            *(LAS bf16x8*)(Kl + sl * 144 + c * 16) = kr[i]; *(LAS bf16x8*)(Vl + sl * 144 + c * 16) = vr[i];
        }
    }
    __syncthreads();
    const int jstart = g == 2 ? -128 * (wave >> 2) : (g == 1 ? 256 * (w8 & 1) - 128 : 256 * w8 - 128);
    const int kb0 = jt >= 4 ? 0 : 4 - jt;
    f32x16 S[5];
    float mx = -INFINITY;
#pragma unroll
    for (int kb = 0; kb < 5; ++kb) {
        f32x16 c;
#pragma unroll
        for (int i = 0; i < 16; ++i) c[i] = 0.f;
        const int jb = j0 - 128 + kb * 32;
        const int slot = jb < 0 ? -jstart : jb - jstart + q;
        bf16x8 kf[4];
#pragma unroll
        for (int s = 0; s < 4; ++s) kf[s] = *(const LAS bf16x8*)(Kl + slot * 144 + s * 32 + hh * 16);
#pragma unroll
        for (int s = 0; s < 4; ++s) c = MFMA32(kf[s], qf[s], c);
#pragma unroll
        for (int i = 0; i < 16; ++i) {
            const int ki = (i & 3) + 8 * (i >> 2) + 4 * hh;
            bool valid = kb >= kb0;
            if (kb == 0) valid = valid && (ki >= q);
            if (kb == 4) valid = valid && (ki <= q);
            const float sv = valid ? c[i] * 0.125f : -INFINITY;
            c[i] = sv; mx = fmaxf(mx, sv);
        }
        S[kb] = c;
    }
    mx = fmaxf(mx, __shfl_xor(mx, 32));
    float l = 0.f;
#pragma unroll
    for (int kb = 0; kb < 5; ++kb)
#pragma unroll
        for (int i = 0; i < 16; ++i) { const float e = __expf(S[kb][i] - mx); S[kb][i] = e; l += e; }
    l += __shfl_xor(l, 32);
    const float inv = 1.0f / l;
    f32x16 o0, o1;
#pragma unroll
    for (int i = 0; i < 16; ++i) { o0[i] = 0.f; o1[i] = 0.f; }
    const unsigned vbase = (unsigned)(uintptr_t)Vl;
    const int trrow = 4 * hh + ((lane & 15) >> 2);
    const unsigned trcol = (unsigned)(((lane >> 4) & 1) * 32 + 8 * (lane & 3));
#pragma unroll
    for (int kb = 0; kb < 5; ++kb) {
        const int jb = j0 - 128 + kb * 32;
        const int sbase = jb < 0 ? -jstart : jb - jstart, sstr = jb < 0 ? 0 : 144;
#pragma unroll
        for (int s2 = 0; s2 < 2; ++s2) {
            f32x16 pn = S[kb];
#pragma unroll
            for (int i = 0; i < 16; ++i) pn[i] *= inv;
            const bf16x8 pb = pack8(pn, s2);
#pragma unroll
            for (int nb = 0; nb < 2; ++nb) {
                const unsigned a0 = vbase + (unsigned)(sbase * 144 + (16 * s2 + trrow) * sstr) + trcol + (unsigned)(nb * 64);
                const s16x4 lo = tr_read(a0), hi = tr_read(a0 + (unsigned)(8 * sstr));
                const bf16x8 va = __builtin_shufflevector(lo, hi, 0, 1, 2, 3, 4, 5, 6, 7);
                if (nb == 0) o0 = MFMA32(va, pb, o0); else o1 = MFMA32(va, pb, o1);
            }
        }
    }
    const size_t orow = (size_t)g * M + rowb + tq;
    bf16_t* op = OG + orow * AW + h * 64 + 4 * hh;
#pragma unroll
    for (int g4 = 0; g4 < 4; ++g4) {
        u32x2 w0, w1;
        w0.x = cvt_pk_bf16(o0[4 * g4], o0[4 * g4 + 1]); w0.y = cvt_pk_bf16(o0[4 * g4 + 2], o0[4 * g4 + 3]);
        w1.x = cvt_pk_bf16(o1[4 * g4], o1[4 * g4 + 1]); w1.y = cvt_pk_bf16(o1[4 * g4 + 2], o1[4 * g4 + 3]);
        *(u32x2*)(op + 8 * g4) = w0; *(u32x2*)(op + 32 + 8 * g4) = w1;
    }
    if (hh == 0) LSE[orow * 8 + h] = mx + __logf(l);
}
__device__ __forceinline__ void phase_attn(const Params& p, unsigned char* ws, LAS unsigned char* lds, const int tid) {
    const int lane = tid & 63, wave = __builtin_amdgcn_readfirstlane(tid >> 6);
    LAS unsigned char* vl = lds + wave * 4608;
    constexpr int NS = 768, NP = 3072;
    for (int bi = blockIdx.x; bi < NS; bi += gridDim.x) attn_sample_item(p, ws, bi * 8 + wave, (LAS float*)vl, lane);
    for (int x = blockIdx.x; x < NP; x += gridDim.x) {
        const int w8 = x & 7, h = (x >> 3) & 7, b = (x >> 6) & 15, g = x >> 10;
        attn_prompt_block((const bf16_t*)(ws + WS_BIG), (bf16_t*)(ws + WS_OG), (float*)(ws + WS_LSE), lds, g, b, h, w8, tid);
    }
    __syncthreads();
}
__device__ __forceinline__ void phase_merge(unsigned char* ws, const int tid) {
    const bf16_t* OG = (const bf16_t*)(ws + WS_OG); const float* LSE = (const float*)(ws + WS_LSE); bf16_t* AO = (bf16_t*)(ws + WS_AO);
    for (int e = blockIdx.x * 512 + tid; e < M * 64; e += gridDim.x * 512) {
        const int rh = e >> 3, c8 = e & 7;
        const float l0 = LSE[rh], l1 = LSE[(size_t)M * 8 + rh], l2 = LSE[(size_t)2 * M * 8 + rh];
        const float mx = fmaxf(l0, fmaxf(l1, l2));
        float w0 = __expf(l0 - mx), w1 = __expf(l1 - mx), w2 = __expf(l2 - mx); const float inv = 1.0f / (w0 + w1 + w2); w0 *= inv; w1 *= inv; w2 *= inv;
        const size_t off = (size_t)rh * 64 + c8 * 8;
        const u32x4 a = *(const u32x4*)(OG + off), b = *(const u32x4*)(OG + (size_t)M * AW + off), c = *(const u32x4*)(OG + (size_t)2 * M * AW + off);
        u32x4 o;
#pragma unroll
        for (int k = 0; k < 4; ++k) o[k] = cvt_pk_bf16(w0 * bf_lo(a[k]) + w1 * bf_lo(b[k]) + w2 * bf_lo(c[k]), w0 * bf_hi(a[k]) + w1 * bf_hi(b[k]) + w2 * bf_hi(c[k]));
        *(u32x4*)(AO + off) = o;
    }
}

__device__ __forceinline__ void phase_vnorm(const Params& p, unsigned char* ws, float* out, const int tid) {
    const int lane = tid & 63, wave = tid >> 6;
    const int gw = blockIdx.x * 8 + wave, NGW = gridDim.x * 8;
    const bf16_t* UV = (const bf16_t*)(ws + WS_BIG); float* RV = (float*)(ws + WS_RV);
    for (int m = gw; m < M; m += NGW) {
        const u32x4* vr = (const u32x4*)(UV + (size_t)m * NUV + BW) + lane;
        u32x4 v[4]; float ss = 0.f;
#pragma unroll
        for (int j = 0; j < 4; ++j) { v[j] = vr[64 * j];
#pragma unroll
            for (int k = 0; k < 4; ++k) { const float a = bf_lo(v[j][k]), b = bf_hi(v[j][k]); ss += a * a + b * b; } }
        const float r = 1.0f / sqrtf(wave_sum(ss) * (1.0f / BW) + EPS);
        if (lane == 0) RV[m] = r;
        if (m >= MP) {
            float* dst = out + O_VS + (size_t)(m - MP) * BW;
#pragma unroll
            for (int j = 0; j < 4; ++j) { const int c0 = 8 * (lane + 64 * j); const f32x4 ga = *(const f32x4*)(p.in[12] + c0), gb = *(const f32x4*)(p.in[12] + c0 + 4);
                *(f32x4*)(dst + c0) = (f32x4){bf_lo(v[j][0]) * r * ga.x, bf_hi(v[j][0]) * r * ga.y, bf_lo(v[j][1]) * r * ga.z, bf_hi(v[j][1]) * r * ga.w};
                *(f32x4*)(dst + c0 + 4) = (f32x4){bf_lo(v[j][2]) * r * gb.x, bf_hi(v[j][2]) * r * gb.y, bf_lo(v[j][3]) * r * gb.z, bf_hi(v[j][3]) * r * gb.w}; }
        }
    }
}
__device__ __forceinline__ void spatial_tile(const Params& p, unsigned char* ws, LAS unsigned char* vl, int chunk, int gi, int tb, int ch, int lane) {
    const bf16_t* UV = (const bf16_t*)(ws + WS_BIG); const float* RV = (const float*)(ws + WS_RV); bf16_t* UM = (bf16_t*)(ws + WS_UM);
    const bf16_t* WSP = (const bf16_t*)(ws + WS_WSP);
    const int hh = lane >> 5;
    const int colb = gi * 128 + 64 * ch;
    const f32x4 ga = *(const f32x4*)(p.in[12] + colb + (lane & 7) * 8), gb = *(const f32x4*)(p.in[12] + colb + (lane & 7) * 8 + 4);
    f32x16 a0, a1;
#pragma unroll
    for (int i = 0; i < 16; ++i) { a0[i] = 0.f; a1[i] = 0.f; }
    const int t = 32 * tb + (lane & 31);
    const bf16_t* wp = WSP + ((size_t)gi * 128 + t) * 128 + 8 * hh;
    const unsigned vbase = (unsigned)(uintptr_t)vl;
    const unsigned tr_off = (unsigned)((8 * hh + ((lane & 15) >> 2)) * 144 + ((lane >> 4) & 1) * 32 + 8 * (lane & 3));
    bf16x8 wfa[8];
#pragma unroll
    for (int ks = 0; ks < 8; ++ks) wfa[ks] = *(const bf16x8*)(wp + 16 * ks);
    u32x4 rawa[4][4]; float rva[4][4];
#pragma unroll
    for (int sb = 0; sb < 4; ++sb)
#pragma unroll
        for (int c4 = 0; c4 < 4; ++c4) {
            const int srow = chunk * 128 + 32 * sb + c4 * 8 + (lane >> 3);
            rawa[sb][c4] = *(const u32x4*)(UV + (size_t)srow * NUV + BW + colb + (lane & 7) * 8);
            rva[sb][c4] = RV[srow];
        }
#pragma unroll
    for (int sb = 0; sb < 4; ++sb) {
        if (sb <= tb) {
        u32x4 raw[4]; float rv[4];
#pragma unroll
        for (int c4 = 0; c4 < 4; ++c4) { raw[c4] = rawa[sb][c4]; rv[c4] = rva[sb][c4]; }
#pragma unroll
        for (int c4 = 0; c4 < 4; ++c4) {
            const float r = rv[c4]; u32x4 o;
            o.x = cvt_pk_bf16(bf_lo(raw[c4].x) * r * ga.x, bf_hi(raw[c4].x) * r * ga.y); o.y = cvt_pk_bf16(bf_lo(raw[c4].y) * r * ga.z, bf_hi(raw[c4].y) * r * ga.w);
            o.z = cvt_pk_bf16(bf_lo(raw[c4].z) * r * gb.x, bf_hi(raw[c4].z) * r * gb.y); o.w = cvt_pk_bf16(bf_lo(raw[c4].w) * r * gb.z, bf_hi(raw[c4].w) * r * gb.w);
            *(LAS u32x4*)(vl + (c4 * 8 + (lane >> 3)) * 144 + (lane & 7) * 16) = o;
        }
#pragma unroll
        for (int s2 = 0; s2 < 2; ++s2) {
            const bf16x8 wf = wfa[2 * sb + s2];
#pragma unroll
            for (int cb = 0; cb < 2; ++cb) {
                const unsigned a = vbase + tr_off + (unsigned)(16 * s2 * 144 + cb * 64);
                const s16x4 lo = tr_read(a), hi = tr_read(a + 4 * 144);
                const bf16x8 va = __builtin_shufflevector(lo, hi, 0, 1, 2, 3, 4, 5, 6, 7);
                if (cb == 0) a0 = MFMA32(va, wf, a0); else a1 = MFMA32(va, wf, a1);
            }
        }
        }
    }
    const size_t row = (size_t)chunk * 128 + t;
    const float bias = p.in[14][gi * 128 + t];
    const bf16_t* up = UV + row * NUV + colb + 4 * hh;
    bf16_t* op = UM + row * LDU + colb + 4 * hh;
#pragma unroll
    for (int cb = 0; cb < 2; ++cb)
#pragma unroll
        for (int g4 = 0; g4 < 4; ++g4) {
            const u32x2 ur = *(const u32x2*)(up + 32 * cb + 8 * g4);
            const f32x16& a = cb == 0 ? a0 : a1;
            u32x2 w;
            w.x = cvt_pk_bf16(bf_lo(ur.x) * (a[4 * g4] + bias), bf_hi(ur.x) * (a[4 * g4 + 1] + bias));
            w.y = cvt_pk_bf16(bf_lo(ur.y) * (a[4 * g4 + 2] + bias), bf_hi(ur.y) * (a[4 * g4 + 3] + bias));
            *(u32x2*)(op + 32 * cb + 8 * g4) = w;
        }
}
__device__ __forceinline__ void phase_spatial(const Params& p, unsigned char* ws, LAS unsigned char* lds, const int tid) {
    const int lane = tid & 63, wave = __builtin_amdgcn_readfirstlane(tid >> 6);
    const bf16_t* UV = (const bf16_t*)(ws + WS_BIG); const float* RV = (const float*)(ws + WS_RV); bf16_t* UM = (bf16_t*)(ws + WS_UM);
    const float* vgain = p.in[12]; const float* bsp = p.in[14];
    constexpr int NPI = 256 * 16, NSI = 256;
    LAS unsigned char* vl = lds + wave * 4608;
    for (int it = blockIdx.x; it < NPI + NSI; it += gridDim.x) {
        if (it < NPI) spatial_tile(p, ws, vl, it >> 4, it & 15, wave & 3, wave >> 2, lane);
        else {
            const int e = (it - NPI) * 512 + tid;
            const int c4 = e & 511, bt = e >> 9, t = bt & 7, b = bt >> 3, c0 = 4 * c4, gi = c0 >> 7;
            f32x4 acc = {0.f, 0.f, 0.f, 0.f};
            const f32x4 vg = *(const f32x4*)(vgain + c0);
            for (int s = 0; s <= t; ++s) {
                const size_t r = (size_t)MP + b * 8 + s;
                const u32x2 vr = *(const u32x2*)(UV + r * NUV + BW + c0);
                const float wv = p.in[13][((size_t)gi * 128 + t) * 128 + s] * RV[r];
                acc += (f32x4){bf_lo(vr.x), bf_hi(vr.x), bf_lo(vr.y), bf_hi(vr.y)} * wv;
            }
            const float bias = bsp[gi * 128 + t];
            const size_t r = (size_t)MP + b * 8 + t;
            const u32x2 ur = *(const u32x2*)(UV + r * NUV + c0);
            u32x2 w;
            w.x = cvt_pk_bf16(bf_lo(ur.x) * (acc.x * vg.x + bias), bf_hi(ur.x) * (acc.y * vg.y + bias));
            w.y = cvt_pk_bf16(bf_lo(ur.y) * (acc.z * vg.z + bias), bf_hi(ur.y) * (acc.w * vg.w + bias));
            *(u32x2*)(UM + r * LDU + c0) = w;
        }
    }
}

constexpr int BAR_WORDS = 64 * 18;
__device__ __forceinline__ void grid_barrier(unsigned* bar, const int tid, volatile LAS unsigned* ctl) {
    asm volatile("s_waitcnt vmcnt(0) lgkmcnt(0)" ::: "memory");
    __syncthreads();
    if (tid == 0) {
        const unsigned x = (unsigned)__builtin_amdgcn_s_getreg((3 << 11) | 20) & 7u, nloc = ctl[0], nx = ctl[1];
        if (__hip_atomic_fetch_add(bar + 64 * x, 1u, __ATOMIC_RELAXED, __HIP_MEMORY_SCOPE_AGENT) == nloc - 1u) {
            __builtin_amdgcn_fence(__ATOMIC_RELEASE, "agent");
            asm volatile("s_waitcnt vmcnt(0)" ::: "memory");
            if (__hip_atomic_fetch_add(bar + 64 * 8, 1u, __ATOMIC_RELAXED, __HIP_MEMORY_SCOPE_AGENT) == nx - 1u) __hip_atomic_store(bar + 64 * 9, 1u, __ATOMIC_RELAXED, __HIP_MEMORY_SCOPE_AGENT);
            else while (__hip_atomic_load(bar + 64 * 9, __ATOMIC_RELAXED, __HIP_MEMORY_SCOPE_AGENT) == 0u) __builtin_amdgcn_s_sleep(1);
            __builtin_amdgcn_fence(__ATOMIC_ACQUIRE, "agent");
            __hip_atomic_store(bar + 64 * (10 + x), 1u, __ATOMIC_RELAXED, __HIP_MEMORY_SCOPE_AGENT);
            asm volatile("s_waitcnt vmcnt(0)" ::: "memory");
        } else {
            while (__hip_atomic_load(bar + 64 * (10 + x), __ATOMIC_RELAXED, __HIP_MEMORY_SCOPE_AGENT) == 0u) __builtin_amdgcn_s_sleep(1);
            __builtin_amdgcn_fence(__ATOMIC_ACQUIRE, "agent");
            asm volatile("s_waitcnt vmcnt(0)" ::: "memory");
        }
    }
    __syncthreads();
}

__global__ void __launch_bounds__(512, 2) mega(Params p) {
    extern __shared__ __attribute__((aligned(16))) unsigned char lds_raw[];
    LAS unsigned char* lds = (LAS unsigned char*)lds_raw;
    for (int ph = p.ph_lo; ph < p.ph_hi; ++ph) {
        int tid = threadIdx.x; asm volatile("" : "+v"(tid));
        unsigned z; asm volatile("s_mov_b32 %0, 0" : "=s"(z));
        unsigned char* ws = p.ws + z; float* out = p.out + z;
        bf16_t* XN = (bf16_t*)(ws + WS_XN); bf16_t* BIG = (bf16_t*)(ws + WS_BIG);
        bf16_t* YB = (bf16_t*)(ws + WS_YB);
        int fi = -1, fo = -1, ni = -1; float sy = 0.5f;
        switch (ph) {
            case 1: fi = 0; break; case 10: fi = 1; break; case 13: fi = 2; break; case 21: fi = 3; break;
            case 2: fo = 0; break; case 11: fo = 1; break; case 14: fo = 2; break; case 22: fo = 3; break;
            case 3: ni = 1; break; case 9: ni = 2; sy = 1.0f; break; case 12: ni = 3; break; case 15: ni = 4; break; case 20: ni = 5; sy = 1.0f; break; case 23: ni = 6; break;
            default: break;
        }
#ifndef PMASK
#define PMASK 0xFFFF
#endif
        if ((PMASK & 1) && ph == 0) phase_prologue(p, ws, out, lds, tid);
        else if ((PMASK & 2) && fi >= 0) { const bf16_t* W = (const bf16_t*)(ws + WS_WIN + fi * SZ_WIN); sample_gemm<2>(lds, XN + (size_t)MP * D, D, W, D, D, FF, BIG + (size_t)MP * FF, FF, tid);
            pg8::EpiSwiglu E{BIG}; pg8::gemm_phase(lds, XN, W, MP, 2 * FF, D, E, tid); }
        else if (ph == 22) {
            const bf16_t* B = (const bf16_t*)(ws + WS_WOUT + 3 * SZ_WOUT);
            sample_gemm<4>(lds, BIG + (size_t)MP * FF, FF, B, FF, FF, D, nullptr, D, tid, out + (size_t)MP * D);
            pg8::EpiFinal E{out, 0.5f}; pg8::gemm_phase(lds, BIG, B, MP, D, FF, E, tid); }
        else if ((PMASK & 4) && (fo >= 0 || ph == 8 || ph == 19)) {
            const bf16_t* A = BIG; const bf16_t* B = (const bf16_t*)(ws + WS_WOUT + (fo < 0 ? 0 : fo) * SZ_WOUT); int K = FF, ld = FF;
            if (ph == 8) { A = (const bf16_t*)(ws + WS_AO); B = (const bf16_t*)(ws + WS_WOA); K = AW; ld = AW; }
            if (ph == 19) { A = (const bf16_t*)(ws + WS_UM); B = (const bf16_t*)(ws + WS_WOB); K = BW; ld = LDU; }
            sample_gemm<0>(lds, A + (size_t)MP * ld, ld, B, ld, K, D, YB + (size_t)MP * D, D, tid);
            pg8::EpiBf16<0> E{YB, D}; pg8::gemm_phase(lds, A, B, MP, D, K, E, tid, ld, ld); }
#ifdef DUMPSEL
        else if (ph == 20) {
            const bf16_t* wsp = (const bf16_t*)(ws + WS_WSP); const float* rvp = (const float*)(ws + WS_RV);
            for (size_t e = (size_t)blockIdx.x * 512 + tid; e < (size_t)M * D; e += (size_t)gridDim.x * 512) { const size_t r = e / D, c = e % D;
                out[e] = (DUMPSEL == 10) ? p.in[12][(c + r) % 2048] * p.in[14][(c * 3 + r) % 2048] * (1.0f + p.in[13][(r * 1024 + c) % 262144]) : (DUMPSEL == 2) ? (r >= (size_t)MP ? 0.f : 1.f) * __uint_as_float((unsigned)((const bf16_t*)(ws + WS_UM))[r * LDU + c] << 16) : (DUMPSEL == 8) ? (r < 256 ? __uint_as_float((unsigned)wsp[r * 1024 + c] << 16) : 0.f) : rvp[r]; }
        }
#endif
        else if ((PMASK & 8) && ni >= 0) phase_norm(ws, out, ni < 6 ? p.in[5] + ni * D : nullptr, sy, tid);
        else if ((PMASK & 16) && ph == 4) { sample_gemm<0>(lds, XN + (size_t)MP * D, D, (const bf16_t*)(ws + WS_WQKV), D, D, NQKV, BIG + (size_t)MP * NQKV, NQKV, tid);
            pg8::EpiBf16<0> E{BIG, NQKV}; pg8::gemm_phase(lds, XN, (const bf16_t*)(ws + WS_WQKV), MP, NQKV, D, E, tid); }
        else if ((PMASK & 32) && ph == 5) phase_qknorm(p, ws, out, tid);
        else if ((PMASK & 64) && ph == 6) phase_attn(p, ws, lds, tid);
        else if ((PMASK & 128) && ph == 7) phase_merge(ws, tid);
        else if ((PMASK & 512) && ph == 16) { sample_gemm<1>(lds, XN + (size_t)MP * D, D, (const bf16_t*)(ws + WS_WUV), D, D, NUV, BIG + (size_t)MP * NUV, NUV, tid);
            pg8::EpiBf16<1> E{BIG, NUV}; pg8::gemm_phase(lds, XN, (const bf16_t*)(ws + WS_WUV), MP, NUV, D, E, tid); }
        else if ((PMASK & 1024) && ph == 17) phase_vnorm(p, ws, out, tid);
        else if ((PMASK & 2048) && ph == 18) phase_spatial(p, ws, lds, tid);
        if (ph + 1 < p.ph_hi) {
            volatile LAS unsigned* ctl = (volatile LAS unsigned*)(lds + 135168);
            if (ph == 0) {
                const unsigned x = (unsigned)__builtin_amdgcn_s_getreg((3 << 11) | 20) & 7u;
                if (tid == 0) __hip_atomic_fetch_add((unsigned*)p.ws + 64 * x, 1u, __ATOMIC_RELAXED, __HIP_MEMORY_SCOPE_AGENT);
                __syncthreads(); cg::this_grid().sync();
                if (tid == 0) { unsigned nx = 0;
                    for (int j = 0; j < 8; ++j) nx += __hip_atomic_load((unsigned*)p.ws + 64 * j, __ATOMIC_RELAXED, __HIP_MEMORY_SCOPE_AGENT) != 0u;
                    ctl[0] = __hip_atomic_load((unsigned*)p.ws + 64 * x, __ATOMIC_RELAXED, __HIP_MEMORY_SCOPE_AGENT); ctl[1] = nx; }
                __syncthreads();
            }
            else grid_barrier((unsigned*)p.ws + (size_t)BAR_WORDS * ph, tid, ctl);
        }
    }
}

extern "C" void kernel_launch(void* const* d_in, const int* in_sizes, int n_in, void* d_out, int out_size, void* d_ws, size_t ws_size, hipStream_t stream) {
    static int grid = 0;
    if (grid == 0) {
        if (n_in != 16 || ws_size < WS_END) { fprintf(stderr, "kernel_launch: unexpected inputs (n_in %d, ws %zu < %zu)\n", n_in, ws_size, (size_t)WS_END); grid = -1; return; }
        int dev = 0, cus = 0, per_cu = 0;
        (void)hipGetDevice(&dev);
        (void)hipDeviceGetAttribute(&cus, hipDeviceAttributeMultiprocessorCount, dev);
        if (hipFuncSetAttribute((const void*)mega, hipFuncAttributeMaxDynamicSharedMemorySize, LDS_BYTES) != hipSuccess) { fprintf(stderr, "kernel_launch: hipFuncSetAttribute failed\n"); grid = -1; return; }
        if (hipOccupancyMaxActiveBlocksPerMultiprocessor(&per_cu, (const void*)mega, 512, LDS_BYTES) != hipSuccess || per_cu < 1) { fprintf(stderr, "kernel_launch: occupancy query says %d\n", per_cu); per_cu = 1; }
        (void)hipGetLastError();
        grid = cus * 1;
    }
    if (grid < 0) return;
    if (hipMemsetAsync(d_ws, 0, 262144, stream) != hipSuccess) { fprintf(stderr, "kernel_launch: memset failed\n"); return; }
    Params p{};
    for (int i = 0; i < 16; ++i) p.in[i] = (const float*)d_in[i];
    p.out = (float*)d_out; p.ws = (unsigned char*)d_ws;
#if ONE_LAUNCH
    p.ph_lo = 0; p.ph_hi = NPHASE;
    void* args[] = {&p};
    hipError_t e = hipLaunchCooperativeKernel((const void*)mega, dim3(grid), dim3(512), args, LDS_BYTES, stream);
    if (e != hipSuccess) fprintf(stderr, "cooperative launch failed: %s (grid %d)\n", hipGetErrorString(e), grid);
#else
    for (int ph = 0; ph < NPHASE; ++ph) {
        p.ph_lo = ph; p.ph_hi = ph + 1;
        hipLaunchKernelGGL(mega, dim3(grid), dim3(512), LDS_BYTES, stream, p);
    }
#endif
}
```

```cpp
#include <hip/hip_runtime.h>
#include <hip/hip_cooperative_groups.h>
#include <cstdio>
#include <cstdint>
namespace cg = cooperative_groups;

#ifndef ONE_LAUNCH
#define ONE_LAUNCH 1
#endif

#define LAS __attribute__((address_space(3)))
typedef unsigned short bf16_t;
typedef short bf16x8 __attribute__((ext_vector_type(8)));
typedef short s16x4 __attribute__((ext_vector_type(4)));
typedef float f32x2 __attribute__((ext_vector_type(2)));
typedef float f32x4 __attribute__((ext_vector_type(4)));
typedef float f32x16 __attribute__((ext_vector_type(16)));
typedef unsigned u32x2 __attribute__((ext_vector_type(2)));
typedef unsigned u32x4 __attribute__((ext_vector_type(4)));

constexpr int D = 1024, SEQ = 2048, NBATCH = 16, MP = NBATCH * SEQ, MS = 256, M = MP + MS;
constexpr int FF = 2816, NQKV = 4608, AW = 512, BW = 2048, NUV = 4096, PAST = 16384;
constexpr float EPS = 1e-6f;
constexpr int LDU = BW + 64;
constexpr int NPOS = SEQ + 8;
constexpr size_t O_YP = 0, O_YS = (size_t)MP * D, O_KP0 = O_YS + (size_t)MS * D, O_KP1 = O_KP0 + 2097152, O_KP2 = O_KP1 + 8388608,
                 O_KS0 = O_KP2 + 33554432, O_KS1 = O_KS0 + 262144, O_KS2 = O_KS1 + 262144, O_VS = O_KS2 + 262144;
constexpr size_t al256(size_t x) { return (x + 255) & ~(size_t)255; }
constexpr size_t WS_WIN = 1u << 20;
constexpr size_t SZ_WIN = (size_t)2 * FF * D * 2;
constexpr size_t WS_WOUT = WS_WIN + 4 * SZ_WIN;
constexpr size_t SZ_WOUT = (size_t)D * FF * 2;
constexpr size_t WS_WQKV = WS_WOUT + 4 * SZ_WOUT;
constexpr size_t WS_WOA = WS_WQKV + (size_t)NQKV * D * 2;
constexpr size_t WS_WUV = WS_WOA + (size_t)D * AW * 2;
constexpr size_t WS_WOB = WS_WUV + (size_t)NUV * D * 2;
constexpr size_t WS_WSP = WS_WOB + (size_t)D * LDU * 2;
constexpr size_t WS_ROPE = WS_WSP + (size_t)16 * 128 * 128 * 2;
constexpr size_t WS_XN = al256(WS_ROPE + (size_t)NPOS * 32 * 4 * 2);
constexpr size_t WS_BIG = al256(WS_XN + (size_t)M * D * 2);
constexpr size_t WS_OG = al256(WS_BIG + (size_t)M * NQKV * 2);
constexpr size_t WS_LSE = al256(WS_OG + (size_t)3 * M * AW * 2);
constexpr size_t WS_AO = al256(WS_LSE + (size_t)3 * M * 8 * 4);
constexpr size_t WS_UM = al256(WS_AO + (size_t)M * AW * 2);
constexpr size_t WS_RV = al256(WS_UM + (size_t)M * LDU * 2);
constexpr size_t WS_YB = al256(WS_RV + (size_t)M * 4);
constexpr size_t WS_END = al256(WS_YB + (size_t)M * D * 2);

constexpr int LDS_BYTES = 139264;
#ifdef DUMPSEL
constexpr int NPHASE = 21;
#else
constexpr int NPHASE = 23;
#endif

__device__ __forceinline__ float wave_sum(float v) {
#pragma unroll
    for (int o = 1; o < 64; o <<= 1) v += __shfl_xor(v, o);
    return v;
}
__device__ __forceinline__ float wave_max(float v) {
#pragma unroll
    for (int o = 1; o < 64; o <<= 1) v = fmaxf(v, __shfl_xor(v, o));
    return v;
}
typedef __bf16 bf16x2_t __attribute__((ext_vector_type(2)));
__device__ __forceinline__ unsigned cvt_pk_bf16(float lo, float hi) { const f32x2 v = {lo, hi}; return __builtin_bit_cast(unsigned, __builtin_convertvector(v, bf16x2_t)); }
__device__ __forceinline__ float bf_lo(unsigned w) { return __uint_as_float(w << 16); }
__device__ __forceinline__ float bf_hi(unsigned w) { return __uint_as_float(w & 0xffff0000u); }
__device__ __forceinline__ float silu_f(float x) { return x * __builtin_amdgcn_rcpf(1.0f + __expf(-x)); }
__device__ __forceinline__ float gelu_tanh_f(float x) { const float y = 0.7978845608028654f * (x + 0.044715f * x * x * x); return x * __builtin_amdgcn_rcpf(1.0f + __expf(-2.0f * y)); }

namespace pg8 {
constexpr int BM = 256, BK = 64, HALF = 128, HTB = HALF * BK * 2, STAGE_BYTES = 8 * HTB, NXCD = 8, WGM = 8;
__device__ __forceinline__ int lds_byte(int r, int c) { const int st = (r >> 4) * 2 + (c >> 5), rr = r & 15, cc = c & 31, ob = rr * 64 + cc * 2; return st * 1024 + (ob ^ (((ob >> 9) & 1) << 5)); }
__device__ __forceinline__ void stage_rc(int b, int& R, int& C) { const int st = b / 1024, sb = b % 1024, swz = sb ^ (((sb >> 9) & 1) << 5); R = (st >> 1) * 16 + swz / 64; C = (st & 1) * 32 + (swz % 64) / 2; }
__device__ __forceinline__ int perm32(int rho) { const int n = rho >> 4, i = rho & 15; return 8 * (i >> 2) + 4 * n + (i & 3); }
struct Unit { int pm, pn; };
struct StaticOrder {
    int nM, nN, nwg, G, c;
    __device__ void init(int M_, int N_, int G_, int c_) { nM = M_ / BM; nN = N_ / BM; nwg = nM * nN; G = G_; c = c_; }
    __device__ bool next(int i, Unit& u) const {
        const long L = (long)i * G + c; if (L >= nwg) return false;
        int wgid = (int)L; { const int q = nwg / NXCD, r = nwg % NXCD, xcd = wgid % NXCD, off = wgid / NXCD; wgid = (xcd < r ? xcd * (q + 1) : r * (q + 1) + (xcd - r) * q) + off; }
        const int nig = WGM * nN, gid = wgid / nig, fm = gid * WGM, gsz = (nM - fm) < WGM ? (nM - fm) : WGM;
        u.pm = fm + ((wgid % nig) % gsz); u.pn = (wgid % nig) / gsz; return true;
    }
};
template <class Epi>
__device__ __forceinline__ void gemm_phase(LAS unsigned char* lds, const bf16_t* gA, const bf16_t* gBt, int gM, int gN, int K, const Epi& E, const int tid, const int lda = 0, const int ldb = 0) {
    const int LA = lda ? lda : K, LB = ldb ? ldb : K;
    const int wid = __builtin_amdgcn_readfirstlane(tid >> 6), lane = tid & 63, wr = wid >> 2, wc = wid & 3, fr = lane & 15, fq = lane >> 4;
    const int nt = K / BK;
    StaticOrder S; S.init(gM, gN, (int)gridDim.x, (int)blockIdx.x);
    unsigned voffA[2], voffB[2];
#pragma unroll
    for (int i = 0; i < 2; ++i) { int R, C; stage_rc(tid * 16 + i * 8192, R, C); const int Rb = Epi::PERM ? ((R & ~31) + perm32(R & 31)) : R;
        voffA[i] = (unsigned)(R * LA + C) * 2u; voffB[i] = (unsigned)(Rb * LB + C) * 2u; }
    const size_t kstep = (size_t)(BK * 2);
    const size_t hstepA = (size_t)HALF * LA * 2, hstepB = (size_t)HALF * LB * 2;
    const size_t tstepA = 2 * hstepA, tstepB = 2 * hstepB;
    const unsigned ldsw = (unsigned)wid * 1024u;
    const int aoff = lds_byte(wr * 64 + fr, fq * 8), boff = lds_byte(wc * 32 + fr, fq * 8);
#define PG8_SA(b, h) (((b) * 2 + (h)) * HTB)
#define PG8_SB(b, h) ((4 + (b) * 2 + (h)) * HTB)
#define PG8_STAGE(bufoff, gbase, voff) do { _Pragma("unroll") for (int _i = 0; _i < 2; ++_i) \
        __builtin_amdgcn_global_load_lds((const unsigned*)((const char*)(gbase) + (voff)[_i]), (LAS unsigned*)(lds + (bufoff) + ldsw + _i * 8192), 16, 0, 0); } while (0)
#define PG8_LDA(dst, b, h) do { _Pragma("unroll") for (int m = 0; m < 4; ++m) _Pragma("unroll") for (int k = 0; k < 2; ++k) dst[m][k] = *(const LAS bf16x8*)(lds + PG8_SA(b, h) + aoff + m * 2048 + k * 1024); } while (0)
#define PG8_LDB(dst, b, h) do { _Pragma("unroll") for (int n = 0; n < 2; ++n) _Pragma("unroll") for (int k = 0; k < 2; ++k) dst[n][k] = *(const LAS bf16x8*)(lds + PG8_SB(b, h) + boff + n * 2048 + k * 1024); } while (0)
#define PG8_MMA(ai, bj, At, Bt) do { __builtin_amdgcn_s_setprio(1); _Pragma("unroll") for (int m = 0; m < 4; ++m) _Pragma("unroll") for (int n = 0; n < 2; ++n) _Pragma("unroll") for (int k = 0; k < 2; ++k) \
        acc[ai][bj][m][n] = __builtin_amdgcn_mfma_f32_16x16x32_bf16(Bt[n][k], At[m][k], acc[ai][bj][m][n], 0, 0, 0); __builtin_amdgcn_s_setprio(0); } while (0)
#define PG8_WAIT_V(n) asm volatile("s_waitcnt vmcnt(" #n ")" ::: "memory")
#define PG8_WAIT_L(n) asm volatile("s_waitcnt lgkmcnt(" #n ")" ::: "memory")
#define PG8_BAR __builtin_amdgcn_s_barrier()
#define PG8_SCHED __builtin_amdgcn_sched_barrier(0)
    Unit cur, nxt; int ui = 0;
    if (!S.next(0, cur)) return;
    f32x4 acc[2][2][4][2];
#pragma unroll
    for (int a = 0; a < 2; ++a)
#pragma unroll
        for (int b = 0; b < 2; ++b)
#pragma unroll
            for (int m = 0; m < 4; ++m)
#pragma unroll
                for (int n = 0; n < 2; ++n) acc[a][b][m][n] = (f32x4){0.f, 0.f, 0.f, 0.f};
    bf16x8 At[4][2], B0[2][2], B1[2][2];
    const char* cA = (const char*)gA + (size_t)cur.pm * tstepA; const char* cB = (const char*)gBt + (size_t)cur.pn * tstepB;
    PG8_STAGE(PG8_SB(0, 0), cB, voffB); PG8_STAGE(PG8_SB(0, 1), cB + hstepB, voffB); PG8_STAGE(PG8_SA(0, 0), cA, voffA); PG8_STAGE(PG8_SA(0, 1), cA + hstepA, voffA);
    if (wr == 1) PG8_BAR;
    PG8_WAIT_V(2); PG8_BAR;
    PG8_STAGE(PG8_SB(1, 0), cB + kstep, voffB); PG8_STAGE(PG8_SA(1, 0), cA + kstep, voffA); PG8_STAGE(PG8_SB(1, 1), cB + hstepB + kstep, voffB);
    PG8_WAIT_V(6); PG8_BAR;
    for (;;) {
        const bool has_next = S.next(ui + 1, nxt);
        const char* nA = has_next ? (const char*)gA + (size_t)nxt.pm * tstepA : cA; const char* nB = has_next ? (const char*)gBt + (size_t)nxt.pn * tstepB : cB;
        for (int t = 0; t < nt; t += 2) {
            const bool last = (t == nt - 2);
            const char* a1 = cA + (size_t)(t + 1) * kstep;
            const char* a2 = last ? nA : cA + (size_t)(t + 2) * kstep; const char* b2 = last ? nB : cB + (size_t)(t + 2) * kstep;
            const char* a3 = a2 + kstep; const char* b3 = b2 + kstep;
            PG8_LDB(B0, 0, 0); PG8_LDB(B1, 0, 1); PG8_SCHED; PG8_LDA(At, 0, 0); PG8_STAGE(PG8_SA(1, 1), a1 + hstepA, voffA);
            PG8_WAIT_V(8); PG8_WAIT_L(0); PG8_BAR; PG8_MMA(0, 0, At, B0); PG8_MMA(0, 1, At, B1); PG8_BAR; PG8_SCHED;
            PG8_LDA(At, 0, 1); PG8_STAGE(PG8_SB(0, 0), b2, voffB); PG8_STAGE(PG8_SB(0, 1), b2 + hstepB, voffB); PG8_STAGE(PG8_SA(0, 0), a2, voffA);
            PG8_WAIT_V(8); PG8_WAIT_L(0); PG8_BAR; PG8_MMA(1, 0, At, B0); PG8_MMA(1, 1, At, B1); PG8_BAR; PG8_SCHED;
            PG8_LDB(B0, 1, 0); PG8_LDB(B1, 1, 1); PG8_SCHED; PG8_LDA(At, 1, 0); PG8_STAGE(PG8_SA(0, 1), a2 + hstepA, voffA);
            PG8_WAIT_V(8); PG8_WAIT_L(0); PG8_BAR; PG8_MMA(0, 0, At, B0); PG8_MMA(0, 1, At, B1); PG8_BAR; PG8_SCHED;
            PG8_LDA(At, 1, 1); PG8_STAGE(PG8_SB(1, 0), b3, voffB); PG8_STAGE(PG8_SB(1, 1), b3 + hstepB, voffB); PG8_STAGE(PG8_SA(1, 0), a3, voffA);
            PG8_WAIT_V(8); PG8_WAIT_L(0); PG8_BAR; PG8_MMA(1, 0, At, B0); PG8_MMA(1, 1, At, B1); PG8_BAR; PG8_SCHED;
        }
        if (wr == 0) PG8_BAR;
        E(acc, cur, wr, wc, fr, fq);
        if (!has_next) break;
#pragma unroll
        for (int a = 0; a < 2; ++a)
#pragma unroll
            for (int b = 0; b < 2; ++b)
#pragma unroll
                for (int m = 0; m < 4; ++m)
#pragma unroll
                    for (int n = 0; n < 2; ++n) acc[a][b][m][n] = (f32x4){0.f, 0.f, 0.f, 0.f};
        cur = nxt; cA = nA; cB = nB; ++ui;
        if (wr == 1) PG8_BAR;
    }
    PG8_WAIT_V(0);
    PG8_BAR;
#undef PG8_SA
#undef PG8_SB
#undef PG8_STAGE
#undef PG8_LDA
#undef PG8_LDB
#undef PG8_MMA
#undef PG8_WAIT_V
#undef PG8_WAIT_L
#undef PG8_BAR
#undef PG8_SCHED
}

struct EpiSwiglu {
    static constexpr bool PERM = true;
    bf16_t* O;
    __device__ __forceinline__ void operator()(const f32x4 (&acc)[2][2][4][2], const Unit& u, int wr, int wc, int fr, int fq) const {
        const int row0 = u.pm * BM + wr * 64 + fr, col0 = u.pn * HALF + wc * 32 + 8 * fq;
#pragma unroll
        for (int ai = 0; ai < 2; ++ai)
#pragma unroll
            for (int m = 0; m < 4; ++m) {
                const f32x4 g0 = acc[ai][0][m][0], g1 = acc[ai][0][m][1], u0 = acc[ai][1][m][0], u1 = acc[ai][1][m][1];
                u32x4 w;
                w.x = cvt_pk_bf16(silu_f(g0[0]) * u0[0], silu_f(g0[1]) * u0[1]); w.y = cvt_pk_bf16(silu_f(g0[2]) * u0[2], silu_f(g0[3]) * u0[3]);
                w.z = cvt_pk_bf16(silu_f(g1[0]) * u1[0], silu_f(g1[1]) * u1[1]); w.w = cvt_pk_bf16(silu_f(g1[2]) * u1[2], silu_f(g1[3]) * u1[3]);
                *(u32x4*)(O + (size_t)(row0 + ai * HALF + m * 16) * FF + col0) = w;
            }
    }
};
struct EpiResid {
    static constexpr bool PERM = false;
    float* X; float s;
    __device__ __forceinline__ void operator()(const f32x4 (&acc)[2][2][4][2], const Unit& u, int wr, int wc, int fr, int fq) const {
        const int row0 = u.pm * BM + wr * 64 + fr, col0 = u.pn * BM + wc * 32 + 4 * fq;
#pragma unroll
        for (int ai = 0; ai < 2; ++ai)
#pragma unroll
            for (int m = 0; m < 4; ++m) { float* rowp = X + (size_t)(row0 + ai * HALF + m * 16) * D + col0;
#pragma unroll
                for (int bj = 0; bj < 2; ++bj)
#pragma unroll
                    for (int n = 0; n < 2; ++n) { f32x4* p = (f32x4*)(rowp + bj * HALF + n * 16); *p = *p + acc[ai][bj][m][n] * s; } }
    }
};
struct EpiFinal {
    static constexpr bool PERM = false;
    float* X; float s;
    __device__ __forceinline__ void operator()(const f32x4 (&acc)[2][2][4][2], const Unit& u, int wr, int wc, int fr, int fq) const {
        float* base = X + (size_t)(u.pm * BM + wr * 64 + fr) * D + u.pn * BM + wc * 32 + 4 * fq;
        f32x4 x[2][4];
#pragma unroll
        for (int q = 0; q < 4; ++q) x[0][q] = *(const f32x4*)(base + (q >> 1) * HALF + (q & 1) * 16);
#pragma unroll
        for (int g = 0; g < 8; ++g) {
            const int ai = g >> 2, m = g & 3;
            float* rowp = base + (size_t)(ai * HALF + m * 16) * D;
            if (g < 7) { const float* nx = base + (size_t)(((g + 1) >> 2) * HALF + ((g + 1) & 3) * 16) * D;
#pragma unroll
                for (int q = 0; q < 4; ++q) x[(g + 1) & 1][q] = *(const f32x4*)(nx + (q >> 1) * HALF + (q & 1) * 16); }
#pragma unroll
            for (int q = 0; q < 4; ++q) *(f32x4*)(rowp + (q >> 1) * HALF + (q & 1) * 16) = x[g & 1][q] + acc[ai][q >> 1][m][q & 1] * s;
        }
    }
};
struct EpiQKV {
    static constexpr bool PERM = true;
    bf16_t* O; const float* ct; const float* st; const float* gain; float* out;
    __device__ __forceinline__ void operator()(const f32x4 (&acc)[2][2][4][2], const Unit& u, int wr, int wc, int fr, int fq) const {
        const int head = u.pn * 4 + wc, which = head / 24, gh = head - which * 24, g = gh >> 3, h = gh & 7, d0 = 8 * fq;
        const int row0 = u.pm * BM + wr * 64 + fr;
        f32x4 ga0 = {1.f, 1.f, 1.f, 1.f}, ga1 = ga0, gb0 = ga0, gb1 = ga0;
        if (which < 2) { const float* gp = gain + which * 64 + d0; ga0 = *(const f32x4*)gp; ga1 = *(const f32x4*)(gp + 4); gb0 = *(const f32x4*)(gp + 32); gb1 = *(const f32x4*)(gp + 36); }
        const int keep = 128 << (2 * g);
        const size_t tbase = g == 0 ? O_KP0 : (g == 1 ? O_KP1 : O_KP2);
#pragma unroll
        for (int ai = 0; ai < 2; ++ai)
#pragma unroll
            for (int m = 0; m < 4; ++m) {
                const int row = row0 + ai * HALF + m * 16;
                f32x4 a0 = acc[ai][0][m][0], a1 = acc[ai][0][m][1], b0 = acc[ai][1][m][0], b1 = acc[ai][1][m][1];
                if (which < 2) {
                    float ss = ((a0.x * a0.x + a0.y * a0.y) + (a0.z * a0.z + a0.w * a0.w)) + ((a1.x * a1.x + a1.y * a1.y) + (a1.z * a1.z + a1.w * a1.w))
                             + ((b0.x * b0.x + b0.y * b0.y) + (b0.z * b0.z + b0.w * b0.w)) + ((b1.x * b1.x + b1.y * b1.y) + (b1.z * b1.z + b1.w * b1.w));
                    ss += __shfl_xor(ss, 16); ss += __shfl_xor(ss, 32);
                    const float r = 1.0f / sqrtf(ss * (1.0f / 64) + EPS);
                    const int pi = row & 2047;
                    const f32x4 c0 = *(const f32x4*)(ct + pi * 32 + d0), c1 = *(const f32x4*)(ct + pi * 32 + d0 + 4), s0 = *(const f32x4*)(st + pi * 32 + d0), s1 = *(const f32x4*)(st + pi * 32 + d0 + 4);
                    const f32x4 ya0 = a0 * r * ga0, ya1 = a1 * r * ga1, yb0 = b0 * r * gb0, yb1 = b1 * r * gb1;
                    a0 = ya0 * c0 - yb0 * s0; a1 = ya1 * c1 - yb1 * s1; b0 = yb0 * c0 + ya0 * s0; b1 = yb1 * c1 + ya1 * s1;
                }
                bf16_t* dst = O + (size_t)row * NQKV + head * 64 + d0;
                u32x4 w0, w1;
                w0.x = cvt_pk_bf16(a0.x, a0.y); w0.y = cvt_pk_bf16(a0.z, a0.w); w0.z = cvt_pk_bf16(a1.x, a1.y); w0.w = cvt_pk_bf16(a1.z, a1.w);
                w1.x = cvt_pk_bf16(b0.x, b0.y); w1.y = cvt_pk_bf16(b0.z, b0.w); w1.z = cvt_pk_bf16(b1.x, b1.y); w1.w = cvt_pk_bf16(b1.z, b1.w);
                *(u32x4*)dst = w0; *(u32x4*)(dst + 32) = w1;
                if (which >= 1) {
                    const int bb = row >> 11, tt = (row & 2047) - (SEQ - keep);
                    if (tt >= 0) { float* tp = out + tbase + ((((size_t)bb * keep + tt) * 2 + (which - 1)) * 8 + h) * 64 + d0;
                        *(f32x4*)tp = a0; *(f32x4*)(tp + 4) = a1; *(f32x4*)(tp + 32) = b0; *(f32x4*)(tp + 36) = b1; }
                }
            }
    }
};
template <int ACT> struct EpiBf16 {
    static constexpr bool PERM = true;
    bf16_t* O; int ldc;
    __device__ __forceinline__ void operator()(const f32x4 (&acc)[2][2][4][2], const Unit& u, int wr, int wc, int fr, int fq) const {
        const int row0 = u.pm * BM + wr * 64 + fr, col0 = u.pn * BM + wc * 32 + 8 * fq;
#pragma unroll
        for (int ai = 0; ai < 2; ++ai)
#pragma unroll
            for (int m = 0; m < 4; ++m) { bf16_t* rowp = O + (size_t)(row0 + ai * HALF + m * 16) * ldc + col0;
#pragma unroll
                for (int bj = 0; bj < 2; ++bj) { f32x4 v0 = acc[ai][bj][m][0], v1 = acc[ai][bj][m][1];
                    if (ACT == 1) {
#pragma unroll
                        for (int j = 0; j < 4; ++j) { v0[j] = gelu_tanh_f(v0[j]); v1[j] = gelu_tanh_f(v1[j]); } }
                    u32x4 w; w.x = cvt_pk_bf16(v0[0], v0[1]); w.y = cvt_pk_bf16(v0[2], v0[3]); w.z = cvt_pk_bf16(v1[0], v1[1]); w.w = cvt_pk_bf16(v1[2], v1[3]);
                    *(u32x4*)(rowp + bj * HALF) = w; } }
    }
};
}

#define MFMA32S(a, b, c) __builtin_amdgcn_mfma_f32_32x32x16_bf16((a), (b), (c), 0, 0, 0)
template <int MODE>
__device__ __forceinline__ void sample_gemm(LAS unsigned char* lds, const bf16_t* A, int lda, const bf16_t* Bt, int ldb, int K, int N, bf16_t* O, int ldc, const int tid, float* Xs = nullptr) {
    const int lane = tid & 63, wave = __builtin_amdgcn_readfirstlane(tid >> 6), hh = lane >> 5;
    const int ntiles = 8 * (N / 32), kw = K / 8;
    LAS float* red = (LAS float*)lds;
    for (int tile = blockIdx.x; tile < ntiles; tile += gridDim.x) {
        const int rt = tile & 7, ct = tile >> 3;
        const bf16_t* ap = A + (size_t)(32 * rt + (lane & 31)) * lda + wave * kw + 8 * hh;
        int brow = 32 * ct + (lane & 31);
        if (MODE == 2) { const int h0 = 32 * ct; brow = (h0 >> 7) * 256 + (h0 & 127) + (lane & 31); }
        const bf16_t* bp = Bt + (size_t)brow * ldb + wave * kw + 8 * hh;
        f32x16 c0, c1;
#pragma unroll
        for (int i = 0; i < 16; ++i) { c0[i] = 0.f; c1[i] = 0.f; }
#pragma unroll 4
        for (int k = 0; k < kw; k += 16) {
            const bf16x8 a = *(const bf16x8*)(ap + k), b = *(const bf16x8*)(bp + k);
            c0 = MFMA32S(a, b, c0);
            if (MODE == 2) { const bf16x8 b2 = *(const bf16x8*)(bp + (size_t)128 * ldb + k); c1 = MFMA32S(a, b2, c1); }
        }
        __syncthreads();
#pragma unroll
        for (int i = 0; i < 16; ++i) { red[((wave * 2 + 0) * 16 + i) * 64 + lane] = c0[i]; if (MODE == 2) red[((wave * 2 + 1) * 16 + i) * 64 + lane] = c1[i]; }
        __syncthreads();
#pragma unroll
        for (int r = 0; r < 2; ++r) {
            const int e = tid + 512 * r, i = e >> 6, l = e & 63;
            float s0 = 0.f, s1 = 0.f;
#pragma unroll
            for (int w = 0; w < 8; ++w) { s0 += red[((w * 2 + 0) * 16 + i) * 64 + l]; if (MODE == 2) s1 += red[((w * 2 + 1) * 16 + i) * 64 + l]; }
            const int row = 32 * rt + (i & 3) + 8 * (i >> 2) + 4 * (l >> 5);
            int col = 32 * ct + (l & 31);
            if (MODE == 3) col = (((ct >> 3) * 4 + (ct & 3)) * 64 + 32 * ((ct >> 2) & 1)) + (l & 31);
            const float v = MODE == 2 ? silu_f(s0) * s1 : (MODE == 1 ? gelu_tanh_f(s0) : s0);
            if (MODE == 4) Xs[(size_t)row * ldc + col] += 0.5f * s0;
            else O[(size_t)row * ldc + col] = (bf16_t)(cvt_pk_bf16(v, 0.f) & 0xffffu);
        }
    }
    __syncthreads();
}

struct Params { const float* in[16]; float* out; unsigned char* ws; int ph_lo, ph_hi; };

__device__ __forceinline__ void transpose_item(const float* W, int K, int N, bf16_t* WT, int k0, int n0, int drow0, LAS float* scr, int lane, int ldw) {
#pragma unroll 8
    for (int i = 0; i < 32; ++i) { const int kk = 2 * i + (lane >> 5); scr[kk * 33 + (lane & 31)] = W[(size_t)(k0 + kk) * N + n0 + (lane & 31)]; }
    asm volatile("s_waitcnt lgkmcnt(0)" ::: "memory");
    const int c = lane & 7;
#pragma unroll
    for (int j = 0; j < 4; ++j) { const int n = (lane >> 3) + 8 * j; const LAS float* s = scr + (8 * c) * 33 + n;
        u32x4 o; o.x = cvt_pk_bf16(s[0 * 33], s[1 * 33]); o.y = cvt_pk_bf16(s[2 * 33], s[3 * 33]); o.z = cvt_pk_bf16(s[4 * 33], s[5 * 33]); o.w = cvt_pk_bf16(s[6 * 33], s[7 * 33]);
        *(u32x4*)(WT + (size_t)(drow0 + n) * ldw + k0 + 8 * c) = o; }
    asm volatile("s_waitcnt lgkmcnt(0)" ::: "memory");
}
__device__ __forceinline__ void transpose_mat(const float* W, int K, int N, bf16_t* WT, int item, bool swiglu, LAS float* scr, int lane, int ldw = 0, bool qkvperm = false) {
    const int nblk = N / 32, kb = item / nblk, nb = item % nblk, n0 = 32 * nb;
    int drow0 = n0;
    if (swiglu) { const int up = n0 >= FF, nn = up ? n0 - FF : n0; drow0 = (nn >> 7) * 256 + (up ? 128 : 0) + (nn & 127); }
    if (qkvperm) { const int head = n0 >> 6, bj = (n0 >> 5) & 1; drow0 = (head >> 2) * 256 + bj * 128 + (head & 3) * 32; }
    transpose_item(W, K, N, WT, 64 * kb, n0, drow0, scr, lane, ldw ? ldw : K);
}
__constant__ double ROPE_INV[32] = {
    1.0, 0.7498942093324559, 0.5623413251903491, 0.4216965034285822, 0.31622776601683794, 0.23713737056616552, 0.1778279410038923, 0.1333521432163324,
    0.1, 0.07498942093324558, 0.05623413251903491, 0.042169650342858224, 0.03162277660168379, 0.023713737056616554, 0.01778279410038923, 0.01333521432163324,
    0.01, 0.007498942093324558, 0.005623413251903491, 0.004216965034285823, 0.0031622776601683794, 0.0023713737056616554, 0.0017782794100389228, 0.001333521432163324,
    0.001, 0.0007498942093324559, 0.0005623413251903491, 0.00042169650342858224, 0.00031622776601683794, 0.00023713737056616554, 0.00017782794100389227, 0.0001333521432163324};

__device__ __forceinline__ void norm_row(const float* xrow, const bf16_t* yrow, float sy, const float* g, bf16_t* orow, float* xout, int lane) {
    const f32x4* xr = (const f32x4*)xrow + lane;
    f32x4 v[4]; float ss = 0.f;
#pragma unroll
    for (int j = 0; j < 4; ++j) v[j] = xr[64 * j];
    if (yrow) {
#pragma unroll
        for (int j = 0; j < 4; ++j) { const u32x2 y = ((const u32x2*)yrow)[lane + 64 * j];
            v[j].x += sy * bf_lo(y.x); v[j].y += sy * bf_hi(y.x); v[j].z += sy * bf_lo(y.y); v[j].w += sy * bf_hi(y.y); }
    }
#pragma unroll
    for (int j = 0; j < 4; ++j) ss += (v[j].x * v[j].x + v[j].y * v[j].y) + (v[j].z * v[j].z + v[j].w * v[j].w);
    if (xout) {
#pragma unroll
        for (int j = 0; j < 4; ++j) ((f32x4*)xout)[lane + 64 * j] = v[j];
    }
    if (g) {
        const float r = 1.0f / sqrtf(wave_sum(ss) * (1.0f / D) + EPS);
#pragma unroll
        for (int j = 0; j < 4; ++j) {
            const f32x4 gg = ((const f32x4*)g)[lane + 64 * j];
            u32x2 o; o.x = cvt_pk_bf16(v[j].x * r * gg.x, v[j].y * r * gg.y); o.y = cvt_pk_bf16(v[j].z * r * gg.z, v[j].w * r * gg.w);
            ((u32x2*)orow)[lane + 64 * j] = o;
        }
    }
}

__device__ __forceinline__ void phase_prologue(const Params& p, unsigned char* ws, float* out, LAS unsigned char* lds, const int tid) {
    const int lane = tid & 63, wave = tid >> 6;
    const int gw = blockIdx.x * 8 + wave, NGW = gridDim.x * 8;
    LAS float* scr = (LAS float*)(lds + wave * 8704);
    constexpr int I_IN = (D / 64) * (2 * FF / 32), I_OUT = (FF / 64) * (D / 32), I_QKV = (D / 64) * (NQKV / 32), I_OA = (AW / 64) * (D / 32), I_UV = (D / 64) * (NUV / 32), I_OB = (BW / 64) * (D / 32);
    constexpr int NITEMS = 4 * I_IN + 4 * I_OUT + I_QKV + I_OA + I_UV + I_OB;
    for (int it = gw; it < NITEMS; it += NGW) {
        int r = it;
        if (r < 4 * I_IN) { const int w = r / I_IN; transpose_mat(p.in[6] + (size_t)w * D * 2 * FF, D, 2 * FF, (bf16_t*)(ws + WS_WIN + w * SZ_WIN), r % I_IN, true, scr, lane); continue; } r -= 4 * I_IN;
        if (r < 4 * I_OUT) { const int w = r / I_OUT; transpose_mat(p.in[7] + (size_t)w * FF * D, FF, D, (bf16_t*)(ws + WS_WOUT + w * SZ_WOUT), r % I_OUT, false, scr, lane); continue; } r -= 4 * I_OUT;
        if (r < I_QKV) { transpose_mat(p.in[8], D, NQKV, (bf16_t*)(ws + WS_WQKV), r, false, scr, lane, 0, true); continue; } r -= I_QKV;
        if (r < I_OA) { transpose_mat(p.in[10], AW, D, (bf16_t*)(ws + WS_WOA), r, false, scr, lane); continue; } r -= I_OA;
        if (r < I_UV) { transpose_mat(p.in[11], D, NUV, (bf16_t*)(ws + WS_WUV), r, false, scr, lane); continue; } r -= I_UV;
        transpose_mat(p.in[15], BW, D, (bf16_t*)(ws + WS_WOB), r, false, scr, lane, LDU);
    }
    { bf16_t* wsp = (bf16_t*)(ws + WS_WSP); const float* src = p.in[13];
      for (int i = blockIdx.x * 512 + tid; i < 16 * 128 * 128 / 2; i += gridDim.x * 512) {
          const int e = 2 * i, s = e & 127, t = (e >> 7) & 127; const f32x2 v = *(const f32x2*)(src + e);
          ((unsigned*)wsp)[i] = cvt_pk_bf16(s <= t ? v.x : 0.f, (s + 1) <= t ? v.y : 0.f); } }
    { float* ct = (float*)(ws + WS_ROPE); float* st = ct + NPOS * 32;
      for (int i = blockIdx.x * 512 + tid; i < NPOS * 32; i += gridDim.x * 512) {
          const int pi = i >> 5, fi = i & 31; const double pos = (double)(pi < SEQ ? pi : PAST + (pi - SEQ));
          const double a = pos * ROPE_INV[fi]; const double n = __builtin_rint(a * 0.15915494309189535);
          const double r = (a - n * 6.283185307179586) - n * 2.4492935982947064e-16; const double r2 = r * r;
          double sn = 1.0, cs = 1.0;
#pragma unroll 1
          for (int k = 14; k >= 1; --k) { const double k2 = (double)(2 * k); sn = 1.0 - sn * r2 / (k2 * (k2 + 1.0)); cs = 1.0 - cs * r2 / ((k2 - 1.0) * k2); }
          ct[i] = (float)cs; st[i] = (float)(sn * r); } }
#ifdef NANFILL
    { u32x4* f = (u32x4*)(ws + WS_BIG); const size_t n = (WS_END - WS_BIG) / 16; const u32x4 q = {0xffffffffu, 0xffffffffu, 0xffffffffu, 0xffffffffu};
      for (size_t i = (size_t)blockIdx.x * 512 + tid; i < n; i += (size_t)gridDim.x * 512) f[i] = q;
      u32x4* fo = (u32x4*)(out + O_KP0); const size_t no = (O_VS + 524288 - O_KP0) / 4;
      for (size_t i = (size_t)blockIdx.x * 512 + tid; i < no; i += (size_t)gridDim.x * 512) fo[i] = q; }
#endif
    for (int m = gw; m < M; m += NGW) {
        const float* src = m < MP ? p.in[0] + (size_t)m * D : p.in[1] + (size_t)(m - MP) * D;
        norm_row(src, nullptr, 0.f, p.in[5], (bf16_t*)(ws + WS_XN) + (size_t)m * D, out + (size_t)m * D, lane);
    }
}

__device__ __forceinline__ void phase_norm(unsigned char* ws, float* out, const float* g, float sy, const int tid) {
    const int lane = tid & 63, wave = tid >> 6;
    const int gw = blockIdx.x * 8 + wave, NGW = gridDim.x * 8;
    const bf16_t* YB = (const bf16_t*)(ws + WS_YB); bf16_t* XN = (bf16_t*)(ws + WS_XN);
    for (int m0 = gw; m0 < M; m0 += 2 * NGW) {
        const int m1 = m0 + NGW; const bool two = m1 < M; const int mb = two ? m1 : m0;
        f32x4 va[4], vb[4]; u32x2 ya[4], yb[4];
#pragma unroll
        for (int j = 0; j < 4; ++j) { va[j] = ((const f32x4*)(out + (size_t)m0 * D))[lane + 64 * j]; vb[j] = ((const f32x4*)(out + (size_t)mb * D))[lane + 64 * j]; }
#pragma unroll
        for (int j = 0; j < 4; ++j) { ya[j] = ((const u32x2*)(YB + (size_t)m0 * D))[lane + 64 * j]; yb[j] = ((const u32x2*)(YB + (size_t)mb * D))[lane + 64 * j]; }
        float sa = 0.f, sb = 0.f;
#pragma unroll
        for (int j = 0; j < 4; ++j) {
            va[j].x += sy * bf_lo(ya[j].x); va[j].y += sy * bf_hi(ya[j].x); va[j].z += sy * bf_lo(ya[j].y); va[j].w += sy * bf_hi(ya[j].y);
            vb[j].x += sy * bf_lo(yb[j].x); vb[j].y += sy * bf_hi(yb[j].x); vb[j].z += sy * bf_lo(yb[j].y); vb[j].w += sy * bf_hi(yb[j].y);
            sa += (va[j].x * va[j].x + va[j].y * va[j].y) + (va[j].z * va[j].z + va[j].w * va[j].w);
            sb += (vb[j].x * vb[j].x + vb[j].y * vb[j].y) + (vb[j].z * vb[j].z + vb[j].w * vb[j].w);
        }
#pragma unroll
        for (int j = 0; j < 4; ++j) { ((f32x4*)(out + (size_t)m0 * D))[lane + 64 * j] = va[j]; if (two) ((f32x4*)(out + (size_t)m1 * D))[lane + 64 * j] = vb[j]; }
        if (g) {
            const float ra = 1.0f / sqrtf(wave_sum(sa) * (1.0f / D) + EPS), rb = 1.0f / sqrtf(wave_sum(sb) * (1.0f / D) + EPS);
#pragma unroll
            for (int j = 0; j < 4; ++j) {
                const f32x4 gg = ((const f32x4*)g)[lane + 64 * j];
                u32x2 o; o.x = cvt_pk_bf16(va[j].x * ra * gg.x, va[j].y * ra * gg.y); o.y = cvt_pk_bf16(va[j].z * ra * gg.z, va[j].w * ra * gg.w);
                ((u32x2*)(XN + (size_t)m0 * D))[lane + 64 * j] = o;
                if (two) { u32x2 o2; o2.x = cvt_pk_bf16(vb[j].x * rb * gg.x, vb[j].y * rb * gg.y); o2.y = cvt_pk_bf16(vb[j].z * rb * gg.z, vb[j].w * rb * gg.w);
                    ((u32x2*)(XN + (size_t)m1 * D))[lane + 64 * j] = o2; }
            }
        }
    }
}

__device__ __forceinline__ void tail_store(float* out, int g, int h, int kv, int row, int i0, f32x4 a, f32x4 b) {
    float* dst;
    if (row < MP) {
        const int bb = row >> 11, t = row & 2047, keep = 128 << (2 * g), tt = t - (SEQ - keep);
        if (tt < 0) return;
        const size_t base = g == 0 ? O_KP0 : (g == 1 ? O_KP1 : O_KP2);
        dst = out + base + ((((size_t)bb * keep + tt) * 2 + kv) * 8 + h) * 64;
    } else {
        const int s = row - MP; const size_t base = g == 0 ? O_KS0 : (g == 1 ? O_KS1 : O_KS2);
        dst = out + base + (((size_t)s * 2 + kv) * 8 + h) * 64;
    }
    *(f32x4*)(dst + i0) = a; *(f32x4*)(dst + 32 + i0) = b;
}
__device__ __forceinline__ void phase_qknorm(const Params& p, unsigned char* ws, float* out, const int tid) {
    const int lane = tid & 63, wave = tid >> 6;
    const int gw = blockIdx.x * 8 + wave, NGW = gridDim.x * 8;
    bf16_t* QKV = (bf16_t*)(ws + WS_BIG);
    const float* ct = (const float*)(ws + WS_ROPE); const float* st = ct + NPOS * 32;
    const int sub = lane & 7, i0 = 4 * sub;
    for (int it = MP * 9 + gw; it < M * 9; it += NGW) {
        const int row = it / 9, s9 = it - row * 9;
        if (s9 < 6) {
            const int head = s9 * 8 + (lane >> 3), isk = head >= 24, gh = isk ? head - 24 : head, g = gh >> 3, h = gh & 7;
            bf16_t* ptr = QKV + (size_t)row * NQKV + head * 64;
            const u32x2 ra = *(const u32x2*)(ptr + i0), rb = *(const u32x2*)(ptr + 32 + i0);
            f32x4 x1 = {bf_lo(ra.x), bf_hi(ra.x), bf_lo(ra.y), bf_hi(ra.y)}, x2 = {bf_lo(rb.x), bf_hi(rb.x), bf_lo(rb.y), bf_hi(rb.y)};
            float ss = (x1.x * x1.x + x1.y * x1.y) + (x1.z * x1.z + x1.w * x1.w) + (x2.x * x2.x + x2.y * x2.y) + (x2.z * x2.z + x2.w * x2.w);
            ss += __shfl_xor(ss, 1); ss += __shfl_xor(ss, 2); ss += __shfl_xor(ss, 4);
            const float r = 1.0f / sqrtf(ss * (1.0f / 64) + EPS);
            const float* gain = p.in[9] + isk * 64;
            const f32x4 g1 = *(const f32x4*)(gain + i0), g2 = *(const f32x4*)(gain + 32 + i0);
            const int pi = row < MP ? (row & 2047) : SEQ + ((row - MP) & 7);
            const f32x4 c = *(const f32x4*)(ct + pi * 32 + i0), s = *(const f32x4*)(st + pi * 32 + i0);
            const f32x4 y1 = x1 * r * g1, y2 = x2 * r * g2;
            const f32x4 o1 = y1 * c - y2 * s, o2 = y2 * c + y1 * s;
            u32x2 wa, wb; wa.x = cvt_pk_bf16(o1.x, o1.y); wa.y = cvt_pk_bf16(o1.z, o1.w); wb.x = cvt_pk_bf16(o2.x, o2.y); wb.y = cvt_pk_bf16(o2.z, o2.w);
            *(u32x2*)(ptr + i0) = wa; *(u32x2*)(ptr + 32 + i0) = wb;
            if (isk) tail_store(out, g, h, 0, row, i0, o1, o2);
        } else {
            const int vh = (s9 - 6) * 8 + (lane >> 3), g = vh >> 3, h = vh & 7;
            const bf16_t* ptr = QKV + (size_t)row * NQKV + 3072 + vh * 64;
            const u32x2 ra = *(const u32x2*)(ptr + i0), rb = *(const u32x2*)(ptr + 32 + i0);
            const f32x4 x1 = {bf_lo(ra.x), bf_hi(ra.x), bf_lo(ra.y), bf_hi(ra.y)}, x2 = {bf_lo(rb.x), bf_hi(rb.x), bf_lo(rb.y), bf_hi(rb.y)};
            tail_store(out, g, h, 1, row, i0, x1, x2);
        }
    }
}

#define MFMA32(a, b, c) __builtin_amdgcn_mfma_f32_32x32x16_bf16((a), (b), (c), 0, 0, 0)
__device__ __forceinline__ s16x4 tr_read(unsigned lds_addr) { return __builtin_amdgcn_ds_read_tr16_b64_v4i16((LAS s16x4*)(uintptr_t)lds_addr); }
__device__ __forceinline__ bf16x8 pack8(const f32x16& x, int s) {
    u32x4 pk;
    pk.x = cvt_pk_bf16(x[8 * s + 0], x[8 * s + 1]); pk.y = cvt_pk_bf16(x[8 * s + 2], x[8 * s + 3]); pk.z = cvt_pk_bf16(x[8 * s + 4], x[8 * s + 5]); pk.w = cvt_pk_bf16(x[8 * s + 6], x[8 * s + 7]);
    return __builtin_bit_cast(bf16x8, pk);
}
__device__ __forceinline__ void attn_prompt_tile(const bf16_t* QKV, bf16_t* OG, float* LSE, LAS unsigned char* vl, int g, int b, int h, int w, int lane) {
    const int dsh = 2 * g, d = 1 << dsh;
    const int tpr_sh = 6 - dsh;
    const int r = w >> tpr_sh, jt = w & ((1 << tpr_sh) - 1), j0 = jt * 32;
    const int q = lane & 31, hh = lane >> 5;
    const size_t rowb = (size_t)b * SEQ;
    const int qcol = g * 512 + h * 64, kcol = 1536 + qcol, vcol = 3072 + qcol;
    const int tq = ((j0 + q) << dsh) + r;
    const bf16_t* qp = QKV + (rowb + tq) * NQKV + qcol + 8 * hh;
    bf16x8 qf[4];
#pragma unroll
    for (int s = 0; s < 4; ++s) qf[s] = *(const bf16x8*)(qp + 16 * s);
    const int kb0 = jt >= 4 ? 0 : 4 - jt;
    f32x16 S[5];
    float mx = -INFINITY;
    bf16x8 kfa[5][4];
#pragma unroll
    for (int kb = 0; kb < 5; ++kb) {
        int jk = j0 - 128 + kb * 32 + q; jk = jk < 0 ? 0 : jk;
        const bf16_t* kp = QKV + (rowb + (size_t)((jk << dsh) + r)) * NQKV + kcol + 8 * hh;
#pragma unroll
        for (int s = 0; s < 4; ++s) kfa[kb][s] = *(const bf16x8*)(kp + 16 * s);
    }
#pragma unroll
    for (int kb = 0; kb < 5; ++kb) {
        f32x16 c;
#pragma unroll
        for (int i = 0; i < 16; ++i) c[i] = 0.f;
#pragma unroll
        for (int s = 0; s < 4; ++s) c = MFMA32(kfa[kb][s], qf[s], c);
#pragma unroll
        for (int i = 0; i < 16; ++i) {
            const int ki = (i & 3) + 8 * (i >> 2) + 4 * hh;
            bool valid = kb >= kb0;
            if (kb == 0) valid = valid && (ki >= q);
            if (kb == 4) valid = valid && (ki <= q);
            const float sv = valid ? c[i] * 0.125f : -INFINITY;
            c[i] = sv; mx = fmaxf(mx, sv);
        }
        S[kb] = c;
    }
    bf16x8 vva[5][4];
#pragma unroll
    for (int kb = 0; kb < 5; ++kb)
#pragma unroll
        for (int c4 = 0; c4 < 4; ++c4) {
            const int i = c4 * 8 + (lane >> 3); int jk = j0 - 128 + kb * 32 + i; jk = jk < 0 ? 0 : jk;
            vva[kb][c4] = *(const bf16x8*)(QKV + (rowb + (size_t)((jk << dsh) + r)) * NQKV + vcol + (lane & 7) * 8);
        }
    mx = fmaxf(mx, __shfl_xor(mx, 32));
    float l = 0.f;
#pragma unroll
    for (int kb = 0; kb < 5; ++kb)
#pragma unroll
        for (int i = 0; i < 16; ++i) { const float e = __expf(S[kb][i] - mx); S[kb][i] = e; l += e; }
    l += __shfl_xor(l, 32);
    const float inv = 1.0f / l;
    f32x16 o0, o1;
#pragma unroll
    for (int i = 0; i < 16; ++i) { o0[i] = 0.f; o1[i] = 0.f; }
    const unsigned vbase = (unsigned)(uintptr_t)vl;
    const unsigned tr_off = (unsigned)((4 * hh + ((lane & 15) >> 2)) * 144 + ((lane >> 4) & 1) * 32 + 8 * (lane & 3));
#pragma unroll
    for (int kb = 0; kb < 5; ++kb) {
        {
#pragma unroll
            for (int c4 = 0; c4 < 4; ++c4) *(LAS bf16x8*)(vl + (c4 * 8 + (lane >> 3)) * 144 + (lane & 7) * 16) = vva[kb][c4];
#pragma unroll
            for (int s2 = 0; s2 < 2; ++s2) {
                f32x16 pn = S[kb];
#pragma unroll
                for (int i = 0; i < 16; ++i) pn[i] *= inv;
                const bf16x8 pb = pack8(pn, s2);
#pragma unroll
                for (int nb = 0; nb < 2; ++nb) {
                    const unsigned a0 = vbase + tr_off + (unsigned)(16 * s2 * 144 + nb * 64);
                    const s16x4 lo = tr_read(a0), hi = tr_read(a0 + 8 * 144);
                    const bf16x8 va = __builtin_shufflevector(lo, hi, 0, 1, 2, 3, 4, 5, 6, 7);
                    if (nb == 0) o0 = MFMA32(va, pb, o0); else o1 = MFMA32(va, pb, o1);
                }
            }
        }
    }
    const size_t orow = (size_t)g * M + rowb + tq;
    bf16_t* op = OG + orow * AW + h * 64 + 4 * hh;
#pragma unroll
    for (int g4 = 0; g4 < 4; ++g4) {
        u32x2 w0, w1;
        w0.x = cvt_pk_bf16(o0[4 * g4], o0[4 * g4 + 1]); w0.y = cvt_pk_bf16(o0[4 * g4 + 2], o0[4 * g4 + 3]);
        w1.x = cvt_pk_bf16(o1[4 * g4], o1[4 * g4 + 1]); w1.y = cvt_pk_bf16(o1[4 * g4 + 2], o1[4 * g4 + 3]);
        *(u32x2*)(op + 8 * g4) = w0; *(u32x2*)(op + 32 + 8 * g4) = w1;
    }
    if (hh == 0) LSE[orow * 8 + h] = mx + __logf(l);
}
__device__ __forceinline__ void attn_sample_item(const Params& p, unsigned char* ws, int item, LAS float* sc, int lane) {
    const int j = item & 7, h = (item >> 3) & 7, gb = item >> 6, g = gb % 3, b = gb / 3;
    const int dsh = 2 * g, L = 128 << dsh;
    const float* cache = (g == 0 ? p.in[2] : (g == 1 ? p.in[3] : p.in[4])) + (size_t)b * L * 1024;
    const bf16_t* QKV = (const bf16_t*)(ws + WS_BIG);
    const int row = MP + b * 8 + j;
    const int sub = lane & 15, ks = lane >> 4;
    const int qcol = g * 512 + h * 64 + 4 * sub;
    const u32x2 qr = *(const u32x2*)(QKV + (size_t)row * NQKV + qcol);
    const f32x4 qv = {bf_lo(qr.x), bf_hi(qr.x), bf_lo(qr.y), bf_hi(qr.y)};
#pragma unroll 11
    for (int it = 0; it < 33; ++it) {
        const int i = it * 4 + ks;
        float dot = 0.f;
        if (i <= 128) {
            const int idx = L + j - (i << dsh);
            f32x4 kv;
            if (idx >= L) { const u32x2 kr = *(const u32x2*)(QKV + (size_t)(MP + b * 8 + (idx - L)) * NQKV + 1536 + qcol); kv = (f32x4){bf_lo(kr.x), bf_hi(kr.x), bf_lo(kr.y), bf_hi(kr.y)}; }
            else kv = *(const f32x4*)(cache + (size_t)idx * 1024 + h * 64 + 4 * sub);
            dot = (qv.x * kv.x + qv.y * kv.y) + (qv.z * kv.z + qv.w * kv.w);
        }
        dot += __shfl_xor(dot, 1); dot += __shfl_xor(dot, 2); dot += __shfl_xor(dot, 4); dot += __shfl_xor(dot, 8);
        if (sub == 0 && i <= 128) sc[i] = dot * 0.125f;
    }
    asm volatile("s_waitcnt lgkmcnt(0)" ::: "memory");
    float mx = fmaxf(sc[lane], sc[lane + 64]); if (lane == 0) mx = fmaxf(mx, sc[128]);
    mx = wave_max(mx);
    float l = __expf(sc[lane] - mx) + __expf(sc[lane + 64] - mx); if (lane == 0) l += __expf(sc[128] - mx);
    l = wave_sum(l);
    const float inv = 1.0f / l;
    f32x4 acc = {0.f, 0.f, 0.f, 0.f};
#pragma unroll 11
    for (int it = 0; it < 33; ++it) {
        const int i = it * 4 + ks;
        if (i <= 128) {
            const float pw = __expf(sc[i] - mx) * inv;
            const int idx = L + j - (i << dsh);
            f32x4 vv;
            if (idx >= L) { const u32x2 vr = *(const u32x2*)(QKV + (size_t)(MP + b * 8 + (idx - L)) * NQKV + 3072 + qcol); vv = (f32x4){bf_lo(vr.x), bf_hi(vr.x), bf_lo(vr.y), bf_hi(vr.y)}; }
            else vv = *(const f32x4*)(cache + (size_t)idx * 1024 + 512 + h * 64 + 4 * sub);
            acc += vv * pw;
        }
    }
#pragma unroll
    for (int k = 0; k < 4; ++k) { acc[k] += __shfl_xor(acc[k], 16); acc[k] += __shfl_xor(acc[k], 32); }
    const size_t orow = (size_t)g * M + row;
    if (ks == 0) { u32x2 w; w.x = cvt_pk_bf16(acc.x, acc.y); w.y = cvt_pk_bf16(acc.z, acc.w); *(u32x2*)((bf16_t*)(ws + WS_OG) + orow * AW + h * 64 + 4 * sub) = w; }
    if (lane == 0) ((float*)(ws + WS_LSE))[orow * 8 + h] = mx + __logf(l);
    asm volatile("s_waitcnt lgkmcnt(0)" ::: "memory");
}
__device__ __forceinline__ void attn_prompt_block(const bf16_t* QKV, bf16_t* OG, float* LSE, LAS unsigned char* lds, int g, int b, int h, int w8, const int tid) {
    const int lane = tid & 63, wave = __builtin_amdgcn_readfirstlane(tid >> 6);
    const int dsh = 2 * g, tpr_sh = 6 - dsh;
    const size_t rowb = (size_t)b * SEQ;
    const int qcol = g * 512 + h * 64, kcol = 1536 + qcol, vcol = 3072 + qcol;
    LAS unsigned char* Kl = lds; LAS unsigned char* Vl = lds + 55296;
    const int w = w8 * 8 + wave, r = w >> tpr_sh, jt = w & ((1 << tpr_sh) - 1), j0 = jt * 32;
    const int q = lane & 31, hh = lane >> 5;
    const int tq = ((j0 + q) << dsh) + r;
    const bf16_t* qp = QKV + (rowb + tq) * NQKV + qcol + 8 * hh;
    bf16x8 qf[4];
#pragma unroll
    for (int s = 0; s < 4; ++s) qf[s] = *(const bf16x8*)(qp + 16 * s);
    __syncthreads();
    {
        bf16x8 kr[6], vr[6];
#pragma unroll
        for (int i = 0; i < 6; ++i) {
            const int p = tid + 512 * i, sl = p >> 3, c = p & 7;
            int j, rr; bool valid;
            if (g == 2) { valid = sl < 256; j = sl & 127; rr = 2 * w8 + (sl >> 7); }
            else if (g == 1) { j = 256 * (w8 & 1) - 128 + sl; rr = w8 >> 1; valid = j >= 0; }
            else { j = 256 * w8 - 128 + sl; rr = 0; valid = j >= 0; }
            j = valid ? j : 0;
            const bf16_t* src = QKV + (rowb + (size_t)((j << dsh) + rr)) * NQKV + c * 8;
            kr[i] = *(const bf16x8*)(src + kcol); vr[i] = *(const bf16x8*)(src + vcol);
        }
#pragma unroll
        for (int i = 0; i < 6; ++i) {
            const int p = tid + 512 * i, sl = p >> 3, c = p & 7;
            *(LAS bf16x8*)(Kl + sl * 144 + c * 16) = kr[i]; *(LAS bf16x8*)(Vl + sl * 144 + c * 16) = vr[i];
        }
    }
    __syncthreads();
    const int jstart = g == 2 ? -128 * (wave >> 2) : (g == 1 ? 256 * (w8 & 1) - 128 : 256 * w8 - 128);
    const int kb0 = jt >= 4 ? 0 : 4 - jt;
    f32x16 S[5];
    float mx = -INFINITY;
#pragma unroll
    for (int kb = 0; kb < 5; ++kb) {
        f32x16 c;
#pragma unroll
        for (int i = 0; i < 16; ++i) c[i] = 0.f;
        const int jb = j0 - 128 + kb * 32;
        const int slot = jb < 0 ? -jstart : jb - jstart + q;
        bf16x8 kf[4];
#pragma unroll
        for (int s = 0; s < 4; ++s) kf[s] = *(const LAS bf16x8*)(Kl + slot * 144 + s * 32 + hh * 16);
#pragma unroll
        for (int s = 0; s < 4; ++s) c = MFMA32(kf[s], qf[s], c);
#pragma unroll
        for (int i = 0; i < 16; ++i) {
            const int ki = (i & 3) + 8 * (i >> 2) + 4 * hh;
            bool valid = kb >= kb0;
            if (kb == 0) valid = valid && (ki >= q);
            if (kb == 4) valid = valid && (ki <= q);
            const float sv = valid ? c[i] * 0.125f : -INFINITY;
            c[i] = sv; mx = fmaxf(mx, sv);
        }
        S[kb] = c;
    }
    mx = fmaxf(mx, __shfl_xor(mx, 32));
    float l = 0.f;
#pragma unroll
    for (int kb = 0; kb < 5; ++kb)
#pragma unroll
        for (int i = 0; i < 16; ++i) { const float e = __expf(S[kb][i] - mx); S[kb][i] = e; l += e; }
    l += __shfl_xor(l, 32);
    const float inv = 1.0f / l;
    f32x16 o0, o1;
#pragma unroll
    for (int i = 0; i < 16; ++i) { o0[i] = 0.f; o1[i] = 0.f; }
    const unsigned vbase = (unsigned)(uintptr_t)Vl;
    const int trrow = 4 * hh + ((lane & 15) >> 2);
    const unsigned trcol = (unsigned)(((lane >> 4) & 1) * 32 + 8 * (lane & 3));
#pragma unroll
    for (int kb = 0; kb < 5; ++kb) {
        const int jb = j0 - 128 + kb * 32;
        const int sbase = jb < 0 ? -jstart : jb - jstart, sstr = jb < 0 ? 0 : 144;
#pragma unroll
        for (int s2 = 0; s2 < 2; ++s2) {
            f32x16 pn = S[kb];
#pragma unroll
            for (int i = 0; i < 16; ++i) pn[i] *= inv;
            const bf16x8 pb = pack8(pn, s2);
#pragma unroll
            for (int nb = 0; nb < 2; ++nb) {
                const unsigned a0 = vbase + (unsigned)(sbase * 144 + (16 * s2 + trrow) * sstr) + trcol + (unsigned)(nb * 64);
                const s16x4 lo = tr_read(a0), hi = tr_read(a0 + (unsigned)(8 * sstr));
                const bf16x8 va = __builtin_shufflevector(lo, hi, 0, 1, 2, 3, 4, 5, 6, 7);
                if (nb == 0) o0 = MFMA32(va, pb, o0); else o1 = MFMA32(va, pb, o1);
            }
        }
    }
    const size_t orow = (size_t)g * M + rowb + tq;
    bf16_t* op = OG + orow * AW + h * 64 + 4 * hh;
#pragma unroll
    for (int g4 = 0; g4 < 4; ++g4) {
        u32x2 w0, w1;
        w0.x = cvt_pk_bf16(o0[4 * g4], o0[4 * g4 + 1]); w0.y = cvt_pk_bf16(o0[4 * g4 + 2], o0[4 * g4 + 3]);
        w1.x = cvt_pk_bf16(o1[4 * g4], o1[4 * g4 + 1]); w1.y = cvt_pk_bf16(o1[4 * g4 + 2], o1[4 * g4 + 3]);
        *(u32x2*)(op + 8 * g4) = w0; *(u32x2*)(op + 32 + 8 * g4) = w1;
    }
    if (hh == 0) LSE[orow * 8 + h] = mx + __logf(l);
}
__device__ __forceinline__ void phase_attn(const Params& p, unsigned char* ws, LAS unsigned char* lds, const int tid) {
    const int lane = tid & 63, wave = __builtin_amdgcn_readfirstlane(tid >> 6);
    LAS unsigned char* vl = lds + wave * 4608;
    constexpr int NS = 768, NP = 3072;
    for (int bi = blockIdx.x; bi < NS; bi += gridDim.x) attn_sample_item(p, ws, bi * 8 + wave, (LAS float*)vl, lane);
    for (int x = blockIdx.x; x < NP; x += gridDim.x) {
        const int w8 = x & 7, h = (x >> 3) & 7, b = (x >> 6) & 15, g = x >> 10;
        attn_prompt_block((const bf16_t*)(ws + WS_BIG), (bf16_t*)(ws + WS_OG), (float*)(ws + WS_LSE), lds, g, b, h, w8, tid);
    }
    __syncthreads();
}
__device__ __forceinline__ void phase_merge(unsigned char* ws, const int tid) {
    const bf16_t* OG = (const bf16_t*)(ws + WS_OG); const float* LSE = (const float*)(ws + WS_LSE); bf16_t* AO = (bf16_t*)(ws + WS_AO);
    for (int e = blockIdx.x * 512 + tid; e < M * 64; e += gridDim.x * 512) {
        const int rh = e >> 3, c8 = e & 7;
        const float l0 = LSE[rh], l1 = LSE[(size_t)M * 8 + rh], l2 = LSE[(size_t)2 * M * 8 + rh];
        const float mx = fmaxf(l0, fmaxf(l1, l2));
        float w0 = __expf(l0 - mx), w1 = __expf(l1 - mx), w2 = __expf(l2 - mx); const float inv = 1.0f / (w0 + w1 + w2); w0 *= inv; w1 *= inv; w2 *= inv;
        const size_t off = (size_t)rh * 64 + c8 * 8;
        const u32x4 a = *(const u32x4*)(OG + off), b = *(const u32x4*)(OG + (size_t)M * AW + off), c = *(const u32x4*)(OG + (size_t)2 * M * AW + off);
        u32x4 o;
#pragma unroll
        for (int k = 0; k < 4; ++k) o[k] = cvt_pk_bf16(w0 * bf_lo(a[k]) + w1 * bf_lo(b[k]) + w2 * bf_lo(c[k]), w0 * bf_hi(a[k]) + w1 * bf_hi(b[k]) + w2 * bf_hi(c[k]));
        *(u32x4*)(AO + off) = o;
    }
}

__device__ __forceinline__ void phase_vnorm(const Params& p, unsigned char* ws, float* out, const int tid) {
    const int lane = tid & 63, wave = tid >> 6;
    const int gw = blockIdx.x * 8 + wave, NGW = gridDim.x * 8;
    const bf16_t* UV = (const bf16_t*)(ws + WS_BIG); float* RV = (float*)(ws + WS_RV);
    for (int m = gw; m < M; m += NGW) {
        const u32x4* vr = (const u32x4*)(UV + (size_t)m * NUV + BW) + lane;
        u32x4 v[4]; float ss = 0.f;
#pragma unroll
        for (int j = 0; j < 4; ++j) { v[j] = vr[64 * j];
#pragma unroll
            for (int k = 0; k < 4; ++k) { const float a = bf_lo(v[j][k]), b = bf_hi(v[j][k]); ss += a * a + b * b; } }
        const float r = 1.0f / sqrtf(wave_sum(ss) * (1.0f / BW) + EPS);
        if (lane == 0) RV[m] = r;
        if (m >= MP) {
            float* dst = out + O_VS + (size_t)(m - MP) * BW;
#pragma unroll
            for (int j = 0; j < 4; ++j) { const int c0 = 8 * (lane + 64 * j); const f32x4 ga = *(const f32x4*)(p.in[12] + c0), gb = *(const f32x4*)(p.in[12] + c0 + 4);
                *(f32x4*)(dst + c0) = (f32x4){bf_lo(v[j][0]) * r * ga.x, bf_hi(v[j][0]) * r * ga.y, bf_lo(v[j][1]) * r * ga.z, bf_hi(v[j][1]) * r * ga.w};
                *(f32x4*)(dst + c0 + 4) = (f32x4){bf_lo(v[j][2]) * r * gb.x, bf_hi(v[j][2]) * r * gb.y, bf_lo(v[j][3]) * r * gb.z, bf_hi(v[j][3]) * r * gb.w}; }
        }
    }
}
__device__ __forceinline__ void spatial_tile(const Params& p, unsigned char* ws, LAS unsigned char* vl, int chunk, int gi, int tb, int ch, int lane) {
    const bf16_t* UV = (const bf16_t*)(ws + WS_BIG); const float* RV = (const float*)(ws + WS_RV); bf16_t* UM = (bf16_t*)(ws + WS_UM);
    const bf16_t* WSP = (const bf16_t*)(ws + WS_WSP);
    const int hh = lane >> 5;
    const int colb = gi * 128 + 64 * ch;
    const f32x4 ga = *(const f32x4*)(p.in[12] + colb + (lane & 7) * 8), gb = *(const f32x4*)(p.in[12] + colb + (lane & 7) * 8 + 4);
    f32x16 a0, a1;
#pragma unroll
    for (int i = 0; i < 16; ++i) { a0[i] = 0.f; a1[i] = 0.f; }
    const int t = 32 * tb + (lane & 31);
    const bf16_t* wp = WSP + ((size_t)gi * 128 + t) * 128 + 8 * hh;
    const unsigned vbase = (unsigned)(uintptr_t)vl;
    const unsigned tr_off = (unsigned)((8 * hh + ((lane & 15) >> 2)) * 144 + ((lane >> 4) & 1) * 32 + 8 * (lane & 3));
    bf16x8 wfa[8];
#pragma unroll
    for (int ks = 0; ks < 8; ++ks) wfa[ks] = *(const bf16x8*)(wp + 16 * ks);
    u32x4 rawa[4][4]; float rva[4][4];
#pragma unroll
    for (int sb = 0; sb < 4; ++sb)
#pragma unroll
        for (int c4 = 0; c4 < 4; ++c4) {
            const int srow = chunk * 128 + 32 * sb + c4 * 8 + (lane >> 3);
            rawa[sb][c4] = *(const u32x4*)(UV + (size_t)srow * NUV + BW + colb + (lane & 7) * 8);
            rva[sb][c4] = RV[srow];
        }
#pragma unroll
    for (int sb = 0; sb < 4; ++sb) {
        if (sb <= tb) {
        u32x4 raw[4]; float rv[4];
#pragma unroll
        for (int c4 = 0; c4 < 4; ++c4) { raw[c4] = rawa[sb][c4]; rv[c4] = rva[sb][c4]; }
#pragma unroll
        for (int c4 = 0; c4 < 4; ++c4) {
            const float r = rv[c4]; u32x4 o;
            o.x = cvt_pk_bf16(bf_lo(raw[c4].x) * r * ga.x, bf_hi(raw[c4].x) * r * ga.y); o.y = cvt_pk_bf16(bf_lo(raw[c4].y) * r * ga.z, bf_hi(raw[c4].y) * r * ga.w);
            o.z = cvt_pk_bf16(bf_lo(raw[c4].z) * r * gb.x, bf_hi(raw[c4].z) * r * gb.y); o.w = cvt_pk_bf16(bf_lo(raw[c4].w) * r * gb.z, bf_hi(raw[c4].w) * r * gb.w);
            *(LAS u32x4*)(vl + (c4 * 8 + (lane >> 3)) * 144 + (lane & 7) * 16) = o;
        }
#pragma unroll
        for (int s2 = 0; s2 < 2; ++s2) {
            const bf16x8 wf = wfa[2 * sb + s2];
#pragma unroll
            for (int cb = 0; cb < 2; ++cb) {
                const unsigned a = vbase + tr_off + (unsigned)(16 * s2 * 144 + cb * 64);
                const s16x4 lo = tr_read(a), hi = tr_read(a + 4 * 144);
                const bf16x8 va = __builtin_shufflevector(lo, hi, 0, 1, 2, 3, 4, 5, 6, 7);
                if (cb == 0) a0 = MFMA32(va, wf, a0); else a1 = MFMA32(va, wf, a1);
            }
        }
        }
    }
    const size_t row = (size_t)chunk * 128 + t;
    const float bias = p.in[14][gi * 128 + t];
    const bf16_t* up = UV + row * NUV + colb + 4 * hh;
    bf16_t* op = UM + row * LDU + colb + 4 * hh;
#pragma unroll
    for (int cb = 0; cb < 2; ++cb)
#pragma unroll
        for (int g4 = 0; g4 < 4; ++g4) {
            const u32x2 ur = *(const u32x2*)(up + 32 * cb + 8 * g4);
            const f32x16& a = cb == 0 ? a0 : a1;
            u32x2 w;
            w.x = cvt_pk_bf16(bf_lo(ur.x) * (a[4 * g4] + bias), bf_hi(ur.x) * (a[4 * g4 + 1] + bias));
            w.y = cvt_pk_bf16(bf_lo(ur.y) * (a[4 * g4 + 2] + bias), bf_hi(ur.y) * (a[4 * g4 + 3] + bias));
            *(u32x2*)(op + 32 * cb + 8 * g4) = w;
        }
}
__device__ __forceinline__ void phase_spatial(const Params& p, unsigned char* ws, LAS unsigned char* lds, const int tid) {
    const int lane = tid & 63, wave = __builtin_amdgcn_readfirstlane(tid >> 6);
    const bf16_t* UV = (const bf16_t*)(ws + WS_BIG); const float* RV = (const float*)(ws + WS_RV); bf16_t* UM = (bf16_t*)(ws + WS_UM);
    const float* vgain = p.in[12]; const float* bsp = p.in[14];
    constexpr int NPI = 256 * 16, NSI = 256;
    LAS unsigned char* vl = lds + wave * 4608;
    for (int it = blockIdx.x; it < NPI + NSI; it += gridDim.x) {
        if (it < NPI) spatial_tile(p, ws, vl, it >> 4, it & 15, wave & 3, wave >> 2, lane);
        else {
            const int e = (it - NPI) * 512 + tid;
            const int c4 = e & 511, bt = e >> 9, t = bt & 7, b = bt >> 3, c0 = 4 * c4, gi = c0 >> 7;
            f32x4 acc = {0.f, 0.f, 0.f, 0.f};
            const f32x4 vg = *(const f32x4*)(vgain + c0);
            for (int s = 0; s <= t; ++s) {
                const size_t r = (size_t)MP + b * 8 + s;
                const u32x2 vr = *(const u32x2*)(UV + r * NUV + BW + c0);
                const float wv = p.in[13][((size_t)gi * 128 + t) * 128 + s] * RV[r];
                acc += (f32x4){bf_lo(vr.x), bf_hi(vr.x), bf_lo(vr.y), bf_hi(vr.y)} * wv;
            }
            const float bias = bsp[gi * 128 + t];
            const size_t r = (size_t)MP + b * 8 + t;
            const u32x2 ur = *(const u32x2*)(UV + r * NUV + c0);
            u32x2 w;
            w.x = cvt_pk_bf16(bf_lo(ur.x) * (acc.x * vg.x + bias), bf_hi(ur.x) * (acc.y * vg.y + bias));
            w.y = cvt_pk_bf16(bf_lo(ur.y) * (acc.z * vg.z + bias), bf_hi(ur.y) * (acc.w * vg.w + bias));
            *(u32x2*)(UM + r * LDU + c0) = w;
        }
    }
}

constexpr int BAR_WORDS = 64 * 18;
__device__ __forceinline__ void grid_barrier(unsigned* bar, const int tid, volatile LAS unsigned* ctl) {
    asm volatile("s_waitcnt vmcnt(0) lgkmcnt(0)" ::: "memory");
    __syncthreads();
    if (tid == 0) {
        const unsigned x = (unsigned)__builtin_amdgcn_s_getreg((3 << 11) | 20) & 7u, nloc = ctl[0], nx = ctl[1];
        if (__hip_atomic_fetch_add(bar + 64 * x, 1u, __ATOMIC_RELAXED, __HIP_MEMORY_SCOPE_AGENT) == nloc - 1u) {
            __builtin_amdgcn_fence(__ATOMIC_RELEASE, "agent");
            asm volatile("s_waitcnt vmcnt(0)" ::: "memory");
            if (__hip_atomic_fetch_add(bar + 64 * 8, 1u, __ATOMIC_RELAXED, __HIP_MEMORY_SCOPE_AGENT) == nx - 1u) __hip_atomic_store(bar + 64 * 9, 1u, __ATOMIC_RELAXED, __HIP_MEMORY_SCOPE_AGENT);
            else while (__hip_atomic_load(bar + 64 * 9, __ATOMIC_RELAXED, __HIP_MEMORY_SCOPE_AGENT) == 0u) __builtin_amdgcn_s_sleep(1);
            __builtin_amdgcn_fence(__ATOMIC_ACQUIRE, "agent");
            __hip_atomic_store(bar + 64 * (10 + x), 1u, __ATOMIC_RELAXED, __HIP_MEMORY_SCOPE_AGENT);
            asm volatile("s_waitcnt vmcnt(0)" ::: "memory");
        } else {
            while (__hip_atomic_load(bar + 64 * (10 + x), __ATOMIC_RELAXED, __HIP_MEMORY_SCOPE_AGENT) == 0u) __builtin_amdgcn_s_sleep(1);
            __builtin_amdgcn_fence(__ATOMIC_ACQUIRE, "agent");
            asm volatile("s_waitcnt vmcnt(0)" ::: "memory");
        }
    }
    __syncthreads();
}

__global__ void __launch_bounds__(512, 2) mega(Params p) {
    extern __shared__ __attribute__((aligned(16))) unsigned char lds_raw[];
    LAS unsigned char* lds = (LAS unsigned char*)lds_raw;
    for (int ph = p.ph_lo; ph < p.ph_hi; ++ph) {
        int tid = threadIdx.x; asm volatile("" : "+v"(tid));
        unsigned z; asm volatile("s_mov_b32 %0, 0" : "=s"(z));
        unsigned char* ws = p.ws + z; float* out = p.out + z;
        bf16_t* XN = (bf16_t*)(ws + WS_XN); bf16_t* BIG = (bf16_t*)(ws + WS_BIG);
        bf16_t* YB = (bf16_t*)(ws + WS_YB);
        int fi = -1, fo = -1, ni = -1; float sy = 0.5f;
        switch (ph) {
            case 1: fi = 0; break; case 10: fi = 1; break; case 13: fi = 2; break; case 21: fi = 3; break;
            case 2: fo = 0; break; case 11: fo = 1; break; case 14: fo = 2; break; case 22: fo = 3; break;
            case 3: ni = 1; break; case 9: ni = 2; sy = 1.0f; break; case 12: ni = 3; break; case 15: ni = 4; break; case 20: ni = 5; sy = 1.0f; break; case 23: ni = 6; break;
            default: break;
        }
#ifndef PMASK
#define PMASK 0xFFFF
#endif
        if ((PMASK & 1) && ph == 0) phase_prologue(p, ws, out, lds, tid);
        else if ((PMASK & 2) && fi >= 0) { const bf16_t* W = (const bf16_t*)(ws + WS_WIN + fi * SZ_WIN); sample_gemm<2>(lds, XN + (size_t)MP * D, D, W, D, D, FF, BIG + (size_t)MP * FF, FF, tid);
            pg8::EpiSwiglu E{BIG}; pg8::gemm_phase(lds, XN, W, MP, 2 * FF, D, E, tid); }
        else if (ph == 22) {
            const bf16_t* B = (const bf16_t*)(ws + WS_WOUT + 3 * SZ_WOUT);
            sample_gemm<4>(lds, BIG + (size_t)MP * FF, FF, B, FF, FF, D, nullptr, D, tid, out + (size_t)MP * D);
            pg8::EpiFinal E{out, 0.5f}; pg8::gemm_phase(lds, BIG, B, MP, D, FF, E, tid); }
        else if ((PMASK & 4) && (fo >= 0 || ph == 8 || ph == 19)) {
            const bf16_t* A = BIG; const bf16_t* B = (const bf16_t*)(ws + WS_WOUT + (fo < 0 ? 0 : fo) * SZ_WOUT); int K = FF, ld = FF;
            if (ph == 8) { A = (const bf16_t*)(ws + WS_AO); B = (const bf16_t*)(ws + WS_WOA); K = AW; ld = AW; }
            if (ph == 19) { A = (const bf16_t*)(ws + WS_UM); B = (const bf16_t*)(ws + WS_WOB); K = BW; ld = LDU; }
            sample_gemm<0>(lds, A + (size_t)MP * ld, ld, B, ld, K, D, YB + (size_t)MP * D, D, tid);
            pg8::EpiBf16<0> E{YB, D}; pg8::gemm_phase(lds, A, B, MP, D, K, E, tid, ld, ld); }
#ifdef DUMPSEL
        else if (ph == 20) {
            const bf16_t* wsp = (const bf16_t*)(ws + WS_WSP); const float* rvp = (const float*)(ws + WS_RV);
            for (size_t e = (size_t)blockIdx.x * 512 + tid; e < (size_t)M * D; e += (size_t)gridDim.x * 512) { const size_t r = e / D, c = e % D;
                out[e] = (DUMPSEL == 10) ? p.in[12][(c + r) % 2048] * p.in[14][(c * 3 + r) % 2048] * (1.0f + p.in[13][(r * 1024 + c) % 262144]) : (DUMPSEL == 2) ? (r >= (size_t)MP ? 0.f : 1.f) * __uint_as_float((unsigned)((const bf16_t*)(ws + WS_UM))[r * LDU + c] << 16) : (DUMPSEL == 8) ? (r < 256 ? __uint_as_float((unsigned)wsp[r * 1024 + c] << 16) : 0.f) : rvp[r]; }
        }
#endif
        else if ((PMASK & 8) && ni >= 0) phase_norm(ws, out, ni < 6 ? p.in[5] + ni * D : nullptr, sy, tid);
        else if ((PMASK & 16) && ph == 4) { sample_gemm<3>(lds, XN + (size_t)MP * D, D, (const bf16_t*)(ws + WS_WQKV), D, D, NQKV, BIG + (size_t)MP * NQKV, NQKV, tid);
            const float* ctab = (const float*)(ws + WS_ROPE);
            pg8::EpiQKV E{BIG, ctab, ctab + NPOS * 32, p.in[9], out}; pg8::gemm_phase(lds, XN, (const bf16_t*)(ws + WS_WQKV), MP, NQKV, D, E, tid); }
        else if ((PMASK & 32) && ph == 5) phase_qknorm(p, ws, out, tid);
        else if ((PMASK & 64) && ph == 6) phase_attn(p, ws, lds, tid);
        else if ((PMASK & 128) && ph == 7) phase_merge(ws, tid);
        else if ((PMASK & 512) && ph == 16) { sample_gemm<1>(lds, XN + (size_t)MP * D, D, (const bf16_t*)(ws + WS_WUV), D, D, NUV, BIG + (size_t)MP * NUV, NUV, tid);
            pg8::EpiBf16<1> E{BIG, NUV}; pg8::gemm_phase(lds, XN, (const bf16_t*)(ws + WS_WUV), MP, NUV, D, E, tid); }
        else if ((PMASK & 1024) && ph == 17) phase_vnorm(p, ws, out, tid);
        else if ((PMASK & 2048) && ph == 18) phase_spatial(p, ws, lds, tid);
        if (ph + 1 < p.ph_hi) {
            volatile LAS unsigned* ctl = (volatile LAS unsigned*)(lds + 135168);
            if (ph == 0) {
                const unsigned x = (unsigned)__builtin_amdgcn_s_getreg((3 << 11) | 20) & 7u;
                if (tid == 0) __hip_atomic_fetch_add((unsigned*)p.ws + 64 * x, 1u, __ATOMIC_RELAXED, __HIP_MEMORY_SCOPE_AGENT);
                __syncthreads(); cg::this_grid().sync();
                if (tid == 0) { unsigned nx = 0;
                    for (int j = 0; j < 8; ++j) nx += __hip_atomic_load((unsigned*)p.ws + 64 * j, __ATOMIC_RELAXED, __HIP_MEMORY_SCOPE_AGENT) != 0u;
                    ctl[0] = __hip_atomic_load((unsigned*)p.ws + 64 * x, __ATOMIC_RELAXED, __HIP_MEMORY_SCOPE_AGENT); ctl[1] = nx; }
                __syncthreads();
            }
            else grid_barrier((unsigned*)p.ws + (size_t)BAR_WORDS * ph, tid, ctl);
        }
    }
}

extern "C" void kernel_launch(void* const* d_in, const int* in_sizes, int n_in, void* d_out, int out_size, void* d_ws, size_t ws_size, hipStream_t stream) {
    static int grid = 0;
    if (grid == 0) {
        if (n_in != 16 || ws_size < WS_END) { fprintf(stderr, "kernel_launch: unexpected inputs (n_in %d, ws %zu < %zu)\n", n_in, ws_size, (size_t)WS_END); grid = -1; return; }
        int dev = 0, cus = 0, per_cu = 0;
        (void)hipGetDevice(&dev);
        (void)hipDeviceGetAttribute(&cus, hipDeviceAttributeMultiprocessorCount, dev);
        if (hipFuncSetAttribute((const void*)mega, hipFuncAttributeMaxDynamicSharedMemorySize, LDS_BYTES) != hipSuccess) { fprintf(stderr, "kernel_launch: hipFuncSetAttribute failed\n"); grid = -1; return; }
        if (hipOccupancyMaxActiveBlocksPerMultiprocessor(&per_cu, (const void*)mega, 512, LDS_BYTES) != hipSuccess || per_cu < 1) { fprintf(stderr, "kernel_launch: occupancy query says %d\n", per_cu); per_cu = 1; }
        (void)hipGetLastError();
        grid = cus * 1;
    }
    if (grid < 0) return;
    if (hipMemsetAsync(d_ws, 0, 262144, stream) != hipSuccess) { fprintf(stderr, "kernel_launch: memset failed\n"); return; }
    Params p{};
    for (int i = 0; i < 16; ++i) p.in[i] = (const float*)d_in[i];
    p.out = (float*)d_out; p.ws = (unsigned char*)d_ws;
#if ONE_LAUNCH
    p.ph_lo = 0; p.ph_hi = NPHASE;
    void* args[] = {&p};
    hipError_t e = hipLaunchCooperativeKernel((const void*)mega, dim3(grid), dim3(512), args, LDS_BYTES, stream);
    if (e != hipSuccess) fprintf(stderr, "cooperative launch failed: %s (grid %d)\n", hipGetErrorString(e), grid);
#else
    for (int ph = 0; ph < NPHASE; ++ph) {
        p.ph_lo = ph; p.ph_hi = ph + 1;
        hipLaunchKernelGGL(mega, dim3(grid), dim3(512), LDS_BYTES, stream, p);
    }
#endif
}
```

```cpp
#include <hip/hip_runtime.h>
#include <hip/hip_cooperative_groups.h>
#include <cstdio>
#include <cstdint>
namespace cg = cooperative_groups;

#ifndef ONE_LAUNCH
#define ONE_LAUNCH 1
#endif

#define LAS __attribute__((address_space(3)))
typedef unsigned short bf16_t;
typedef short bf16x8 __attribute__((ext_vector_type(8)));
typedef short s16x4 __attribute__((ext_vector_type(4)));
typedef float f32x2 __attribute__((ext_vector_type(2)));
typedef float f32x4 __attribute__((ext_vector_type(4)));
typedef float f32x16 __attribute__((ext_vector_type(16)));
typedef unsigned u32x2 __attribute__((ext_vector_type(2)));
typedef unsigned u32x4 __attribute__((ext_vector_type(4)));

constexpr int D = 1024, SEQ = 2048, NBATCH = 16, MP = NBATCH * SEQ, MS = 256, M = MP + MS;
constexpr int FF = 2816, NQKV = 4608, AW = 512, BW = 2048, NUV = 4096, PAST = 16384;
constexpr float EPS = 1e-6f;
constexpr int LDU = BW + 64;
constexpr int NPOS = SEQ + 8;
constexpr size_t O_YP = 0, O_YS = (size_t)MP * D, O_KP0 = O_YS + (size_t)MS * D, O_KP1 = O_KP0 + 2097152, O_KP2 = O_KP1 + 8388608,
                 O_KS0 = O_KP2 + 33554432, O_KS1 = O_KS0 + 262144, O_KS2 = O_KS1 + 262144, O_VS = O_KS2 + 262144;
constexpr size_t al256(size_t x) { return (x + 255) & ~(size_t)255; }
constexpr size_t WS_WIN = 1u << 20;
constexpr size_t SZ_WIN = (size_t)2 * FF * D * 2;
constexpr size_t WS_WOUT = WS_WIN + 4 * SZ_WIN;
constexpr size_t SZ_WOUT = (size_t)D * FF * 2;
constexpr size_t WS_WQKV = WS_WOUT + 4 * SZ_WOUT;
constexpr size_t WS_WOA = WS_WQKV + (size_t)NQKV * D * 2;
constexpr size_t WS_WUV = WS_WOA + (size_t)D * AW * 2;
constexpr size_t WS_WOB = WS_WUV + (size_t)NUV * D * 2;
constexpr size_t WS_WSP = WS_WOB + (size_t)D * LDU * 2;
constexpr size_t WS_ROPE = WS_WSP + (size_t)16 * 128 * 128 * 2;
constexpr size_t WS_XN = al256(WS_ROPE + (size_t)NPOS * 32 * 4 * 2);
constexpr size_t WS_BIG = al256(WS_XN + (size_t)M * D * 2);
constexpr size_t WS_OG = al256(WS_BIG + (size_t)M * NQKV * 2);
constexpr size_t WS_LSE = al256(WS_OG + (size_t)3 * M * AW * 2);
constexpr size_t WS_AO = al256(WS_LSE + (size_t)3 * M * 8 * 4);
constexpr size_t WS_UM = al256(WS_AO + (size_t)M * AW * 2);
constexpr size_t WS_RV = al256(WS_UM + (size_t)M * LDU * 2);
constexpr size_t WS_YB = al256(WS_RV + (size_t)M * 4);
constexpr size_t WS_END = al256(WS_YB + (size_t)M * D * 2);

#ifndef DUPMASK
#define DUPMASK 0u
#endif
constexpr int LDS_BYTES = 139264;
#ifdef DUMPSEL
constexpr int NPHASE = 21;
#else
constexpr int NPHASE = 23;
#endif

__device__ __forceinline__ float wave_sum(float v) {
#pragma unroll
    for (int o = 1; o < 64; o <<= 1) v += __shfl_xor(v, o);
    return v;
}
__device__ __forceinline__ float wave_max(float v) {
#pragma unroll
    for (int o = 1; o < 64; o <<= 1) v = fmaxf(v, __shfl_xor(v, o));
    return v;
}
typedef __bf16 bf16x2_t __attribute__((ext_vector_type(2)));
__device__ __forceinline__ unsigned cvt_pk_bf16(float lo, float hi) { const f32x2 v = {lo, hi}; return __builtin_bit_cast(unsigned, __builtin_convertvector(v, bf16x2_t)); }
__device__ __forceinline__ float bf_lo(unsigned w) { return __uint_as_float(w << 16); }
__device__ __forceinline__ float bf_hi(unsigned w) { return __uint_as_float(w & 0xffff0000u); }
__device__ __forceinline__ float silu_f(float x) { return x * __builtin_amdgcn_rcpf(1.0f + __expf(-x)); }
__device__ __forceinline__ float gelu_tanh_f(float x) { const float y = 0.7978845608028654f * (x + 0.044715f * x * x * x); return x * __builtin_amdgcn_rcpf(1.0f + __expf(-2.0f * y)); }

namespace pg8 {
constexpr int BM = 256, BK = 64, HALF = 128, HTB = HALF * BK * 2, STAGE_BYTES = 8 * HTB, NXCD = 8, WGM = 8;
__device__ __forceinline__ int lds_byte(int r, int c) { const int st = (r >> 4) * 2 + (c >> 5), rr = r & 15, cc = c & 31, ob = rr * 64 + cc * 2; return st * 1024 + (ob ^ (((ob >> 9) & 1) << 5)); }
__device__ __forceinline__ void stage_rc(int b, int& R, int& C) { const int st = b / 1024, sb = b % 1024, swz = sb ^ (((sb >> 9) & 1) << 5); R = (st >> 1) * 16 + swz / 64; C = (st & 1) * 32 + (swz % 64) / 2; }
__device__ __forceinline__ int perm32(int rho) { const int n = rho >> 4, i = rho & 15; return 8 * (i >> 2) + 4 * n + (i & 3); }
struct Unit { int pm, pn; };
struct StaticOrder {
    int nM, nN, nwg, G, c;
    __device__ void init(int M_, int N_, int G_, int c_) { nM = M_ / BM; nN = N_ / BM; nwg = nM * nN; G = G_; c = c_; }
    __device__ bool next(int i, Unit& u) const {
        const long L = (long)i * G + c; if (L >= nwg) return false;
        int wgid = (int)L; { const int q = nwg / NXCD, r = nwg % NXCD, xcd = wgid % NXCD, off = wgid / NXCD; wgid = (xcd < r ? xcd * (q + 1) : r * (q + 1) + (xcd - r) * q) + off; }
        const int nig = WGM * nN, gid = wgid / nig, fm = gid * WGM, gsz = (nM - fm) < WGM ? (nM - fm) : WGM;
        u.pm = fm + ((wgid % nig) % gsz); u.pn = (wgid % nig) / gsz; return true;
    }
};
template <class Epi>
__device__ __forceinline__ void gemm_phase(LAS unsigned char* lds, const bf16_t* gA, const bf16_t* gBt, int gM, int gN, int K, const Epi& E, const int tid, const int lda = 0, const int ldb = 0) {
    const int LA = lda ? lda : K, LB = ldb ? ldb : K;
    const int wid = __builtin_amdgcn_readfirstlane(tid >> 6), lane = tid & 63, wr = wid >> 2, wc = wid & 3, fr = lane & 15, fq = lane >> 4;
    const int nt = K / BK;
    StaticOrder S; S.init(gM, gN, (int)gridDim.x, (int)blockIdx.x);
    unsigned voffA[2], voffB[2];
#pragma unroll
    for (int i = 0; i < 2; ++i) { int R, C; stage_rc(tid * 16 + i * 8192, R, C); const int Rb = Epi::PERM ? ((R & ~31) + perm32(R & 31)) : R;
        voffA[i] = (unsigned)(R * LA + C) * 2u; voffB[i] = (unsigned)(Rb * LB + C) * 2u; }
    const size_t kstep = (size_t)(BK * 2);
    const size_t hstepA = (size_t)HALF * LA * 2, hstepB = (size_t)HALF * LB * 2;
    const size_t tstepA = 2 * hstepA, tstepB = 2 * hstepB;
    const unsigned ldsw = (unsigned)wid * 1024u;
    const int aoff = lds_byte(wr * 64 + fr, fq * 8), boff = lds_byte(wc * 32 + fr, fq * 8);
#define PG8_SA(b, h) (((b) * 2 + (h)) * HTB)
#define PG8_SB(b, h) ((4 + (b) * 2 + (h)) * HTB)
#define PG8_STAGE(bufoff, gbase, voff) do { _Pragma("unroll") for (int _i = 0; _i < 2; ++_i) \
        __builtin_amdgcn_global_load_lds((const unsigned*)((const char*)(gbase) + (voff)[_i]), (LAS unsigned*)(lds + (bufoff) + ldsw + _i * 8192), 16, 0, 0); } while (0)
#define PG8_LDA(dst, b, h) do { _Pragma("unroll") for (int m = 0; m < 4; ++m) _Pragma("unroll") for (int k = 0; k < 2; ++k) dst[m][k] = *(const LAS bf16x8*)(lds + PG8_SA(b, h) + aoff + m * 2048 + k * 1024); } while (0)
#define PG8_LDB(dst, b, h) do { _Pragma("unroll") for (int n = 0; n < 2; ++n) _Pragma("unroll") for (int k = 0; k < 2; ++k) dst[n][k] = *(const LAS bf16x8*)(lds + PG8_SB(b, h) + boff + n * 2048 + k * 1024); } while (0)
#define PG8_MMA(ai, bj, At, Bt) do { __builtin_amdgcn_s_setprio(1); _Pragma("unroll") for (int m = 0; m < 4; ++m) _Pragma("unroll") for (int n = 0; n < 2; ++n) _Pragma("unroll") for (int k = 0; k < 2; ++k) \
        acc[ai][bj][m][n] = __builtin_amdgcn_mfma_f32_16x16x32_bf16(Bt[n][k], At[m][k], acc[ai][bj][m][n], 0, 0, 0); __builtin_amdgcn_s_setprio(0); } while (0)
#define PG8_WAIT_V(n) asm volatile("s_waitcnt vmcnt(" #n ")" ::: "memory")
#define PG8_WAIT_L(n) asm volatile("s_waitcnt lgkmcnt(" #n ")" ::: "memory")
#define PG8_BAR __builtin_amdgcn_s_barrier()
#define PG8_SCHED __builtin_amdgcn_sched_barrier(0)
    Unit cur, nxt; int ui = 0;
    if (!S.next(0, cur)) return;
    f32x4 acc[2][2][4][2];
#pragma unroll
    for (int a = 0; a < 2; ++a)
#pragma unroll
        for (int b = 0; b < 2; ++b)
#pragma unroll
            for (int m = 0; m < 4; ++m)
#pragma unroll
                for (int n = 0; n < 2; ++n) acc[a][b][m][n] = (f32x4){0.f, 0.f, 0.f, 0.f};
    bf16x8 At[4][2], B0[2][2], B1[2][2];
    const char* cA = (const char*)gA + (size_t)cur.pm * tstepA; const char* cB = (const char*)gBt + (size_t)cur.pn * tstepB;
    PG8_STAGE(PG8_SB(0, 0), cB, voffB); PG8_STAGE(PG8_SB(0, 1), cB + hstepB, voffB); PG8_STAGE(PG8_SA(0, 0), cA, voffA); PG8_STAGE(PG8_SA(0, 1), cA + hstepA, voffA);
    if (wr == 1) PG8_BAR;
    PG8_WAIT_V(2); PG8_BAR;
    PG8_STAGE(PG8_SB(1, 0), cB + kstep, voffB); PG8_STAGE(PG8_SA(1, 0), cA + kstep, voffA); PG8_STAGE(PG8_SB(1, 1), cB + hstepB + kstep, voffB);
    PG8_WAIT_V(6); PG8_BAR;
    for (;;) {
        const bool has_next = S.next(ui + 1, nxt);
        const char* nA = has_next ? (const char*)gA + (size_t)nxt.pm * tstepA : cA; const char* nB = has_next ? (const char*)gBt + (size_t)nxt.pn * tstepB : cB;
        for (int t = 0; t < nt; t += 2) {
            const bool last = (t == nt - 2);
            const char* a1 = cA + (size_t)(t + 1) * kstep;
            const char* a2 = last ? nA : cA + (size_t)(t + 2) * kstep; const char* b2 = last ? nB : cB + (size_t)(t + 2) * kstep;
            const char* a3 = a2 + kstep; const char* b3 = b2 + kstep;
            PG8_LDB(B0, 0, 0); PG8_LDB(B1, 0, 1); PG8_SCHED; PG8_LDA(At, 0, 0); PG8_STAGE(PG8_SA(1, 1), a1 + hstepA, voffA);
            PG8_WAIT_V(8); PG8_WAIT_L(0); PG8_BAR; PG8_MMA(0, 0, At, B0); PG8_MMA(0, 1, At, B1); PG8_BAR; PG8_SCHED;
            PG8_LDA(At, 0, 1); PG8_STAGE(PG8_SB(0, 0), b2, voffB); PG8_STAGE(PG8_SB(0, 1), b2 + hstepB, voffB); PG8_STAGE(PG8_SA(0, 0), a2, voffA);
            PG8_WAIT_V(8); PG8_WAIT_L(0); PG8_BAR; PG8_MMA(1, 0, At, B0); PG8_MMA(1, 1, At, B1); PG8_BAR; PG8_SCHED;
            PG8_LDB(B0, 1, 0); PG8_LDB(B1, 1, 1); PG8_SCHED; PG8_LDA(At, 1, 0); PG8_STAGE(PG8_SA(0, 1), a2 + hstepA, voffA);
            PG8_WAIT_V(8); PG8_WAIT_L(0); PG8_BAR; PG8_MMA(0, 0, At, B0); PG8_MMA(0, 1, At, B1); PG8_BAR; PG8_SCHED;
            PG8_LDA(At, 1, 1); PG8_STAGE(PG8_SB(1, 0), b3, voffB); PG8_STAGE(PG8_SB(1, 1), b3 + hstepB, voffB); PG8_STAGE(PG8_SA(1, 0), a3, voffA);
            PG8_WAIT_V(8); PG8_WAIT_L(0); PG8_BAR; PG8_MMA(1, 0, At, B0); PG8_MMA(1, 1, At, B1); PG8_BAR; PG8_SCHED;
        }
        if (wr == 0) PG8_BAR;
        E(acc, cur, wr, wc, fr, fq);
        if (!has_next) break;
#pragma unroll
        for (int a = 0; a < 2; ++a)
#pragma unroll
            for (int b = 0; b < 2; ++b)
#pragma unroll
                for (int m = 0; m < 4; ++m)
#pragma unroll
                    for (int n = 0; n < 2; ++n) acc[a][b][m][n] = (f32x4){0.f, 0.f, 0.f, 0.f};
        cur = nxt; cA = nA; cB = nB; ++ui;
        if (wr == 1) PG8_BAR;
    }
    PG8_WAIT_V(0);
    PG8_BAR;
#undef PG8_SA
#undef PG8_SB
#undef PG8_STAGE
#undef PG8_LDA
#undef PG8_LDB
#undef PG8_MMA
#undef PG8_WAIT_V
#undef PG8_WAIT_L
#undef PG8_BAR
#undef PG8_SCHED
}

struct EpiSwiglu {
    static constexpr bool PERM = true;
    bf16_t* O;
    __device__ __forceinline__ void operator()(const f32x4 (&acc)[2][2][4][2], const Unit& u, int wr, int wc, int fr, int fq) const {
        const int row0 = u.pm * BM + wr * 64 + fr, col0 = u.pn * HALF + wc * 32 + 8 * fq;
#pragma unroll
        for (int ai = 0; ai < 2; ++ai)
#pragma unroll
            for (int m = 0; m < 4; ++m) {
                const f32x4 g0 = acc[ai][0][m][0], g1 = acc[ai][0][m][1], u0 = acc[ai][1][m][0], u1 = acc[ai][1][m][1];
                u32x4 w;
                w.x = cvt_pk_bf16(silu_f(g0[0]) * u0[0], silu_f(g0[1]) * u0[1]); w.y = cvt_pk_bf16(silu_f(g0[2]) * u0[2], silu_f(g0[3]) * u0[3]);
                w.z = cvt_pk_bf16(silu_f(g1[0]) * u1[0], silu_f(g1[1]) * u1[1]); w.w = cvt_pk_bf16(silu_f(g1[2]) * u1[2], silu_f(g1[3]) * u1[3]);
                *(u32x4*)(O + (size_t)(row0 + ai * HALF + m * 16) * FF + col0) = w;
            }
    }
};
struct EpiResid {
    static constexpr bool PERM = false;
    float* X; float s;
    __device__ __forceinline__ void operator()(const f32x4 (&acc)[2][2][4][2], const Unit& u, int wr, int wc, int fr, int fq) const {
        const int row0 = u.pm * BM + wr * 64 + fr, col0 = u.pn * BM + wc * 32 + 4 * fq;
#pragma unroll
        for (int ai = 0; ai < 2; ++ai)
#pragma unroll
            for (int m = 0; m < 4; ++m) { float* rowp = X + (size_t)(row0 + ai * HALF + m * 16) * D + col0;
#pragma unroll
                for (int bj = 0; bj < 2; ++bj)
#pragma unroll
                    for (int n = 0; n < 2; ++n) { f32x4* p = (f32x4*)(rowp + bj * HALF + n * 16); *p = *p + acc[ai][bj][m][n] * s; } }
    }
};
struct EpiFinal {
    static constexpr bool PERM = false;
    float* X; float s;
    __device__ __forceinline__ void operator()(const f32x4 (&acc)[2][2][4][2], const Unit& u, int wr, int wc, int fr, int fq) const {
        float* base = X + (size_t)(u.pm * BM + wr * 64 + fr) * D + u.pn * BM + wc * 32 + 4 * fq;
        f32x4 x[2][4];
#pragma unroll
        for (int q = 0; q < 4; ++q) x[0][q] = *(const f32x4*)(base + (q >> 1) * HALF + (q & 1) * 16);
#pragma unroll
        for (int g = 0; g < 8; ++g) {
            const int ai = g >> 2, m = g & 3;
            float* rowp = base + (size_t)(ai * HALF + m * 16) * D;
            if (g < 7) { const float* nx = base + (size_t)(((g + 1) >> 2) * HALF + ((g + 1) & 3) * 16) * D;
#pragma unroll
                for (int q = 0; q < 4; ++q) x[(g + 1) & 1][q] = *(const f32x4*)(nx + (q >> 1) * HALF + (q & 1) * 16); }
#pragma unroll
            for (int q = 0; q < 4; ++q) *(f32x4*)(rowp + (q >> 1) * HALF + (q & 1) * 16) = x[g & 1][q] + acc[ai][q >> 1][m][q & 1] * s;
        }
    }
};
struct EpiQKV {
    static constexpr bool PERM = true;
    bf16_t* O; const float* ct; const float* st; const float* gain; float* out;
    __device__ __forceinline__ void operator()(const f32x4 (&acc)[2][2][4][2], const Unit& u, int wr, int wc, int fr, int fq) const {
        const int head = u.pn * 4 + wc, which = head / 24, gh = head - which * 24, g = gh >> 3, h = gh & 7, d0 = 8 * fq;
        const int row0 = u.pm * BM + wr * 64 + fr;
        f32x4 ga0 = {1.f, 1.f, 1.f, 1.f}, ga1 = ga0, gb0 = ga0, gb1 = ga0;
        if (which < 2) { const float* gp = gain + which * 64 + d0; ga0 = *(const f32x4*)gp; ga1 = *(const f32x4*)(gp + 4); gb0 = *(const f32x4*)(gp + 32); gb1 = *(const f32x4*)(gp + 36); }
        const int keep = 128 << (2 * g);
        const size_t tbase = g == 0 ? O_KP0 : (g == 1 ? O_KP1 : O_KP2);
#pragma unroll
        for (int ai = 0; ai < 2; ++ai)
#pragma unroll
            for (int m = 0; m < 4; ++m) {
                const int row = row0 + ai * HALF + m * 16;
                f32x4 a0 = acc[ai][0][m][0], a1 = acc[ai][0][m][1], b0 = acc[ai][1][m][0], b1 = acc[ai][1][m][1];
                if (which < 2) {
                    float ss = ((a0.x * a0.x + a0.y * a0.y) + (a0.z * a0.z + a0.w * a0.w)) + ((a1.x * a1.x + a1.y * a1.y) + (a1.z * a1.z + a1.w * a1.w))
                             + ((b0.x * b0.x + b0.y * b0.y) + (b0.z * b0.z + b0.w * b0.w)) + ((b1.x * b1.x + b1.y * b1.y) + (b1.z * b1.z + b1.w * b1.w));
                    ss += __shfl_xor(ss, 16); ss += __shfl_xor(ss, 32);
                    const float r = 1.0f / sqrtf(ss * (1.0f / 64) + EPS);
                    const int pi = row & 2047;
                    const f32x4 c0 = *(const f32x4*)(ct + pi * 32 + d0), c1 = *(const f32x4*)(ct + pi * 32 + d0 + 4), s0 = *(const f32x4*)(st + pi * 32 + d0), s1 = *(const f32x4*)(st + pi * 32 + d0 + 4);
                    const f32x4 ya0 = a0 * r * ga0, ya1 = a1 * r * ga1, yb0 = b0 * r * gb0, yb1 = b1 * r * gb1;
                    a0 = ya0 * c0 - yb0 * s0; a1 = ya1 * c1 - yb1 * s1; b0 = yb0 * c0 + ya0 * s0; b1 = yb1 * c1 + ya1 * s1;
                }
                bf16_t* dst = O + (size_t)row * NQKV + head * 64 + d0;
                u32x4 w0, w1;
                w0.x = cvt_pk_bf16(a0.x, a0.y); w0.y = cvt_pk_bf16(a0.z, a0.w); w0.z = cvt_pk_bf16(a1.x, a1.y); w0.w = cvt_pk_bf16(a1.z, a1.w);
                w1.x = cvt_pk_bf16(b0.x, b0.y); w1.y = cvt_pk_bf16(b0.z, b0.w); w1.z = cvt_pk_bf16(b1.x, b1.y); w1.w = cvt_pk_bf16(b1.z, b1.w);
                *(u32x4*)dst = w0; *(u32x4*)(dst + 32) = w1;
                if (which >= 1) {
                    const int bb = row >> 11, tt = (row & 2047) - (SEQ - keep);
                    if (tt >= 0) { float* tp = out + tbase + ((((size_t)bb * keep + tt) * 2 + (which - 1)) * 8 + h) * 64 + d0;
                        *(f32x4*)tp = a0; *(f32x4*)(tp + 4) = a1; *(f32x4*)(tp + 32) = b0; *(f32x4*)(tp + 36) = b1; }
                }
            }
    }
};
template <int ACT> struct EpiBf16 {
    static constexpr bool PERM = true;
    bf16_t* O; int ldc;
    __device__ __forceinline__ void operator()(const f32x4 (&acc)[2][2][4][2], const Unit& u, int wr, int wc, int fr, int fq) const {
        const int row0 = u.pm * BM + wr * 64 + fr, col0 = u.pn * BM + wc * 32 + 8 * fq;
#pragma unroll
        for (int ai = 0; ai < 2; ++ai)
#pragma unroll
            for (int m = 0; m < 4; ++m) { bf16_t* rowp = O + (size_t)(row0 + ai * HALF + m * 16) * ldc + col0;
#pragma unroll
                for (int bj = 0; bj < 2; ++bj) { f32x4 v0 = acc[ai][bj][m][0], v1 = acc[ai][bj][m][1];
                    if (ACT == 1) {
#pragma unroll
                        for (int j = 0; j < 4; ++j) { v0[j] = gelu_tanh_f(v0[j]); v1[j] = gelu_tanh_f(v1[j]); } }
                    u32x4 w; w.x = cvt_pk_bf16(v0[0], v0[1]); w.y = cvt_pk_bf16(v0[2], v0[3]); w.z = cvt_pk_bf16(v1[0], v1[1]); w.w = cvt_pk_bf16(v1[2], v1[3]);
                    *(u32x4*)(rowp + bj * HALF) = w; } }
    }
};
}

#define MFMA32S(a, b, c) __builtin_amdgcn_mfma_f32_32x32x16_bf16((a), (b), (c), 0, 0, 0)
template <int MODE, int KSTEPS>
__device__ __forceinline__ void sample_gemm(LAS unsigned char* lds, const bf16_t* A, int lda, const bf16_t* Bt, int ldb, int K, int N, bf16_t* O, int ldc, const int tid, float* Xs = nullptr) {
    const int lane = tid & 63, wave = __builtin_amdgcn_readfirstlane(tid >> 6), hh = lane >> 5;
    const int ntiles = 8 * (N / 32), kw = K / 8;
    LAS float* red = (LAS float*)lds;
    for (int tile = blockIdx.x; tile < ntiles; tile += gridDim.x) {
        const int rt = tile & 7, ct = tile >> 3;
        const bf16_t* ap = A + (size_t)(32 * rt + (lane & 31)) * lda + wave * kw + 8 * hh;
        int brow = 32 * ct + (lane & 31);
        if (MODE == 2) { const int h0 = 32 * ct; brow = (h0 >> 7) * 256 + (h0 & 127) + (lane & 31); }
        const bf16_t* bp = Bt + (size_t)brow * ldb + wave * kw + 8 * hh;
        f32x16 c0, c1;
#pragma unroll
        for (int i = 0; i < 16; ++i) { c0[i] = 0.f; c1[i] = 0.f; }
        constexpr int CH = KSTEPS > 11 ? KSTEPS / 2 : KSTEPS;
#pragma unroll
        for (int cb = 0; cb < KSTEPS; cb += CH) {
            bf16x8 af[CH], bfr[CH], b2f[CH];
#pragma unroll
            for (int i = 0; i < CH; ++i) { af[i] = *(const bf16x8*)(ap + 16 * (cb + i)); bfr[i] = *(const bf16x8*)(bp + 16 * (cb + i));
                if (MODE == 2) b2f[i] = *(const bf16x8*)(bp + (size_t)128 * ldb + 16 * (cb + i)); }
#pragma unroll
            for (int i = 0; i < CH; ++i) { c0 = MFMA32S(af[i], bfr[i], c0); if (MODE == 2) c1 = MFMA32S(af[i], b2f[i], c1); }
        }
        __syncthreads();
#pragma unroll
        for (int i = 0; i < 16; ++i) { red[((wave * 2 + 0) * 16 + i) * 64 + lane] = c0[i]; if (MODE == 2) red[((wave * 2 + 1) * 16 + i) * 64 + lane] = c1[i]; }
        __syncthreads();
#pragma unroll
        for (int r = 0; r < 2; ++r) {
            const int e = tid + 512 * r, i = e >> 6, l = e & 63;
            float s0 = 0.f, s1 = 0.f;
#pragma unroll
            for (int w = 0; w < 8; ++w) { s0 += red[((w * 2 + 0) * 16 + i) * 64 + l]; if (MODE == 2) s1 += red[((w * 2 + 1) * 16 + i) * 64 + l]; }
            const int row = 32 * rt + (i & 3) + 8 * (i >> 2) + 4 * (l >> 5);
            int col = 32 * ct + (l & 31);
            if (MODE == 3) col = (((ct >> 3) * 4 + (ct & 3)) * 64 + 32 * ((ct >> 2) & 1)) + (l & 31);
            const float v = MODE == 2 ? silu_f(s0) * s1 : (MODE == 1 ? gelu_tanh_f(s0) : s0);
            if (MODE == 4) Xs[(size_t)row * ldc + col] += 0.5f * s0;
            else O[(size_t)row * ldc + col] = (bf16_t)(cvt_pk_bf16(v, 0.f) & 0xffffu);
        }
    }
    __syncthreads();
}

struct Params { const float* in[16]; float* out; unsigned char* ws; int ph_lo, ph_hi; };

__device__ __forceinline__ void transpose_item(const float* W, int K, int N, bf16_t* WT, int k0, int n0, int drow0, LAS float* scr, int lane, int ldw) {
#pragma unroll 8
    for (int i = 0; i < 32; ++i) { const int kk = 2 * i + (lane >> 5); scr[kk * 33 + (lane & 31)] = W[(size_t)(k0 + kk) * N + n0 + (lane & 31)]; }
    asm volatile("s_waitcnt lgkmcnt(0)" ::: "memory");
    const int c = lane & 7;
#pragma unroll
    for (int j = 0; j < 4; ++j) { const int n = (lane >> 3) + 8 * j; const LAS float* s = scr + (8 * c) * 33 + n;
        u32x4 o; o.x = cvt_pk_bf16(s[0 * 33], s[1 * 33]); o.y = cvt_pk_bf16(s[2 * 33], s[3 * 33]); o.z = cvt_pk_bf16(s[4 * 33], s[5 * 33]); o.w = cvt_pk_bf16(s[6 * 33], s[7 * 33]);
        *(u32x4*)(WT + (size_t)(drow0 + n) * ldw + k0 + 8 * c) = o; }
    asm volatile("s_waitcnt lgkmcnt(0)" ::: "memory");
}
__device__ __forceinline__ void transpose_mat(const float* W, int K, int N, bf16_t* WT, int item, bool swiglu, LAS float* scr, int lane, int ldw = 0, bool qkvperm = false) {
    const int nblk = N / 32, kb = item / nblk, nb = item % nblk, n0 = 32 * nb;
    int drow0 = n0;
    if (swiglu) { const int up = n0 >= FF, nn = up ? n0 - FF : n0; drow0 = (nn >> 7) * 256 + (up ? 128 : 0) + (nn & 127); }
    if (qkvperm) { const int head = n0 >> 6, bj = (n0 >> 5) & 1; drow0 = (head >> 2) * 256 + bj * 128 + (head & 3) * 32; }
    transpose_item(W, K, N, WT, 64 * kb, n0, drow0, scr, lane, ldw ? ldw : K);
}
__constant__ double ROPE_INV[32] = {
    1.0, 0.7498942093324559, 0.5623413251903491, 0.4216965034285822, 0.31622776601683794, 0.23713737056616552, 0.1778279410038923, 0.1333521432163324,
    0.1, 0.07498942093324558, 0.05623413251903491, 0.042169650342858224, 0.03162277660168379, 0.023713737056616554, 0.01778279410038923, 0.01333521432163324,
    0.01, 0.007498942093324558, 0.005623413251903491, 0.004216965034285823, 0.0031622776601683794, 0.0023713737056616554, 0.0017782794100389228, 0.001333521432163324,
    0.001, 0.0007498942093324559, 0.0005623413251903491, 0.00042169650342858224, 0.00031622776601683794, 0.00023713737056616554, 0.00017782794100389227, 0.0001333521432163324};

__device__ __forceinline__ void norm_row(const float* xrow, const bf16_t* yrow, float sy, const float* g, bf16_t* orow, float* xout, int lane) {
    const f32x4* xr = (const f32x4*)xrow + lane;
    f32x4 v[4]; float ss = 0.f;
#pragma unroll
    for (int j = 0; j < 4; ++j) v[j] = xr[64 * j];
    if (yrow) {
#pragma unroll
        for (int j = 0; j < 4; ++j) { const u32x2 y = ((const u32x2*)yrow)[lane + 64 * j];
            v[j].x += sy * bf_lo(y.x); v[j].y += sy * bf_hi(y.x); v[j].z += sy * bf_lo(y.y); v[j].w += sy * bf_hi(y.y); }
    }
#pragma unroll
    for (int j = 0; j < 4; ++j) ss += (v[j].x * v[j].x + v[j].y * v[j].y) + (v[j].z * v[j].z + v[j].w * v[j].w);
    if (xout) {
#pragma unroll
        for (int j = 0; j < 4; ++j) ((f32x4*)xout)[lane + 64 * j] = v[j];
    }
    if (g) {
        const float r = 1.0f / sqrtf(wave_sum(ss) * (1.0f / D) + EPS);
#pragma unroll
        for (int j = 0; j < 4; ++j) {
            const f32x4 gg = ((const f32x4*)g)[lane + 64 * j];
            u32x2 o; o.x = cvt_pk_bf16(v[j].x * r * gg.x, v[j].y * r * gg.y); o.y = cvt_pk_bf16(v[j].z * r * gg.z, v[j].w * r * gg.w);
            ((u32x2*)orow)[lane + 64 * j] = o;
        }
    }
}

__device__ __forceinline__ void phase_prologue(const Params& p, unsigned char* ws, float* out, LAS unsigned char* lds, const int tid) {
    const int lane = tid & 63, wave = tid >> 6;
    const int gw = blockIdx.x * 8 + wave, NGW = gridDim.x * 8;
    LAS float* scr = (LAS float*)(lds + wave * 8704);
    constexpr int I_IN = (D / 64) * (2 * FF / 32), I_OUT = (FF / 64) * (D / 32), I_QKV = (D / 64) * (NQKV / 32), I_OA = (AW / 64) * (D / 32), I_UV = (D / 64) * (NUV / 32), I_OB = (BW / 64) * (D / 32);
    constexpr int NITEMS = 4 * I_IN + 4 * I_OUT + I_QKV + I_OA + I_UV + I_OB;
    for (int it = gw; it < NITEMS; it += NGW) {
        int r = it;
        if (r < 4 * I_IN) { const int w = r / I_IN; transpose_mat(p.in[6] + (size_t)w * D * 2 * FF, D, 2 * FF, (bf16_t*)(ws + WS_WIN + w * SZ_WIN), r % I_IN, true, scr, lane); continue; } r -= 4 * I_IN;
        if (r < 4 * I_OUT) { const int w = r / I_OUT; transpose_mat(p.in[7] + (size_t)w * FF * D, FF, D, (bf16_t*)(ws + WS_WOUT + w * SZ_WOUT), r % I_OUT, false, scr, lane); continue; } r -= 4 * I_OUT;
        if (r < I_QKV) { transpose_mat(p.in[8], D, NQKV, (bf16_t*)(ws + WS_WQKV), r, false, scr, lane, 0, true); continue; } r -= I_QKV;
        if (r < I_OA) { transpose_mat(p.in[10], AW, D, (bf16_t*)(ws + WS_WOA), r, false, scr, lane); continue; } r -= I_OA;
        if (r < I_UV) { transpose_mat(p.in[11], D, NUV, (bf16_t*)(ws + WS_WUV), r, false, scr, lane); continue; } r -= I_UV;
        transpose_mat(p.in[15], BW, D, (bf16_t*)(ws + WS_WOB), r, false, scr, lane, LDU);
    }
    { bf16_t* wsp = (bf16_t*)(ws + WS_WSP); const float* src = p.in[13];
      for (int i = blockIdx.x * 512 + tid; i < 16 * 128 * 128 / 2; i += gridDim.x * 512) {
          const int e = 2 * i, s = e & 127, t = (e >> 7) & 127; const f32x2 v = *(const f32x2*)(src + e);
          ((unsigned*)wsp)[i] = cvt_pk_bf16(s <= t ? v.x : 0.f, (s + 1) <= t ? v.y : 0.f); } }
    { float* ct = (float*)(ws + WS_ROPE); float* st = ct + NPOS * 32;
      for (int i = blockIdx.x * 512 + tid; i < NPOS * 32; i += gridDim.x * 512) {
          const int pi = i >> 5, fi = i & 31; const double pos = (double)(pi < SEQ ? pi : PAST + (pi - SEQ));
          const double a = pos * ROPE_INV[fi]; const double n = __builtin_rint(a * 0.15915494309189535);
          const double r = (a - n * 6.283185307179586) - n * 2.4492935982947064e-16; const double r2 = r * r;
          double sn = 1.0, cs = 1.0;
#pragma unroll 1
          for (int k = 14; k >= 1; --k) { const double k2 = (double)(2 * k); sn = 1.0 - sn * r2 / (k2 * (k2 + 1.0)); cs = 1.0 - cs * r2 / ((k2 - 1.0) * k2); }
          ct[i] = (float)cs; st[i] = (float)(sn * r); } }
#ifdef NANFILL
    { u32x4* f = (u32x4*)(ws + WS_BIG); const size_t n = (WS_END - WS_BIG) / 16; const u32x4 q = {0xffffffffu, 0xffffffffu, 0xffffffffu, 0xffffffffu};
      for (size_t i = (size_t)blockIdx.x * 512 + tid; i < n; i += (size_t)gridDim.x * 512) f[i] = q;
      u32x4* fo = (u32x4*)(out + O_KP0); const size_t no = (O_VS + 524288 - O_KP0) / 4;
      for (size_t i = (size_t)blockIdx.x * 512 + tid; i < no; i += (size_t)gridDim.x * 512) fo[i] = q; }
#endif
    for (int m = gw; m < M; m += NGW) {
        const float* src = m < MP ? p.in[0] + (size_t)m * D : p.in[1] + (size_t)(m - MP) * D;
        norm_row(src, nullptr, 0.f, p.in[5], (bf16_t*)(ws + WS_XN) + (size_t)m * D, out + (size_t)m * D, lane);
    }
}

__device__ __forceinline__ void phase_norm(unsigned char* ws, float* out, const float* g, float sy, const int tid) {
    const int lane = tid & 63, wave = tid >> 6;
    const int gw = blockIdx.x * 8 + wave, NGW = gridDim.x * 8;
    const bf16_t* YB = (const bf16_t*)(ws + WS_YB); bf16_t* XN = (bf16_t*)(ws + WS_XN);
    for (int m0 = gw; m0 < M; m0 += 2 * NGW) {
        const int m1 = m0 + NGW; const bool two = m1 < M; const int mb = two ? m1 : m0;
        f32x4 va[4], vb[4]; u32x2 ya[4], yb[4];
#pragma unroll
        for (int j = 0; j < 4; ++j) { va[j] = ((const f32x4*)(out + (size_t)m0 * D))[lane + 64 * j]; vb[j] = ((const f32x4*)(out + (size_t)mb * D))[lane + 64 * j]; }
#pragma unroll
        for (int j = 0; j < 4; ++j) { ya[j] = ((const u32x2*)(YB + (size_t)m0 * D))[lane + 64 * j]; yb[j] = ((const u32x2*)(YB + (size_t)mb * D))[lane + 64 * j]; }
        float sa = 0.f, sb = 0.f;
#pragma unroll
        for (int j = 0; j < 4; ++j) {
            va[j].x += sy * bf_lo(ya[j].x); va[j].y += sy * bf_hi(ya[j].x); va[j].z += sy * bf_lo(ya[j].y); va[j].w += sy * bf_hi(ya[j].y);
            vb[j].x += sy * bf_lo(yb[j].x); vb[j].y += sy * bf_hi(yb[j].x); vb[j].z += sy * bf_lo(yb[j].y); vb[j].w += sy * bf_hi(yb[j].y);
            sa += (va[j].x * va[j].x + va[j].y * va[j].y) + (va[j].z * va[j].z + va[j].w * va[j].w);
            sb += (vb[j].x * vb[j].x + vb[j].y * vb[j].y) + (vb[j].z * vb[j].z + vb[j].w * vb[j].w);
        }
#pragma unroll
        for (int j = 0; j < 4; ++j) { ((f32x4*)(out + (size_t)m0 * D))[lane + 64 * j] = va[j]; if (two) ((f32x4*)(out + (size_t)m1 * D))[lane + 64 * j] = vb[j]; }
        if (g) {
            const float ra = 1.0f / sqrtf(wave_sum(sa) * (1.0f / D) + EPS), rb = 1.0f / sqrtf(wave_sum(sb) * (1.0f / D) + EPS);
#pragma unroll
            for (int j = 0; j < 4; ++j) {
                const f32x4 gg = ((const f32x4*)g)[lane + 64 * j];
                u32x2 o; o.x = cvt_pk_bf16(va[j].x * ra * gg.x, va[j].y * ra * gg.y); o.y = cvt_pk_bf16(va[j].z * ra * gg.z, va[j].w * ra * gg.w);
                ((u32x2*)(XN + (size_t)m0 * D))[lane + 64 * j] = o;
                if (two) { u32x2 o2; o2.x = cvt_pk_bf16(vb[j].x * rb * gg.x, vb[j].y * rb * gg.y); o2.y = cvt_pk_bf16(vb[j].z * rb * gg.z, vb[j].w * rb * gg.w);
                    ((u32x2*)(XN + (size_t)m1 * D))[lane + 64 * j] = o2; }
            }
        }
    }
}

__device__ __forceinline__ void tail_store(float* out, int g, int h, int kv, int row, int i0, f32x4 a, f32x4 b) {
    float* dst;
    if (row < MP) {
        const int bb = row >> 11, t = row & 2047, keep = 128 << (2 * g), tt = t - (SEQ - keep);
        if (tt < 0) return;
        const size_t base = g == 0 ? O_KP0 : (g == 1 ? O_KP1 : O_KP2);
        dst = out + base + ((((size_t)bb * keep + tt) * 2 + kv) * 8 + h) * 64;
    } else {
        const int s = row - MP; const size_t base = g == 0 ? O_KS0 : (g == 1 ? O_KS1 : O_KS2);
        dst = out + base + (((size_t)s * 2 + kv) * 8 + h) * 64;
    }
    *(f32x4*)(dst + i0) = a; *(f32x4*)(dst + 32 + i0) = b;
}
__device__ __forceinline__ void phase_qknorm(const Params& p, unsigned char* ws, float* out, const int tid) {
    const int lane = tid & 63, wave = tid >> 6;
    const int gw = blockIdx.x * 8 + wave, NGW = gridDim.x * 8;
    bf16_t* QKV = (bf16_t*)(ws + WS_BIG);
    const float* ct = (const float*)(ws + WS_ROPE); const float* st = ct + NPOS * 32;
    const int sub = lane & 7, i0 = 4 * sub;
    for (int it = MP * 9 + gw; it < M * 9; it += NGW) {
        const int row = it / 9, s9 = it - row * 9;
        if (s9 < 6) {
            const int head = s9 * 8 + (lane >> 3), isk = head >= 24, gh = isk ? head - 24 : head, g = gh >> 3, h = gh & 7;
            bf16_t* ptr = QKV + (size_t)row * NQKV + head * 64;
            const u32x2 ra = *(const u32x2*)(ptr + i0), rb = *(const u32x2*)(ptr + 32 + i0);
            f32x4 x1 = {bf_lo(ra.x), bf_hi(ra.x), bf_lo(ra.y), bf_hi(ra.y)}, x2 = {bf_lo(rb.x), bf_hi(rb.x), bf_lo(rb.y), bf_hi(rb.y)};
            float ss = (x1.x * x1.x + x1.y * x1.y) + (x1.z * x1.z + x1.w * x1.w) + (x2.x * x2.x + x2.y * x2.y) + (x2.z * x2.z + x2.w * x2.w);
            ss += __shfl_xor(ss, 1); ss += __shfl_xor(ss, 2); ss += __shfl_xor(ss, 4);
            const float r = 1.0f / sqrtf(ss * (1.0f / 64) + EPS);
            const float* gain = p.in[9] + isk * 64;
            const f32x4 g1 = *(const f32x4*)(gain + i0), g2 = *(const f32x4*)(gain + 32 + i0);
            const int pi = row < MP ? (row & 2047) : SEQ + ((row - MP) & 7);
            const f32x4 c = *(const f32x4*)(ct + pi * 32 + i0), s = *(const f32x4*)(st + pi * 32 + i0);
            const f32x4 y1 = x1 * r * g1, y2 = x2 * r * g2;
            const f32x4 o1 = y1 * c - y2 * s, o2 = y2 * c + y1 * s;
            u32x2 wa, wb; wa.x = cvt_pk_bf16(o1.x, o1.y); wa.y = cvt_pk_bf16(o1.z, o1.w); wb.x = cvt_pk_bf16(o2.x, o2.y); wb.y = cvt_pk_bf16(o2.z, o2.w);
            *(u32x2*)(ptr + i0) = wa; *(u32x2*)(ptr + 32 + i0) = wb;
            if (isk) tail_store(out, g, h, 0, row, i0, o1, o2);
        } else {
            const int vh = (s9 - 6) * 8 + (lane >> 3), g = vh >> 3, h = vh & 7;
            const bf16_t* ptr = QKV + (size_t)row * NQKV + 3072 + vh * 64;
            const u32x2 ra = *(const u32x2*)(ptr + i0), rb = *(const u32x2*)(ptr + 32 + i0);
            const f32x4 x1 = {bf_lo(ra.x), bf_hi(ra.x), bf_lo(ra.y), bf_hi(ra.y)}, x2 = {bf_lo(rb.x), bf_hi(rb.x), bf_lo(rb.y), bf_hi(rb.y)};
            tail_store(out, g, h, 1, row, i0, x1, x2);
        }
    }
}

#define MFMA32(a, b, c) __builtin_amdgcn_mfma_f32_32x32x16_bf16((a), (b), (c), 0, 0, 0)
__device__ __forceinline__ s16x4 tr_read(unsigned lds_addr) { return __builtin_amdgcn_ds_read_tr16_b64_v4i16((LAS s16x4*)(uintptr_t)lds_addr); }
__device__ __forceinline__ bf16x8 pack8(const f32x16& x, int s) {
    u32x4 pk;
    pk.x = cvt_pk_bf16(x[8 * s + 0], x[8 * s + 1]); pk.y = cvt_pk_bf16(x[8 * s + 2], x[8 * s + 3]); pk.z = cvt_pk_bf16(x[8 * s + 4], x[8 * s + 5]); pk.w = cvt_pk_bf16(x[8 * s + 6], x[8 * s + 7]);
    return __builtin_bit_cast(bf16x8, pk);
}
__device__ __forceinline__ void attn_prompt_tile(const bf16_t* QKV, bf16_t* OG, float* LSE, LAS unsigned char* vl, int g, int b, int h, int w, int lane) {
    const int dsh = 2 * g, d = 1 << dsh;
    const int tpr_sh = 6 - dsh;
    const int r = w >> tpr_sh, jt = w & ((1 << tpr_sh) - 1), j0 = jt * 32;
    const int q = lane & 31, hh = lane >> 5;
    const size_t rowb = (size_t)b * SEQ;
    const int qcol = g * 512 + h * 64, kcol = 1536 + qcol, vcol = 3072 + qcol;
    const int tq = ((j0 + q) << dsh) + r;
    const bf16_t* qp = QKV + (rowb + tq) * NQKV + qcol + 8 * hh;
    bf16x8 qf[4];
#pragma unroll
    for (int s = 0; s < 4; ++s) qf[s] = *(const bf16x8*)(qp + 16 * s);
    const int kb0 = jt >= 4 ? 0 : 4 - jt;
    f32x16 S[5];
    float mx = -INFINITY;
    bf16x8 kfa[5][4];
#pragma unroll
    for (int kb = 0; kb < 5; ++kb) {
        int jk = j0 - 128 + kb * 32 + q; jk = jk < 0 ? 0 : jk;
        const bf16_t* kp = QKV + (rowb + (size_t)((jk << dsh) + r)) * NQKV + kcol + 8 * hh;
#pragma unroll
        for (int s = 0; s < 4; ++s) kfa[kb][s] = *(const bf16x8*)(kp + 16 * s);
    }
#pragma unroll
    for (int kb = 0; kb < 5; ++kb) {
        f32x16 c;
#pragma unroll
        for (int i = 0; i < 16; ++i) c[i] = 0.f;
#pragma unroll
        for (int s = 0; s < 4; ++s) c = MFMA32(kfa[kb][s], qf[s], c);
#pragma unroll
        for (int i = 0; i < 16; ++i) {
            const int ki = (i & 3) + 8 * (i >> 2) + 4 * hh;
            bool valid = kb >= kb0;
            if (kb == 0) valid = valid && (ki >= q);
            if (kb == 4) valid = valid && (ki <= q);
            const float sv = valid ? c[i] * 0.125f : -INFINITY;
            c[i] = sv; mx = fmaxf(mx, sv);
        }
        S[kb] = c;
    }
    bf16x8 vva[5][4];
#pragma unroll
    for (int kb = 0; kb < 5; ++kb)
#pragma unroll
        for (int c4 = 0; c4 < 4; ++c4) {
            const int i = c4 * 8 + (lane >> 3); int jk = j0 - 128 + kb * 32 + i; jk = jk < 0 ? 0 : jk;
            vva[kb][c4] = *(const bf16x8*)(QKV + (rowb + (size_t)((jk << dsh) + r)) * NQKV + vcol + (lane & 7) * 8);
        }
    mx = fmaxf(mx, __shfl_xor(mx, 32));
    float l = 0.f;
#pragma unroll
    for (int kb = 0; kb < 5; ++kb)
#pragma unroll
        for (int i = 0; i < 16; ++i) { const float e = __expf(S[kb][i] - mx); S[kb][i] = e; l += e; }
    l += __shfl_xor(l, 32);
    const float inv = 1.0f / l;
    f32x16 o0, o1;
#pragma unroll
    for (int i = 0; i < 16; ++i) { o0[i] = 0.f; o1[i] = 0.f; }
    const unsigned vbase = (unsigned)(uintptr_t)vl;
    const unsigned tr_off = (unsigned)((4 * hh + ((lane & 15) >> 2)) * 144 + ((lane >> 4) & 1) * 32 + 8 * (lane & 3));
#pragma unroll
    for (int kb = 0; kb < 5; ++kb) {
        {
#pragma unroll
            for (int c4 = 0; c4 < 4; ++c4) *(LAS bf16x8*)(vl + (c4 * 8 + (lane >> 3)) * 144 + (lane & 7) * 16) = vva[kb][c4];
#pragma unroll
            for (int s2 = 0; s2 < 2; ++s2) {
                f32x16 pn = S[kb];
#pragma unroll
                for (int i = 0; i < 16; ++i) pn[i] *= inv;
                const bf16x8 pb = pack8(pn, s2);
#pragma unroll
                for (int nb = 0; nb < 2; ++nb) {
                    const unsigned a0 = vbase + tr_off + (unsigned)(16 * s2 * 144 + nb * 64);
                    const s16x4 lo = tr_read(a0), hi = tr_read(a0 + 8 * 144);
                    const bf16x8 va = __builtin_shufflevector(lo, hi, 0, 1, 2, 3, 4, 5, 6, 7);
                    if (nb == 0) o0 = MFMA32(va, pb, o0); else o1 = MFMA32(va, pb, o1);
                }
            }
        }
    }
    const size_t orow = (size_t)g * M + rowb + tq;
    bf16_t* op = OG + orow * AW + h * 64 + 4 * hh;
#pragma unroll
    for (int g4 = 0; g4 < 4; ++g4) {
        u32x2 w0, w1;
        w0.x = cvt_pk_bf16(o0[4 * g4], o0[4 * g4 + 1]); w0.y = cvt_pk_bf16(o0[4 * g4 + 2], o0[4 * g4 + 3]);
        w1.x = cvt_pk_bf16(o1[4 * g4], o1[4 * g4 + 1]); w1.y = cvt_pk_bf16(o1[4 * g4 + 2], o1[4 * g4 + 3]);
        *(u32x2*)(op + 8 * g4) = w0; *(u32x2*)(op + 32 + 8 * g4) = w1;
    }
    if (hh == 0) LSE[orow * 8 + h] = mx + __logf(l);
}
__device__ __forceinline__ void attn_sample_item(const Params& p, unsigned char* ws, int item, LAS float* sc, int lane) {
    const int j = item & 7, h = (item >> 3) & 7, gb = item >> 6, g = gb % 3, b = gb / 3;
    const int dsh = 2 * g, L = 128 << dsh;
    const float* cache = (g == 0 ? p.in[2] : (g == 1 ? p.in[3] : p.in[4])) + (size_t)b * L * 1024;
    const bf16_t* QKV = (const bf16_t*)(ws + WS_BIG);
    const int row = MP + b * 8 + j;
    const int sub = lane & 15, ks = lane >> 4;
    const int qcol = g * 512 + h * 64 + 4 * sub;
    const u32x2 qr = *(const u32x2*)(QKV + (size_t)row * NQKV + qcol);
    const f32x4 qv = {bf_lo(qr.x), bf_hi(qr.x), bf_lo(qr.y), bf_hi(qr.y)};
#pragma unroll 11
    for (int it = 0; it < 33; ++it) {
        const int i = it * 4 + ks;
        float dot = 0.f;
        if (i <= 128) {
            const int idx = L + j - (i << dsh);
            f32x4 kv;
            if (idx >= L) { const u32x2 kr = *(const u32x2*)(QKV + (size_t)(MP + b * 8 + (idx - L)) * NQKV + 1536 + qcol); kv = (f32x4){bf_lo(kr.x), bf_hi(kr.x), bf_lo(kr.y), bf_hi(kr.y)}; }
            else kv = *(const f32x4*)(cache + (size_t)idx * 1024 + h * 64 + 4 * sub);
            dot = (qv.x * kv.x + qv.y * kv.y) + (qv.z * kv.z + qv.w * kv.w);
        }
        dot += __shfl_xor(dot, 1); dot += __shfl_xor(dot, 2); dot += __shfl_xor(dot, 4); dot += __shfl_xor(dot, 8);
        if (sub == 0 && i <= 128) sc[i] = dot * 0.125f;
    }
    asm volatile("s_waitcnt lgkmcnt(0)" ::: "memory");
    float mx = fmaxf(sc[lane], sc[lane + 64]); if (lane == 0) mx = fmaxf(mx, sc[128]);
    mx = wave_max(mx);
    float l = __expf(sc[lane] - mx) + __expf(sc[lane + 64] - mx); if (lane == 0) l += __expf(sc[128] - mx);
    l = wave_sum(l);
    const float inv = 1.0f / l;
    f32x4 acc = {0.f, 0.f, 0.f, 0.f};
#pragma unroll 11
    for (int it = 0; it < 33; ++it) {
        const int i = it * 4 + ks;
        if (i <= 128) {
            const float pw = __expf(sc[i] - mx) * inv;
            const int idx = L + j - (i << dsh);
            f32x4 vv;
            if (idx >= L) { const u32x2 vr = *(const u32x2*)(QKV + (size_t)(MP + b * 8 + (idx - L)) * NQKV + 3072 + qcol); vv = (f32x4){bf_lo(vr.x), bf_hi(vr.x), bf_lo(vr.y), bf_hi(vr.y)}; }
            else vv = *(const f32x4*)(cache + (size_t)idx * 1024 + 512 + h * 64 + 4 * sub);
            acc += vv * pw;
        }
    }
#pragma unroll
    for (int k = 0; k < 4; ++k) { acc[k] += __shfl_xor(acc[k], 16); acc[k] += __shfl_xor(acc[k], 32); }
    const size_t orow = (size_t)g * M + row;
    if (ks == 0) { u32x2 w; w.x = cvt_pk_bf16(acc.x, acc.y); w.y = cvt_pk_bf16(acc.z, acc.w); *(u32x2*)((bf16_t*)(ws + WS_OG) + orow * AW + h * 64 + 4 * sub) = w; }
    if (lane == 0) ((float*)(ws + WS_LSE))[orow * 8 + h] = mx + __logf(l);
    asm volatile("s_waitcnt lgkmcnt(0)" ::: "memory");
}
__device__ __forceinline__ void attn_prompt_block(const bf16_t* QKV, bf16_t* OG, float* LSE, LAS unsigned char* lds, int g, int b, int h, int w8, const int tid) {
    const int lane = tid & 63, wave = __builtin_amdgcn_readfirstlane(tid >> 6);
    const int dsh = 2 * g, tpr_sh = 6 - dsh;
    const size_t rowb = (size_t)b * SEQ;
    const int qcol = g * 512 + h * 64, kcol = 1536 + qcol, vcol = 3072 + qcol;
    LAS unsigned char* Kl = lds; LAS unsigned char* Vl = lds + 55296;
    const int w = w8 * 8 + wave, r = w >> tpr_sh, jt = w & ((1 << tpr_sh) - 1), j0 = jt * 32;
    const int q = lane & 31, hh = lane >> 5;
    const int tq = ((j0 + q) << dsh) + r;
    const bf16_t* qp = QKV + (rowb + tq) * NQKV + qcol + 8 * hh;
    bf16x8 qf[4];
#pragma unroll
    for (int s = 0; s < 4; ++s) qf[s] = *(const bf16x8*)(qp + 16 * s);
    __syncthreads();
    {
        bf16x8 kr[6], vr[6];
#pragma unroll
        for (int i = 0; i < 6; ++i) {
            const int p = tid + 512 * i, sl = p >> 3, c = p & 7;
            int j, rr; bool valid;
            if (g == 2) { valid = sl < 256; j = sl & 127; rr = 2 * w8 + (sl >> 7); }
            else if (g == 1) { j = 256 * (w8 & 1) - 128 + sl; rr = w8 >> 1; valid = j >= 0; }
            else { j = 256 * w8 - 128 + sl; rr = 0; valid = j >= 0; }
            j = valid ? j : 0;
            const bf16_t* src = QKV + (rowb + (size_t)((j << dsh) + rr)) * NQKV + c * 8;
            kr[i] = *(const bf16x8*)(src + kcol); vr[i] = *(const bf16x8*)(src + vcol);
        }
#pragma unroll
        for (int i = 0; i < 6; ++i) {
            const int p = tid + 512 * i, sl = p >> 3, c = p & 7;
            *(LAS bf16x8*)(Kl + sl * 144 + c * 16) = kr[i]; *(LAS bf16x8*)(Vl + sl * 144 + c * 16) = vr[i];
        }
    }
    __syncthreads();
    const int jstart = g == 2 ? -128 * (wave >> 2) : (g == 1 ? 256 * (w8 & 1) - 128 : 256 * w8 - 128);
    const int kb0 = jt >= 4 ? 0 : 4 - jt;
    f32x16 S[5];
    float mx = -INFINITY;
#pragma unroll
    for (int kb = 0; kb < 5; ++kb) {
        f32x16 c;
#pragma unroll
        for (int i = 0; i < 16; ++i) c[i] = 0.f;
        const int jb = j0 - 128 + kb * 32;
        const int slot = jb < 0 ? -jstart : jb - jstart + q;
        bf16x8 kf[4];
#pragma unroll
        for (int s = 0; s < 4; ++s) kf[s] = *(const LAS bf16x8*)(Kl + slot * 144 + s * 32 + hh * 16);
#pragma unroll
        for (int s = 0; s < 4; ++s) c = MFMA32(kf[s], qf[s], c);
#pragma unroll
        for (int i = 0; i < 16; ++i) {
            const int ki = (i & 3) + 8 * (i >> 2) + 4 * hh;
            bool valid = kb >= kb0;
            if (kb == 0) valid = valid && (ki >= q);
            if (kb == 4) valid = valid && (ki <= q);
            const float sv = valid ? c[i] * 0.125f : -INFINITY;
            c[i] = sv; mx = fmaxf(mx, sv);
        }
        S[kb] = c;
    }
    mx = fmaxf(mx, __shfl_xor(mx, 32));
    float l = 0.f;
#pragma unroll
    for (int kb = 0; kb < 5; ++kb)
#pragma unroll
        for (int i = 0; i < 16; ++i) { const float e = __expf(S[kb][i] - mx); S[kb][i] = e; l += e; }
    l += __shfl_xor(l, 32);
    const float inv = 1.0f / l;
    f32x16 o0, o1;
#pragma unroll
    for (int i = 0; i < 16; ++i) { o0[i] = 0.f; o1[i] = 0.f; }
    const unsigned vbase = (unsigned)(uintptr_t)Vl;
    const int trrow = 4 * hh + ((lane & 15) >> 2);
    const unsigned trcol = (unsigned)(((lane >> 4) & 1) * 32 + 8 * (lane & 3));
#pragma unroll
    for (int kb = 0; kb < 5; ++kb) {
        const int jb = j0 - 128 + kb * 32;
        const int sbase = jb < 0 ? -jstart : jb - jstart, sstr = jb < 0 ? 0 : 144;
#pragma unroll
        for (int s2 = 0; s2 < 2; ++s2) {
            f32x16 pn = S[kb];
#pragma unroll
            for (int i = 0; i < 16; ++i) pn[i] *= inv;
            const bf16x8 pb = pack8(pn, s2);
#pragma unroll
            for (int nb = 0; nb < 2; ++nb) {
                const unsigned a0 = vbase + (unsigned)(sbase * 144 + (16 * s2 + trrow) * sstr) + trcol + (unsigned)(nb * 64);
                const s16x4 lo = tr_read(a0), hi = tr_read(a0 + (unsigned)(8 * sstr));
                const bf16x8 va = __builtin_shufflevector(lo, hi, 0, 1, 2, 3, 4, 5, 6, 7);
                if (nb == 0) o0 = MFMA32(va, pb, o0); else o1 = MFMA32(va, pb, o1);
            }
        }
    }
    const size_t orow = (size_t)g * M + rowb + tq;
    bf16_t* op = OG + orow * AW + h * 64 + 4 * hh;
#pragma unroll
    for (int g4 = 0; g4 < 4; ++g4) {
        u32x2 w0, w1;
        w0.x = cvt_pk_bf16(o0[4 * g4], o0[4 * g4 + 1]); w0.y = cvt_pk_bf16(o0[4 * g4 + 2], o0[4 * g4 + 3]);
        w1.x = cvt_pk_bf16(o1[4 * g4], o1[4 * g4 + 1]); w1.y = cvt_pk_bf16(o1[4 * g4 + 2], o1[4 * g4 + 3]);
        *(u32x2*)(op + 8 * g4) = w0; *(u32x2*)(op + 32 + 8 * g4) = w1;
    }
    if (hh == 0) LSE[orow * 8 + h] = mx + __logf(l);
}
__device__ __forceinline__ void phase_attn(const Params& p, unsigned char* ws, LAS unsigned char* lds, const int tid) {
    const int lane = tid & 63, wave = __builtin_amdgcn_readfirstlane(tid >> 6);
    LAS unsigned char* vl = lds + wave * 4608;
    constexpr int NS = 768, NP = 3072;
    for (int bi = blockIdx.x; bi < NS; bi += gridDim.x) attn_sample_item(p, ws, bi * 8 + wave, (LAS float*)vl, lane);
    for (int x = blockIdx.x; x < NP; x += gridDim.x) {
        const int w8 = x & 7, h = (x >> 3) & 7, b = (x >> 6) & 15, g = x >> 10;
        attn_prompt_block((const bf16_t*)(ws + WS_BIG), (bf16_t*)(ws + WS_OG), (float*)(ws + WS_LSE), lds, g, b, h, w8, tid);
    }
    __syncthreads();
}
__device__ __forceinline__ void phase_merge(unsigned char* ws, const int tid) {
    const bf16_t* OG = (const bf16_t*)(ws + WS_OG); const float* LSE = (const float*)(ws + WS_LSE); bf16_t* AO = (bf16_t*)(ws + WS_AO);
    for (int e = blockIdx.x * 512 + tid; e < M * 64; e += gridDim.x * 512) {
        const int rh = e >> 3, c8 = e & 7;
        const float l0 = LSE[rh], l1 = LSE[(size_t)M * 8 + rh], l2 = LSE[(size_t)2 * M * 8 + rh];
        const float mx = fmaxf(l0, fmaxf(l1, l2));
        float w0 = __expf(l0 - mx), w1 = __expf(l1 - mx), w2 = __expf(l2 - mx); const float inv = 1.0f / (w0 + w1 + w2); w0 *= inv; w1 *= inv; w2 *= inv;
        const size_t off = (size_t)rh * 64 + c8 * 8;
        const u32x4 a = *(const u32x4*)(OG + off), b = *(const u32x4*)(OG + (size_t)M * AW + off), c = *(const u32x4*)(OG + (size_t)2 * M * AW + off);
        u32x4 o;
#pragma unroll
        for (int k = 0; k < 4; ++k) o[k] = cvt_pk_bf16(w0 * bf_lo(a[k]) + w1 * bf_lo(b[k]) + w2 * bf_lo(c[k]), w0 * bf_hi(a[k]) + w1 * bf_hi(b[k]) + w2 * bf_hi(c[k]));
        *(u32x4*)(AO + off) = o;
    }
}

__device__ __forceinline__ void phase_vnorm(const Params& p, unsigned char* ws, float* out, const int tid) {
    const int lane = tid & 63, wave = tid >> 6;
    const int gw = blockIdx.x * 8 + wave, NGW = gridDim.x * 8;
    const bf16_t* UV = (const bf16_t*)(ws + WS_BIG); float* RV = (float*)(ws + WS_RV);
    for (int m = gw; m < M; m += NGW) {
        const u32x4* vr = (const u32x4*)(UV + (size_t)m * NUV + BW) + lane;
        u32x4 v[4]; float ss = 0.f;
#pragma unroll
        for (int j = 0; j < 4; ++j) { v[j] = vr[64 * j];
#pragma unroll
            for (int k = 0; k < 4; ++k) { const float a = bf_lo(v[j][k]), b = bf_hi(v[j][k]); ss += a * a + b * b; } }
        const float r = 1.0f / sqrtf(wave_sum(ss) * (1.0f / BW) + EPS);
        if (lane == 0) RV[m] = r;
        if (m >= MP) {
            float* dst = out + O_VS + (size_t)(m - MP) * BW;
#pragma unroll
            for (int j = 0; j < 4; ++j) { const int c0 = 8 * (lane + 64 * j); const f32x4 ga = *(const f32x4*)(p.in[12] + c0), gb = *(const f32x4*)(p.in[12] + c0 + 4);
                *(f32x4*)(dst + c0) = (f32x4){bf_lo(v[j][0]) * r * ga.x, bf_hi(v[j][0]) * r * ga.y, bf_lo(v[j][1]) * r * ga.z, bf_hi(v[j][1]) * r * ga.w};
                *(f32x4*)(dst + c0 + 4) = (f32x4){bf_lo(v[j][2]) * r * gb.x, bf_hi(v[j][2]) * r * gb.y, bf_lo(v[j][3]) * r * gb.z, bf_hi(v[j][3]) * r * gb.w}; }
        }
    }
}
__device__ __forceinline__ void spatial_item(const Params& p, unsigned char* ws, LAS unsigned char* lds, int chunk, int gi, const int tid) {
    const bf16_t* UV = (const bf16_t*)(ws + WS_BIG); const float* RV = (const float*)(ws + WS_RV); bf16_t* UM = (bf16_t*)(ws + WS_UM);
    const bf16_t* WSP = (const bf16_t*)(ws + WS_WSP);
    constexpr int PITCH = 272;
    const int lane = tid & 63, wave = __builtin_amdgcn_readfirstlane(tid >> 6), tb = wave & 3, ch = wave >> 2, hh = lane >> 5;
    const int t = 32 * tb + (lane & 31);
    const bf16_t* wp = WSP + ((size_t)gi * 128 + t) * 128 + 8 * hh;
    bf16x8 wfa[8];
#pragma unroll
    for (int ks = 0; ks < 8; ++ks) wfa[ks] = *(const bf16x8*)(wp + 16 * ks);
    const size_t row = (size_t)chunk * 128 + t;
    const int colb = gi * 128 + 64 * ch;
    const bf16_t* up = UV + row * NUV + colb + 4 * hh;
    u32x2 ur[8];
#pragma unroll
    for (int k = 0; k < 8; ++k) ur[k] = *(const u32x2*)(up + 32 * (k >> 2) + 8 * (k & 3));
    const float bias = p.in[14][gi * 128 + t];
    __syncthreads();
#pragma unroll
    for (int k = 0; k < 4; ++k) {
        const int pc = tid + 512 * k, sr = pc >> 4, c16 = pc & 15;
        const u32x4 raw = *(const u32x4*)(UV + (size_t)(chunk * 128 + sr) * NUV + BW + gi * 128 + c16 * 8);
        const float rv = RV[chunk * 128 + sr];
        const f32x4 ga = *(const f32x4*)(p.in[12] + gi * 128 + c16 * 8), gb = *(const f32x4*)(p.in[12] + gi * 128 + c16 * 8 + 4);
        u32x4 o;
        o.x = cvt_pk_bf16(bf_lo(raw.x) * rv * ga.x, bf_hi(raw.x) * rv * ga.y); o.y = cvt_pk_bf16(bf_lo(raw.y) * rv * ga.z, bf_hi(raw.y) * rv * ga.w);
        o.z = cvt_pk_bf16(bf_lo(raw.z) * rv * gb.x, bf_hi(raw.z) * rv * gb.y); o.w = cvt_pk_bf16(bf_lo(raw.w) * rv * gb.z, bf_hi(raw.w) * rv * gb.w);
        *(LAS u32x4*)(lds + sr * PITCH + c16 * 16) = o;
    }
    __syncthreads();
    f32x16 a0, a1;
#pragma unroll
    for (int i = 0; i < 16; ++i) { a0[i] = 0.f; a1[i] = 0.f; }
    const unsigned lbase = (unsigned)(uintptr_t)lds;
    const unsigned tr_off = (unsigned)((8 * hh + ((lane & 15) >> 2)) * PITCH + (64 * ch + 16 * ((lane >> 4) & 1)) * 2 + 8 * (lane & 3));
#pragma unroll
    for (int ks = 0; ks < 8; ++ks) {
        if (ks < 2 * (tb + 1)) {
#pragma unroll
            for (int cb = 0; cb < 2; ++cb) {
                const unsigned a = lbase + tr_off + (unsigned)(16 * ks * PITCH + cb * 64);
                const s16x4 lo = tr_read(a), hi = tr_read(a + 4 * PITCH);
                const bf16x8 va = __builtin_shufflevector(lo, hi, 0, 1, 2, 3, 4, 5, 6, 7);
                if (cb == 0) a0 = MFMA32(va, wfa[ks], a0); else a1 = MFMA32(va, wfa[ks], a1);
            }
        }
    }
    bf16_t* op = UM + row * LDU + colb + 4 * hh;
#pragma unroll
    for (int cb = 0; cb < 2; ++cb)
#pragma unroll
        for (int g4 = 0; g4 < 4; ++g4) {
            const u32x2 uu = ur[cb * 4 + g4];
            const f32x16& a = cb == 0 ? a0 : a1;
            u32x2 w;
            w.x = cvt_pk_bf16(bf_lo(uu.x) * (a[4 * g4] + bias), bf_hi(uu.x) * (a[4 * g4 + 1] + bias));
            w.y = cvt_pk_bf16(bf_lo(uu.y) * (a[4 * g4 + 2] + bias), bf_hi(uu.y) * (a[4 * g4 + 3] + bias));
            *(u32x2*)(op + 32 * cb + 8 * g4) = w;
        }
}
__device__ __forceinline__ void phase_spatial(const Params& p, unsigned char* ws, LAS unsigned char* lds, const int tid) {
    const int lane = tid & 63, wave = __builtin_amdgcn_readfirstlane(tid >> 6);
    const bf16_t* UV = (const bf16_t*)(ws + WS_BIG); const float* RV = (const float*)(ws + WS_RV); bf16_t* UM = (bf16_t*)(ws + WS_UM);
    const float* vgain = p.in[12]; const float* bsp = p.in[14];
    constexpr int NPI = 256 * 16, NSI = 256;
    LAS unsigned char* vl = lds + wave * 4608;
    for (int it = blockIdx.x; it < NPI + NSI; it += gridDim.x) {
        if (it < NPI) spatial_item(p, ws, lds, it >> 4, it & 15, tid);
        else {
            const int e = (it - NPI) * 512 + tid;
            const int c4 = e & 511, bt = e >> 9, t = bt & 7, b = bt >> 3, c0 = 4 * c4, gi = c0 >> 7;
            f32x4 acc = {0.f, 0.f, 0.f, 0.f};
            const f32x4 vg = *(const f32x4*)(vgain + c0);
            for (int s = 0; s <= t; ++s) {
                const size_t r = (size_t)MP + b * 8 + s;
                const u32x2 vr = *(const u32x2*)(UV + r * NUV + BW + c0);
                const float wv = p.in[13][((size_t)gi * 128 + t) * 128 + s] * RV[r];
                acc += (f32x4){bf_lo(vr.x), bf_hi(vr.x), bf_lo(vr.y), bf_hi(vr.y)} * wv;
            }
            const float bias = bsp[gi * 128 + t];
            const size_t r = (size_t)MP + b * 8 + t;
            const u32x2 ur = *(const u32x2*)(UV + r * NUV + c0);
            u32x2 w;
            w.x = cvt_pk_bf16(bf_lo(ur.x) * (acc.x * vg.x + bias), bf_hi(ur.x) * (acc.y * vg.y + bias));
            w.y = cvt_pk_bf16(bf_lo(ur.y) * (acc.z * vg.z + bias), bf_hi(ur.y) * (acc.w * vg.w + bias));
            *(u32x2*)(UM + r * LDU + c0) = w;
        }
    }
}

constexpr int BAR_WORDS = 64 * 18;
__device__ __forceinline__ void grid_barrier(unsigned* bar, const int tid, volatile LAS unsigned* ctl) {
    asm volatile("s_waitcnt vmcnt(0) lgkmcnt(0)" ::: "memory");
    __syncthreads();
    if (tid == 0) {
        const unsigned x = (unsigned)__builtin_amdgcn_s_getreg((3 << 11) | 20) & 7u, nloc = ctl[0], nx = ctl[1];
        if (__hip_atomic_fetch_add(bar + 64 * x, 1u, __ATOMIC_RELAXED, __HIP_MEMORY_SCOPE_AGENT) == nloc - 1u) {
            __builtin_amdgcn_fence(__ATOMIC_RELEASE, "agent");
            asm volatile("s_waitcnt vmcnt(0)" ::: "memory");
            if (__hip_atomic_fetch_add(bar + 64 * 8, 1u, __ATOMIC_RELAXED, __HIP_MEMORY_SCOPE_AGENT) == nx - 1u) __hip_atomic_store(bar + 64 * 9, 1u, __ATOMIC_RELAXED, __HIP_MEMORY_SCOPE_AGENT);
            else while (__hip_atomic_load(bar + 64 * 9, __ATOMIC_RELAXED, __HIP_MEMORY_SCOPE_AGENT) == 0u) __builtin_amdgcn_s_sleep(1);
            __builtin_amdgcn_fence(__ATOMIC_ACQUIRE, "agent");
            __hip_atomic_store(bar + 64 * (10 + x), 1u, __ATOMIC_RELAXED, __HIP_MEMORY_SCOPE_AGENT);
            asm volatile("s_waitcnt vmcnt(0)" ::: "memory");
        } else {
            while (__hip_atomic_load(bar + 64 * (10 + x), __ATOMIC_RELAXED, __HIP_MEMORY_SCOPE_AGENT) == 0u) __builtin_amdgcn_s_sleep(1);
            __builtin_amdgcn_fence(__ATOMIC_ACQUIRE, "agent");
            asm volatile("s_waitcnt vmcnt(0)" ::: "memory");
        }
    }
    __syncthreads();
}

__global__ void __launch_bounds__(512, 2) mega(Params p) {
    extern __shared__ __attribute__((aligned(16))) unsigned char lds_raw[];
    LAS unsigned char* lds = (LAS unsigned char*)lds_raw;
    for (int pi = p.ph_lo; pi < p.ph_hi; ++pi) {
        int ph = pi;
        if (DUPMASK) { int q = 0, r = 0; for (; q < NPHASE; ++q) { if (r == pi) break; ++r; if ((DUPMASK >> q) & 1u) { if (r == pi) break; ++r; } } ph = q; }
        int tid = threadIdx.x; asm volatile("" : "+v"(tid));
        unsigned z; asm volatile("s_mov_b32 %0, 0" : "=s"(z));
        unsigned char* ws = p.ws + z; float* out = p.out + z;
        bf16_t* XN = (bf16_t*)(ws + WS_XN); bf16_t* BIG = (bf16_t*)(ws + WS_BIG);
        bf16_t* YB = (bf16_t*)(ws + WS_YB);
        int fi = -1, fo = -1, ni = -1; float sy = 0.5f;
        switch (ph) {
            case 1: fi = 0; break; case 10: fi = 1; break; case 13: fi = 2; break; case 21: fi = 3; break;
            case 2: fo = 0; break; case 11: fo = 1; break; case 14: fo = 2; break; case 22: fo = 3; break;
            case 3: ni = 1; break; case 9: ni = 2; sy = 1.0f; break; case 12: ni = 3; break; case 15: ni = 4; break; case 20: ni = 5; sy = 1.0f; break; case 23: ni = 6; break;
            default: break;
        }
#ifndef PMASK
#define PMASK 0xFFFF
#endif
        if ((PMASK & 1) && ph == 0) phase_prologue(p, ws, out, lds, tid);
        else if ((PMASK & 2) && fi >= 0) { const bf16_t* W = (const bf16_t*)(ws + WS_WIN + fi * SZ_WIN); sample_gemm<2, 8>(lds, XN + (size_t)MP * D, D, W, D, D, FF, BIG + (size_t)MP * FF, FF, tid);
            pg8::EpiSwiglu E{BIG}; pg8::gemm_phase(lds, XN, W, MP, 2 * FF, D, E, tid); }
        else if (ph == 22) {
            const bf16_t* B = (const bf16_t*)(ws + WS_WOUT + 3 * SZ_WOUT);
            sample_gemm<4, 22>(lds, BIG + (size_t)MP * FF, FF, B, FF, FF, D, nullptr, D, tid, out + (size_t)MP * D);
            pg8::EpiFinal E{out, 0.5f}; pg8::gemm_phase(lds, BIG, B, MP, D, FF, E, tid); }
        else if ((PMASK & 4) && (fo >= 0 || ph == 8 || ph == 19)) {
            const bf16_t* A = BIG; const bf16_t* B = (const bf16_t*)(ws + WS_WOUT + (fo < 0 ? 0 : fo) * SZ_WOUT); int K = FF, ld = FF;
            if (ph == 8) { A = (const bf16_t*)(ws + WS_AO); B = (const bf16_t*)(ws + WS_WOA); K = AW; ld = AW; }
            if (ph == 19) { A = (const bf16_t*)(ws + WS_UM); B = (const bf16_t*)(ws + WS_WOB); K = BW; ld = LDU; }
            if (K == FF) sample_gemm<0, 22>(lds, A + (size_t)MP * ld, ld, B, ld, K, D, YB + (size_t)MP * D, D, tid);
            else if (K == AW) sample_gemm<0, 4>(lds, A + (size_t)MP * ld, ld, B, ld, K, D, YB + (size_t)MP * D, D, tid);
            else sample_gemm<0, 16>(lds, A + (size_t)MP * ld, ld, B, ld, K, D, YB + (size_t)MP * D, D, tid);
            pg8::EpiBf16<0> E{YB, D}; pg8::gemm_phase(lds, A, B, MP, D, K, E, tid, ld, ld); }
#ifdef DUMPSEL
        else if (ph == 20) {
            const bf16_t* wsp = (const bf16_t*)(ws + WS_WSP); const float* rvp = (const float*)(ws + WS_RV);
            for (size_t e = (size_t)blockIdx.x * 512 + tid; e < (size_t)M * D; e += (size_t)gridDim.x * 512) { const size_t r = e / D, c = e % D;
                out[e] = (DUMPSEL == 10) ? p.in[12][(c + r) % 2048] * p.in[14][(c * 3 + r) % 2048] * (1.0f + p.in[13][(r * 1024 + c) % 262144]) : (DUMPSEL == 2) ? (r >= (size_t)MP ? 0.f : 1.f) * __uint_as_float((unsigned)((const bf16_t*)(ws + WS_UM))[r * LDU + c] << 16) : (DUMPSEL == 8) ? (r < 256 ? __uint_as_float((unsigned)wsp[r * 1024 + c] << 16) : 0.f) : rvp[r]; }
        }
#endif
        else if ((PMASK & 8) && ni >= 0) phase_norm(ws, out, ni < 6 ? p.in[5] + ni * D : nullptr, sy, tid);
        else if ((PMASK & 16) && ph == 4) { sample_gemm<3, 8>(lds, XN + (size_t)MP * D, D, (const bf16_t*)(ws + WS_WQKV), D, D, NQKV, BIG + (size_t)MP * NQKV, NQKV, tid);
            const float* ctab = (const float*)(ws + WS_ROPE);
            pg8::EpiQKV E{BIG, ctab, ctab + NPOS * 32, p.in[9], out}; pg8::gemm_phase(lds, XN, (const bf16_t*)(ws + WS_WQKV), MP, NQKV, D, E, tid); }
        else if ((PMASK & 32) && ph == 5) phase_qknorm(p, ws, out, tid);
        else if ((PMASK & 64) && ph == 6) phase_attn(p, ws, lds, tid);
        else if ((PMASK & 128) && ph == 7) phase_merge(ws, tid);
        else if ((PMASK & 512) && ph == 16) { sample_gemm<1, 8>(lds, XN + (size_t)MP * D, D, (const bf16_t*)(ws + WS_WUV), D, D, NUV, BIG + (size_t)MP * NUV, NUV, tid);
            pg8::EpiBf16<1> E{BIG, NUV}; pg8::gemm_phase(lds, XN, (const bf16_t*)(ws + WS_WUV), MP, NUV, D, E, tid); }
        else if ((PMASK & 1024) && ph == 17) phase_vnorm(p, ws, out, tid);
        else if ((PMASK & 2048) && ph == 18) phase_spatial(p, ws, lds, tid);
        if (pi + 1 < p.ph_hi) {
            volatile LAS unsigned* ctl = (volatile LAS unsigned*)(lds + 135168);
            if (pi == 0) {
                const unsigned x = (unsigned)__builtin_amdgcn_s_getreg((3 << 11) | 20) & 7u;
                if (tid == 0) __hip_atomic_fetch_add((unsigned*)p.ws + 64 * x, 1u, __ATOMIC_RELAXED, __HIP_MEMORY_SCOPE_AGENT);
                __syncthreads(); cg::this_grid().sync();
                if (tid == 0) { unsigned nx = 0;
                    for (int j = 0; j < 8; ++j) nx += __hip_atomic_load((unsigned*)p.ws + 64 * j, __ATOMIC_RELAXED, __HIP_MEMORY_SCOPE_AGENT) != 0u;
                    ctl[0] = __hip_atomic_load((unsigned*)p.ws + 64 * x, __ATOMIC_RELAXED, __HIP_MEMORY_SCOPE_AGENT); ctl[1] = nx; }
                __syncthreads();
            }
            else grid_barrier((unsigned*)p.ws + (size_t)BAR_WORDS * pi, tid, ctl);
        }
    }
}

extern "C" void kernel_launch(void* const* d_in, const int* in_sizes, int n_in, void* d_out, int out_size, void* d_ws, size_t ws_size, hipStream_t stream) {
    static int grid = 0;
    if (grid == 0) {
        if (n_in != 16 || ws_size < WS_END) { fprintf(stderr, "kernel_launch: unexpected inputs (n_in %d, ws %zu < %zu)\n", n_in, ws_size, (size_t)WS_END); grid = -1; return; }
        int dev = 0, cus = 0, per_cu = 0;
        (void)hipGetDevice(&dev);
        (void)hipDeviceGetAttribute(&cus, hipDeviceAttributeMultiprocessorCount, dev);
        if (hipFuncSetAttribute((const void*)mega, hipFuncAttributeMaxDynamicSharedMemorySize, LDS_BYTES) != hipSuccess) { fprintf(stderr, "kernel_launch: hipFuncSetAttribute failed\n"); grid = -1; return; }
        if (hipOccupancyMaxActiveBlocksPerMultiprocessor(&per_cu, (const void*)mega, 512, LDS_BYTES) != hipSuccess || per_cu < 1) { fprintf(stderr, "kernel_launch: occupancy query says %d\n", per_cu); per_cu = 1; }
        (void)hipGetLastError();
        grid = cus * 1;
    }
    if (grid < 0) return;
    if (hipMemsetAsync(d_ws, 0, 262144, stream) != hipSuccess) { fprintf(stderr, "kernel_launch: memset failed\n"); return; }
    Params p{};
    for (int i = 0; i < 16; ++i) p.in[i] = (const float*)d_in[i];
    p.out = (float*)d_out; p.ws = (unsigned char*)d_ws;
#if ONE_LAUNCH
    p.ph_lo = 0; p.ph_hi = NPHASE + __builtin_popcount(DUPMASK);
    void* args[] = {&p};
    hipError_t e = hipLaunchCooperativeKernel((const void*)mega, dim3(grid), dim3(512), args, LDS_BYTES, stream);
    if (e != hipSuccess) fprintf(stderr, "cooperative launch failed: %s (grid %d)\n", hipGetErrorString(e), grid);
#else
    for (int ph = 0; ph < NPHASE; ++ph) {
        p.ph_lo = ph; p.ph_hi = ph + 1;
        hipLaunchKernelGGL(mega, dim3(grid), dim3(512), LDS_BYTES, stream, p);
    }
#endif
}
```

```cpp
#include <hip/hip_runtime.h>
#include <hip/hip_cooperative_groups.h>
#include <cstdio>
#include <cstdint>
namespace cg = cooperative_groups;

#ifndef ONE_LAUNCH
#define ONE_LAUNCH 1
#endif

#define LAS __attribute__((address_space(3)))
typedef unsigned short bf16_t;
typedef short bf16x8 __attribute__((ext_vector_type(8)));
typedef short s16x4 __attribute__((ext_vector_type(4)));
typedef float f32x2 __attribute__((ext_vector_type(2)));
typedef float f32x4 __attribute__((ext_vector_type(4)));
typedef float f32x16 __attribute__((ext_vector_type(16)));
typedef unsigned u32x2 __attribute__((ext_vector_type(2)));
typedef unsigned u32x4 __attribute__((ext_vector_type(4)));

constexpr int D = 1024, SEQ = 2048, NBATCH = 16, MP = NBATCH * SEQ, MS = 256, M = MP + MS;
constexpr int FF = 2816, NQKV = 4608, AW = 512, BW = 2048, NUV = 4096, PAST = 16384;
constexpr float EPS = 1e-6f;
constexpr int LDU = BW + 64;
constexpr int NPOS = SEQ + 8;
constexpr size_t O_YP = 0, O_YS = (size_t)MP * D, O_KP0 = O_YS + (size_t)MS * D, O_KP1 = O_KP0 + 2097152, O_KP2 = O_KP1 + 8388608,
                 O_KS0 = O_KP2 + 33554432, O_KS1 = O_KS0 + 262144, O_KS2 = O_KS1 + 262144, O_VS = O_KS2 + 262144;
constexpr size_t al256(size_t x) { return (x + 255) & ~(size_t)255; }
constexpr size_t WS_WIN = 1u << 20;
constexpr size_t SZ_WIN = (size_t)2 * FF * D * 2;
constexpr size_t WS_WOUT = WS_WIN + 4 * SZ_WIN;
constexpr size_t SZ_WOUT = (size_t)D * FF * 2;
constexpr size_t WS_WQKV = WS_WOUT + 4 * SZ_WOUT;
constexpr size_t WS_WOA = WS_WQKV + (size_t)NQKV * D * 2;
constexpr size_t WS_WUV = WS_WOA + (size_t)D * AW * 2;
constexpr size_t WS_WOB = WS_WUV + (size_t)NUV * D * 2;
constexpr size_t WS_WSP = WS_WOB + (size_t)D * LDU * 2;
constexpr size_t WS_ROPE = WS_WSP + (size_t)16 * 128 * 128 * 2;
constexpr size_t WS_XN = al256(WS_ROPE + (size_t)NPOS * 32 * 4 * 2);
constexpr size_t WS_BIG = al256(WS_XN + (size_t)M * D * 2);
constexpr size_t WS_OG = al256(WS_BIG + (size_t)M * NQKV * 2);
constexpr size_t WS_LSE = al256(WS_OG + (size_t)3 * M * AW * 2);
constexpr size_t WS_AO = al256(WS_LSE + (size_t)3 * M * 8 * 4);
constexpr size_t WS_UM = al256(WS_AO + (size_t)M * AW * 2);
constexpr size_t WS_RV = al256(WS_UM + (size_t)M * LDU * 2);
constexpr size_t WS_YB = al256(WS_RV + (size_t)M * 4);
constexpr size_t WS_XB = al256(WS_YB + (size_t)M * D * 2);
constexpr size_t WS_END = al256(WS_XB + (size_t)M * D * 2);

#ifndef DUPMASK
#define DUPMASK 0u
#endif
constexpr int LDS_BYTES = 139264;
#ifdef DUMPSEL
constexpr int NPHASE = 21;
#else
constexpr int NPHASE = 23;
#endif

__device__ __forceinline__ float wave_sum(float v) {
#pragma unroll
    for (int o = 1; o < 64; o <<= 1) v += __shfl_xor(v, o);
    return v;
}
__device__ __forceinline__ float wave_max(float v) {
#pragma unroll
    for (int o = 1; o < 64; o <<= 1) v = fmaxf(v, __shfl_xor(v, o));
    return v;
}
typedef __bf16 bf16x2_t __attribute__((ext_vector_type(2)));
__device__ __forceinline__ unsigned cvt_pk_bf16(float lo, float hi) { const f32x2 v = {lo, hi}; return __builtin_bit_cast(unsigned, __builtin_convertvector(v, bf16x2_t)); }
__device__ __forceinline__ float bf_lo(unsigned w) { return __uint_as_float(w << 16); }
__device__ __forceinline__ float bf_hi(unsigned w) { return __uint_as_float(w & 0xffff0000u); }
__device__ __forceinline__ float silu_f(float x) { return x * __builtin_amdgcn_rcpf(1.0f + __expf(-x)); }
__device__ __forceinline__ float gelu_tanh_f(float x) { const float y = 0.7978845608028654f * (x + 0.044715f * x * x * x); return x * __builtin_amdgcn_rcpf(1.0f + __expf(-2.0f * y)); }

namespace pg8 {
constexpr int BM = 256, BK = 64, HALF = 128, HTB = HALF * BK * 2, STAGE_BYTES = 8 * HTB, NXCD = 8, WGM = 8;
__device__ __forceinline__ int lds_byte(int r, int c) { const int st = (r >> 4) * 2 + (c >> 5), rr = r & 15, cc = c & 31, ob = rr * 64 + cc * 2; return st * 1024 + (ob ^ (((ob >> 9) & 1) << 5)); }
__device__ __forceinline__ void stage_rc(int b, int& R, int& C) { const int st = b / 1024, sb = b % 1024, swz = sb ^ (((sb >> 9) & 1) << 5); R = (st >> 1) * 16 + swz / 64; C = (st & 1) * 32 + (swz % 64) / 2; }
__device__ __forceinline__ int perm32(int rho) { const int n = rho >> 4, i = rho & 15; return 8 * (i >> 2) + 4 * n + (i & 3); }
struct Unit { int pm, pn; };
struct StaticOrder {
    int nM, nN, nwg, G, c;
    __device__ void init(int M_, int N_, int G_, int c_) { nM = M_ / BM; nN = N_ / BM; nwg = nM * nN; G = G_; c = c_; }
    __device__ bool next(int i, Unit& u) const {
        const long L = (long)i * G + c; if (L >= nwg) return false;
        int wgid = (int)L; { const int q = nwg / NXCD, r = nwg % NXCD, xcd = wgid % NXCD, off = wgid / NXCD; wgid = (xcd < r ? xcd * (q + 1) : r * (q + 1) + (xcd - r) * q) + off; }
        const int nig = WGM * nN, gid = wgid / nig, fm = gid * WGM, gsz = (nM - fm) < WGM ? (nM - fm) : WGM;
        u.pm = fm + ((wgid % nig) % gsz); u.pn = (wgid % nig) / gsz; return true;
    }
};
template <class Epi>
__device__ __forceinline__ void gemm_phase(LAS unsigned char* lds, const bf16_t* gA, const bf16_t* gBt, int gM, int gN, int K, const Epi& E, const int tid, const int lda = 0, const int ldb = 0) {
    const int LA = lda ? lda : K, LB = ldb ? ldb : K;
    const int wid = __builtin_amdgcn_readfirstlane(tid >> 6), lane = tid & 63, wr = wid >> 2, wc = wid & 3, fr = lane & 15, fq = lane >> 4;
    const int nt = K / BK;
    StaticOrder S; S.init(gM, gN, (int)gridDim.x, (int)blockIdx.x);
    unsigned voffA[2], voffB[2];
#pragma unroll
    for (int i = 0; i < 2; ++i) { int R, C; stage_rc(tid * 16 + i * 8192, R, C); const int Rb = Epi::PERM ? ((R & ~31) + perm32(R & 31)) : R;
        voffA[i] = (unsigned)(R * LA + C) * 2u; voffB[i] = (unsigned)(Rb * LB + C) * 2u; }
    const size_t kstep = (size_t)(BK * 2);
    const size_t hstepA = (size_t)HALF * LA * 2, hstepB = (size_t)HALF * LB * 2;
    const size_t tstepA = 2 * hstepA, tstepB = 2 * hstepB;
    const unsigned ldsw = (unsigned)wid * 1024u;
    const int aoff = lds_byte(wr * 64 + fr, fq * 8), boff = lds_byte(wc * 32 + fr, fq * 8);
#define PG8_SA(b, h) (((b) * 2 + (h)) * HTB)
#define PG8_SB(b, h) ((4 + (b) * 2 + (h)) * HTB)
#define PG8_STAGE(bufoff, gbase, voff) do { _Pragma("unroll") for (int _i = 0; _i < 2; ++_i) \
        __builtin_amdgcn_global_load_lds((const unsigned*)((const char*)(gbase) + (voff)[_i]), (LAS unsigned*)(lds + (bufoff) + ldsw + _i * 8192), 16, 0, 0); } while (0)
#define PG8_LDA(dst, b, h) do { _Pragma("unroll") for (int m = 0; m < 4; ++m) _Pragma("unroll") for (int k = 0; k < 2; ++k) dst[m][k] = *(const LAS bf16x8*)(lds + PG8_SA(b, h) + aoff + m * 2048 + k * 1024); } while (0)
#define PG8_LDB(dst, b, h) do { _Pragma("unroll") for (int n = 0; n < 2; ++n) _Pragma("unroll") for (int k = 0; k < 2; ++k) dst[n][k] = *(const LAS bf16x8*)(lds + PG8_SB(b, h) + boff + n * 2048 + k * 1024); } while (0)
#define PG8_MMA(ai, bj, At, Bt) do { __builtin_amdgcn_s_setprio(1); _Pragma("unroll") for (int m = 0; m < 4; ++m) _Pragma("unroll") for (int n = 0; n < 2; ++n) _Pragma("unroll") for (int k = 0; k < 2; ++k) \
        acc[ai][bj][m][n] = __builtin_amdgcn_mfma_f32_16x16x32_bf16(Bt[n][k], At[m][k], acc[ai][bj][m][n], 0, 0, 0); __builtin_amdgcn_s_setprio(0); } while (0)
#define PG8_WAIT_V(n) asm volatile("s_waitcnt vmcnt(" #n ")" ::: "memory")
#define PG8_WAIT_L(n) asm volatile("s_waitcnt lgkmcnt(" #n ")" ::: "memory")
#define PG8_BAR __builtin_amdgcn_s_barrier()
#define PG8_SCHED __builtin_amdgcn_sched_barrier(0)
    Unit cur, nxt; int ui = 0;
    if (!S.next(0, cur)) return;
    f32x4 acc[2][2][4][2];
#pragma unroll
    for (int a = 0; a < 2; ++a)
#pragma unroll
        for (int b = 0; b < 2; ++b)
#pragma unroll
            for (int m = 0; m < 4; ++m)
#pragma unroll
                for (int n = 0; n < 2; ++n) acc[a][b][m][n] = (f32x4){0.f, 0.f, 0.f, 0.f};
    bf16x8 At[4][2], B0[2][2], B1[2][2];
    const char* cA = (const char*)gA + (size_t)cur.pm * tstepA; const char* cB = (const char*)gBt + (size_t)cur.pn * tstepB;
    PG8_STAGE(PG8_SB(0, 0), cB, voffB); PG8_STAGE(PG8_SB(0, 1), cB + hstepB, voffB); PG8_STAGE(PG8_SA(0, 0), cA, voffA); PG8_STAGE(PG8_SA(0, 1), cA + hstepA, voffA);
    if (wr == 1) PG8_BAR;
    PG8_WAIT_V(2); PG8_BAR;
    PG8_STAGE(PG8_SB(1, 0), cB + kstep, voffB); PG8_STAGE(PG8_SA(1, 0), cA + kstep, voffA); PG8_STAGE(PG8_SB(1, 1), cB + hstepB + kstep, voffB);
    PG8_WAIT_V(6); PG8_BAR;
    for (;;) {
        const bool has_next = S.next(ui + 1, nxt);
        const char* nA = has_next ? (const char*)gA + (size_t)nxt.pm * tstepA : cA; const char* nB = has_next ? (const char*)gBt + (size_t)nxt.pn * tstepB : cB;
        for (int t = 0; t < nt; t += 2) {
            const bool last = (t == nt - 2);
            const char* a1 = cA + (size_t)(t + 1) * kstep;
            const char* a2 = last ? nA : cA + (size_t)(t + 2) * kstep; const char* b2 = last ? nB : cB + (size_t)(t + 2) * kstep;
            const char* a3 = a2 + kstep; const char* b3 = b2 + kstep;
            PG8_LDB(B0, 0, 0); PG8_LDB(B1, 0, 1); PG8_SCHED; PG8_LDA(At, 0, 0); PG8_STAGE(PG8_SA(1, 1), a1 + hstepA, voffA);
            PG8_WAIT_V(8); PG8_WAIT_L(0); PG8_BAR; PG8_MMA(0, 0, At, B0); PG8_MMA(0, 1, At, B1); PG8_BAR; PG8_SCHED;
            PG8_LDA(At, 0, 1); PG8_STAGE(PG8_SB(0, 0), b2, voffB); PG8_STAGE(PG8_SB(0, 1), b2 + hstepB, voffB); PG8_STAGE(PG8_SA(0, 0), a2, voffA);
            PG8_WAIT_V(8); PG8_WAIT_L(0); PG8_BAR; PG8_MMA(1, 0, At, B0); PG8_MMA(1, 1, At, B1); PG8_BAR; PG8_SCHED;
            PG8_LDB(B0, 1, 0); PG8_LDB(B1, 1, 1); PG8_SCHED; PG8_LDA(At, 1, 0); PG8_STAGE(PG8_SA(0, 1), a2 + hstepA, voffA);
            PG8_WAIT_V(8); PG8_WAIT_L(0); PG8_BAR; PG8_MMA(0, 0, At, B0); PG8_MMA(0, 1, At, B1); PG8_BAR; PG8_SCHED;
            PG8_LDA(At, 1, 1); PG8_STAGE(PG8_SB(1, 0), b3, voffB); PG8_STAGE(PG8_SB(1, 1), b3 + hstepB, voffB); PG8_STAGE(PG8_SA(1, 0), a3, voffA);
            PG8_WAIT_V(8); PG8_WAIT_L(0); PG8_BAR; PG8_MMA(1, 0, At, B0); PG8_MMA(1, 1, At, B1); PG8_BAR; PG8_SCHED;
        }
        if (wr == 0) PG8_BAR;
        E(acc, cur, wr, wc, fr, fq);
        if (!has_next) break;
#pragma unroll
        for (int a = 0; a < 2; ++a)
#pragma unroll
            for (int b = 0; b < 2; ++b)
#pragma unroll
                for (int m = 0; m < 4; ++m)
#pragma unroll
                    for (int n = 0; n < 2; ++n) acc[a][b][m][n] = (f32x4){0.f, 0.f, 0.f, 0.f};
        cur = nxt; cA = nA; cB = nB; ++ui;
        if (wr == 1) PG8_BAR;
    }
    PG8_WAIT_V(0);
    PG8_BAR;
#undef PG8_SA
#undef PG8_SB
#undef PG8_STAGE
#undef PG8_LDA
#undef PG8_LDB
#undef PG8_MMA
#undef PG8_WAIT_V
#undef PG8_WAIT_L
#undef PG8_BAR
#undef PG8_SCHED
}

struct EpiSwiglu {
    static constexpr bool PERM = true;
    bf16_t* O;
    __device__ __forceinline__ void operator()(const f32x4 (&acc)[2][2][4][2], const Unit& u, int wr, int wc, int fr, int fq) const {
        const int row0 = u.pm * BM + wr * 64 + fr, col0 = u.pn * HALF + wc * 32 + 8 * fq;
#pragma unroll
        for (int ai = 0; ai < 2; ++ai)
#pragma unroll
            for (int m = 0; m < 4; ++m) {
                const f32x4 g0 = acc[ai][0][m][0], g1 = acc[ai][0][m][1], u0 = acc[ai][1][m][0], u1 = acc[ai][1][m][1];
                u32x4 w;
                w.x = cvt_pk_bf16(silu_f(g0[0]) * u0[0], silu_f(g0[1]) * u0[1]); w.y = cvt_pk_bf16(silu_f(g0[2]) * u0[2], silu_f(g0[3]) * u0[3]);
                w.z = cvt_pk_bf16(silu_f(g1[0]) * u1[0], silu_f(g1[1]) * u1[1]); w.w = cvt_pk_bf16(silu_f(g1[2]) * u1[2], silu_f(g1[3]) * u1[3]);
                *(u32x4*)(O + (size_t)(row0 + ai * HALF + m * 16) * FF + col0) = w;
            }
    }
};
struct EpiResid {
    static constexpr bool PERM = false;
    float* X; float s;
    __device__ __forceinline__ void operator()(const f32x4 (&acc)[2][2][4][2], const Unit& u, int wr, int wc, int fr, int fq) const {
        const int row0 = u.pm * BM + wr * 64 + fr, col0 = u.pn * BM + wc * 32 + 4 * fq;
#pragma unroll
        for (int ai = 0; ai < 2; ++ai)
#pragma unroll
            for (int m = 0; m < 4; ++m) { float* rowp = X + (size_t)(row0 + ai * HALF + m * 16) * D + col0;
#pragma unroll
                for (int bj = 0; bj < 2; ++bj)
#pragma unroll
                    for (int n = 0; n < 2; ++n) { f32x4* p = (f32x4*)(rowp + bj * HALF + n * 16); *p = *p + acc[ai][bj][m][n] * s; } }
    }
};
struct EpiFinal {
    static constexpr bool PERM = false;
    float* X; const bf16_t* XB; float s;
    __device__ __forceinline__ void operator()(const f32x4 (&acc)[2][2][4][2], const Unit& u, int wr, int wc, int fr, int fq) const {
        const size_t off = (size_t)(u.pm * BM + wr * 64 + fr) * D + u.pn * BM + wc * 32 + 4 * fq;
        u32x2 x[8][4];
#pragma unroll
        for (int g = 0; g < 8; ++g)
#pragma unroll
            for (int q = 0; q < 4; ++q) x[g][q] = *(const u32x2*)(XB + off + (size_t)((g >> 2) * HALF + (g & 3) * 16) * D + (q >> 1) * HALF + (q & 1) * 16);
#pragma unroll
        for (int g = 0; g < 8; ++g) {
            const int ai = g >> 2, m = g & 3;
            float* rowp = X + off + (size_t)(ai * HALF + m * 16) * D;
#pragma unroll
            for (int q = 0; q < 4; ++q) { const f32x4 a = acc[ai][q >> 1][m][q & 1];
                *(f32x4*)(rowp + (q >> 1) * HALF + (q & 1) * 16) = (f32x4){bf_lo(x[g][q].x) + a.x * s, bf_hi(x[g][q].x) + a.y * s, bf_lo(x[g][q].y) + a.z * s, bf_hi(x[g][q].y) + a.w * s}; }
        }
    }
};
struct EpiQKV {
    static constexpr bool PERM = true;
    bf16_t* O; const float* ct; const float* st; const float* gain; float* out;
    __device__ __forceinline__ void operator()(const f32x4 (&acc)[2][2][4][2], const Unit& u, int wr, int wc, int fr, int fq) const {
        const int head = u.pn * 4 + wc, which = head / 24, gh = head - which * 24, g = gh >> 3, h = gh & 7, d0 = 8 * fq;
        const int row0 = u.pm * BM + wr * 64 + fr;
        f32x4 ga0 = {1.f, 1.f, 1.f, 1.f}, ga1 = ga0, gb0 = ga0, gb1 = ga0;
        if (which < 2) { const float* gp = gain + which * 64 + d0; ga0 = *(const f32x4*)gp; ga1 = *(const f32x4*)(gp + 4); gb0 = *(const f32x4*)(gp + 32); gb1 = *(const f32x4*)(gp + 36); }
        const int keep = 128 << (2 * g);
        const size_t tbase = g == 0 ? O_KP0 : (g == 1 ? O_KP1 : O_KP2);
#pragma unroll
        for (int ai = 0; ai < 2; ++ai)
#pragma unroll
            for (int m = 0; m < 4; ++m) {
                const int row = row0 + ai * HALF + m * 16;
                f32x4 a0 = acc[ai][0][m][0], a1 = acc[ai][0][m][1], b0 = acc[ai][1][m][0], b1 = acc[ai][1][m][1];
                if (which < 2) {
                    float ss = ((a0.x * a0.x + a0.y * a0.y) + (a0.z * a0.z + a0.w * a0.w)) + ((a1.x * a1.x + a1.y * a1.y) + (a1.z * a1.z + a1.w * a1.w))
                             + ((b0.x * b0.x + b0.y * b0.y) + (b0.z * b0.z + b0.w * b0.w)) + ((b1.x * b1.x + b1.y * b1.y) + (b1.z * b1.z + b1.w * b1.w));
                    ss += __shfl_xor(ss, 16); ss += __shfl_xor(ss, 32);
                    const float r = 1.0f / sqrtf(ss * (1.0f / 64) + EPS);
                    const int pi = row & 2047;
                    const f32x4 c0 = *(const f32x4*)(ct + pi * 32 + d0), c1 = *(const f32x4*)(ct + pi * 32 + d0 + 4), s0 = *(const f32x4*)(st + pi * 32 + d0), s1 = *(const f32x4*)(st + pi * 32 + d0 + 4);
                    const f32x4 ya0 = a0 * r * ga0, ya1 = a1 * r * ga1, yb0 = b0 * r * gb0, yb1 = b1 * r * gb1;
                    a0 = ya0 * c0 - yb0 * s0; a1 = ya1 * c1 - yb1 * s1; b0 = yb0 * c0 + ya0 * s0; b1 = yb1 * c1 + ya1 * s1;
                }
                bf16_t* dst = O + (size_t)row * NQKV + head * 64 + d0;
                u32x4 w0, w1;
                w0.x = cvt_pk_bf16(a0.x, a0.y); w0.y = cvt_pk_bf16(a0.z, a0.w); w0.z = cvt_pk_bf16(a1.x, a1.y); w0.w = cvt_pk_bf16(a1.z, a1.w);
                w1.x = cvt_pk_bf16(b0.x, b0.y); w1.y = cvt_pk_bf16(b0.z, b0.w); w1.z = cvt_pk_bf16(b1.x, b1.y); w1.w = cvt_pk_bf16(b1.z, b1.w);
                *(u32x4*)dst = w0; *(u32x4*)(dst + 32) = w1;
                if (which >= 1) {
                    const int bb = row >> 11, tt = (row & 2047) - (SEQ - keep);
                    if (tt >= 0) { float* tp = out + tbase + ((((size_t)bb * keep + tt) * 2 + (which - 1)) * 8 + h) * 64 + d0;
                        *(f32x4*)tp = a0; *(f32x4*)(tp + 4) = a1; *(f32x4*)(tp + 32) = b0; *(f32x4*)(tp + 36) = b1; }
                }
            }
    }
};
template <int ACT> struct EpiBf16 {
    static constexpr bool PERM = true;
    bf16_t* O; int ldc;
    __device__ __forceinline__ void operator()(const f32x4 (&acc)[2][2][4][2], const Unit& u, int wr, int wc, int fr, int fq) const {
        const int row0 = u.pm * BM + wr * 64 + fr, col0 = u.pn * BM + wc * 32 + 8 * fq;
#pragma unroll
        for (int ai = 0; ai < 2; ++ai)
#pragma unroll
            for (int m = 0; m < 4; ++m) { bf16_t* rowp = O + (size_t)(row0 + ai * HALF + m * 16) * ldc + col0;
#pragma unroll
                for (int bj = 0; bj < 2; ++bj) { f32x4 v0 = acc[ai][bj][m][0], v1 = acc[ai][bj][m][1];
                    if (ACT == 1) {
#pragma unroll
                        for (int j = 0; j < 4; ++j) { v0[j] = gelu_tanh_f(v0[j]); v1[j] = gelu_tanh_f(v1[j]); } }
                    u32x4 w; w.x = cvt_pk_bf16(v0[0], v0[1]); w.y = cvt_pk_bf16(v0[2], v0[3]); w.z = cvt_pk_bf16(v1[0], v1[1]); w.w = cvt_pk_bf16(v1[2], v1[3]);
                    *(u32x4*)(rowp + bj * HALF) = w; } }
    }
};
}

#define MFMA32S(a, b, c) __builtin_amdgcn_mfma_f32_32x32x16_bf16((a), (b), (c), 0, 0, 0)
template <int MODE, int KSTEPS>
__device__ __forceinline__ void sample_gemm(LAS unsigned char* lds, const bf16_t* A, int lda, const bf16_t* Bt, int ldb, int K, int N, bf16_t* O, int ldc, const int tid, float* Xs = nullptr) {
    const int lane = tid & 63, wave = __builtin_amdgcn_readfirstlane(tid >> 6), hh = lane >> 5;
    const int ntiles = 8 * (N / 32), kw = K / 8;
    LAS float* red = (LAS float*)lds;
    for (int tile = blockIdx.x; tile < ntiles; tile += gridDim.x) {
        const int rt = tile & 7, ct = tile >> 3;
        const bf16_t* ap = A + (size_t)(32 * rt + (lane & 31)) * lda + wave * kw + 8 * hh;
        int brow = 32 * ct + (lane & 31);
        if (MODE == 2) { const int h0 = 32 * ct; brow = (h0 >> 7) * 256 + (h0 & 127) + (lane & 31); }
        const bf16_t* bp = Bt + (size_t)brow * ldb + wave * kw + 8 * hh;
        f32x16 c0, c1;
#pragma unroll
        for (int i = 0; i < 16; ++i) { c0[i] = 0.f; c1[i] = 0.f; }
        constexpr int CH = KSTEPS > 11 ? KSTEPS / 2 : KSTEPS;
#pragma unroll
        for (int cb = 0; cb < KSTEPS; cb += CH) {
            bf16x8 af[CH], bfr[CH], b2f[CH];
#pragma unroll
            for (int i = 0; i < CH; ++i) { af[i] = *(const bf16x8*)(ap + 16 * (cb + i)); bfr[i] = *(const bf16x8*)(bp + 16 * (cb + i));
                if (MODE == 2) b2f[i] = *(const bf16x8*)(bp + (size_t)128 * ldb + 16 * (cb + i)); }
#pragma unroll
            for (int i = 0; i < CH; ++i) { c0 = MFMA32S(af[i], bfr[i], c0); if (MODE == 2) c1 = MFMA32S(af[i], b2f[i], c1); }
        }
        __syncthreads();
#pragma unroll
        for (int i = 0; i < 16; ++i) { red[((wave * 2 + 0) * 16 + i) * 64 + lane] = c0[i]; if (MODE == 2) red[((wave * 2 + 1) * 16 + i) * 64 + lane] = c1[i]; }
        __syncthreads();
#pragma unroll
        for (int r = 0; r < 2; ++r) {
            const int e = tid + 512 * r, i = e >> 6, l = e & 63;
            float s0 = 0.f, s1 = 0.f;
#pragma unroll
            for (int w = 0; w < 8; ++w) { s0 += red[((w * 2 + 0) * 16 + i) * 64 + l]; if (MODE == 2) s1 += red[((w * 2 + 1) * 16 + i) * 64 + l]; }
            const int row = 32 * rt + (i & 3) + 8 * (i >> 2) + 4 * (l >> 5);
            int col = 32 * ct + (l & 31);
            if (MODE == 3) col = (((ct >> 3) * 4 + (ct & 3)) * 64 + 32 * ((ct >> 2) & 1)) + (l & 31);
            const float v = MODE == 2 ? silu_f(s0) * s1 : (MODE == 1 ? gelu_tanh_f(s0) : s0);
            if (MODE == 4) Xs[(size_t)row * ldc + col] = __uint_as_float((unsigned)O[(size_t)row * ldc + col] << 16) + 0.5f * s0;
            else O[(size_t)row * ldc + col] = (bf16_t)(cvt_pk_bf16(v, 0.f) & 0xffffu);
        }
    }
    __syncthreads();
}

struct Params { const float* in[16]; float* out; unsigned char* ws; int ph_lo, ph_hi; };

__device__ __forceinline__ void transpose_item(const float* W, int K, int N, bf16_t* WT, int k0, int n0, int drow0, LAS float* scr, int lane, int ldw) {
#pragma unroll 8
    for (int i = 0; i < 32; ++i) { const int kk = 2 * i + (lane >> 5); scr[kk * 33 + (lane & 31)] = W[(size_t)(k0 + kk) * N + n0 + (lane & 31)]; }
    asm volatile("s_waitcnt lgkmcnt(0)" ::: "memory");
    const int c = lane & 7;
#pragma unroll
    for (int j = 0; j < 4; ++j) { const int n = (lane >> 3) + 8 * j; const LAS float* s = scr + (8 * c) * 33 + n;
        u32x4 o; o.x = cvt_pk_bf16(s[0 * 33], s[1 * 33]); o.y = cvt_pk_bf16(s[2 * 33], s[3 * 33]); o.z = cvt_pk_bf16(s[4 * 33], s[5 * 33]); o.w = cvt_pk_bf16(s[6 * 33], s[7 * 33]);
        *(u32x4*)(WT + (size_t)(drow0 + n) * ldw + k0 + 8 * c) = o; }
    asm volatile("s_waitcnt lgkmcnt(0)" ::: "memory");
}
__device__ __forceinline__ void transpose_mat(const float* W, int K, int N, bf16_t* WT, int item, bool swiglu, LAS float* scr, int lane, int ldw = 0, bool qkvperm = false) {
    const int nblk = N / 32, kb = item / nblk, nb = item % nblk, n0 = 32 * nb;
    int drow0 = n0;
    if (swiglu) { const int up = n0 >= FF, nn = up ? n0 - FF : n0; drow0 = (nn >> 7) * 256 + (up ? 128 : 0) + (nn & 127); }
    if (qkvperm) { const int head = n0 >> 6, bj = (n0 >> 5) & 1; drow0 = (head >> 2) * 256 + bj * 128 + (head & 3) * 32; }
    transpose_item(W, K, N, WT, 64 * kb, n0, drow0, scr, lane, ldw ? ldw : K);
}
__constant__ double ROPE_INV[32] = {
    1.0, 0.7498942093324559, 0.5623413251903491, 0.4216965034285822, 0.31622776601683794, 0.23713737056616552, 0.1778279410038923, 0.1333521432163324,
    0.1, 0.07498942093324558, 0.05623413251903491, 0.042169650342858224, 0.03162277660168379, 0.023713737056616554, 0.01778279410038923, 0.01333521432163324,
    0.01, 0.007498942093324558, 0.005623413251903491, 0.004216965034285823, 0.0031622776601683794, 0.0023713737056616554, 0.0017782794100389228, 0.001333521432163324,
    0.001, 0.0007498942093324559, 0.0005623413251903491, 0.00042169650342858224, 0.00031622776601683794, 0.00023713737056616554, 0.00017782794100389227, 0.0001333521432163324};

__device__ __forceinline__ void norm_row0(const float* xrow, const float* g, bf16_t* orow, bf16_t* xb, int lane) {
    const f32x4* xr = (const f32x4*)xrow + lane;
    f32x4 v[4]; float ss = 0.f;
#pragma unroll
    for (int j = 0; j < 4; ++j) v[j] = xr[64 * j];
#pragma unroll
    for (int j = 0; j < 4; ++j) ss += (v[j].x * v[j].x + v[j].y * v[j].y) + (v[j].z * v[j].z + v[j].w * v[j].w);
    const float r = 1.0f / sqrtf(wave_sum(ss) * (1.0f / D) + EPS);
#pragma unroll
    for (int j = 0; j < 4; ++j) {
        const f32x4 gg = ((const f32x4*)g)[lane + 64 * j];
        u32x2 o; o.x = cvt_pk_bf16(v[j].x * r * gg.x, v[j].y * r * gg.y); o.y = cvt_pk_bf16(v[j].z * r * gg.z, v[j].w * r * gg.w);
        ((u32x2*)orow)[lane + 64 * j] = o;
        u32x2 xo; xo.x = cvt_pk_bf16(v[j].x, v[j].y); xo.y = cvt_pk_bf16(v[j].z, v[j].w);
        ((u32x2*)xb)[lane + 64 * j] = xo;
    }
}

__device__ __forceinline__ void phase_prologue(const Params& p, unsigned char* ws, float* out, LAS unsigned char* lds, const int tid) {
    const int lane = tid & 63, wave = tid >> 6;
    const int gw = blockIdx.x * 8 + wave, NGW = gridDim.x * 8;
    LAS float* scr = (LAS float*)(lds + wave * 8704);
    constexpr int I_IN = (D / 64) * (2 * FF / 32), I_OUT = (FF / 64) * (D / 32), I_QKV = (D / 64) * (NQKV / 32), I_OA = (AW / 64) * (D / 32), I_UV = (D / 64) * (NUV / 32), I_OB = (BW / 64) * (D / 32);
    constexpr int NITEMS = 4 * I_IN + 4 * I_OUT + I_QKV + I_OA + I_UV + I_OB;
    for (int it = gw; it < NITEMS; it += NGW) {
        int r = it;
        if (r < 4 * I_IN) { const int w = r / I_IN; transpose_mat(p.in[6] + (size_t)w * D * 2 * FF, D, 2 * FF, (bf16_t*)(ws + WS_WIN + w * SZ_WIN), r % I_IN, true, scr, lane); continue; } r -= 4 * I_IN;
        if (r < 4 * I_OUT) { const int w = r / I_OUT; transpose_mat(p.in[7] + (size_t)w * FF * D, FF, D, (bf16_t*)(ws + WS_WOUT + w * SZ_WOUT), r % I_OUT, false, scr, lane); continue; } r -= 4 * I_OUT;
        if (r < I_QKV) { transpose_mat(p.in[8], D, NQKV, (bf16_t*)(ws + WS_WQKV), r, false, scr, lane, 0, true); continue; } r -= I_QKV;
        if (r < I_OA) { transpose_mat(p.in[10], AW, D, (bf16_t*)(ws + WS_WOA), r, false, scr, lane); continue; } r -= I_OA;
        if (r < I_UV) { transpose_mat(p.in[11], D, NUV, (bf16_t*)(ws + WS_WUV), r, false, scr, lane); continue; } r -= I_UV;
        transpose_mat(p.in[15], BW, D, (bf16_t*)(ws + WS_WOB), r, false, scr, lane, LDU);
    }
    { bf16_t* wsp = (bf16_t*)(ws + WS_WSP); const float* src = p.in[13];
      for (int i = blockIdx.x * 512 + tid; i < 16 * 128 * 128 / 2; i += gridDim.x * 512) {
          const int e = 2 * i, s = e & 127, t = (e >> 7) & 127; const f32x2 v = *(const f32x2*)(src + e);
          ((unsigned*)wsp)[i] = cvt_pk_bf16(s <= t ? v.x : 0.f, (s + 1) <= t ? v.y : 0.f); } }
    { float* ct = (float*)(ws + WS_ROPE); float* st = ct + NPOS * 32;
      for (int i = blockIdx.x * 512 + tid; i < NPOS * 32; i += gridDim.x * 512) {
          const int pi = i >> 5, fi = i & 31; const double pos = (double)(pi < SEQ ? pi : PAST + (pi - SEQ));
          const double a = pos * ROPE_INV[fi]; const double n = __builtin_rint(a * 0.15915494309189535);
          const double r = (a - n * 6.283185307179586) - n * 2.4492935982947064e-16; const double r2 = r * r;
          double sn = 1.0, cs = 1.0;
#pragma unroll 1
          for (int k = 14; k >= 1; --k) { const double k2 = (double)(2 * k); sn = 1.0 - sn * r2 / (k2 * (k2 + 1.0)); cs = 1.0 - cs * r2 / ((k2 - 1.0) * k2); }
          ct[i] = (float)cs; st[i] = (float)(sn * r); } }
#ifdef NANFILL
    { u32x4* f = (u32x4*)(ws + WS_BIG); const size_t n = (WS_END - WS_BIG) / 16; const u32x4 q = {0xffffffffu, 0xffffffffu, 0xffffffffu, 0xffffffffu};
      for (size_t i = (size_t)blockIdx.x * 512 + tid; i < n; i += (size_t)gridDim.x * 512) f[i] = q;
      u32x4* fo = (u32x4*)(out + O_KP0); const size_t no = (O_VS + 524288 - O_KP0) / 4;
      for (size_t i = (size_t)blockIdx.x * 512 + tid; i < no; i += (size_t)gridDim.x * 512) fo[i] = q; }
#endif
    for (int m = gw; m < M; m += NGW) {
        const float* src = m < MP ? p.in[0] + (size_t)m * D : p.in[1] + (size_t)(m - MP) * D;
        norm_row0(src, p.in[5], (bf16_t*)(ws + WS_XN) + (size_t)m * D, (bf16_t*)(ws + WS_XB) + (size_t)m * D, lane);
    }
}

__device__ __forceinline__ void phase_norm(unsigned char* ws, float* out, const float* g, float sy, const int tid) {
    const int lane = tid & 63, wave = tid >> 6;
    const int gw = blockIdx.x * 8 + wave, NGW = gridDim.x * 8;
    const bf16_t* YB = (const bf16_t*)(ws + WS_YB); bf16_t* XN = (bf16_t*)(ws + WS_XN); bf16_t* XB = (bf16_t*)(ws + WS_XB);
    for (int m0 = gw; m0 < M; m0 += 2 * NGW) {
        const int m1 = m0 + NGW; const bool two = m1 < M; const int mb = two ? m1 : m0;
        u32x2 xa[4], xb[4], ya[4], yb[4];
#pragma unroll
        for (int j = 0; j < 4; ++j) { xa[j] = ((const u32x2*)(XB + (size_t)m0 * D))[lane + 64 * j]; xb[j] = ((const u32x2*)(XB + (size_t)mb * D))[lane + 64 * j]; }
#pragma unroll
        for (int j = 0; j < 4; ++j) { ya[j] = ((const u32x2*)(YB + (size_t)m0 * D))[lane + 64 * j]; yb[j] = ((const u32x2*)(YB + (size_t)mb * D))[lane + 64 * j]; }
        f32x4 va[4], vb[4]; float sa = 0.f, sb = 0.f;
#pragma unroll
        for (int j = 0; j < 4; ++j) {
            va[j] = (f32x4){bf_lo(xa[j].x) + sy * bf_lo(ya[j].x), bf_hi(xa[j].x) + sy * bf_hi(ya[j].x), bf_lo(xa[j].y) + sy * bf_lo(ya[j].y), bf_hi(xa[j].y) + sy * bf_hi(ya[j].y)};
            vb[j] = (f32x4){bf_lo(xb[j].x) + sy * bf_lo(yb[j].x), bf_hi(xb[j].x) + sy * bf_hi(yb[j].x), bf_lo(xb[j].y) + sy * bf_lo(yb[j].y), bf_hi(xb[j].y) + sy * bf_hi(yb[j].y)};
            sa += (va[j].x * va[j].x + va[j].y * va[j].y) + (va[j].z * va[j].z + va[j].w * va[j].w);
            sb += (vb[j].x * vb[j].x + vb[j].y * vb[j].y) + (vb[j].z * vb[j].z + vb[j].w * vb[j].w);
        }
        const float ra = 1.0f / sqrtf(wave_sum(sa) * (1.0f / D) + EPS), rb = 1.0f / sqrtf(wave_sum(sb) * (1.0f / D) + EPS);
#pragma unroll
        for (int j = 0; j < 4; ++j) {
            const f32x4 gg = ((const f32x4*)g)[lane + 64 * j];
            u32x2 o, xo; o.x = cvt_pk_bf16(va[j].x * ra * gg.x, va[j].y * ra * gg.y); o.y = cvt_pk_bf16(va[j].z * ra * gg.z, va[j].w * ra * gg.w);
            xo.x = cvt_pk_bf16(va[j].x, va[j].y); xo.y = cvt_pk_bf16(va[j].z, va[j].w);
            ((u32x2*)(XN + (size_t)m0 * D))[lane + 64 * j] = o; ((u32x2*)(XB + (size_t)m0 * D))[lane + 64 * j] = xo;
            if (two) { u32x2 o2, xo2; o2.x = cvt_pk_bf16(vb[j].x * rb * gg.x, vb[j].y * rb * gg.y); o2.y = cvt_pk_bf16(vb[j].z * rb * gg.z, vb[j].w * rb * gg.w);
                xo2.x = cvt_pk_bf16(vb[j].x, vb[j].y); xo2.y = cvt_pk_bf16(vb[j].z, vb[j].w);
                ((u32x2*)(XN + (size_t)m1 * D))[lane + 64 * j] = o2; ((u32x2*)(XB + (size_t)m1 * D))[lane + 64 * j] = xo2; }
        }
    }
}

__device__ __forceinline__ void tail_store(float* out, int g, int h, int kv, int row, int i0, f32x4 a, f32x4 b) {
    float* dst;
    if (row < MP) {
        const int bb = row >> 11, t = row & 2047, keep = 128 << (2 * g), tt = t - (SEQ - keep);
        if (tt < 0) return;
        const size_t base = g == 0 ? O_KP0 : (g == 1 ? O_KP1 : O_KP2);
        dst = out + base + ((((size_t)bb * keep + tt) * 2 + kv) * 8 + h) * 64;
    } else {
        const int s = row - MP; const size_t base = g == 0 ? O_KS0 : (g == 1 ? O_KS1 : O_KS2);
        dst = out + base + (((size_t)s * 2 + kv) * 8 + h) * 64;
    }
    *(f32x4*)(dst + i0) = a; *(f32x4*)(dst + 32 + i0) = b;
}
__device__ __forceinline__ void phase_qknorm(const Params& p, unsigned char* ws, float* out, const int tid) {
    const int lane = tid & 63, wave = tid >> 6;
    const int gw = blockIdx.x * 8 + wave, NGW = gridDim.x * 8;
    bf16_t* QKV = (bf16_t*)(ws + WS_BIG);
    const float* ct = (const float*)(ws + WS_ROPE); const float* st = ct + NPOS * 32;
    const int sub = lane & 7, i0 = 4 * sub;
    for (int it = MP * 9 + gw; it < M * 9; it += NGW) {
        const int row = it / 9, s9 = it - row * 9;
        if (s9 < 6) {
            const int head = s9 * 8 + (lane >> 3), isk = head >= 24, gh = isk ? head - 24 : head, g = gh >> 3, h = gh & 7;
            bf16_t* ptr = QKV + (size_t)row * NQKV + head * 64;
            const u32x2 ra = *(const u32x2*)(ptr + i0), rb = *(const u32x2*)(ptr + 32 + i0);
            f32x4 x1 = {bf_lo(ra.x), bf_hi(ra.x), bf_lo(ra.y), bf_hi(ra.y)}, x2 = {bf_lo(rb.x), bf_hi(rb.x), bf_lo(rb.y), bf_hi(rb.y)};
            float ss = (x1.x * x1.x + x1.y * x1.y) + (x1.z * x1.z + x1.w * x1.w) + (x2.x * x2.x + x2.y * x2.y) + (x2.z * x2.z + x2.w * x2.w);
            ss += __shfl_xor(ss, 1); ss += __shfl_xor(ss, 2); ss += __shfl_xor(ss, 4);
            const float r = 1.0f / sqrtf(ss * (1.0f / 64) + EPS);
            const float* gain = p.in[9] + isk * 64;
            const f32x4 g1 = *(const f32x4*)(gain + i0), g2 = *(const f32x4*)(gain + 32 + i0);
            const int pi = row < MP ? (row & 2047) : SEQ + ((row - MP) & 7);
            const f32x4 c = *(const f32x4*)(ct + pi * 32 + i0), s = *(const f32x4*)(st + pi * 32 + i0);
            const f32x4 y1 = x1 * r * g1, y2 = x2 * r * g2;
            const f32x4 o1 = y1 * c - y2 * s, o2 = y2 * c + y1 * s;
            u32x2 wa, wb; wa.x = cvt_pk_bf16(o1.x, o1.y); wa.y = cvt_pk_bf16(o1.z, o1.w); wb.x = cvt_pk_bf16(o2.x, o2.y); wb.y = cvt_pk_bf16(o2.z, o2.w);
            *(u32x2*)(ptr + i0) = wa; *(u32x2*)(ptr + 32 + i0) = wb;
            if (isk) tail_store(out, g, h, 0, row, i0, o1, o2);
        } else {
            const int vh = (s9 - 6) * 8 + (lane >> 3), g = vh >> 3, h = vh & 7;
            const bf16_t* ptr = QKV + (size_t)row * NQKV + 3072 + vh * 64;
            const u32x2 ra = *(const u32x2*)(ptr + i0), rb = *(const u32x2*)(ptr + 32 + i0);
            const f32x4 x1 = {bf_lo(ra.x), bf_hi(ra.x), bf_lo(ra.y), bf_hi(ra.y)}, x2 = {bf_lo(rb.x), bf_hi(rb.x), bf_lo(rb.y), bf_hi(rb.y)};
            tail_store(out, g, h, 1, row, i0, x1, x2);
        }
    }
}

#define MFMA32(a, b, c) __builtin_amdgcn_mfma_f32_32x32x16_bf16((a), (b), (c), 0, 0, 0)
__device__ __forceinline__ s16x4 tr_read(unsigned lds_addr) { return __builtin_amdgcn_ds_read_tr16_b64_v4i16((LAS s16x4*)(uintptr_t)lds_addr); }
__device__ __forceinline__ bf16x8 pack8(const f32x16& x, int s) {
    u32x4 pk;
    pk.x = cvt_pk_bf16(x[8 * s + 0], x[8 * s + 1]); pk.y = cvt_pk_bf16(x[8 * s + 2], x[8 * s + 3]); pk.z = cvt_pk_bf16(x[8 * s + 4], x[8 * s + 5]); pk.w = cvt_pk_bf16(x[8 * s + 6], x[8 * s + 7]);
    return __builtin_bit_cast(bf16x8, pk);
}
__device__ __forceinline__ void attn_prompt_tile(const bf16_t* QKV, bf16_t* OG, float* LSE, LAS unsigned char* vl, int g, int b, int h, int w, int lane) {
    const int dsh = 2 * g, d = 1 << dsh;
    const int tpr_sh = 6 - dsh;
    const int r = w >> tpr_sh, jt = w & ((1 << tpr_sh) - 1), j0 = jt * 32;
    const int q = lane & 31, hh = lane >> 5;
    const size_t rowb = (size_t)b * SEQ;
    const int qcol = g * 512 + h * 64, kcol = 1536 + qcol, vcol = 3072 + qcol;
    const int tq = ((j0 + q) << dsh) + r;
    const bf16_t* qp = QKV + (rowb + tq) * NQKV + qcol + 8 * hh;
    bf16x8 qf[4];
#pragma unroll
    for (int s = 0; s < 4; ++s) qf[s] = *(const bf16x8*)(qp + 16 * s);
    const int kb0 = jt >= 4 ? 0 : 4 - jt;
    f32x16 S[5];
    float mx = -INFINITY;
    bf16x8 kfa[5][4];
#pragma unroll
    for (int kb = 0; kb < 5; ++kb) {
        int jk = j0 - 128 + kb * 32 + q; jk = jk < 0 ? 0 : jk;
        const bf16_t* kp = QKV + (rowb + (size_t)((jk << dsh) + r)) * NQKV + kcol + 8 * hh;
#pragma unroll
        for (int s = 0; s < 4; ++s) kfa[kb][s] = *(const bf16x8*)(kp + 16 * s);
    }
#pragma unroll
    for (int kb = 0; kb < 5; ++kb) {
        f32x16 c;
#pragma unroll
        for (int i = 0; i < 16; ++i) c[i] = 0.f;
#pragma unroll
        for (int s = 0; s < 4; ++s) c = MFMA32(kfa[kb][s], qf[s], c);
#pragma unroll
        for (int i = 0; i < 16; ++i) {
            const int ki = (i & 3) + 8 * (i >> 2) + 4 * hh;
            bool valid = kb >= kb0;
            if (kb == 0) valid = valid && (ki >= q);
            if (kb == 4) valid = valid && (ki <= q);
            const float sv = valid ? c[i] * 0.125f : -INFINITY;
            c[i] = sv; mx = fmaxf(mx, sv);
        }
        S[kb] = c;
    }
    bf16x8 vva[5][4];
#pragma unroll
    for (int kb = 0; kb < 5; ++kb)
#pragma unroll
        for (int c4 = 0; c4 < 4; ++c4) {
            const int i = c4 * 8 + (lane >> 3); int jk = j0 - 128 + kb * 32 + i; jk = jk < 0 ? 0 : jk;
            vva[kb][c4] = *(const bf16x8*)(QKV + (rowb + (size_t)((jk << dsh) + r)) * NQKV + vcol + (lane & 7) * 8);
        }
    mx = fmaxf(mx, __shfl_xor(mx, 32));
    float l = 0.f;
#pragma unroll
    for (int kb = 0; kb < 5; ++kb)
#pragma unroll
        for (int i = 0; i < 16; ++i) { const float e = __expf(S[kb][i] - mx); S[kb][i] = e; l += e; }
    l += __shfl_xor(l, 32);
    const float inv = 1.0f / l;
    f32x16 o0, o1;
#pragma unroll
    for (int i = 0; i < 16; ++i) { o0[i] = 0.f; o1[i] = 0.f; }
    const unsigned vbase = (unsigned)(uintptr_t)vl;
    const unsigned tr_off = (unsigned)((4 * hh + ((lane & 15) >> 2)) * 144 + ((lane >> 4) & 1) * 32 + 8 * (lane & 3));
#pragma unroll
    for (int kb = 0; kb < 5; ++kb) {
        {
#pragma unroll
            for (int c4 = 0; c4 < 4; ++c4) *(LAS bf16x8*)(vl + (c4 * 8 + (lane >> 3)) * 144 + (lane & 7) * 16) = vva[kb][c4];
#pragma unroll
            for (int s2 = 0; s2 < 2; ++s2) {
                f32x16 pn = S[kb];
#pragma unroll
                for (int i = 0; i < 16; ++i) pn[i] *= inv;
                const bf16x8 pb = pack8(pn, s2);
#pragma unroll
                for (int nb = 0; nb < 2; ++nb) {
                    const unsigned a0 = vbase + tr_off + (unsigned)(16 * s2 * 144 + nb * 64);
                    const s16x4 lo = tr_read(a0), hi = tr_read(a0 + 8 * 144);
                    const bf16x8 va = __builtin_shufflevector(lo, hi, 0, 1, 2, 3, 4, 5, 6, 7);
                    if (nb == 0) o0 = MFMA32(va, pb, o0); else o1 = MFMA32(va, pb, o1);
                }
            }
        }
    }
    const size_t orow = (size_t)g * M + rowb + tq;
    bf16_t* op = OG + orow * AW + h * 64 + 4 * hh;
#pragma unroll
    for (int g4 = 0; g4 < 4; ++g4) {
        u32x2 w0, w1;
        w0.x = cvt_pk_bf16(o0[4 * g4], o0[4 * g4 + 1]); w0.y = cvt_pk_bf16(o0[4 * g4 + 2], o0[4 * g4 + 3]);
        w1.x = cvt_pk_bf16(o1[4 * g4], o1[4 * g4 + 1]); w1.y = cvt_pk_bf16(o1[4 * g4 + 2], o1[4 * g4 + 3]);
        *(u32x2*)(op + 8 * g4) = w0; *(u32x2*)(op + 32 + 8 * g4) = w1;
    }
    if (hh == 0) LSE[orow * 8 + h] = mx + __logf(l);
}
__device__ __forceinline__ void attn_sample_item(const Params& p, unsigned char* ws, int item, LAS float* sc, int lane) {
    const int j = item & 7, h = (item >> 3) & 7, gb = item >> 6, g = gb % 3, b = gb / 3;
    const int dsh = 2 * g, L = 128 << dsh;
    const float* cache = (g == 0 ? p.in[2] : (g == 1 ? p.in[3] : p.in[4])) + (size_t)b * L * 1024;
    const bf16_t* QKV = (const bf16_t*)(ws + WS_BIG);
    const int row = MP + b * 8 + j;
    const int sub = lane & 15, ks = lane >> 4;
    const int qcol = g * 512 + h * 64 + 4 * sub;
    const u32x2 qr = *(const u32x2*)(QKV + (size_t)row * NQKV + qcol);
    const f32x4 qv = {bf_lo(qr.x), bf_hi(qr.x), bf_lo(qr.y), bf_hi(qr.y)};
#pragma unroll 11
    for (int it = 0; it < 33; ++it) {
        const int i = it * 4 + ks;
        float dot = 0.f;
        if (i <= 128) {
            const int idx = L + j - (i << dsh);
            f32x4 kv;
            if (idx >= L) { const u32x2 kr = *(const u32x2*)(QKV + (size_t)(MP + b * 8 + (idx - L)) * NQKV + 1536 + qcol); kv = (f32x4){bf_lo(kr.x), bf_hi(kr.x), bf_lo(kr.y), bf_hi(kr.y)}; }
            else kv = *(const f32x4*)(cache + (size_t)idx * 1024 + h * 64 + 4 * sub);
            dot = (qv.x * kv.x + qv.y * kv.y) + (qv.z * kv.z + qv.w * kv.w);
        }
        dot += __shfl_xor(dot, 1); dot += __shfl_xor(dot, 2); dot += __shfl_xor(dot, 4); dot += __shfl_xor(dot, 8);
        if (sub == 0 && i <= 128) sc[i] = dot * 0.125f;
    }
    asm volatile("s_waitcnt lgkmcnt(0)" ::: "memory");
    float mx = fmaxf(sc[lane], sc[lane + 64]); if (lane == 0) mx = fmaxf(mx, sc[128]);
    mx = wave_max(mx);
    float l = __expf(sc[lane] - mx) + __expf(sc[lane + 64] - mx); if (lane == 0) l += __expf(sc[128] - mx);
    l = wave_sum(l);
    const float inv = 1.0f / l;
    f32x4 acc = {0.f, 0.f, 0.f, 0.f};
#pragma unroll 11
    for (int it = 0; it < 33; ++it) {
        const int i = it * 4 + ks;
        if (i <= 128) {
            const float pw = __expf(sc[i] - mx) * inv;
            const int idx = L + j - (i << dsh);
            f32x4 vv;
            if (idx >= L) { const u32x2 vr = *(const u32x2*)(QKV + (size_t)(MP + b * 8 + (idx - L)) * NQKV + 3072 + qcol); vv = (f32x4){bf_lo(vr.x), bf_hi(vr.x), bf_lo(vr.y), bf_hi(vr.y)}; }
            else vv = *(const f32x4*)(cache + (size_t)idx * 1024 + 512 + h * 64 + 4 * sub);
            acc += vv * pw;
        }
    }
#pragma unroll
    for (int k = 0; k < 4; ++k) { acc[k] += __shfl_xor(acc[k], 16); acc[k] += __shfl_xor(acc[k], 32); }
    const size_t orow = (size_t)g * M + row;
    if (ks == 0) { u32x2 w; w.x = cvt_pk_bf16(acc.x, acc.y); w.y = cvt_pk_bf16(acc.z, acc.w); *(u32x2*)((bf16_t*)(ws + WS_OG) + orow * AW + h * 64 + 4 * sub) = w; }
    if (lane == 0) ((float*)(ws + WS_LSE))[orow * 8 + h] = mx + __logf(l);
    asm volatile("s_waitcnt lgkmcnt(0)" ::: "memory");
}
__device__ __forceinline__ void attn_prompt_block(const bf16_t* QKV, bf16_t* OG, float* LSE, LAS unsigned char* lds, int g, int b, int h, int w8, const int tid) {
    const int lane = tid & 63, wave = __builtin_amdgcn_readfirstlane(tid >> 6);
    const int dsh = 2 * g, tpr_sh = 6 - dsh;
    const size_t rowb = (size_t)b * SEQ;
    const int qcol = g * 512 + h * 64, kcol = 1536 + qcol, vcol = 3072 + qcol;
    LAS unsigned char* Kl = lds; LAS unsigned char* Vl = lds + 55296;
    const int w = w8 * 8 + wave, r = w >> tpr_sh, jt = w & ((1 << tpr_sh) - 1), j0 = jt * 32;
    const int q = lane & 31, hh = lane >> 5;
    const int tq = ((j0 + q) << dsh) + r;
    const bf16_t* qp = QKV + (rowb + tq) * NQKV + qcol + 8 * hh;
    bf16x8 qf[4];
#pragma unroll
    for (int s = 0; s < 4; ++s) qf[s] = *(const bf16x8*)(qp + 16 * s);
    __syncthreads();
    {
        bf16x8 kr[6], vr[6];
#pragma unroll
        for (int i = 0; i < 6; ++i) {
            const int p = tid + 512 * i, sl = p >> 3, c = p & 7;
            int j, rr; bool valid;
            if (g == 2) { valid = sl < 256; j = sl & 127; rr = 2 * w8 + (sl >> 7); }
            else if (g == 1) { j = 256 * (w8 & 1) - 128 + sl; rr = w8 >> 1; valid = j >= 0; }
            else { j = 256 * w8 - 128 + sl; rr = 0; valid = j >= 0; }
            j = valid ? j : 0;
            const bf16_t* src = QKV + (rowb + (size_t)((j << dsh) + rr)) * NQKV + c * 8;
            kr[i] = *(const bf16x8*)(src + kcol); vr[i] = *(const bf16x8*)(src + vcol);
        }
#pragma unroll
        for (int i = 0; i < 6; ++i) {
            const int p = tid + 512 * i, sl = p >> 3, c = p & 7;
            *(LAS bf16x8*)(Kl + sl * 144 + c * 16) = kr[i]; *(LAS bf16x8*)(Vl + sl * 144 + c * 16) = vr[i];
        }
    }
    __syncthreads();
    const int jstart = g == 2 ? -128 * (wave >> 2) : (g == 1 ? 256 * (w8 & 1) - 128 : 256 * w8 - 128);
    const int kb0 = jt >= 4 ? 0 : 4 - jt;
    f32x16 S[5];
    float mx = -INFINITY;
#pragma unroll
    for (int kb = 0; kb < 5; ++kb) {
        f32x16 c;
#pragma unroll
        for (int i = 0; i < 16; ++i) c[i] = 0.f;
        const int jb = j0 - 128 + kb * 32;
        const int slot = jb < 0 ? -jstart : jb - jstart + q;
        bf16x8 kf[4];
#pragma unroll
        for (int s = 0; s < 4; ++s) kf[s] = *(const LAS bf16x8*)(Kl + slot * 144 + s * 32 + hh * 16);
#pragma unroll
        for (int s = 0; s < 4; ++s) c = MFMA32(kf[s], qf[s], c);
#pragma unroll
        for (int i = 0; i < 16; ++i) {
            const int ki = (i & 3) + 8 * (i >> 2) + 4 * hh;
            bool valid = kb >= kb0;
            if (kb == 0) valid = valid && (ki >= q);
            if (kb == 4) valid = valid && (ki <= q);
            const float sv = valid ? c[i] * 0.125f : -INFINITY;
            c[i] = sv; mx = fmaxf(mx, sv);
        }
        S[kb] = c;
    }
    mx = fmaxf(mx, __shfl_xor(mx, 32));
    float l = 0.f;
#pragma unroll
    for (int kb = 0; kb < 5; ++kb)
#pragma unroll
        for (int i = 0; i < 16; ++i) { const float e = __expf(S[kb][i] - mx); S[kb][i] = e; l += e; }
    l += __shfl_xor(l, 32);
    const float inv = 1.0f / l;
    f32x16 o0, o1;
#pragma unroll
    for (int i = 0; i < 16; ++i) { o0[i] = 0.f; o1[i] = 0.f; }
    const unsigned vbase = (unsigned)(uintptr_t)Vl;
    const int trrow = 4 * hh + ((lane & 15) >> 2);
    const unsigned trcol = (unsigned)(((lane >> 4) & 1) * 32 + 8 * (lane & 3));
#pragma unroll
    for (int kb = 0; kb < 5; ++kb) {
        const int jb = j0 - 128 + kb * 32;
        const int sbase = jb < 0 ? -jstart : jb - jstart, sstr = jb < 0 ? 0 : 144;
#pragma unroll
        for (int s2 = 0; s2 < 2; ++s2) {
            f32x16 pn = S[kb];
#pragma unroll
            for (int i = 0; i < 16; ++i) pn[i] *= inv;
            const bf16x8 pb = pack8(pn, s2);
#pragma unroll
            for (int nb = 0; nb < 2; ++nb) {
                const unsigned a0 = vbase + (unsigned)(sbase * 144 + (16 * s2 + trrow) * sstr) + trcol + (unsigned)(nb * 64);
                const s16x4 lo = tr_read(a0), hi = tr_read(a0 + (unsigned)(8 * sstr));
                const bf16x8 va = __builtin_shufflevector(lo, hi, 0, 1, 2, 3, 4, 5, 6, 7);
                if (nb == 0) o0 = MFMA32(va, pb, o0); else o1 = MFMA32(va, pb, o1);
            }
        }
    }
    const size_t orow = (size_t)g * M + rowb + tq;
    bf16_t* op = OG + orow * AW + h * 64 + 4 * hh;
#pragma unroll
    for (int g4 = 0; g4 < 4; ++g4) {
        u32x2 w0, w1;
        w0.x = cvt_pk_bf16(o0[4 * g4], o0[4 * g4 + 1]); w0.y = cvt_pk_bf16(o0[4 * g4 + 2], o0[4 * g4 + 3]);
        w1.x = cvt_pk_bf16(o1[4 * g4], o1[4 * g4 + 1]); w1.y = cvt_pk_bf16(o1[4 * g4 + 2], o1[4 * g4 + 3]);
        *(u32x2*)(op + 8 * g4) = w0; *(u32x2*)(op + 32 + 8 * g4) = w1;
    }
    if (hh == 0) LSE[orow * 8 + h] = mx + __logf(l);
}
__device__ __forceinline__ void phase_attn(const Params& p, unsigned char* ws, LAS unsigned char* lds, const int tid) {
    const int lane = tid & 63, wave = __builtin_amdgcn_readfirstlane(tid >> 6);
    LAS unsigned char* vl = lds + wave * 4608;
    constexpr int NS = 768, NP = 3072;
    for (int bi = blockIdx.x; bi < NS; bi += gridDim.x) attn_sample_item(p, ws, bi * 8 + wave, (LAS float*)vl, lane);
    for (int x = blockIdx.x; x < NP; x += gridDim.x) {
        const int w8 = x & 7, h = (x >> 3) & 7, b = (x >> 6) & 15, g = x >> 10;
        attn_prompt_block((const bf16_t*)(ws + WS_BIG), (bf16_t*)(ws + WS_OG), (float*)(ws + WS_LSE), lds, g, b, h, w8, tid);
    }
    __syncthreads();
}
__device__ __forceinline__ void phase_merge(unsigned char* ws, const int tid) {
    const bf16_t* OG = (const bf16_t*)(ws + WS_OG); const float* LSE = (const float*)(ws + WS_LSE); bf16_t* AO = (bf16_t*)(ws + WS_AO);
    for (int e = blockIdx.x * 512 + tid; e < M * 64; e += gridDim.x * 512) {
        const int rh = e >> 3, c8 = e & 7;
        const float l0 = LSE[rh], l1 = LSE[(size_t)M * 8 + rh], l2 = LSE[(size_t)2 * M * 8 + rh];
        const float mx = fmaxf(l0, fmaxf(l1, l2));
        float w0 = __expf(l0 - mx), w1 = __expf(l1 - mx), w2 = __expf(l2 - mx); const float inv = 1.0f / (w0 + w1 + w2); w0 *= inv; w1 *= inv; w2 *= inv;
        const size_t off = (size_t)rh * 64 + c8 * 8;
        const u32x4 a = *(const u32x4*)(OG + off), b = *(const u32x4*)(OG + (size_t)M * AW + off), c = *(const u32x4*)(OG + (size_t)2 * M * AW + off);
        u32x4 o;
#pragma unroll
        for (int k = 0; k < 4; ++k) o[k] = cvt_pk_bf16(w0 * bf_lo(a[k]) + w1 * bf_lo(b[k]) + w2 * bf_lo(c[k]), w0 * bf_hi(a[k]) + w1 * bf_hi(b[k]) + w2 * bf_hi(c[k]));
        *(u32x4*)(AO + off) = o;
    }
}

__device__ __forceinline__ void phase_vnorm(const Params& p, unsigned char* ws, float* out, const int tid) {
    const int lane = tid & 63, wave = tid >> 6;
    const int gw = blockIdx.x * 8 + wave, NGW = gridDim.x * 8;
    const bf16_t* UV = (const bf16_t*)(ws + WS_BIG); float* RV = (float*)(ws + WS_RV);
    for (int m = gw; m < M; m += NGW) {
        const u32x4* vr = (const u32x4*)(UV + (size_t)m * NUV + BW) + lane;
        u32x4 v[4]; float ss = 0.f;
#pragma unroll
        for (int j = 0; j < 4; ++j) { v[j] = vr[64 * j];
#pragma unroll
            for (int k = 0; k < 4; ++k) { const float a = bf_lo(v[j][k]), b = bf_hi(v[j][k]); ss += a * a + b * b; } }
        const float r = 1.0f / sqrtf(wave_sum(ss) * (1.0f / BW) + EPS);
        if (lane == 0) RV[m] = r;
        if (m >= MP) {
            float* dst = out + O_VS + (size_t)(m - MP) * BW;
#pragma unroll
            for (int j = 0; j < 4; ++j) { const int c0 = 8 * (lane + 64 * j); const f32x4 ga = *(const f32x4*)(p.in[12] + c0), gb = *(const f32x4*)(p.in[12] + c0 + 4);
                *(f32x4*)(dst + c0) = (f32x4){bf_lo(v[j][0]) * r * ga.x, bf_hi(v[j][0]) * r * ga.y, bf_lo(v[j][1]) * r * ga.z, bf_hi(v[j][1]) * r * ga.w};
                *(f32x4*)(dst + c0 + 4) = (f32x4){bf_lo(v[j][2]) * r * gb.x, bf_hi(v[j][2]) * r * gb.y, bf_lo(v[j][3]) * r * gb.z, bf_hi(v[j][3]) * r * gb.w}; }
        }
    }
}
__device__ __forceinline__ void spatial_item(const Params& p, unsigned char* ws, LAS unsigned char* lds, int chunk, int gi, const int tid) {
    const bf16_t* UV = (const bf16_t*)(ws + WS_BIG); const float* RV = (const float*)(ws + WS_RV); bf16_t* UM = (bf16_t*)(ws + WS_UM);
    const bf16_t* WSP = (const bf16_t*)(ws + WS_WSP);
    constexpr int PITCH = 272;
    const int lane = tid & 63, wave = __builtin_amdgcn_readfirstlane(tid >> 6), tb = wave & 3, ch = wave >> 2, hh = lane >> 5;
    const int t = 32 * tb + (lane & 31);
    const bf16_t* wp = WSP + ((size_t)gi * 128 + t) * 128 + 8 * hh;
    bf16x8 wfa[8];
#pragma unroll
    for (int ks = 0; ks < 8; ++ks) wfa[ks] = *(const bf16x8*)(wp + 16 * ks);
    const size_t row = (size_t)chunk * 128 + t;
    const int colb = gi * 128 + 64 * ch;
    const bf16_t* up = UV + row * NUV + colb + 4 * hh;
    u32x2 ur[8];
#pragma unroll
    for (int k = 0; k < 8; ++k) ur[k] = *(const u32x2*)(up + 32 * (k >> 2) + 8 * (k & 3));
    const float bias = p.in[14][gi * 128 + t];
    __syncthreads();
#pragma unroll
    for (int k = 0; k < 4; ++k) {
        const int pc = tid + 512 * k, sr = pc >> 4, c16 = pc & 15;
        const u32x4 raw = *(const u32x4*)(UV + (size_t)(chunk * 128 + sr) * NUV + BW + gi * 128 + c16 * 8);
        const float rv = RV[chunk * 128 + sr];
        const f32x4 ga = *(const f32x4*)(p.in[12] + gi * 128 + c16 * 8), gb = *(const f32x4*)(p.in[12] + gi * 128 + c16 * 8 + 4);
        u32x4 o;
        o.x = cvt_pk_bf16(bf_lo(raw.x) * rv * ga.x, bf_hi(raw.x) * rv * ga.y); o.y = cvt_pk_bf16(bf_lo(raw.y) * rv * ga.z, bf_hi(raw.y) * rv * ga.w);
        o.z = cvt_pk_bf16(bf_lo(raw.z) * rv * gb.x, bf_hi(raw.z) * rv * gb.y); o.w = cvt_pk_bf16(bf_lo(raw.w) * rv * gb.z, bf_hi(raw.w) * rv * gb.w);
        *(LAS u32x4*)(lds + sr * PITCH + c16 * 16) = o;
    }
    __syncthreads();
    f32x16 a0, a1;
#pragma unroll
    for (int i = 0; i < 16; ++i) { a0[i] = 0.f; a1[i] = 0.f; }
    const unsigned lbase = (unsigned)(uintptr_t)lds;
    const unsigned tr_off = (unsigned)((8 * hh + ((lane & 15) >> 2)) * PITCH + (64 * ch + 16 * ((lane >> 4) & 1)) * 2 + 8 * (lane & 3));
#pragma unroll
    for (int ks = 0; ks < 8; ++ks) {
        if (ks < 2 * (tb + 1)) {
#pragma unroll
            for (int cb = 0; cb < 2; ++cb) {
                const unsigned a = lbase + tr_off + (unsigned)(16 * ks * PITCH + cb * 64);
                const s16x4 lo = tr_read(a), hi = tr_read(a + 4 * PITCH);
                const bf16x8 va = __builtin_shufflevector(lo, hi, 0, 1, 2, 3, 4, 5, 6, 7);
                if (cb == 0) a0 = MFMA32(va, wfa[ks], a0); else a1 = MFMA32(va, wfa[ks], a1);
            }
        }
    }
    bf16_t* op = UM + row * LDU + colb + 4 * hh;
#pragma unroll
    for (int cb = 0; cb < 2; ++cb)
#pragma unroll
        for (int g4 = 0; g4 < 4; ++g4) {
            const u32x2 uu = ur[cb * 4 + g4];
            const f32x16& a = cb == 0 ? a0 : a1;
            u32x2 w;
            w.x = cvt_pk_bf16(bf_lo(uu.x) * (a[4 * g4] + bias), bf_hi(uu.x) * (a[4 * g4 + 1] + bias));
            w.y = cvt_pk_bf16(bf_lo(uu.y) * (a[4 * g4 + 2] + bias), bf_hi(uu.y) * (a[4 * g4 + 3] + bias));
            *(u32x2*)(op + 32 * cb + 8 * g4) = w;
        }
}
__device__ __forceinline__ void phase_spatial(const Params& p, unsigned char* ws, LAS unsigned char* lds, const int tid) {
    const int lane = tid & 63, wave = __builtin_amdgcn_readfirstlane(tid >> 6);
    const bf16_t* UV = (const bf16_t*)(ws + WS_BIG); const float* RV = (const float*)(ws + WS_RV); bf16_t* UM = (bf16_t*)(ws + WS_UM);
    const float* vgain = p.in[12]; const float* bsp = p.in[14];
    constexpr int NPI = 256 * 16, NSI = 256;
    LAS unsigned char* vl = lds + wave * 4608;
    for (int it = blockIdx.x; it < NPI + NSI; it += gridDim.x) {
        if (it < NPI) spatial_item(p, ws, lds, it >> 4, it & 15, tid);
        else {
            const int e = (it - NPI) * 512 + tid;
            const int c4 = e & 511, bt = e >> 9, t = bt & 7, b = bt >> 3, c0 = 4 * c4, gi = c0 >> 7;
            f32x4 acc = {0.f, 0.f, 0.f, 0.f};
            const f32x4 vg = *(const f32x4*)(vgain + c0);
            for (int s = 0; s <= t; ++s) {
                const size_t r = (size_t)MP + b * 8 + s;
                const u32x2 vr = *(const u32x2*)(UV + r * NUV + BW + c0);
                const float wv = p.in[13][((size_t)gi * 128 + t) * 128 + s] * RV[r];
                acc += (f32x4){bf_lo(vr.x), bf_hi(vr.x), bf_lo(vr.y), bf_hi(vr.y)} * wv;
            }
            const float bias = bsp[gi * 128 + t];
            const size_t r = (size_t)MP + b * 8 + t;
            const u32x2 ur = *(const u32x2*)(UV + r * NUV + c0);
            u32x2 w;
            w.x = cvt_pk_bf16(bf_lo(ur.x) * (acc.x * vg.x + bias), bf_hi(ur.x) * (acc.y * vg.y + bias));
            w.y = cvt_pk_bf16(bf_lo(ur.y) * (acc.z * vg.z + bias), bf_hi(ur.y) * (acc.w * vg.w + bias));
            *(u32x2*)(UM + r * LDU + c0) = w;
        }
    }
}

constexpr int BAR_WORDS = 64 * 18;
__device__ __forceinline__ void grid_barrier(unsigned* bar, const int tid, volatile LAS unsigned* ctl) {
    asm volatile("s_waitcnt vmcnt(0) lgkmcnt(0)" ::: "memory");
    __syncthreads();
    if (tid == 0) {
        const unsigned x = (unsigned)__builtin_amdgcn_s_getreg((3 << 11) | 20) & 7u, nloc = ctl[0], nx = ctl[1];
        if (__hip_atomic_fetch_add(bar + 64 * x, 1u, __ATOMIC_RELAXED, __HIP_MEMORY_SCOPE_AGENT) == nloc - 1u) {
            __builtin_amdgcn_fence(__ATOMIC_RELEASE, "agent");
            asm volatile("s_waitcnt vmcnt(0)" ::: "memory");
            if (__hip_atomic_fetch_add(bar + 64 * 8, 1u, __ATOMIC_RELAXED, __HIP_MEMORY_SCOPE_AGENT) == nx - 1u) __hip_atomic_store(bar + 64 * 9, 1u, __ATOMIC_RELAXED, __HIP_MEMORY_SCOPE_AGENT);
            else while (__hip_atomic_load(bar + 64 * 9, __ATOMIC_RELAXED, __HIP_MEMORY_SCOPE_AGENT) == 0u) __builtin_amdgcn_s_sleep(1);
            __builtin_amdgcn_fence(__ATOMIC_ACQUIRE, "agent");
            __hip_atomic_store(bar + 64 * (10 + x), 1u, __ATOMIC_RELAXED, __HIP_MEMORY_SCOPE_AGENT);
            asm volatile("s_waitcnt vmcnt(0)" ::: "memory");
        } else {
            while (__hip_atomic_load(bar + 64 * (10 + x), __ATOMIC_RELAXED, __HIP_MEMORY_SCOPE_AGENT) == 0u) __builtin_amdgcn_s_sleep(1);
            __builtin_amdgcn_fence(__ATOMIC_ACQUIRE, "agent");
            asm volatile("s_waitcnt vmcnt(0)" ::: "memory");
        }
    }
    __syncthreads();
}

__global__ void __launch_bounds__(512, 2) mega(Params p) {
    extern __shared__ __attribute__((aligned(16))) unsigned char lds_raw[];
    LAS unsigned char* lds = (LAS unsigned char*)lds_raw;
    for (int pi = p.ph_lo; pi < p.ph_hi; ++pi) {
        int ph = pi;
        if (DUPMASK) { int q = 0, r = 0; for (; q < NPHASE; ++q) { if (r == pi) break; ++r; if ((DUPMASK >> q) & 1u) { if (r == pi) break; ++r; } } ph = q; }
        int tid = threadIdx.x; asm volatile("" : "+v"(tid));
        unsigned z; asm volatile("s_mov_b32 %0, 0" : "=s"(z));
        unsigned char* ws = p.ws + z; float* out = p.out + z;
        bf16_t* XN = (bf16_t*)(ws + WS_XN); bf16_t* BIG = (bf16_t*)(ws + WS_BIG);
        bf16_t* YB = (bf16_t*)(ws + WS_YB);
        int fi = -1, fo = -1, ni = -1; float sy = 0.5f;
        switch (ph) {
            case 1: fi = 0; break; case 10: fi = 1; break; case 13: fi = 2; break; case 21: fi = 3; break;
            case 2: fo = 0; break; case 11: fo = 1; break; case 14: fo = 2; break; case 22: fo = 3; break;
            case 3: ni = 1; break; case 9: ni = 2; sy = 1.0f; break; case 12: ni = 3; break; case 15: ni = 4; break; case 20: ni = 5; sy = 1.0f; break; case 23: ni = 6; break;
            default: break;
        }
#ifndef PMASK
#define PMASK 0xFFFF
#endif
        if ((PMASK & 1) && ph == 0) phase_prologue(p, ws, out, lds, tid);
        else if ((PMASK & 2) && fi >= 0) { const bf16_t* W = (const bf16_t*)(ws + WS_WIN + fi * SZ_WIN); sample_gemm<2, 8>(lds, XN + (size_t)MP * D, D, W, D, D, FF, BIG + (size_t)MP * FF, FF, tid);
            pg8::EpiSwiglu E{BIG}; pg8::gemm_phase(lds, XN, W, MP, 2 * FF, D, E, tid); }
        else if (ph == 22) {
            const bf16_t* B = (const bf16_t*)(ws + WS_WOUT + 3 * SZ_WOUT);
            sample_gemm<4, 22>(lds, BIG + (size_t)MP * FF, FF, B, FF, FF, D, (bf16_t*)(ws + WS_XB) + (size_t)MP * D, D, tid, out + (size_t)MP * D);
            pg8::EpiFinal E{out, (const bf16_t*)(ws + WS_XB), 0.5f}; pg8::gemm_phase(lds, BIG, B, MP, D, FF, E, tid); }
        else if ((PMASK & 4) && (fo >= 0 || ph == 8 || ph == 19)) {
            const bf16_t* A = BIG; const bf16_t* B = (const bf16_t*)(ws + WS_WOUT + (fo < 0 ? 0 : fo) * SZ_WOUT); int K = FF, ld = FF;
            if (ph == 8) { A = (const bf16_t*)(ws + WS_AO); B = (const bf16_t*)(ws + WS_WOA); K = AW; ld = AW; }
            if (ph == 19) { A = (const bf16_t*)(ws + WS_UM); B = (const bf16_t*)(ws + WS_WOB); K = BW; ld = LDU; }
            if (K == FF) sample_gemm<0, 22>(lds, A + (size_t)MP * ld, ld, B, ld, K, D, YB + (size_t)MP * D, D, tid);
            else if (K == AW) sample_gemm<0, 4>(lds, A + (size_t)MP * ld, ld, B, ld, K, D, YB + (size_t)MP * D, D, tid);
            else sample_gemm<0, 16>(lds, A + (size_t)MP * ld, ld, B, ld, K, D, YB + (size_t)MP * D, D, tid);
            pg8::EpiBf16<0> E{YB, D}; pg8::gemm_phase(lds, A, B, MP, D, K, E, tid, ld, ld); }
#ifdef DUMPSEL
        else if (ph == 20) {
            const bf16_t* wsp = (const bf16_t*)(ws + WS_WSP); const float* rvp = (const float*)(ws + WS_RV);
            for (size_t e = (size_t)blockIdx.x * 512 + tid; e < (size_t)M * D; e += (size_t)gridDim.x * 512) { const size_t r = e / D, c = e % D;
                out[e] = (DUMPSEL == 10) ? p.in[12][(c + r) % 2048] * p.in[14][(c * 3 + r) % 2048] * (1.0f + p.in[13][(r * 1024 + c) % 262144]) : (DUMPSEL == 2) ? (r >= (size_t)MP ? 0.f : 1.f) * __uint_as_float((unsigned)((const bf16_t*)(ws + WS_UM))[r * LDU + c] << 16) : (DUMPSEL == 8) ? (r < 256 ? __uint_as_float((unsigned)wsp[r * 1024 + c] << 16) : 0.f) : rvp[r]; }
        }
#endif
        else if ((PMASK & 8) && ni >= 0) phase_norm(ws, out, ni < 6 ? p.in[5] + ni * D : nullptr, sy, tid);
        else if ((PMASK & 16) && ph == 4) { sample_gemm<3, 8>(lds, XN + (size_t)MP * D, D, (const bf16_t*)(ws + WS_WQKV), D, D, NQKV, BIG + (size_t)MP * NQKV, NQKV, tid);
            const float* ctab = (const float*)(ws + WS_ROPE);
            pg8::EpiQKV E{BIG, ctab, ctab + NPOS * 32, p.in[9], out}; pg8::gemm_phase(lds, XN, (const bf16_t*)(ws + WS_WQKV), MP, NQKV, D, E, tid); }
        else if ((PMASK & 32) && ph == 5) phase_qknorm(p, ws, out, tid);
        else if ((PMASK & 64) && ph == 6) phase_attn(p, ws, lds, tid);
        else if ((PMASK & 128) && ph == 7) phase_merge(ws, tid);
        else if ((PMASK & 512) && ph == 16) { sample_gemm<1, 8>(lds, XN + (size_t)MP * D, D, (const bf16_t*)(ws + WS_WUV), D, D, NUV, BIG + (size_t)MP * NUV, NUV, tid);
            pg8::EpiBf16<1> E{BIG, NUV}; pg8::gemm_phase(lds, XN, (const bf16_t*)(ws + WS_WUV), MP, NUV, D, E, tid); }
        else if ((PMASK & 1024) && ph == 17) phase_vnorm(p, ws, out, tid);
        else if ((PMASK & 2048) && ph == 18) phase_spatial(p, ws, lds, tid);
        if (pi + 1 < p.ph_hi) {
            volatile LAS unsigned* ctl = (volatile LAS unsigned*)(lds + 135168);
            if (pi == 0) {
                const unsigned x = (unsigned)__builtin_amdgcn_s_getreg((3 << 11) | 20) & 7u;
                if (tid == 0) __hip_atomic_fetch_add((unsigned*)p.ws + 64 * x, 1u, __ATOMIC_RELAXED, __HIP_MEMORY_SCOPE_AGENT);
                __syncthreads(); cg::this_grid().sync();
                if (tid == 0) { unsigned nx = 0;
                    for (int j = 0; j < 8; ++j) nx += __hip_atomic_load((unsigned*)p.ws + 64 * j, __ATOMIC_RELAXED, __HIP_MEMORY_SCOPE_AGENT) != 0u;
                    ctl[0] = __hip_atomic_load((unsigned*)p.ws + 64 * x, __ATOMIC_RELAXED, __HIP_MEMORY_SCOPE_AGENT); ctl[1] = nx; }
                __syncthreads();
            }
            else grid_barrier((unsigned*)p.ws + (size_t)BAR_WORDS * pi, tid, ctl);
        }
    }
}

extern "C" void kernel_launch(void* const* d_in, const int* in_sizes, int n_in, void* d_out, int out_size, void* d_ws, size_t ws_size, hipStream_t stream) {
    static int grid = 0;
    if (grid == 0) {
        if (n_in != 16 || ws_size < WS_END) { fprintf(stderr, "kernel_launch: unexpected inputs (n_in %d, ws %zu < %zu)\n", n_in, ws_size, (size_t)WS_END); grid = -1; return; }
        int dev = 0, cus = 0, per_cu = 0;
        (void)hipGetDevice(&dev);
        (void)hipDeviceGetAttribute(&cus, hipDeviceAttributeMultiprocessorCount, dev);
        if (hipFuncSetAttribute((const void*)mega, hipFuncAttributeMaxDynamicSharedMemorySize, LDS_BYTES) != hipSuccess) { fprintf(stderr, "kernel_launch: hipFuncSetAttribute failed\n"); grid = -1; return; }
        if (hipOccupancyMaxActiveBlocksPerMultiprocessor(&per_cu, (const void*)mega, 512, LDS_BYTES) != hipSuccess || per_cu < 1) { fprintf(stderr, "kernel_launch: occupancy query says %d\n", per_cu); per_cu = 1; }
        (void)hipGetLastError();
        grid = cus * 1;
    }
    if (grid < 0) return;
    if (hipMemsetAsync(d_ws, 0, 262144, stream) != hipSuccess) { fprintf(stderr, "kernel_launch: memset failed\n"); return; }
    Params p{};
    for (int i = 0; i < 16; ++i) p.in[i] = (const float*)d_in[i];
    p.out = (float*)d_out; p.ws = (unsigned char*)d_ws;
#if ONE_LAUNCH
    p.ph_lo = 0; p.ph_hi = NPHASE + __builtin_popcount(DUPMASK);
    void* args[] = {&p};
    hipError_t e = hipLaunchCooperativeKernel((const void*)mega, dim3(grid), dim3(512), args, LDS_BYTES, stream);
    if (e != hipSuccess) fprintf(stderr, "cooperative launch failed: %s (grid %d)\n", hipGetErrorString(e), grid);
#else
    for (int ph = 0; ph < NPHASE; ++ph) {
        p.ph_lo = ph; p.ph_hi = ph + 1;
        hipLaunchKernelGGL(mega, dim3(grid), dim3(512), LDS_BYTES, stream, p);
    }
#endif
}
```

```cpp
#include <hip/hip_runtime.h>
#include <hip/hip_cooperative_groups.h>
#include <cstdio>
#include <cstdint>
namespace cg = cooperative_groups;

#ifndef ONE_LAUNCH
#define ONE_LAUNCH 1
#endif

#define LAS __attribute__((address_space(3)))
typedef unsigned short bf16_t;
typedef short bf16x8 __attribute__((ext_vector_type(8)));
typedef short s16x4 __attribute__((ext_vector_type(4)));
typedef float f32x2 __attribute__((ext_vector_type(2)));
typedef float f32x4 __attribute__((ext_vector_type(4)));
typedef float f32x16 __attribute__((ext_vector_type(16)));
typedef unsigned u32x2 __attribute__((ext_vector_type(2)));
typedef unsigned u32x4 __attribute__((ext_vector_type(4)));

constexpr int D = 1024, SEQ = 2048, NBATCH = 16, MP = NBATCH * SEQ, MS = 256, M = MP + MS;
constexpr int FF = 2816, NQKV = 4608, AW = 512, BW = 2048, NUV = 4096, PAST = 16384;
constexpr float EPS = 1e-6f;
constexpr int LDU = BW + 64;
constexpr int NPOS = SEQ + 8;
constexpr size_t O_YP = 0, O_YS = (size_t)MP * D, O_KP0 = O_YS + (size_t)MS * D, O_KP1 = O_KP0 + 2097152, O_KP2 = O_KP1 + 8388608,
                 O_KS0 = O_KP2 + 33554432, O_KS1 = O_KS0 + 262144, O_KS2 = O_KS1 + 262144, O_VS = O_KS2 + 262144;
constexpr size_t al256(size_t x) { return (x + 255) & ~(size_t)255; }
constexpr size_t WS_WIN = 1u << 20;
constexpr size_t SZ_WIN = (size_t)2 * FF * D * 2;
constexpr size_t WS_WOUT = WS_WIN + 4 * SZ_WIN;
constexpr size_t SZ_WOUT = (size_t)D * FF * 2;
constexpr size_t WS_WQKV = WS_WOUT + 4 * SZ_WOUT;
constexpr size_t WS_WOA = WS_WQKV + (size_t)NQKV * D * 2;
constexpr size_t WS_WUV = WS_WOA + (size_t)D * AW * 2;
constexpr size_t WS_WOB = WS_WUV + (size_t)NUV * D * 2;
constexpr size_t WS_WSP = WS_WOB + (size_t)D * LDU * 2;
constexpr size_t WS_ROPE = WS_WSP + (size_t)16 * 128 * 128 * 2;
constexpr size_t WS_XN = al256(WS_ROPE + (size_t)NPOS * 32 * 4 * 2);
constexpr size_t WS_BIG = al256(WS_XN + (size_t)M * D * 2);
constexpr size_t WS_OG = al256(WS_BIG + (size_t)M * NQKV * 2);
constexpr size_t WS_LSE = al256(WS_OG + (size_t)3 * M * AW * 2);
constexpr size_t WS_AO = al256(WS_LSE + (size_t)3 * M * 8 * 4);
constexpr size_t WS_UM = al256(WS_AO + (size_t)M * AW * 2);
constexpr size_t WS_RV = al256(WS_UM + (size_t)M * LDU * 2);
constexpr size_t WS_YB = al256(WS_RV + (size_t)M * 4);
constexpr size_t WS_XB = al256(WS_YB + (size_t)M * D * 2);
constexpr size_t WS_END = al256(WS_XB + (size_t)M * D * 2);

#ifndef DUPMASK
#define DUPMASK 0u
#endif
constexpr int LDS_BYTES = 139264;
#ifdef DUMPSEL
constexpr int NPHASE = 21;
#else
constexpr int NPHASE = 23;
#endif

__device__ __forceinline__ float wave_sum(float v) {
#pragma unroll
    for (int o = 1; o < 64; o <<= 1) v += __shfl_xor(v, o);
    return v;
}
__device__ __forceinline__ float wave_max(float v) {
#pragma unroll
    for (int o = 1; o < 64; o <<= 1) v = fmaxf(v, __shfl_xor(v, o));
    return v;
}
typedef __bf16 bf16x2_t __attribute__((ext_vector_type(2)));
__device__ __forceinline__ unsigned cvt_pk_bf16(float lo, float hi) { const f32x2 v = {lo, hi}; return __builtin_bit_cast(unsigned, __builtin_convertvector(v, bf16x2_t)); }
__device__ __forceinline__ float bf_lo(unsigned w) { return __uint_as_float(w << 16); }
__device__ __forceinline__ float bf_hi(unsigned w) { return __uint_as_float(w & 0xffff0000u); }
__device__ __forceinline__ float silu_f(float x) { return x * __builtin_amdgcn_rcpf(1.0f + __expf(-x)); }
__device__ __forceinline__ float gelu_tanh_f(float x) { const float y = 0.7978845608028654f * (x + 0.044715f * x * x * x); return x * __builtin_amdgcn_rcpf(1.0f + __expf(-2.0f * y)); }

namespace pg8 {
constexpr int BM = 256, BK = 64, HALF = 128, HTB = HALF * BK * 2, STAGE_BYTES = 8 * HTB, NXCD = 8, WGM = 8;
__device__ __forceinline__ int lds_byte(int r, int c) { const int st = (r >> 4) * 2 + (c >> 5), rr = r & 15, cc = c & 31, ob = rr * 64 + cc * 2; return st * 1024 + (ob ^ (((ob >> 9) & 1) << 5)); }
__device__ __forceinline__ void stage_rc(int b, int& R, int& C) { const int st = b / 1024, sb = b % 1024, swz = sb ^ (((sb >> 9) & 1) << 5); R = (st >> 1) * 16 + swz / 64; C = (st & 1) * 32 + (swz % 64) / 2; }
__device__ __forceinline__ int perm32(int rho) { const int n = rho >> 4, i = rho & 15; return 8 * (i >> 2) + 4 * n + (i & 3); }
struct Unit { int pm, pn; };
struct StaticOrder {
    int nM, nN, nwg, G, c;
    __device__ void init(int M_, int N_, int G_, int c_) { nM = M_ / BM; nN = N_ / BM; nwg = nM * nN; G = G_; c = c_; }
    __device__ bool next(int i, Unit& u) const {
        const long L = (long)i * G + c; if (L >= nwg) return false;
        int wgid = (int)L; { const int q = nwg / NXCD, r = nwg % NXCD, xcd = wgid % NXCD, off = wgid / NXCD; wgid = (xcd < r ? xcd * (q + 1) : r * (q + 1) + (xcd - r) * q) + off; }
        const int nig = WGM * nN, gid = wgid / nig, fm = gid * WGM, gsz = (nM - fm) < WGM ? (nM - fm) : WGM;
        u.pm = fm + ((wgid % nig) % gsz); u.pn = (wgid % nig) / gsz; return true;
    }
};
template <class Epi>
__device__ __forceinline__ void gemm_phase(LAS unsigned char* lds, const bf16_t* gA, const bf16_t* gBt, int gM, int gN, int K, const Epi& E, const int tid, const int lda = 0, const int ldb = 0) {
    const int LA = lda ? lda : K, LB = ldb ? ldb : K;
    const int wid = __builtin_amdgcn_readfirstlane(tid >> 6), lane = tid & 63, wr = wid >> 2, wc = wid & 3, fr = lane & 15, fq = lane >> 4;
    const int nt = K / BK;
    StaticOrder S; S.init(gM, gN, (int)gridDim.x, (int)blockIdx.x);
    unsigned voffA[2], voffB[2];
#pragma unroll
    for (int i = 0; i < 2; ++i) { int R, C; stage_rc(tid * 16 + i * 8192, R, C); const int Rb = Epi::PERM ? ((R & ~31) + perm32(R & 31)) : R;
        voffA[i] = (unsigned)(R * LA + C) * 2u; voffB[i] = (unsigned)(Rb * LB + C) * 2u; }
    const size_t kstep = (size_t)(BK * 2);
    const size_t hstepA = (size_t)HALF * LA * 2, hstepB = (size_t)HALF * LB * 2;
    const size_t tstepA = 2 * hstepA, tstepB = 2 * hstepB;
    const unsigned ldsw = (unsigned)wid * 1024u;
    const int aoff = lds_byte(wr * 64 + fr, fq * 8), boff = lds_byte(wc * 32 + fr, fq * 8);
#define PG8_SA(b, h) (((b) * 2 + (h)) * HTB)
#define PG8_SB(b, h) ((4 + (b) * 2 + (h)) * HTB)
#define PG8_STAGE(bufoff, gbase, voff) do { _Pragma("unroll") for (int _i = 0; _i < 2; ++_i) \
        __builtin_amdgcn_global_load_lds((const unsigned*)((const char*)(gbase) + (voff)[_i]), (LAS unsigned*)(lds + (bufoff) + ldsw + _i * 8192), 16, 0, 0); } while (0)
#define PG8_LDA(dst, b, h) do { _Pragma("unroll") for (int m = 0; m < 4; ++m) _Pragma("unroll") for (int k = 0; k < 2; ++k) dst[m][k] = *(const LAS bf16x8*)(lds + PG8_SA(b, h) + aoff + m * 2048 + k * 1024); } while (0)
#define PG8_LDB(dst, b, h) do { _Pragma("unroll") for (int n = 0; n < 2; ++n) _Pragma("unroll") for (int k = 0; k < 2; ++k) dst[n][k] = *(const LAS bf16x8*)(lds + PG8_SB(b, h) + boff + n * 2048 + k * 1024); } while (0)
#define PG8_MMA(ai, bj, At, Bt) do { __builtin_amdgcn_s_setprio(1); _Pragma("unroll") for (int m = 0; m < 4; ++m) _Pragma("unroll") for (int n = 0; n < 2; ++n) _Pragma("unroll") for (int k = 0; k < 2; ++k) \
        acc[ai][bj][m][n] = __builtin_amdgcn_mfma_f32_16x16x32_bf16(Bt[n][k], At[m][k], acc[ai][bj][m][n], 0, 0, 0); __builtin_amdgcn_s_setprio(0); } while (0)
#define PG8_WAIT_V(n) asm volatile("s_waitcnt vmcnt(" #n ")" ::: "memory")
#define PG8_WAIT_L(n) asm volatile("s_waitcnt lgkmcnt(" #n ")" ::: "memory")
#define PG8_BAR __builtin_amdgcn_s_barrier()
#define PG8_SCHED __builtin_amdgcn_sched_barrier(0)
    Unit cur, nxt; int ui = 0;
    if (!S.next(0, cur)) return;
    f32x4 acc[2][2][4][2];
#pragma unroll
    for (int a = 0; a < 2; ++a)
#pragma unroll
        for (int b = 0; b < 2; ++b)
#pragma unroll
            for (int m = 0; m < 4; ++m)
#pragma unroll
                for (int n = 0; n < 2; ++n) acc[a][b][m][n] = (f32x4){0.f, 0.f, 0.f, 0.f};
    bf16x8 At[4][2], B0[2][2], B1[2][2];
    const char* cA = (const char*)gA + (size_t)cur.pm * tstepA; const char* cB = (const char*)gBt + (size_t)cur.pn * tstepB;
    PG8_STAGE(PG8_SB(0, 0), cB, voffB); PG8_STAGE(PG8_SB(0, 1), cB + hstepB, voffB); PG8_STAGE(PG8_SA(0, 0), cA, voffA); PG8_STAGE(PG8_SA(0, 1), cA + hstepA, voffA);
    if (wr == 1) PG8_BAR;
    PG8_WAIT_V(2); PG8_BAR;
    PG8_STAGE(PG8_SB(1, 0), cB + kstep, voffB); PG8_STAGE(PG8_SA(1, 0), cA + kstep, voffA); PG8_STAGE(PG8_SB(1, 1), cB + hstepB + kstep, voffB);
    PG8_WAIT_V(6); PG8_BAR;
    for (;;) {
        const bool has_next = S.next(ui + 1, nxt);
        const char* nA = has_next ? (const char*)gA + (size_t)nxt.pm * tstepA : cA; const char* nB = has_next ? (const char*)gBt + (size_t)nxt.pn * tstepB : cB;
        for (int t = 0; t < nt; t += 2) {
            const bool last = (t == nt - 2);
            const char* a1 = cA + (size_t)(t + 1) * kstep;
            const char* a2 = last ? nA : cA + (size_t)(t + 2) * kstep; const char* b2 = last ? nB : cB + (size_t)(t + 2) * kstep;
            const char* a3 = a2 + kstep; const char* b3 = b2 + kstep;
            PG8_LDB(B0, 0, 0); PG8_LDB(B1, 0, 1); PG8_SCHED; PG8_LDA(At, 0, 0); PG8_STAGE(PG8_SA(1, 1), a1 + hstepA, voffA);
            PG8_WAIT_V(8); PG8_WAIT_L(0); PG8_BAR; PG8_MMA(0, 0, At, B0); PG8_MMA(0, 1, At, B1); PG8_BAR; PG8_SCHED;
            PG8_LDA(At, 0, 1); PG8_STAGE(PG8_SB(0, 0), b2, voffB); PG8_STAGE(PG8_SB(0, 1), b2 + hstepB, voffB); PG8_STAGE(PG8_SA(0, 0), a2, voffA);
            PG8_WAIT_V(8); PG8_WAIT_L(0); PG8_BAR; PG8_MMA(1, 0, At, B0); PG8_MMA(1, 1, At, B1); PG8_BAR; PG8_SCHED;
            PG8_LDB(B0, 1, 0); PG8_LDB(B1, 1, 1); PG8_SCHED; PG8_LDA(At, 1, 0); PG8_STAGE(PG8_SA(0, 1), a2 + hstepA, voffA);
            PG8_WAIT_V(8); PG8_WAIT_L(0); PG8_BAR; PG8_MMA(0, 0, At, B0); PG8_MMA(0, 1, At, B1); PG8_BAR; PG8_SCHED;
            PG8_LDA(At, 1, 1); PG8_STAGE(PG8_SB(1, 0), b3, voffB); PG8_STAGE(PG8_SB(1, 1), b3 + hstepB, voffB); PG8_STAGE(PG8_SA(1, 0), a3, voffA);
            PG8_WAIT_V(8); PG8_WAIT_L(0); PG8_BAR; PG8_MMA(1, 0, At, B0); PG8_MMA(1, 1, At, B1); PG8_BAR; PG8_SCHED;
        }
        if (wr == 0) PG8_BAR;
        E(acc, cur, wr, wc, fr, fq);
        if (!has_next) break;
#pragma unroll
        for (int a = 0; a < 2; ++a)
#pragma unroll
            for (int b = 0; b < 2; ++b)
#pragma unroll
                for (int m = 0; m < 4; ++m)
#pragma unroll
                    for (int n = 0; n < 2; ++n) acc[a][b][m][n] = (f32x4){0.f, 0.f, 0.f, 0.f};
        cur = nxt; cA = nA; cB = nB; ++ui;
        if (wr == 1) PG8_BAR;
    }
    PG8_WAIT_V(0);
    PG8_BAR;
#undef PG8_SA
#undef PG8_SB
#undef PG8_STAGE
#undef PG8_LDA
#undef PG8_LDB
#undef PG8_MMA
#undef PG8_WAIT_V
#undef PG8_WAIT_L
#undef PG8_BAR
#undef PG8_SCHED
}

struct EpiSwiglu {
    static constexpr bool PERM = true;
    bf16_t* O;
    __device__ __forceinline__ void operator()(const f32x4 (&acc)[2][2][4][2], const Unit& u, int wr, int wc, int fr, int fq) const {
        const int row0 = u.pm * BM + wr * 64 + fr, col0 = u.pn * HALF + wc * 32 + 8 * fq;
#pragma unroll
        for (int ai = 0; ai < 2; ++ai)
#pragma unroll
            for (int m = 0; m < 4; ++m) {
                const f32x4 g0 = acc[ai][0][m][0], g1 = acc[ai][0][m][1], u0 = acc[ai][1][m][0], u1 = acc[ai][1][m][1];
                u32x4 w;
                w.x = cvt_pk_bf16(silu_f(g0[0]) * u0[0], silu_f(g0[1]) * u0[1]); w.y = cvt_pk_bf16(silu_f(g0[2]) * u0[2], silu_f(g0[3]) * u0[3]);
                w.z = cvt_pk_bf16(silu_f(g1[0]) * u1[0], silu_f(g1[1]) * u1[1]); w.w = cvt_pk_bf16(silu_f(g1[2]) * u1[2], silu_f(g1[3]) * u1[3]);
                *(u32x4*)(O + (size_t)(row0 + ai * HALF + m * 16) * FF + col0) = w;
            }
    }
};
struct EpiResid {
    static constexpr bool PERM = false;
    float* X; float s;
    __device__ __forceinline__ void operator()(const f32x4 (&acc)[2][2][4][2], const Unit& u, int wr, int wc, int fr, int fq) const {
        const int row0 = u.pm * BM + wr * 64 + fr, col0 = u.pn * BM + wc * 32 + 4 * fq;
#pragma unroll
        for (int ai = 0; ai < 2; ++ai)
#pragma unroll
            for (int m = 0; m < 4; ++m) { float* rowp = X + (size_t)(row0 + ai * HALF + m * 16) * D + col0;
#pragma unroll
                for (int bj = 0; bj < 2; ++bj)
#pragma unroll
                    for (int n = 0; n < 2; ++n) { f32x4* p = (f32x4*)(rowp + bj * HALF + n * 16); *p = *p + acc[ai][bj][m][n] * s; } }
    }
};
struct EpiResidB {
    static constexpr bool PERM = true;
    bf16_t* XB; float s;
    __device__ __forceinline__ void operator()(const f32x4 (&acc)[2][2][4][2], const Unit& u, int wr, int wc, int fr, int fq) const {
        bf16_t* base = XB + (size_t)(u.pm * BM + wr * 64 + fr) * D + u.pn * BM + wc * 32 + 8 * fq;
        u32x4 x[8][2];
#pragma unroll
        for (int g = 0; g < 8; ++g)
#pragma unroll
            for (int bj = 0; bj < 2; ++bj) x[g][bj] = *(const u32x4*)(base + (size_t)((g >> 2) * HALF + (g & 3) * 16) * D + bj * HALF);
#pragma unroll
        for (int g = 0; g < 8; ++g) {
            const int ai = g >> 2, m = g & 3;
#pragma unroll
            for (int bj = 0; bj < 2; ++bj) { const f32x4 v0 = acc[ai][bj][m][0], v1 = acc[ai][bj][m][1]; const u32x4 xx = x[g][bj];
                u32x4 w;
                w.x = cvt_pk_bf16(bf_lo(xx.x) + v0.x * s, bf_hi(xx.x) + v0.y * s); w.y = cvt_pk_bf16(bf_lo(xx.y) + v0.z * s, bf_hi(xx.y) + v0.w * s);
                w.z = cvt_pk_bf16(bf_lo(xx.z) + v1.x * s, bf_hi(xx.z) + v1.y * s); w.w = cvt_pk_bf16(bf_lo(xx.w) + v1.z * s, bf_hi(xx.w) + v1.w * s);
                *(u32x4*)(base + (size_t)(ai * HALF + m * 16) * D + bj * HALF) = w; }
        }
    }
};
struct EpiFinal {
    static constexpr bool PERM = false;
    float* X; const bf16_t* XB; float s;
    __device__ __forceinline__ void operator()(const f32x4 (&acc)[2][2][4][2], const Unit& u, int wr, int wc, int fr, int fq) const {
        const size_t off = (size_t)(u.pm * BM + wr * 64 + fr) * D + u.pn * BM + wc * 32 + 4 * fq;
        u32x2 x[8][4];
#pragma unroll
        for (int g = 0; g < 8; ++g)
#pragma unroll
            for (int q = 0; q < 4; ++q) x[g][q] = *(const u32x2*)(XB + off + (size_t)((g >> 2) * HALF + (g & 3) * 16) * D + (q >> 1) * HALF + (q & 1) * 16);
#pragma unroll
        for (int g = 0; g < 8; ++g) {
            const int ai = g >> 2, m = g & 3;
            float* rowp = X + off + (size_t)(ai * HALF + m * 16) * D;
#pragma unroll
            for (int q = 0; q < 4; ++q) { const f32x4 a = acc[ai][q >> 1][m][q & 1];
                *(f32x4*)(rowp + (q >> 1) * HALF + (q & 1) * 16) = (f32x4){bf_lo(x[g][q].x) + a.x * s, bf_hi(x[g][q].x) + a.y * s, bf_lo(x[g][q].y) + a.z * s, bf_hi(x[g][q].y) + a.w * s}; }
        }
    }
};
struct EpiQKV {
    static constexpr bool PERM = true;
    bf16_t* O; const float* ct; const float* st; const float* gain; float* out;
    __device__ __forceinline__ void operator()(const f32x4 (&acc)[2][2][4][2], const Unit& u, int wr, int wc, int fr, int fq) const {
        const int head = u.pn * 4 + wc, which = head / 24, gh = head - which * 24, g = gh >> 3, h = gh & 7, d0 = 8 * fq;
        const int row0 = u.pm * BM + wr * 64 + fr;
        f32x4 ga0 = {1.f, 1.f, 1.f, 1.f}, ga1 = ga0, gb0 = ga0, gb1 = ga0;
        if (which < 2) { const float* gp = gain + which * 64 + d0; ga0 = *(const f32x4*)gp; ga1 = *(const f32x4*)(gp + 4); gb0 = *(const f32x4*)(gp + 32); gb1 = *(const f32x4*)(gp + 36); }
        const int keep = 128 << (2 * g);
        const size_t tbase = g == 0 ? O_KP0 : (g == 1 ? O_KP1 : O_KP2);
#pragma unroll
        for (int ai = 0; ai < 2; ++ai)
#pragma unroll
            for (int m = 0; m < 4; ++m) {
                const int row = row0 + ai * HALF + m * 16;
                f32x4 a0 = acc[ai][0][m][0], a1 = acc[ai][0][m][1], b0 = acc[ai][1][m][0], b1 = acc[ai][1][m][1];
                if (which < 2) {
                    float ss = ((a0.x * a0.x + a0.y * a0.y) + (a0.z * a0.z + a0.w * a0.w)) + ((a1.x * a1.x + a1.y * a1.y) + (a1.z * a1.z + a1.w * a1.w))
                             + ((b0.x * b0.x + b0.y * b0.y) + (b0.z * b0.z + b0.w * b0.w)) + ((b1.x * b1.x + b1.y * b1.y) + (b1.z * b1.z + b1.w * b1.w));
                    ss += __shfl_xor(ss, 16); ss += __shfl_xor(ss, 32);
                    const float r = 1.0f / sqrtf(ss * (1.0f / 64) + EPS);
                    const int pi = row & 2047;
                    const f32x4 c0 = *(const f32x4*)(ct + pi * 32 + d0), c1 = *(const f32x4*)(ct + pi * 32 + d0 + 4), s0 = *(const f32x4*)(st + pi * 32 + d0), s1 = *(const f32x4*)(st + pi * 32 + d0 + 4);
                    const f32x4 ya0 = a0 * r * ga0, ya1 = a1 * r * ga1, yb0 = b0 * r * gb0, yb1 = b1 * r * gb1;
                    a0 = ya0 * c0 - yb0 * s0; a1 = ya1 * c1 - yb1 * s1; b0 = yb0 * c0 + ya0 * s0; b1 = yb1 * c1 + ya1 * s1;
                }
                bf16_t* dst = O + (size_t)row * NQKV + head * 64 + d0;
                u32x4 w0, w1;
                w0.x = cvt_pk_bf16(a0.x, a0.y); w0.y = cvt_pk_bf16(a0.z, a0.w); w0.z = cvt_pk_bf16(a1.x, a1.y); w0.w = cvt_pk_bf16(a1.z, a1.w);
                w1.x = cvt_pk_bf16(b0.x, b0.y); w1.y = cvt_pk_bf16(b0.z, b0.w); w1.z = cvt_pk_bf16(b1.x, b1.y); w1.w = cvt_pk_bf16(b1.z, b1.w);
                *(u32x4*)dst = w0; *(u32x4*)(dst + 32) = w1;
                if (which >= 1) {
                    const int bb = row >> 11, tt = (row & 2047) - (SEQ - keep);
                    if (tt >= 0) { float* tp = out + tbase + ((((size_t)bb * keep + tt) * 2 + (which - 1)) * 8 + h) * 64 + d0;
                        *(f32x4*)tp = a0; *(f32x4*)(tp + 4) = a1; *(f32x4*)(tp + 32) = b0; *(f32x4*)(tp + 36) = b1; }
                }
            }
    }
};
template <int ACT> struct EpiBf16 {
    static constexpr bool PERM = true;
    bf16_t* O; int ldc;
    __device__ __forceinline__ void operator()(const f32x4 (&acc)[2][2][4][2], const Unit& u, int wr, int wc, int fr, int fq) const {
        const int row0 = u.pm * BM + wr * 64 + fr, col0 = u.pn * BM + wc * 32 + 8 * fq;
#pragma unroll
        for (int ai = 0; ai < 2; ++ai)
#pragma unroll
            for (int m = 0; m < 4; ++m) { bf16_t* rowp = O + (size_t)(row0 + ai * HALF + m * 16) * ldc + col0;
#pragma unroll
                for (int bj = 0; bj < 2; ++bj) { f32x4 v0 = acc[ai][bj][m][0], v1 = acc[ai][bj][m][1];
                    if (ACT == 1) {
#pragma unroll
                        for (int j = 0; j < 4; ++j) { v0[j] = gelu_tanh_f(v0[j]); v1[j] = gelu_tanh_f(v1[j]); } }
                    u32x4 w; w.x = cvt_pk_bf16(v0[0], v0[1]); w.y = cvt_pk_bf16(v0[2], v0[3]); w.z = cvt_pk_bf16(v1[0], v1[1]); w.w = cvt_pk_bf16(v1[2], v1[3]);
                    *(u32x4*)(rowp + bj * HALF) = w; } }
    }
};
}

#define MFMA32S(a, b, c) __builtin_amdgcn_mfma_f32_32x32x16_bf16((a), (b), (c), 0, 0, 0)
template <int MODE, int KSTEPS>
__device__ __forceinline__ void sample_gemm(LAS unsigned char* lds, const bf16_t* A, int lda, const bf16_t* Bt, int ldb, int K, int N, bf16_t* O, int ldc, const int tid, float* Xs = nullptr, float rs = 0.f) {
    const int lane = tid & 63, wave = __builtin_amdgcn_readfirstlane(tid >> 6), hh = lane >> 5;
    const int ntiles = 8 * (N / 32), kw = K / 8;
    LAS float* red = (LAS float*)lds;
    for (int tile = blockIdx.x; tile < ntiles; tile += gridDim.x) {
        const int rt = tile & 7, ct = tile >> 3;
        const bf16_t* ap = A + (size_t)(32 * rt + (lane & 31)) * lda + wave * kw + 8 * hh;
        int brow = 32 * ct + (lane & 31);
        if (MODE == 2) { const int h0 = 32 * ct; brow = (h0 >> 7) * 256 + (h0 & 127) + (lane & 31); }
        const bf16_t* bp = Bt + (size_t)brow * ldb + wave * kw + 8 * hh;
        f32x16 c0, c1;
#pragma unroll
        for (int i = 0; i < 16; ++i) { c0[i] = 0.f; c1[i] = 0.f; }
        constexpr int CH = KSTEPS > 11 ? KSTEPS / 2 : KSTEPS;
#pragma unroll
        for (int cb = 0; cb < KSTEPS; cb += CH) {
            bf16x8 af[CH], bfr[CH], b2f[CH];
#pragma unroll
            for (int i = 0; i < CH; ++i) { af[i] = *(const bf16x8*)(ap + 16 * (cb + i)); bfr[i] = *(const bf16x8*)(bp + 16 * (cb + i));
                if (MODE == 2) b2f[i] = *(const bf16x8*)(bp + (size_t)128 * ldb + 16 * (cb + i)); }
#pragma unroll
            for (int i = 0; i < CH; ++i) { c0 = MFMA32S(af[i], bfr[i], c0); if (MODE == 2) c1 = MFMA32S(af[i], b2f[i], c1); }
        }
        __syncthreads();
#pragma unroll
        for (int i = 0; i < 16; ++i) { red[((wave * 2 + 0) * 16 + i) * 64 + lane] = c0[i]; if (MODE == 2) red[((wave * 2 + 1) * 16 + i) * 64 + lane] = c1[i]; }
        __syncthreads();
#pragma unroll
        for (int r = 0; r < 2; ++r) {
            const int e = tid + 512 * r, i = e >> 6, l = e & 63;
            float s0 = 0.f, s1 = 0.f;
#pragma unroll
            for (int w = 0; w < 8; ++w) { s0 += red[((w * 2 + 0) * 16 + i) * 64 + l]; if (MODE == 2) s1 += red[((w * 2 + 1) * 16 + i) * 64 + l]; }
            const int row = 32 * rt + (i & 3) + 8 * (i >> 2) + 4 * (l >> 5);
            int col = 32 * ct + (l & 31);
            if (MODE == 3) col = (((ct >> 3) * 4 + (ct & 3)) * 64 + 32 * ((ct >> 2) & 1)) + (l & 31);
            const float v = MODE == 2 ? silu_f(s0) * s1 : (MODE == 1 ? gelu_tanh_f(s0) : s0);
            if (MODE == 5) { bf16_t* xp = O + (size_t)row * ldc + col; *xp = (bf16_t)(cvt_pk_bf16(__uint_as_float((unsigned)*xp << 16) + rs * s0, 0.f) & 0xffffu); }
            else if (MODE == 4) Xs[(size_t)row * ldc + col] = __uint_as_float((unsigned)O[(size_t)row * ldc + col] << 16) + 0.5f * s0;
            else O[(size_t)row * ldc + col] = (bf16_t)(cvt_pk_bf16(v, 0.f) & 0xffffu);
        }
    }
    __syncthreads();
}

struct Params { const float* in[16]; float* out; unsigned char* ws; int ph_lo, ph_hi; };

__device__ __forceinline__ void transpose_item(const float* W, int K, int N, bf16_t* WT, int k0, int n0, int drow0, LAS float* scr, int lane, int ldw) {
#pragma unroll 8
    for (int i = 0; i < 32; ++i) { const int kk = 2 * i + (lane >> 5); scr[kk * 33 + (lane & 31)] = W[(size_t)(k0 + kk) * N + n0 + (lane & 31)]; }
    asm volatile("s_waitcnt lgkmcnt(0)" ::: "memory");
    const int c = lane & 7;
#pragma unroll
    for (int j = 0; j < 4; ++j) { const int n = (lane >> 3) + 8 * j; const LAS float* s = scr + (8 * c) * 33 + n;
        u32x4 o; o.x = cvt_pk_bf16(s[0 * 33], s[1 * 33]); o.y = cvt_pk_bf16(s[2 * 33], s[3 * 33]); o.z = cvt_pk_bf16(s[4 * 33], s[5 * 33]); o.w = cvt_pk_bf16(s[6 * 33], s[7 * 33]);
        *(u32x4*)(WT + (size_t)(drow0 + n) * ldw + k0 + 8 * c) = o; }
    asm volatile("s_waitcnt lgkmcnt(0)" ::: "memory");
}
__device__ __forceinline__ void transpose_mat(const float* W, int K, int N, bf16_t* WT, int item, bool swiglu, LAS float* scr, int lane, int ldw = 0, bool qkvperm = false) {
    const int nblk = N / 32, kb = item / nblk, nb = item % nblk, n0 = 32 * nb;
    int drow0 = n0;
    if (swiglu) { const int up = n0 >= FF, nn = up ? n0 - FF : n0; drow0 = (nn >> 7) * 256 + (up ? 128 : 0) + (nn & 127); }
    if (qkvperm) { const int head = n0 >> 6, bj = (n0 >> 5) & 1; drow0 = (head >> 2) * 256 + bj * 128 + (head & 3) * 32; }
    transpose_item(W, K, N, WT, 64 * kb, n0, drow0, scr, lane, ldw ? ldw : K);
}
__constant__ double ROPE_INV[32] = {
    1.0, 0.7498942093324559, 0.5623413251903491, 0.4216965034285822, 0.31622776601683794, 0.23713737056616552, 0.1778279410038923, 0.1333521432163324,
    0.1, 0.07498942093324558, 0.05623413251903491, 0.042169650342858224, 0.03162277660168379, 0.023713737056616554, 0.01778279410038923, 0.01333521432163324,
    0.01, 0.007498942093324558, 0.005623413251903491, 0.004216965034285823, 0.0031622776601683794, 0.0023713737056616554, 0.0017782794100389228, 0.001333521432163324,
    0.001, 0.0007498942093324559, 0.0005623413251903491, 0.00042169650342858224, 0.00031622776601683794, 0.00023713737056616554, 0.00017782794100389227, 0.0001333521432163324};

__device__ __forceinline__ void norm_row0(const float* xrow, const float* g, bf16_t* orow, bf16_t* xb, int lane) {
    const f32x4* xr = (const f32x4*)xrow + lane;
    f32x4 v[4]; float ss = 0.f;
#pragma unroll
    for (int j = 0; j < 4; ++j) v[j] = xr[64 * j];
#pragma unroll
    for (int j = 0; j < 4; ++j) ss += (v[j].x * v[j].x + v[j].y * v[j].y) + (v[j].z * v[j].z + v[j].w * v[j].w);
    const float r = 1.0f / sqrtf(wave_sum(ss) * (1.0f / D) + EPS);
#pragma unroll
    for (int j = 0; j < 4; ++j) {
        const f32x4 gg = ((const f32x4*)g)[lane + 64 * j];
        u32x2 o; o.x = cvt_pk_bf16(v[j].x * r * gg.x, v[j].y * r * gg.y); o.y = cvt_pk_bf16(v[j].z * r * gg.z, v[j].w * r * gg.w);
        ((u32x2*)orow)[lane + 64 * j] = o;
        u32x2 xo; xo.x = cvt_pk_bf16(v[j].x, v[j].y); xo.y = cvt_pk_bf16(v[j].z, v[j].w);
        ((u32x2*)xb)[lane + 64 * j] = xo;
    }
}

__device__ __forceinline__ void phase_prologue(const Params& p, unsigned char* ws, float* out, LAS unsigned char* lds, const int tid) {
    const int lane = tid & 63, wave = tid >> 6;
    const int gw = blockIdx.x * 8 + wave, NGW = gridDim.x * 8;
    LAS float* scr = (LAS float*)(lds + wave * 8704);
    constexpr int I_IN = (D / 64) * (2 * FF / 32), I_OUT = (FF / 64) * (D / 32), I_QKV = (D / 64) * (NQKV / 32), I_OA = (AW / 64) * (D / 32), I_UV = (D / 64) * (NUV / 32), I_OB = (BW / 64) * (D / 32);
    constexpr int NITEMS = 4 * I_IN + 4 * I_OUT + I_QKV + I_OA + I_UV + I_OB;
    for (int it = gw; it < NITEMS; it += NGW) {
        int r = it;
        if (r < 4 * I_IN) { const int w = r / I_IN; transpose_mat(p.in[6] + (size_t)w * D * 2 * FF, D, 2 * FF, (bf16_t*)(ws + WS_WIN + w * SZ_WIN), r % I_IN, true, scr, lane); continue; } r -= 4 * I_IN;
        if (r < 4 * I_OUT) { const int w = r / I_OUT; transpose_mat(p.in[7] + (size_t)w * FF * D, FF, D, (bf16_t*)(ws + WS_WOUT + w * SZ_WOUT), r % I_OUT, false, scr, lane); continue; } r -= 4 * I_OUT;
        if (r < I_QKV) { transpose_mat(p.in[8], D, NQKV, (bf16_t*)(ws + WS_WQKV), r, false, scr, lane, 0, true); continue; } r -= I_QKV;
        if (r < I_OA) { transpose_mat(p.in[10], AW, D, (bf16_t*)(ws + WS_WOA), r, false, scr, lane); continue; } r -= I_OA;
        if (r < I_UV) { transpose_mat(p.in[11], D, NUV, (bf16_t*)(ws + WS_WUV), r, false, scr, lane); continue; } r -= I_UV;
        transpose_mat(p.in[15], BW, D, (bf16_t*)(ws + WS_WOB), r, false, scr, lane, LDU);
    }
    { bf16_t* wsp = (bf16_t*)(ws + WS_WSP); const float* src = p.in[13];
      for (int i = blockIdx.x * 512 + tid; i < 16 * 128 * 128 / 2; i += gridDim.x * 512) {
          const int e = 2 * i, s = e & 127, t = (e >> 7) & 127; const f32x2 v = *(const f32x2*)(src + e);
          ((unsigned*)wsp)[i] = cvt_pk_bf16(s <= t ? v.x : 0.f, (s + 1) <= t ? v.y : 0.f); } }
    { float* ct = (float*)(ws + WS_ROPE); float* st = ct + NPOS * 32;
      for (int i = blockIdx.x * 512 + tid; i < NPOS * 32; i += gridDim.x * 512) {
          const int pi = i >> 5, fi = i & 31; const double pos = (double)(pi < SEQ ? pi : PAST + (pi - SEQ));
          const double a = pos * ROPE_INV[fi]; const double n = __builtin_rint(a * 0.15915494309189535);
          const double r = (a - n * 6.283185307179586) - n * 2.4492935982947064e-16; const double r2 = r * r;
          double sn = 1.0, cs = 1.0;
#pragma unroll 1
          for (int k = 14; k >= 1; --k) { const double k2 = (double)(2 * k); sn = 1.0 - sn * r2 / (k2 * (k2 + 1.0)); cs = 1.0 - cs * r2 / ((k2 - 1.0) * k2); }
          ct[i] = (float)cs; st[i] = (float)(sn * r); } }
#ifdef NANFILL
    { u32x4* f = (u32x4*)(ws + WS_BIG); const size_t n = (WS_END - WS_BIG) / 16; const u32x4 q = {0xffffffffu, 0xffffffffu, 0xffffffffu, 0xffffffffu};
      for (size_t i = (size_t)blockIdx.x * 512 + tid; i < n; i += (size_t)gridDim.x * 512) f[i] = q;
      u32x4* fo = (u32x4*)(out + O_KP0); const size_t no = (O_VS + 524288 - O_KP0) / 4;
      for (size_t i = (size_t)blockIdx.x * 512 + tid; i < no; i += (size_t)gridDim.x * 512) fo[i] = q; }
#endif
    for (int m = gw; m < M; m += NGW) {
        const float* src = m < MP ? p.in[0] + (size_t)m * D : p.in[1] + (size_t)(m - MP) * D;
        norm_row0(src, p.in[5], (bf16_t*)(ws + WS_XN) + (size_t)m * D, (bf16_t*)(ws + WS_XB) + (size_t)m * D, lane);
    }
}

__device__ __forceinline__ void phase_norm(unsigned char* ws, float* out, const float* g, float sy, const int tid) {
    const int lane = tid & 63, wave = tid >> 6;
    const int gw = blockIdx.x * 8 + wave, NGW = gridDim.x * 8;
    bf16_t* XN = (bf16_t*)(ws + WS_XN); const bf16_t* XB = (const bf16_t*)(ws + WS_XB);
    for (int m0 = gw; m0 < M; m0 += 2 * NGW) {
        const int m1 = m0 + NGW; const bool two = m1 < M; const int mb = two ? m1 : m0;
        u32x2 xa[4], xb[4];
#pragma unroll
        for (int j = 0; j < 4; ++j) { xa[j] = ((const u32x2*)(XB + (size_t)m0 * D))[lane + 64 * j]; xb[j] = ((const u32x2*)(XB + (size_t)mb * D))[lane + 64 * j]; }
        f32x4 va[4], vb[4]; float sa = 0.f, sb = 0.f;
#pragma unroll
        for (int j = 0; j < 4; ++j) {
            va[j] = (f32x4){bf_lo(xa[j].x), bf_hi(xa[j].x), bf_lo(xa[j].y), bf_hi(xa[j].y)};
            vb[j] = (f32x4){bf_lo(xb[j].x), bf_hi(xb[j].x), bf_lo(xb[j].y), bf_hi(xb[j].y)};
            sa += (va[j].x * va[j].x + va[j].y * va[j].y) + (va[j].z * va[j].z + va[j].w * va[j].w);
            sb += (vb[j].x * vb[j].x + vb[j].y * vb[j].y) + (vb[j].z * vb[j].z + vb[j].w * vb[j].w);
        }
        const float ra = 1.0f / sqrtf(wave_sum(sa) * (1.0f / D) + EPS), rb = 1.0f / sqrtf(wave_sum(sb) * (1.0f / D) + EPS);
#pragma unroll
        for (int j = 0; j < 4; ++j) {
            const f32x4 gg = ((const f32x4*)g)[lane + 64 * j];
            u32x2 o; o.x = cvt_pk_bf16(va[j].x * ra * gg.x, va[j].y * ra * gg.y); o.y = cvt_pk_bf16(va[j].z * ra * gg.z, va[j].w * ra * gg.w);
            ((u32x2*)(XN + (size_t)m0 * D))[lane + 64 * j] = o;
            if (two) { u32x2 o2; o2.x = cvt_pk_bf16(vb[j].x * rb * gg.x, vb[j].y * rb * gg.y); o2.y = cvt_pk_bf16(vb[j].z * rb * gg.z, vb[j].w * rb * gg.w);
                ((u32x2*)(XN + (size_t)m1 * D))[lane + 64 * j] = o2; }
        }
    }
}

__device__ __forceinline__ void tail_store(float* out, int g, int h, int kv, int row, int i0, f32x4 a, f32x4 b) {
    float* dst;
    if (row < MP) {
        const int bb = row >> 11, t = row & 2047, keep = 128 << (2 * g), tt = t - (SEQ - keep);
        if (tt < 0) return;
        const size_t base = g == 0 ? O_KP0 : (g == 1 ? O_KP1 : O_KP2);
        dst = out + base + ((((size_t)bb * keep + tt) * 2 + kv) * 8 + h) * 64;
    } else {
        const int s = row - MP; const size_t base = g == 0 ? O_KS0 : (g == 1 ? O_KS1 : O_KS2);
        dst = out + base + (((size_t)s * 2 + kv) * 8 + h) * 64;
    }
    *(f32x4*)(dst + i0) = a; *(f32x4*)(dst + 32 + i0) = b;
}
__device__ __forceinline__ void phase_qknorm(const Params& p, unsigned char* ws, float* out, const int tid) {
    const int lane = tid & 63, wave = tid >> 6;
    const int gw = blockIdx.x * 8 + wave, NGW = gridDim.x * 8;
    bf16_t* QKV = (bf16_t*)(ws + WS_BIG);
    const float* ct = (const float*)(ws + WS_ROPE); const float* st = ct + NPOS * 32;
    const int sub = lane & 7, i0 = 4 * sub;
    for (int it = MP * 9 + gw; it < M * 9; it += NGW) {
        const int row = it / 9, s9 = it - row * 9;
        if (s9 < 6) {
            const int head = s9 * 8 + (lane >> 3), isk = head >= 24, gh = isk ? head - 24 : head, g = gh >> 3, h = gh & 7;
            bf16_t* ptr = QKV + (size_t)row * NQKV + head * 64;
            const u32x2 ra = *(const u32x2*)(ptr + i0), rb = *(const u32x2*)(ptr + 32 + i0);
            f32x4 x1 = {bf_lo(ra.x), bf_hi(ra.x), bf_lo(ra.y), bf_hi(ra.y)}, x2 = {bf_lo(rb.x), bf_hi(rb.x), bf_lo(rb.y), bf_hi(rb.y)};
            float ss = (x1.x * x1.x + x1.y * x1.y) + (x1.z * x1.z + x1.w * x1.w) + (x2.x * x2.x + x2.y * x2.y) + (x2.z * x2.z + x2.w * x2.w);
            ss += __shfl_xor(ss, 1); ss += __shfl_xor(ss, 2); ss += __shfl_xor(ss, 4);
            const float r = 1.0f / sqrtf(ss * (1.0f / 64) + EPS);
            const float* gain = p.in[9] + isk * 64;
            const f32x4 g1 = *(const f32x4*)(gain + i0), g2 = *(const f32x4*)(gain + 32 + i0);
            const int pi = row < MP ? (row & 2047) : SEQ + ((row - MP) & 7);
            const f32x4 c = *(const f32x4*)(ct + pi * 32 + i0), s = *(const f32x4*)(st + pi * 32 + i0);
            const f32x4 y1 = x1 * r * g1, y2 = x2 * r * g2;
            const f32x4 o1 = y1 * c - y2 * s, o2 = y2 * c + y1 * s;
            u32x2 wa, wb; wa.x = cvt_pk_bf16(o1.x, o1.y); wa.y = cvt_pk_bf16(o1.z, o1.w); wb.x = cvt_pk_bf16(o2.x, o2.y); wb.y = cvt_pk_bf16(o2.z, o2.w);
            *(u32x2*)(ptr + i0) = wa; *(u32x2*)(ptr + 32 + i0) = wb;
            if (isk) tail_store(out, g, h, 0, row, i0, o1, o2);
        } else {
            const int vh = (s9 - 6) * 8 + (lane >> 3), g = vh >> 3, h = vh & 7;
            const bf16_t* ptr = QKV + (size_t)row * NQKV + 3072 + vh * 64;
            const u32x2 ra = *(const u32x2*)(ptr + i0), rb = *(const u32x2*)(ptr + 32 + i0);
            const f32x4 x1 = {bf_lo(ra.x), bf_hi(ra.x), bf_lo(ra.y), bf_hi(ra.y)}, x2 = {bf_lo(rb.x), bf_hi(rb.x), bf_lo(rb.y), bf_hi(rb.y)};
            tail_store(out, g, h, 1, row, i0, x1, x2);
        }
    }
}

#define MFMA32(a, b, c) __builtin_amdgcn_mfma_f32_32x32x16_bf16((a), (b), (c), 0, 0, 0)
__device__ __forceinline__ s16x4 tr_read(unsigned lds_addr) { return __builtin_amdgcn_ds_read_tr16_b64_v4i16((LAS s16x4*)(uintptr_t)lds_addr); }
__device__ __forceinline__ bf16x8 pack8(const f32x16& x, int s) {
    u32x4 pk;
    pk.x = cvt_pk_bf16(x[8 * s + 0], x[8 * s + 1]); pk.y = cvt_pk_bf16(x[8 * s + 2], x[8 * s + 3]); pk.z = cvt_pk_bf16(x[8 * s + 4], x[8 * s + 5]); pk.w = cvt_pk_bf16(x[8 * s + 6], x[8 * s + 7]);
    return __builtin_bit_cast(bf16x8, pk);
}
__device__ __forceinline__ void attn_prompt_tile(const bf16_t* QKV, bf16_t* OG, float* LSE, LAS unsigned char* vl, int g, int b, int h, int w, int lane) {
    const int dsh = 2 * g, d = 1 << dsh;
    const int tpr_sh = 6 - dsh;
    const int r = w >> tpr_sh, jt = w & ((1 << tpr_sh) - 1), j0 = jt * 32;
    const int q = lane & 31, hh = lane >> 5;
    const size_t rowb = (size_t)b * SEQ;
    const int qcol = g * 512 + h * 64, kcol = 1536 + qcol, vcol = 3072 + qcol;
    const int tq = ((j0 + q) << dsh) + r;
    const bf16_t* qp = QKV + (rowb + tq) * NQKV + qcol + 8 * hh;
    bf16x8 qf[4];
#pragma unroll
    for (int s = 0; s < 4; ++s) qf[s] = *(const bf16x8*)(qp + 16 * s);
    const int kb0 = jt >= 4 ? 0 : 4 - jt;
    f32x16 S[5];
    float mx = -INFINITY;
    bf16x8 kfa[5][4];
#pragma unroll
    for (int kb = 0; kb < 5; ++kb) {
        int jk = j0 - 128 + kb * 32 + q; jk = jk < 0 ? 0 : jk;
        const bf16_t* kp = QKV + (rowb + (size_t)((jk << dsh) + r)) * NQKV + kcol + 8 * hh;
#pragma unroll
        for (int s = 0; s < 4; ++s) kfa[kb][s] = *(const bf16x8*)(kp + 16 * s);
    }
#pragma unroll
    for (int kb = 0; kb < 5; ++kb) {
        f32x16 c;
#pragma unroll
        for (int i = 0; i < 16; ++i) c[i] = 0.f;
#pragma unroll
        for (int s = 0; s < 4; ++s) c = MFMA32(kfa[kb][s], qf[s], c);
#pragma unroll
        for (int i = 0; i < 16; ++i) {
            const int ki = (i & 3) + 8 * (i >> 2) + 4 * hh;
            bool valid = kb >= kb0;
            if (kb == 0) valid = valid && (ki >= q);
            if (kb == 4) valid = valid && (ki <= q);
            const float sv = valid ? c[i] * 0.125f : -INFINITY;
            c[i] = sv; mx = fmaxf(mx, sv);
        }
        S[kb] = c;
    }
    bf16x8 vva[5][4];
#pragma unroll
    for (int kb = 0; kb < 5; ++kb)
#pragma unroll
        for (int c4 = 0; c4 < 4; ++c4) {
            const int i = c4 * 8 + (lane >> 3); int jk = j0 - 128 + kb * 32 + i; jk = jk < 0 ? 0 : jk;
            vva[kb][c4] = *(const bf16x8*)(QKV + (rowb + (size_t)((jk << dsh) + r)) * NQKV + vcol + (lane & 7) * 8);
        }
    mx = fmaxf(mx, __shfl_xor(mx, 32));
    float l = 0.f;
#pragma unroll
    for (int kb = 0; kb < 5; ++kb)
#pragma unroll
        for (int i = 0; i < 16; ++i) { const float e = __expf(S[kb][i] - mx); S[kb][i] = e; l += e; }
    l += __shfl_xor(l, 32);
    const float inv = 1.0f / l;
    f32x16 o0, o1;
#pragma unroll
    for (int i = 0; i < 16; ++i) { o0[i] = 0.f; o1[i] = 0.f; }
    const unsigned vbase = (unsigned)(uintptr_t)vl;
    const unsigned tr_off = (unsigned)((4 * hh + ((lane & 15) >> 2)) * 144 + ((lane >> 4) & 1) * 32 + 8 * (lane & 3));
#pragma unroll
    for (int kb = 0; kb < 5; ++kb) {
        {
#pragma unroll
            for (int c4 = 0; c4 < 4; ++c4) *(LAS bf16x8*)(vl + (c4 * 8 + (lane >> 3)) * 144 + (lane & 7) * 16) = vva[kb][c4];
#pragma unroll
            for (int s2 = 0; s2 < 2; ++s2) {
                f32x16 pn = S[kb];
#pragma unroll
                for (int i = 0; i < 16; ++i) pn[i] *= inv;
                const bf16x8 pb = pack8(pn, s2);
#pragma unroll
                for (int nb = 0; nb < 2; ++nb) {
                    const unsigned a0 = vbase + tr_off + (unsigned)(16 * s2 * 144 + nb * 64);
                    const s16x4 lo = tr_read(a0), hi = tr_read(a0 + 8 * 144);
                    const bf16x8 va = __builtin_shufflevector(lo, hi, 0, 1, 2, 3, 4, 5, 6, 7);
                    if (nb == 0) o0 = MFMA32(va, pb, o0); else o1 = MFMA32(va, pb, o1);
                }
            }
        }
    }
    const size_t orow = (size_t)g * M + rowb + tq;
    bf16_t* op = OG + orow * AW + h * 64 + 4 * hh;
#pragma unroll
    for (int g4 = 0; g4 < 4; ++g4) {
        u32x2 w0, w1;
        w0.x = cvt_pk_bf16(o0[4 * g4], o0[4 * g4 + 1]); w0.y = cvt_pk_bf16(o0[4 * g4 + 2], o0[4 * g4 + 3]);
        w1.x = cvt_pk_bf16(o1[4 * g4], o1[4 * g4 + 1]); w1.y = cvt_pk_bf16(o1[4 * g4 + 2], o1[4 * g4 + 3]);
        *(u32x2*)(op + 8 * g4) = w0; *(u32x2*)(op + 32 + 8 * g4) = w1;
    }
    if (hh == 0) LSE[orow * 8 + h] = mx + __logf(l);
}
__device__ __forceinline__ void attn_sample_item(const Params& p, unsigned char* ws, int item, LAS float* sc, int lane) {
    const int j = item & 7, h = (item >> 3) & 7, gb = item >> 6, g = gb % 3, b = gb / 3;
    const int dsh = 2 * g, L = 128 << dsh;
    const float* cache = (g == 0 ? p.in[2] : (g == 1 ? p.in[3] : p.in[4])) + (size_t)b * L * 1024;
    const bf16_t* QKV = (const bf16_t*)(ws + WS_BIG);
    const int row = MP + b * 8 + j;
    const int sub = lane & 15, ks = lane >> 4;
    const int qcol = g * 512 + h * 64 + 4 * sub;
    const u32x2 qr = *(const u32x2*)(QKV + (size_t)row * NQKV + qcol);
    const f32x4 qv = {bf_lo(qr.x), bf_hi(qr.x), bf_lo(qr.y), bf_hi(qr.y)};
#pragma unroll 11
    for (int it = 0; it < 33; ++it) {
        const int i = it * 4 + ks;
        float dot = 0.f;
        if (i <= 128) {
            const int idx = L + j - (i << dsh);
            f32x4 kv;
            if (idx >= L) { const u32x2 kr = *(const u32x2*)(QKV + (size_t)(MP + b * 8 + (idx - L)) * NQKV + 1536 + qcol); kv = (f32x4){bf_lo(kr.x), bf_hi(kr.x), bf_lo(kr.y), bf_hi(kr.y)}; }
            else kv = *(const f32x4*)(cache + (size_t)idx * 1024 + h * 64 + 4 * sub);
            dot = (qv.x * kv.x + qv.y * kv.y) + (qv.z * kv.z + qv.w * kv.w);
        }
        dot += __shfl_xor(dot, 1); dot += __shfl_xor(dot, 2); dot += __shfl_xor(dot, 4); dot += __shfl_xor(dot, 8);
        if (sub == 0 && i <= 128) sc[i] = dot * 0.125f;
    }
    asm volatile("s_waitcnt lgkmcnt(0)" ::: "memory");
    float mx = fmaxf(sc[lane], sc[lane + 64]); if (lane == 0) mx = fmaxf(mx, sc[128]);
    mx = wave_max(mx);
    float l = __expf(sc[lane] - mx) + __expf(sc[lane + 64] - mx); if (lane == 0) l += __expf(sc[128] - mx);
    l = wave_sum(l);
    const float inv = 1.0f / l;
    f32x4 acc = {0.f, 0.f, 0.f, 0.f};
#pragma unroll 11
    for (int it = 0; it < 33; ++it) {
        const int i = it * 4 + ks;
        if (i <= 128) {
            const float pw = __expf(sc[i] - mx) * inv;
            const int idx = L + j - (i << dsh);
            f32x4 vv;
            if (idx >= L) { const u32x2 vr = *(const u32x2*)(QKV + (size_t)(MP + b * 8 + (idx - L)) * NQKV + 3072 + qcol); vv = (f32x4){bf_lo(vr.x), bf_hi(vr.x), bf_lo(vr.y), bf_hi(vr.y)}; }
            else vv = *(const f32x4*)(cache + (size_t)idx * 1024 + 512 + h * 64 + 4 * sub);
            acc += vv * pw;
        }
    }
#pragma unroll
    for (int k = 0; k < 4; ++k) { acc[k] += __shfl_xor(acc[k], 16); acc[k] += __shfl_xor(acc[k], 32); }
    const size_t orow = (size_t)g * M + row;
    if (ks == 0) { u32x2 w; w.x = cvt_pk_bf16(acc.x, acc.y); w.y = cvt_pk_bf16(acc.z, acc.w); *(u32x2*)((bf16_t*)(ws + WS_OG) + orow * AW + h * 64 + 4 * sub) = w; }
    if (lane == 0) ((float*)(ws + WS_LSE))[orow * 8 + h] = mx + __logf(l);
    asm volatile("s_waitcnt lgkmcnt(0)" ::: "memory");
}
__device__ __forceinline__ void attn_prompt_block(const bf16_t* QKV, bf16_t* OG, float* LSE, LAS unsigned char* lds, int g, int b, int h, int w8, const int tid) {
    const int lane = tid & 63, wave = __builtin_amdgcn_readfirstlane(tid >> 6);
    const int dsh = 2 * g, tpr_sh = 6 - dsh;
    const size_t rowb = (size_t)b * SEQ;
    const int qcol = g * 512 + h * 64, kcol = 1536 + qcol, vcol = 3072 + qcol;
    LAS unsigned char* Kl = lds; LAS unsigned char* Vl = lds + 55296;
    const int w = w8 * 8 + wave, r = w >> tpr_sh, jt = w & ((1 << tpr_sh) - 1), j0 = jt * 32;
    const int q = lane & 31, hh = lane >> 5;
    const int tq = ((j0 + q) << dsh) + r;
    const bf16_t* qp = QKV + (rowb + tq) * NQKV + qcol + 8 * hh;
    bf16x8 qf[4];
#pragma unroll
    for (int s = 0; s < 4; ++s) qf[s] = *(const bf16x8*)(qp + 16 * s);
    __syncthreads();
    {
        bf16x8 kr[6], vr[6];
#pragma unroll
        for (int i = 0; i < 6; ++i) {
            const int p = tid + 512 * i, sl = p >> 3, c = p & 7;
            int j, rr; bool valid;
            if (g == 2) { valid = sl < 256; j = sl & 127; rr = 2 * w8 + (sl >> 7); }
            else if (g == 1) { j = 256 * (w8 & 1) - 128 + sl; rr = w8 >> 1; valid = j >= 0; }
            else { j = 256 * w8 - 128 + sl; rr = 0; valid = j >= 0; }
            j = valid ? j : 0;
            const bf16_t* src = QKV + (rowb + (size_t)((j << dsh) + rr)) * NQKV + c * 8;
            kr[i] = *(const bf16x8*)(src + kcol); vr[i] = *(const bf16x8*)(src + vcol);
        }
#pragma unroll
        for (int i = 0; i < 6; ++i) {
            const int p = tid + 512 * i, sl = p >> 3, c = p & 7;
            *(LAS bf16x8*)(Kl + sl * 144 + c * 16) = kr[i]; *(LAS bf16x8*)(Vl + sl * 144 + c * 16) = vr[i];
        }
    }
    __syncthreads();
    const int jstart = g == 2 ? -128 * (wave >> 2) : (g == 1 ? 256 * (w8 & 1) - 128 : 256 * w8 - 128);
    const int kb0 = jt >= 4 ? 0 : 4 - jt;
    f32x16 S[5];
    float mx = -INFINITY;
#pragma unroll
    for (int kb = 0; kb < 5; ++kb) {
        f32x16 c;
#pragma unroll
        for (int i = 0; i < 16; ++i) c[i] = 0.f;
        const int jb = j0 - 128 + kb * 32;
        const int slot = jb < 0 ? -jstart : jb - jstart + q;
        bf16x8 kf[4];
#pragma unroll
        for (int s = 0; s < 4; ++s) kf[s] = *(const LAS bf16x8*)(Kl + slot * 144 + s * 32 + hh * 16);
#pragma unroll
        for (int s = 0; s < 4; ++s) c = MFMA32(kf[s], qf[s], c);
#pragma unroll
        for (int i = 0; i < 16; ++i) {
            const int ki = (i & 3) + 8 * (i >> 2) + 4 * hh;
            bool valid = kb >= kb0;
            if (kb == 0) valid = valid && (ki >= q);
            if (kb == 4) valid = valid && (ki <= q);
            const float sv = valid ? c[i] * 0.125f : -INFINITY;
            c[i] = sv; mx = fmaxf(mx, sv);
        }
        S[kb] = c;
    }
    mx = fmaxf(mx, __shfl_xor(mx, 32));
    float l = 0.f;
#pragma unroll
    for (int kb = 0; kb < 5; ++kb)
#pragma unroll
        for (int i = 0; i < 16; ++i) { const float e = __expf(S[kb][i] - mx); S[kb][i] = e; l += e; }
    l += __shfl_xor(l, 32);
    const float inv = 1.0f / l;
    f32x16 o0, o1;
#pragma unroll
    for (int i = 0; i < 16; ++i) { o0[i] = 0.f; o1[i] = 0.f; }
    const unsigned vbase = (unsigned)(uintptr_t)Vl;
    const int trrow = 4 * hh + ((lane & 15) >> 2);
    const unsigned trcol = (unsigned)(((lane >> 4) & 1) * 32 + 8 * (lane & 3));
#pragma unroll
    for (int kb = 0; kb < 5; ++kb) {
        const int jb = j0 - 128 + kb * 32;
        const int sbase = jb < 0 ? -jstart : jb - jstart, sstr = jb < 0 ? 0 : 144;
#pragma unroll
        for (int s2 = 0; s2 < 2; ++s2) {
            f32x16 pn = S[kb];
#pragma unroll
            for (int i = 0; i < 16; ++i) pn[i] *= inv;
            const bf16x8 pb = pack8(pn, s2);
#pragma unroll
            for (int nb = 0; nb < 2; ++nb) {
                const unsigned a0 = vbase + (unsigned)(sbase * 144 + (16 * s2 + trrow) * sstr) + trcol + (unsigned)(nb * 64);
                const s16x4 lo = tr_read(a0), hi = tr_read(a0 + (unsigned)(8 * sstr));
                const bf16x8 va = __builtin_shufflevector(lo, hi, 0, 1, 2, 3, 4, 5, 6, 7);
                if (nb == 0) o0 = MFMA32(va, pb, o0); else o1 = MFMA32(va, pb, o1);
            }
        }
    }
    const size_t orow = (size_t)g * M + rowb + tq;
    bf16_t* op = OG + orow * AW + h * 64 + 4 * hh;
#pragma unroll
    for (int g4 = 0; g4 < 4; ++g4) {
        u32x2 w0, w1;
        w0.x = cvt_pk_bf16(o0[4 * g4], o0[4 * g4 + 1]); w0.y = cvt_pk_bf16(o0[4 * g4 + 2], o0[4 * g4 + 3]);
        w1.x = cvt_pk_bf16(o1[4 * g4], o1[4 * g4 + 1]); w1.y = cvt_pk_bf16(o1[4 * g4 + 2], o1[4 * g4 + 3]);
        *(u32x2*)(op + 8 * g4) = w0; *(u32x2*)(op + 32 + 8 * g4) = w1;
    }
    if (hh == 0) LSE[orow * 8 + h] = mx + __logf(l);
}
__device__ __forceinline__ void phase_attn(const Params& p, unsigned char* ws, LAS unsigned char* lds, const int tid) {
    const int lane = tid & 63, wave = __builtin_amdgcn_readfirstlane(tid >> 6);
    LAS unsigned char* vl = lds + wave * 4608;
    constexpr int NS = 768, NP = 3072;
    for (int bi = blockIdx.x; bi < NS; bi += gridDim.x) attn_sample_item(p, ws, bi * 8 + wave, (LAS float*)vl, lane);
    for (int x = blockIdx.x; x < NP; x += gridDim.x) {
        const int w8 = x & 7, h = (x >> 3) & 7, b = (x >> 6) & 15, g = x >> 10;
        attn_prompt_block((const bf16_t*)(ws + WS_BIG), (bf16_t*)(ws + WS_OG), (float*)(ws + WS_LSE), lds, g, b, h, w8, tid);
    }
    __syncthreads();
}
__device__ __forceinline__ void phase_merge(unsigned char* ws, const int tid) {
    const bf16_t* OG = (const bf16_t*)(ws + WS_OG); const float* LSE = (const float*)(ws + WS_LSE); bf16_t* AO = (bf16_t*)(ws + WS_AO);
    for (int e = blockIdx.x * 512 + tid; e < M * 64; e += gridDim.x * 512) {
        const int rh = e >> 3, c8 = e & 7;
        const float l0 = LSE[rh], l1 = LSE[(size_t)M * 8 + rh], l2 = LSE[(size_t)2 * M * 8 + rh];
        const float mx = fmaxf(l0, fmaxf(l1, l2));
        float w0 = __expf(l0 - mx), w1 = __expf(l1 - mx), w2 = __expf(l2 - mx); const float inv = 1.0f / (w0 + w1 + w2); w0 *= inv; w1 *= inv; w2 *= inv;
        const size_t off = (size_t)rh * 64 + c8 * 8;
        const u32x4 a = *(const u32x4*)(OG + off), b = *(const u32x4*)(OG + (size_t)M * AW + off), c = *(const u32x4*)(OG + (size_t)2 * M * AW + off);
        u32x4 o;
#pragma unroll
        for (int k = 0; k < 4; ++k) o[k] = cvt_pk_bf16(w0 * bf_lo(a[k]) + w1 * bf_lo(b[k]) + w2 * bf_lo(c[k]), w0 * bf_hi(a[k]) + w1 * bf_hi(b[k]) + w2 * bf_hi(c[k]));
        *(u32x4*)(AO + off) = o;
    }
}

__device__ __forceinline__ void phase_vnorm(const Params& p, unsigned char* ws, float* out, const int tid) {
    const int lane = tid & 63, wave = tid >> 6;
    const int gw = blockIdx.x * 8 + wave, NGW = gridDim.x * 8;
    const bf16_t* UV = (const bf16_t*)(ws + WS_BIG); float* RV = (float*)(ws + WS_RV);
    for (int m = gw; m < M; m += NGW) {
        const u32x4* vr = (const u32x4*)(UV + (size_t)m * NUV + BW) + lane;
        u32x4 v[4]; float ss = 0.f;
#pragma unroll
        for (int j = 0; j < 4; ++j) { v[j] = vr[64 * j];
#pragma unroll
            for (int k = 0; k < 4; ++k) { const float a = bf_lo(v[j][k]), b = bf_hi(v[j][k]); ss += a * a + b * b; } }
        const float r = 1.0f / sqrtf(wave_sum(ss) * (1.0f / BW) + EPS);
        if (lane == 0) RV[m] = r;
        if (m >= MP) {
            float* dst = out + O_VS + (size_t)(m - MP) * BW;
#pragma unroll
            for (int j = 0; j < 4; ++j) { const int c0 = 8 * (lane + 64 * j); const f32x4 ga = *(const f32x4*)(p.in[12] + c0), gb = *(const f32x4*)(p.in[12] + c0 + 4);
                *(f32x4*)(dst + c0) = (f32x4){bf_lo(v[j][0]) * r * ga.x, bf_hi(v[j][0]) * r * ga.y, bf_lo(v[j][1]) * r * ga.z, bf_hi(v[j][1]) * r * ga.w};
                *(f32x4*)(dst + c0 + 4) = (f32x4){bf_lo(v[j][2]) * r * gb.x, bf_hi(v[j][2]) * r * gb.y, bf_lo(v[j][3]) * r * gb.z, bf_hi(v[j][3]) * r * gb.w}; }
        }
    }
}
__device__ __forceinline__ void spatial_item(const Params& p, unsigned char* ws, LAS unsigned char* lds, int chunk, int gi, const int tid) {
    const bf16_t* UV = (const bf16_t*)(ws + WS_BIG); const float* RV = (const float*)(ws + WS_RV); bf16_t* UM = (bf16_t*)(ws + WS_UM);
    const bf16_t* WSP = (const bf16_t*)(ws + WS_WSP);
    constexpr int PITCH = 272;
    const int lane = tid & 63, wave = __builtin_amdgcn_readfirstlane(tid >> 6), tb = wave & 3, ch = wave >> 2, hh = lane >> 5;
    const int t = 32 * tb + (lane & 31);
    const bf16_t* wp = WSP + ((size_t)gi * 128 + t) * 128 + 8 * hh;
    bf16x8 wfa[8];
#pragma unroll
    for (int ks = 0; ks < 8; ++ks) wfa[ks] = *(const bf16x8*)(wp + 16 * ks);
    const size_t row = (size_t)chunk * 128 + t;
    const int colb = gi * 128 + 64 * ch;
    const bf16_t* up = UV + row * NUV + colb + 4 * hh;
    u32x2 ur[8];
#pragma unroll
    for (int k = 0; k < 8; ++k) ur[k] = *(const u32x2*)(up + 32 * (k >> 2) + 8 * (k & 3));
    const float bias = p.in[14][gi * 128 + t];
    __syncthreads();
#pragma unroll
    for (int k = 0; k < 4; ++k) {
        const int pc = tid + 512 * k, sr = pc >> 4, c16 = pc & 15;
        const u32x4 raw = *(const u32x4*)(UV + (size_t)(chunk * 128 + sr) * NUV + BW + gi * 128 + c16 * 8);
        const float rv = RV[chunk * 128 + sr];
        const f32x4 ga = *(const f32x4*)(p.in[12] + gi * 128 + c16 * 8), gb = *(const f32x4*)(p.in[12] + gi * 128 + c16 * 8 + 4);
        u32x4 o;
        o.x = cvt_pk_bf16(bf_lo(raw.x) * rv * ga.x, bf_hi(raw.x) * rv * ga.y); o.y = cvt_pk_bf16(bf_lo(raw.y) * rv * ga.z, bf_hi(raw.y) * rv * ga.w);
        o.z = cvt_pk_bf16(bf_lo(raw.z) * rv * gb.x, bf_hi(raw.z) * rv * gb.y); o.w = cvt_pk_bf16(bf_lo(raw.w) * rv * gb.z, bf_hi(raw.w) * rv * gb.w);
        *(LAS u32x4*)(lds + sr * PITCH + c16 * 16) = o;
    }
    __syncthreads();
    f32x16 a0, a1;
#pragma unroll
    for (int i = 0; i < 16; ++i) { a0[i] = 0.f; a1[i] = 0.f; }
    const unsigned lbase = (unsigned)(uintptr_t)lds;
    const unsigned tr_off = (unsigned)((8 * hh + ((lane & 15) >> 2)) * PITCH + (64 * ch + 16 * ((lane >> 4) & 1)) * 2 + 8 * (lane & 3));
#pragma unroll
    for (int ks = 0; ks < 8; ++ks) {
        if (ks < 2 * (tb + 1)) {
#pragma unroll
            for (int cb = 0; cb < 2; ++cb) {
                const unsigned a = lbase + tr_off + (unsigned)(16 * ks * PITCH + cb * 64);
                const s16x4 lo = tr_read(a), hi = tr_read(a + 4 * PITCH);
                const bf16x8 va = __builtin_shufflevector(lo, hi, 0, 1, 2, 3, 4, 5, 6, 7);
                if (cb == 0) a0 = MFMA32(va, wfa[ks], a0); else a1 = MFMA32(va, wfa[ks], a1);
            }
        }
    }
    bf16_t* op = UM + row * LDU + colb + 4 * hh;
#pragma unroll
    for (int cb = 0; cb < 2; ++cb)
#pragma unroll
        for (int g4 = 0; g4 < 4; ++g4) {
            const u32x2 uu = ur[cb * 4 + g4];
            const f32x16& a = cb == 0 ? a0 : a1;
            u32x2 w;
            w.x = cvt_pk_bf16(bf_lo(uu.x) * (a[4 * g4] + bias), bf_hi(uu.x) * (a[4 * g4 + 1] + bias));
            w.y = cvt_pk_bf16(bf_lo(uu.y) * (a[4 * g4 + 2] + bias), bf_hi(uu.y) * (a[4 * g4 + 3] + bias));
            *(u32x2*)(op + 32 * cb + 8 * g4) = w;
        }
}
__device__ __forceinline__ void phase_spatial(const Params& p, unsigned char* ws, LAS unsigned char* lds, const int tid) {
    const int lane = tid & 63, wave = __builtin_amdgcn_readfirstlane(tid >> 6);
    const bf16_t* UV = (const bf16_t*)(ws + WS_BIG); const float* RV = (const float*)(ws + WS_RV); bf16_t* UM = (bf16_t*)(ws + WS_UM);
    const float* vgain = p.in[12]; const float* bsp = p.in[14];
    constexpr int NPI = 256 * 16, NSI = 256;
    LAS unsigned char* vl = lds + wave * 4608;
    for (int it = blockIdx.x; it < NPI + NSI; it += gridDim.x) {
        if (it < NPI) spatial_item(p, ws, lds, it >> 4, it & 15, tid);
        else {
            const int e = (it - NPI) * 512 + tid;
            const int c4 = e & 511, bt = e >> 9, t = bt & 7, b = bt >> 3, c0 = 4 * c4, gi = c0 >> 7;
            f32x4 acc = {0.f, 0.f, 0.f, 0.f};
            const f32x4 vg = *(const f32x4*)(vgain + c0);
            for (int s = 0; s <= t; ++s) {
                const size_t r = (size_t)MP + b * 8 + s;
                const u32x2 vr = *(const u32x2*)(UV + r * NUV + BW + c0);
                const float wv = p.in[13][((size_t)gi * 128 + t) * 128 + s] * RV[r];
                acc += (f32x4){bf_lo(vr.x), bf_hi(vr.x), bf_lo(vr.y), bf_hi(vr.y)} * wv;
            }
            const float bias = bsp[gi * 128 + t];
            const size_t r = (size_t)MP + b * 8 + t;
            const u32x2 ur = *(const u32x2*)(UV + r * NUV + c0);
            u32x2 w;
            w.x = cvt_pk_bf16(bf_lo(ur.x) * (acc.x * vg.x + bias), bf_hi(ur.x) * (acc.y * vg.y + bias));
            w.y = cvt_pk_bf16(bf_lo(ur.y) * (acc.z * vg.z + bias), bf_hi(ur.y) * (acc.w * vg.w + bias));
            *(u32x2*)(UM + r * LDU + c0) = w;
        }
    }
}

constexpr int BAR_WORDS = 64 * 18;
__device__ __forceinline__ void grid_barrier(unsigned* bar, const int tid, volatile LAS unsigned* ctl) {
    asm volatile("s_waitcnt vmcnt(0) lgkmcnt(0)" ::: "memory");
    __syncthreads();
    if (tid == 0) {
        const unsigned x = (unsigned)__builtin_amdgcn_s_getreg((3 << 11) | 20) & 7u, nloc = ctl[0], nx = ctl[1];
        if (__hip_atomic_fetch_add(bar + 64 * x, 1u, __ATOMIC_RELAXED, __HIP_MEMORY_SCOPE_AGENT) == nloc - 1u) {
            __builtin_amdgcn_fence(__ATOMIC_RELEASE, "agent");
            asm volatile("s_waitcnt vmcnt(0)" ::: "memory");
            if (__hip_atomic_fetch_add(bar + 64 * 8, 1u, __ATOMIC_RELAXED, __HIP_MEMORY_SCOPE_AGENT) == nx - 1u) __hip_atomic_store(bar + 64 * 9, 1u, __ATOMIC_RELAXED, __HIP_MEMORY_SCOPE_AGENT);
            else while (__hip_atomic_load(bar + 64 * 9, __ATOMIC_RELAXED, __HIP_MEMORY_SCOPE_AGENT) == 0u) __builtin_amdgcn_s_sleep(1);
            __builtin_amdgcn_fence(__ATOMIC_ACQUIRE, "agent");
            __hip_atomic_store(bar + 64 * (10 + x), 1u, __ATOMIC_RELAXED, __HIP_MEMORY_SCOPE_AGENT);
            asm volatile("s_waitcnt vmcnt(0)" ::: "memory");
        } else {
            while (__hip_atomic_load(bar + 64 * (10 + x), __ATOMIC_RELAXED, __HIP_MEMORY_SCOPE_AGENT) == 0u) __builtin_amdgcn_s_sleep(1);
            __builtin_amdgcn_fence(__ATOMIC_ACQUIRE, "agent");
            asm volatile("s_waitcnt vmcnt(0)" ::: "memory");
        }
    }
    __syncthreads();
}

__global__ void __launch_bounds__(512, 2) mega(Params p) {
    extern __shared__ __attribute__((aligned(16))) unsigned char lds_raw[];
    LAS unsigned char* lds = (LAS unsigned char*)lds_raw;
    for (int pi = p.ph_lo; pi < p.ph_hi; ++pi) {
        int ph = pi;
        if (DUPMASK) { int q = 0, r = 0; for (; q < NPHASE; ++q) { if (r == pi) break; ++r; if ((DUPMASK >> q) & 1u) { if (r == pi) break; ++r; } } ph = q; }
        int tid = threadIdx.x; asm volatile("" : "+v"(tid));
        unsigned z; asm volatile("s_mov_b32 %0, 0" : "=s"(z));
        unsigned char* ws = p.ws + z; float* out = p.out + z;
        bf16_t* XN = (bf16_t*)(ws + WS_XN); bf16_t* BIG = (bf16_t*)(ws + WS_BIG);
        bf16_t* YB = (bf16_t*)(ws + WS_YB);
        int fi = -1, fo = -1, ni = -1; float sy = 0.5f;
        switch (ph) {
            case 1: fi = 0; break; case 10: fi = 1; break; case 13: fi = 2; break; case 21: fi = 3; break;
            case 2: fo = 0; break; case 11: fo = 1; break; case 14: fo = 2; break; case 22: fo = 3; break;
            case 3: ni = 1; break; case 9: ni = 2; sy = 1.0f; break; case 12: ni = 3; break; case 15: ni = 4; break; case 20: ni = 5; sy = 1.0f; break; case 23: ni = 6; break;
            default: break;
        }
#ifndef PMASK
#define PMASK 0xFFFF
#endif
        if ((PMASK & 1) && ph == 0) phase_prologue(p, ws, out, lds, tid);
        else if ((PMASK & 2) && fi >= 0) { const bf16_t* W = (const bf16_t*)(ws + WS_WIN + fi * SZ_WIN); sample_gemm<2, 8>(lds, XN + (size_t)MP * D, D, W, D, D, FF, BIG + (size_t)MP * FF, FF, tid);
            pg8::EpiSwiglu E{BIG}; pg8::gemm_phase(lds, XN, W, MP, 2 * FF, D, E, tid); }
        else if (ph == 22) {
            const bf16_t* B = (const bf16_t*)(ws + WS_WOUT + 3 * SZ_WOUT);
            sample_gemm<4, 22>(lds, BIG + (size_t)MP * FF, FF, B, FF, FF, D, (bf16_t*)(ws + WS_XB) + (size_t)MP * D, D, tid, out + (size_t)MP * D);
            pg8::EpiFinal E{out, (const bf16_t*)(ws + WS_XB), 0.5f}; pg8::gemm_phase(lds, BIG, B, MP, D, FF, E, tid); }
        else if ((PMASK & 4) && (fo >= 0 || ph == 8 || ph == 19)) {
            const bf16_t* A = BIG; const bf16_t* B = (const bf16_t*)(ws + WS_WOUT + (fo < 0 ? 0 : fo) * SZ_WOUT); int K = FF, ld = FF;
            if (ph == 8) { A = (const bf16_t*)(ws + WS_AO); B = (const bf16_t*)(ws + WS_WOA); K = AW; ld = AW; }
            if (ph == 19) { A = (const bf16_t*)(ws + WS_UM); B = (const bf16_t*)(ws + WS_WOB); K = BW; ld = LDU; }
            bf16_t* XBp = (bf16_t*)(ws + WS_XB); const float rs = fo >= 0 ? 0.5f : 1.0f;
            if (K == FF) sample_gemm<5, 22>(lds, A + (size_t)MP * ld, ld, B, ld, K, D, XBp + (size_t)MP * D, D, tid, nullptr, rs);
            else if (K == AW) sample_gemm<5, 4>(lds, A + (size_t)MP * ld, ld, B, ld, K, D, XBp + (size_t)MP * D, D, tid, nullptr, rs);
            else sample_gemm<5, 16>(lds, A + (size_t)MP * ld, ld, B, ld, K, D, XBp + (size_t)MP * D, D, tid, nullptr, rs);
            pg8::EpiResidB E{XBp, rs}; pg8::gemm_phase(lds, A, B, MP, D, K, E, tid, ld, ld); }
#ifdef DUMPSEL
        else if (ph == 20) {
            const bf16_t* wsp = (const bf16_t*)(ws + WS_WSP); const float* rvp = (const float*)(ws + WS_RV);
            for (size_t e = (size_t)blockIdx.x * 512 + tid; e < (size_t)M * D; e += (size_t)gridDim.x * 512) { const size_t r = e / D, c = e % D;
                out[e] = (DUMPSEL == 10) ? p.in[12][(c + r) % 2048] * p.in[14][(c * 3 + r) % 2048] * (1.0f + p.in[13][(r * 1024 + c) % 262144]) : (DUMPSEL == 2) ? (r >= (size_t)MP ? 0.f : 1.f) * __uint_as_float((unsigned)((const bf16_t*)(ws + WS_UM))[r * LDU + c] << 16) : (DUMPSEL == 8) ? (r < 256 ? __uint_as_float((unsigned)wsp[r * 1024 + c] << 16) : 0.f) : rvp[r]; }
        }
#endif
        else if ((PMASK & 8) && ni >= 0) phase_norm(ws, out, ni < 6 ? p.in[5] + ni * D : nullptr, sy, tid);
        else if ((PMASK & 16) && ph == 4) { sample_gemm<3, 8>(lds, XN + (size_t)MP * D, D, (const bf16_t*)(ws + WS_WQKV), D, D, NQKV, BIG + (size_t)MP * NQKV, NQKV, tid);
            const float* ctab = (const float*)(ws + WS_ROPE);
            pg8::EpiQKV E{BIG, ctab, ctab + NPOS * 32, p.in[9], out}; pg8::gemm_phase(lds, XN, (const bf16_t*)(ws + WS_WQKV), MP, NQKV, D, E, tid); }
        else if ((PMASK & 32) && ph == 5) phase_qknorm(p, ws, out, tid);
        else if ((PMASK & 64) && ph == 6) phase_attn(p, ws, lds, tid);
        else if ((PMASK & 128) && ph == 7) phase_merge(ws, tid);
        else if ((PMASK & 512) && ph == 16) { sample_gemm<1, 8>(lds, XN + (size_t)MP * D, D, (const bf16_t*)(ws + WS_WUV), D, D, NUV, BIG + (size_t)MP * NUV, NUV, tid);
            pg8::EpiBf16<1> E{BIG, NUV}; pg8::gemm_phase(lds, XN, (const bf16_t*)(ws + WS_WUV), MP, NUV, D, E, tid); }
        else if ((PMASK & 1024) && ph == 17) phase_vnorm(p, ws, out, tid);
        else if ((PMASK & 2048) && ph == 18) phase_spatial(p, ws, lds, tid);
        if (pi + 1 < p.ph_hi) {
            volatile LAS unsigned* ctl = (volatile LAS unsigned*)(lds + 135168);
            if (pi == 0) {
                const unsigned x = (unsigned)__builtin_amdgcn_s_getreg((3 << 11) | 20) & 7u;
                if (tid == 0) __hip_atomic_fetch_add((unsigned*)p.ws + 64 * x, 1u, __ATOMIC_RELAXED, __HIP_MEMORY_SCOPE_AGENT);
                __syncthreads(); cg::this_grid().sync();
                if (tid == 0) { unsigned nx = 0;
                    for (int j = 0; j < 8; ++j) nx += __hip_atomic_load((unsigned*)p.ws + 64 * j, __ATOMIC_RELAXED, __HIP_MEMORY_SCOPE_AGENT) != 0u;
                    ctl[0] = __hip_atomic_load((unsigned*)p.ws + 64 * x, __ATOMIC_RELAXED, __HIP_MEMORY_SCOPE_AGENT); ctl[1] = nx; }
                __syncthreads();
            }
            else grid_barrier((unsigned*)p.ws + (size_t)BAR_WORDS * pi, tid, ctl);
        }
    }
}

extern "C" void kernel_launch(void* const* d_in, const int* in_sizes, int n_in, void* d_out, int out_size, void* d_ws, size_t ws_size, hipStream_t stream) {
    static int grid = 0;
    if (grid == 0) {
        if (n_in != 16 || ws_size < WS_END) { fprintf(stderr, "kernel_launch: unexpected inputs (n_in %d, ws %zu < %zu)\n", n_in, ws_size, (size_t)WS_END); grid = -1; return; }
        int dev = 0, cus = 0, per_cu = 0;
        (void)hipGetDevice(&dev);
        (void)hipDeviceGetAttribute(&cus, hipDeviceAttributeMultiprocessorCount, dev);
        if (hipFuncSetAttribute((const void*)mega, hipFuncAttributeMaxDynamicSharedMemorySize, LDS_BYTES) != hipSuccess) { fprintf(stderr, "kernel_launch: hipFuncSetAttribute failed\n"); grid = -1; return; }
        if (hipOccupancyMaxActiveBlocksPerMultiprocessor(&per_cu, (const void*)mega, 512, LDS_BYTES) != hipSuccess || per_cu < 1) { fprintf(stderr, "kernel_launch: occupancy query says %d\n", per_cu); per_cu = 1; }
        (void)hipGetLastError();
        grid = cus * 1;
    }
    if (grid < 0) return;
    if (hipMemsetAsync(d_ws, 0, 262144, stream) != hipSuccess) { fprintf(stderr, "kernel_launch: memset failed\n"); return; }
    Params p{};
    for (int i = 0; i < 16; ++i) p.in[i] = (const float*)d_in[i];
    p.out = (float*)d_out; p.ws = (unsigned char*)d_ws;
#if ONE_LAUNCH
    p.ph_lo = 0; p.ph_hi = NPHASE + __builtin_popcount(DUPMASK);
    void* args[] = {&p};
    hipError_t e = hipLaunchCooperativeKernel((const void*)mega, dim3(grid), dim3(512), args, LDS_BYTES, stream);
    if (e != hipSuccess) fprintf(stderr, "cooperative launch failed: %s (grid %d)\n", hipGetErrorString(e), grid);
#else
    for (int ph = 0; ph < NPHASE; ++ph) {
        p.ph_lo = ph; p.ph_hi = ph + 1;
        hipLaunchKernelGGL(mega, dim3(grid), dim3(512), LDS_BYTES, stream, p);
    }
#endif
}
```

```cpp
#include <hip/hip_runtime.h>
#include <hip/hip_cooperative_groups.h>
#include <cstdio>
#include <cstdint>
namespace cg = cooperative_groups;

#ifndef ONE_LAUNCH
#define ONE_LAUNCH 1
#endif

#define LAS __attribute__((address_space(3)))
typedef unsigned short bf16_t;
typedef short bf16x8 __attribute__((ext_vector_type(8)));
typedef short s16x4 __attribute__((ext_vector_type(4)));
typedef float f32x2 __attribute__((ext_vector_type(2)));
typedef float f32x4 __attribute__((ext_vector_type(4)));
typedef float f32x16 __attribute__((ext_vector_type(16)));
typedef unsigned u32x2 __attribute__((ext_vector_type(2)));
typedef unsigned u32x4 __attribute__((ext_vector_type(4)));

constexpr int D = 1024, SEQ = 2048, NBATCH = 16, MP = NBATCH * SEQ, MS = 256, M = MP + MS;
constexpr int FF = 2816, NQKV = 4608, AW = 512, BW = 2048, NUV = 4096, PAST = 16384;
constexpr float EPS = 1e-6f;
constexpr int LDU = BW + 64;
constexpr int NPOS = SEQ + 8;
constexpr size_t O_YP = 0, O_YS = (size_t)MP * D, O_KP0 = O_YS + (size_t)MS * D, O_KP1 = O_KP0 + 2097152, O_KP2 = O_KP1 + 8388608,
                 O_KS0 = O_KP2 + 33554432, O_KS1 = O_KS0 + 262144, O_KS2 = O_KS1 + 262144, O_VS = O_KS2 + 262144;
constexpr size_t al256(size_t x) { return (x + 255) & ~(size_t)255; }
constexpr size_t WS_WIN = 1u << 20;
constexpr size_t SZ_WIN = (size_t)2 * FF * D * 2;
constexpr size_t WS_WOUT = WS_WIN + 4 * SZ_WIN;
constexpr size_t SZ_WOUT = (size_t)D * FF * 2;
constexpr size_t WS_WQKV = WS_WOUT + 4 * SZ_WOUT;
constexpr size_t WS_WOA = WS_WQKV + (size_t)NQKV * D * 2;
constexpr size_t WS_WUV = WS_WOA + (size_t)D * AW * 2;
constexpr size_t WS_WOB = WS_WUV + (size_t)NUV * D * 2;
constexpr size_t WS_WSP = WS_WOB + (size_t)D * LDU * 2;
constexpr size_t WS_ROPE = WS_WSP + (size_t)16 * 128 * 128 * 2;
constexpr size_t WS_XN = al256(WS_ROPE + (size_t)NPOS * 32 * 4 * 2);
constexpr size_t WS_BIG = al256(WS_XN + (size_t)M * D * 2);
constexpr size_t WS_OG = al256(WS_BIG + (size_t)M * NQKV * 2);
constexpr size_t WS_LSE = al256(WS_OG + (size_t)3 * M * AW * 2);
constexpr size_t WS_AO = al256(WS_LSE + (size_t)3 * M * 8 * 4);
constexpr size_t WS_UM = al256(WS_AO + (size_t)M * AW * 2);
constexpr size_t WS_RV = al256(WS_UM + (size_t)M * LDU * 2);
constexpr size_t WS_YB = al256(WS_RV + (size_t)M * 4);
constexpr size_t WS_XB = al256(WS_YB + (size_t)M * D * 2);
constexpr size_t WS_END = al256(WS_XB + (size_t)M * D * 2);

#ifndef DUPMASK
#define DUPMASK 0u
#endif
constexpr int LDS_BYTES = 139264;
#ifdef DUMPSEL
constexpr int NPHASE = 21;
#else
constexpr int NPHASE = 23;
#endif

__device__ __forceinline__ float wave_sum(float v) {
#pragma unroll
    for (int o = 1; o < 64; o <<= 1) v += __shfl_xor(v, o);
    return v;
}
__device__ __forceinline__ float wave_max(float v) {
#pragma unroll
    for (int o = 1; o < 64; o <<= 1) v = fmaxf(v, __shfl_xor(v, o));
    return v;
}
typedef __bf16 bf16x2_t __attribute__((ext_vector_type(2)));
__device__ __forceinline__ unsigned cvt_pk_bf16(float lo, float hi) { const f32x2 v = {lo, hi}; return __builtin_bit_cast(unsigned, __builtin_convertvector(v, bf16x2_t)); }
__device__ __forceinline__ float bf_lo(unsigned w) { return __uint_as_float(w << 16); }
__device__ __forceinline__ float bf_hi(unsigned w) { return __uint_as_float(w & 0xffff0000u); }
__device__ __forceinline__ float silu_f(float x) { return x * __builtin_amdgcn_rcpf(1.0f + __expf(-x)); }
__device__ __forceinline__ float gelu_tanh_f(float x) { const float y = 0.7978845608028654f * (x + 0.044715f * x * x * x); return x * __builtin_amdgcn_rcpf(1.0f + __expf(-2.0f * y)); }

namespace pg8 {
constexpr int BM = 256, BK = 64, HALF = 128, HTB = HALF * BK * 2, STAGE_BYTES = 8 * HTB, NXCD = 8, WGM = 8;
__device__ __forceinline__ int lds_byte(int r, int c) { const int st = (r >> 4) * 2 + (c >> 5), rr = r & 15, cc = c & 31, ob = rr * 64 + cc * 2; return st * 1024 + (ob ^ (((ob >> 9) & 1) << 5)); }
__device__ __forceinline__ void stage_rc(int b, int& R, int& C) { const int st = b / 1024, sb = b % 1024, swz = sb ^ (((sb >> 9) & 1) << 5); R = (st >> 1) * 16 + swz / 64; C = (st & 1) * 32 + (swz % 64) / 2; }
__device__ __forceinline__ int perm32(int rho) { const int n = rho >> 4, i = rho & 15; return 8 * (i >> 2) + 4 * n + (i & 3); }
struct Unit { int pm, pn; };
struct StaticOrder {
    int nM, nN, nwg, G, c;
    __device__ void init(int M_, int N_, int G_, int c_) { nM = M_ / BM; nN = N_ / BM; nwg = nM * nN; G = G_; c = c_; }
    __device__ bool next(int i, Unit& u) const {
        const long L = (long)i * G + c; if (L >= nwg) return false;
        int wgid = (int)L; { const int q = nwg / NXCD, r = nwg % NXCD, xcd = wgid % NXCD, off = wgid / NXCD; wgid = (xcd < r ? xcd * (q + 1) : r * (q + 1) + (xcd - r) * q) + off; }
        const int nig = WGM * nN, gid = wgid / nig, fm = gid * WGM, gsz = (nM - fm) < WGM ? (nM - fm) : WGM;
        u.pm = fm + ((wgid % nig) % gsz); u.pn = (wgid % nig) / gsz; return true;
    }
};
template <class Epi>
__device__ __forceinline__ void gemm_phase(LAS unsigned char* lds, const bf16_t* gA, const bf16_t* gBt, int gM, int gN, int K, const Epi& E, const int tid, const int lda = 0, const int ldb = 0) {
    const int LA = lda ? lda : K, LB = ldb ? ldb : K;
    const int wid = __builtin_amdgcn_readfirstlane(tid >> 6), lane = tid & 63, wr = wid >> 2, wc = wid & 3, fr = lane & 15, fq = lane >> 4;
    const int nt = K / BK;
    StaticOrder S; S.init(gM, gN, (int)gridDim.x, (int)blockIdx.x);
    unsigned voffA[2], voffB[2];
#pragma unroll
    for (int i = 0; i < 2; ++i) { int R, C; stage_rc(tid * 16 + i * 8192, R, C); const int Rb = Epi::PERM ? ((R & ~31) + perm32(R & 31)) : R;
        voffA[i] = (unsigned)(R * LA + C) * 2u; voffB[i] = (unsigned)(Rb * LB + C) * 2u; }
    const size_t kstep = (size_t)(BK * 2);
    const size_t hstepA = (size_t)HALF * LA * 2, hstepB = (size_t)HALF * LB * 2;
    const size_t tstepA = 2 * hstepA, tstepB = 2 * hstepB;
    const unsigned ldsw = (unsigned)wid * 1024u;
    const int aoff = lds_byte(wr * 64 + fr, fq * 8), boff = lds_byte(wc * 32 + fr, fq * 8);
#define PG8_SA(b, h) (((b) * 2 + (h)) * HTB)
#define PG8_SB(b, h) ((4 + (b) * 2 + (h)) * HTB)
#define PG8_STAGE(bufoff, gbase, voff) do { _Pragma("unroll") for (int _i = 0; _i < 2; ++_i) \
        __builtin_amdgcn_global_load_lds((const unsigned*)((const char*)(gbase) + (voff)[_i]), (LAS unsigned*)(lds + (bufoff) + ldsw + _i * 8192), 16, 0, 0); } while (0)
#define PG8_LDA(dst, b, h) do { _Pragma("unroll") for (int m = 0; m < 4; ++m) _Pragma("unroll") for (int k = 0; k < 2; ++k) dst[m][k] = *(const LAS bf16x8*)(lds + PG8_SA(b, h) + aoff + m * 2048 + k * 1024); } while (0)
#define PG8_LDB(dst, b, h) do { _Pragma("unroll") for (int n = 0; n < 2; ++n) _Pragma("unroll") for (int k = 0; k < 2; ++k) dst[n][k] = *(const LAS bf16x8*)(lds + PG8_SB(b, h) + boff + n * 2048 + k * 1024); } while (0)
#define PG8_MMA(ai, bj, At, Bt) do { __builtin_amdgcn_s_setprio(1); _Pragma("unroll") for (int m = 0; m < 4; ++m) _Pragma("unroll") for (int n = 0; n < 2; ++n) _Pragma("unroll") for (int k = 0; k < 2; ++k) \
        acc[ai][bj][m][n] = __builtin_amdgcn_mfma_f32_16x16x32_bf16(Bt[n][k], At[m][k], acc[ai][bj][m][n], 0, 0, 0); __builtin_amdgcn_s_setprio(0); } while (0)
#define PG8_WAIT_V(n) asm volatile("s_waitcnt vmcnt(" #n ")" ::: "memory")
#define PG8_WAIT_L(n) asm volatile("s_waitcnt lgkmcnt(" #n ")" ::: "memory")
#define PG8_BAR __builtin_amdgcn_s_barrier()
#define PG8_SCHED __builtin_amdgcn_sched_barrier(0)
    Unit cur, nxt; int ui = 0;
    if (!S.next(0, cur)) return;
    f32x4 acc[2][2][4][2];
#pragma unroll
    for (int a = 0; a < 2; ++a)
#pragma unroll
        for (int b = 0; b < 2; ++b)
#pragma unroll
            for (int m = 0; m < 4; ++m)
#pragma unroll
                for (int n = 0; n < 2; ++n) acc[a][b][m][n] = (f32x4){0.f, 0.f, 0.f, 0.f};
    bf16x8 At[4][2], B0[2][2], B1[2][2];
    const char* cA = (const char*)gA + (size_t)cur.pm * tstepA; const char* cB = (const char*)gBt + (size_t)cur.pn * tstepB;
    PG8_STAGE(PG8_SB(0, 0), cB, voffB); PG8_STAGE(PG8_SB(0, 1), cB + hstepB, voffB); PG8_STAGE(PG8_SA(0, 0), cA, voffA); PG8_STAGE(PG8_SA(0, 1), cA + hstepA, voffA);
    if (wr == 1) PG8_BAR;
    PG8_WAIT_V(2); PG8_BAR;
    PG8_STAGE(PG8_SB(1, 0), cB + kstep, voffB); PG8_STAGE(PG8_SA(1, 0), cA + kstep, voffA); PG8_STAGE(PG8_SB(1, 1), cB + hstepB + kstep, voffB);
    PG8_WAIT_V(6); PG8_BAR;
    for (;;) {
        const bool has_next = S.next(ui + 1, nxt);
        const char* nA = has_next ? (const char*)gA + (size_t)nxt.pm * tstepA : cA; const char* nB = has_next ? (const char*)gBt + (size_t)nxt.pn * tstepB : cB;
        for (int t = 0; t < nt; t += 2) {
            const bool last = (t == nt - 2);
            const char* a1 = cA + (size_t)(t + 1) * kstep;
            const char* a2 = last ? nA : cA + (size_t)(t + 2) * kstep; const char* b2 = last ? nB : cB + (size_t)(t + 2) * kstep;
            const char* a3 = a2 + kstep; const char* b3 = b2 + kstep;
            PG8_LDB(B0, 0, 0); PG8_LDB(B1, 0, 1); PG8_SCHED; PG8_LDA(At, 0, 0); PG8_STAGE(PG8_SA(1, 1), a1 + hstepA, voffA);
            PG8_WAIT_V(8); PG8_WAIT_L(0); PG8_BAR; PG8_MMA(0, 0, At, B0); PG8_MMA(0, 1, At, B1); PG8_BAR; PG8_SCHED;
            PG8_LDA(At, 0, 1); PG8_STAGE(PG8_SB(0, 0), b2, voffB); PG8_STAGE(PG8_SB(0, 1), b2 + hstepB, voffB); PG8_STAGE(PG8_SA(0, 0), a2, voffA);
            PG8_WAIT_V(8); PG8_WAIT_L(0); PG8_BAR; PG8_MMA(1, 0, At, B0); PG8_MMA(1, 1, At, B1); PG8_BAR; PG8_SCHED;
            PG8_LDB(B0, 1, 0); PG8_LDB(B1, 1, 1); PG8_SCHED; PG8_LDA(At, 1, 0); PG8_STAGE(PG8_SA(0, 1), a2 + hstepA, voffA);
            PG8_WAIT_V(8); PG8_WAIT_L(0); PG8_BAR; PG8_MMA(0, 0, At, B0); PG8_MMA(0, 1, At, B1); PG8_BAR; PG8_SCHED;
            PG8_LDA(At, 1, 1); PG8_STAGE(PG8_SB(1, 0), b3, voffB); PG8_STAGE(PG8_SB(1, 1), b3 + hstepB, voffB); PG8_STAGE(PG8_SA(1, 0), a3, voffA);
            PG8_WAIT_V(8); PG8_WAIT_L(0); PG8_BAR; PG8_MMA(1, 0, At, B0); PG8_MMA(1, 1, At, B1); PG8_BAR; PG8_SCHED;
        }
        if (wr == 0) PG8_BAR;
        E(acc, cur, wr, wc, fr, fq);
        if (!has_next) break;
#pragma unroll
        for (int a = 0; a < 2; ++a)
#pragma unroll
            for (int b = 0; b < 2; ++b)
#pragma unroll
                for (int m = 0; m < 4; ++m)
#pragma unroll
                    for (int n = 0; n < 2; ++n) acc[a][b][m][n] = (f32x4){0.f, 0.f, 0.f, 0.f};
        cur = nxt; cA = nA; cB = nB; ++ui;
        if (wr == 1) PG8_BAR;
    }
    PG8_WAIT_V(0);
    PG8_BAR;
#undef PG8_SA
#undef PG8_SB
#undef PG8_STAGE
#undef PG8_LDA
#undef PG8_LDB
#undef PG8_MMA
#undef PG8_WAIT_V
#undef PG8_WAIT_L
#undef PG8_BAR
#undef PG8_SCHED
}

struct EpiSwiglu {
    static constexpr bool PERM = true;
    bf16_t* O;
    __device__ __forceinline__ void operator()(const f32x4 (&acc)[2][2][4][2], const Unit& u, int wr, int wc, int fr, int fq) const {
        const int row0 = u.pm * BM + wr * 64 + fr, col0 = u.pn * HALF + wc * 32 + 8 * fq;
#pragma unroll
        for (int ai = 0; ai < 2; ++ai)
#pragma unroll
            for (int m = 0; m < 4; ++m) {
                const f32x4 g0 = acc[ai][0][m][0], g1 = acc[ai][0][m][1], u0 = acc[ai][1][m][0], u1 = acc[ai][1][m][1];
                u32x4 w;
                w.x = cvt_pk_bf16(silu_f(g0[0]) * u0[0], silu_f(g0[1]) * u0[1]); w.y = cvt_pk_bf16(silu_f(g0[2]) * u0[2], silu_f(g0[3]) * u0[3]);
                w.z = cvt_pk_bf16(silu_f(g1[0]) * u1[0], silu_f(g1[1]) * u1[1]); w.w = cvt_pk_bf16(silu_f(g1[2]) * u1[2], silu_f(g1[3]) * u1[3]);
                *(u32x4*)(O + (size_t)(row0 + ai * HALF + m * 16) * FF + col0) = w;
            }
    }
};
struct EpiResid {
    static constexpr bool PERM = false;
    float* X; float s;
    __device__ __forceinline__ void operator()(const f32x4 (&acc)[2][2][4][2], const Unit& u, int wr, int wc, int fr, int fq) const {
        const int row0 = u.pm * BM + wr * 64 + fr, col0 = u.pn * BM + wc * 32 + 4 * fq;
#pragma unroll
        for (int ai = 0; ai < 2; ++ai)
#pragma unroll
            for (int m = 0; m < 4; ++m) { float* rowp = X + (size_t)(row0 + ai * HALF + m * 16) * D + col0;
#pragma unroll
                for (int bj = 0; bj < 2; ++bj)
#pragma unroll
                    for (int n = 0; n < 2; ++n) { f32x4* p = (f32x4*)(rowp + bj * HALF + n * 16); *p = *p + acc[ai][bj][m][n] * s; } }
    }
};
struct EpiResidB {
    static constexpr bool PERM = true;
    bf16_t* XB; float s;
    __device__ __forceinline__ void operator()(const f32x4 (&acc)[2][2][4][2], const Unit& u, int wr, int wc, int fr, int fq) const {
        bf16_t* base = XB + (size_t)(u.pm * BM + wr * 64 + fr) * D + u.pn * BM + wc * 32 + 8 * fq;
        u32x4 x[8][2];
#pragma unroll
        for (int g = 0; g < 8; ++g)
#pragma unroll
            for (int bj = 0; bj < 2; ++bj) x[g][bj] = *(const u32x4*)(base + (size_t)((g >> 2) * HALF + (g & 3) * 16) * D + bj * HALF);
#pragma unroll
        for (int g = 0; g < 8; ++g) {
            const int ai = g >> 2, m = g & 3;
#pragma unroll
            for (int bj = 0; bj < 2; ++bj) { const f32x4 v0 = acc[ai][bj][m][0], v1 = acc[ai][bj][m][1]; const u32x4 xx = x[g][bj];
                u32x4 w;
                w.x = cvt_pk_bf16(bf_lo(xx.x) + v0.x * s, bf_hi(xx.x) + v0.y * s); w.y = cvt_pk_bf16(bf_lo(xx.y) + v0.z * s, bf_hi(xx.y) + v0.w * s);
                w.z = cvt_pk_bf16(bf_lo(xx.z) + v1.x * s, bf_hi(xx.z) + v1.y * s); w.w = cvt_pk_bf16(bf_lo(xx.w) + v1.z * s, bf_hi(xx.w) + v1.w * s);
                *(u32x4*)(base + (size_t)(ai * HALF + m * 16) * D + bj * HALF) = w; }
        }
    }
};
struct EpiFinal {
    static constexpr bool PERM = false;
    float* X; const bf16_t* XB; float s;
    __device__ __forceinline__ void operator()(const f32x4 (&acc)[2][2][4][2], const Unit& u, int wr, int wc, int fr, int fq) const {
        const size_t off = (size_t)(u.pm * BM + wr * 64 + fr) * D + u.pn * BM + wc * 32 + 4 * fq;
        u32x2 x[8][4];
#pragma unroll
        for (int g = 0; g < 8; ++g)
#pragma unroll
            for (int q = 0; q < 4; ++q) x[g][q] = *(const u32x2*)(XB + off + (size_t)((g >> 2) * HALF + (g & 3) * 16) * D + (q >> 1) * HALF + (q & 1) * 16);
#pragma unroll
        for (int g = 0; g < 8; ++g) {
            const int ai = g >> 2, m = g & 3;
            float* rowp = X + off + (size_t)(ai * HALF + m * 16) * D;
#pragma unroll
            for (int q = 0; q < 4; ++q) { const f32x4 a = acc[ai][q >> 1][m][q & 1];
                *(f32x4*)(rowp + (q >> 1) * HALF + (q & 1) * 16) = (f32x4){bf_lo(x[g][q].x) + a.x * s, bf_hi(x[g][q].x) + a.y * s, bf_lo(x[g][q].y) + a.z * s, bf_hi(x[g][q].y) + a.w * s}; }
        }
    }
};
struct EpiQKV {
    static constexpr bool PERM = true;
    bf16_t* O; const float* ct; const float* st; const float* gain; float* out;
    __device__ __forceinline__ void operator()(const f32x4 (&acc)[2][2][4][2], const Unit& u, int wr, int wc, int fr, int fq) const {
        const int head = u.pn * 4 + wc, which = head / 24, gh = head - which * 24, g = gh >> 3, h = gh & 7, d0 = 8 * fq;
        const int row0 = u.pm * BM + wr * 64 + fr;
        f32x4 ga0 = {1.f, 1.f, 1.f, 1.f}, ga1 = ga0, gb0 = ga0, gb1 = ga0;
        if (which < 2) { const float* gp = gain + which * 64 + d0; ga0 = *(const f32x4*)gp; ga1 = *(const f32x4*)(gp + 4); gb0 = *(const f32x4*)(gp + 32); gb1 = *(const f32x4*)(gp + 36); }
        const int keep = 128 << (2 * g);
        const size_t tbase = g == 0 ? O_KP0 : (g == 1 ? O_KP1 : O_KP2);
#pragma unroll
        for (int ai = 0; ai < 2; ++ai)
#pragma unroll
            for (int m = 0; m < 4; ++m) {
                const int row = row0 + ai * HALF + m * 16;
                f32x4 a0 = acc[ai][0][m][0], a1 = acc[ai][0][m][1], b0 = acc[ai][1][m][0], b1 = acc[ai][1][m][1];
                if (which < 2) {
                    float ss = ((a0.x * a0.x + a0.y * a0.y) + (a0.z * a0.z + a0.w * a0.w)) + ((a1.x * a1.x + a1.y * a1.y) + (a1.z * a1.z + a1.w * a1.w))
                             + ((b0.x * b0.x + b0.y * b0.y) + (b0.z * b0.z + b0.w * b0.w)) + ((b1.x * b1.x + b1.y * b1.y) + (b1.z * b1.z + b1.w * b1.w));
                    ss += __shfl_xor(ss, 16); ss += __shfl_xor(ss, 32);
                    const float r = 1.0f / sqrtf(ss * (1.0f / 64) + EPS);
                    const int pi = row & 2047;
                    const f32x4 c0 = *(const f32x4*)(ct + pi * 32 + d0), c1 = *(const f32x4*)(ct + pi * 32 + d0 + 4), s0 = *(const f32x4*)(st + pi * 32 + d0), s1 = *(const f32x4*)(st + pi * 32 + d0 + 4);
                    const f32x4 ya0 = a0 * r * ga0, ya1 = a1 * r * ga1, yb0 = b0 * r * gb0, yb1 = b1 * r * gb1;
                    a0 = ya0 * c0 - yb0 * s0; a1 = ya1 * c1 - yb1 * s1; b0 = yb0 * c0 + ya0 * s0; b1 = yb1 * c1 + ya1 * s1;
                }
                bf16_t* dst = O + (size_t)row * NQKV + head * 64 + d0;
                u32x4 w0, w1;
                w0.x = cvt_pk_bf16(a0.x, a0.y); w0.y = cvt_pk_bf16(a0.z, a0.w); w0.z = cvt_pk_bf16(a1.x, a1.y); w0.w = cvt_pk_bf16(a1.z, a1.w);
                w1.x = cvt_pk_bf16(b0.x, b0.y); w1.y = cvt_pk_bf16(b0.z, b0.w); w1.z = cvt_pk_bf16(b1.x, b1.y); w1.w = cvt_pk_bf16(b1.z, b1.w);
                *(u32x4*)dst = w0; *(u32x4*)(dst + 32) = w1;
                if (which >= 1) {
                    const int bb = row >> 11, tt = (row & 2047) - (SEQ - keep);
                    if (tt >= 0) { float* tp = out + tbase + ((((size_t)bb * keep + tt) * 2 + (which - 1)) * 8 + h) * 64 + d0;
                        *(f32x4*)tp = a0; *(f32x4*)(tp + 4) = a1; *(f32x4*)(tp + 32) = b0; *(f32x4*)(tp + 36) = b1; }
                }
            }
    }
};
template <int ACT> struct EpiBf16 {
    static constexpr bool PERM = true;
    bf16_t* O; int ldc;
    __device__ __forceinline__ void operator()(const f32x4 (&acc)[2][2][4][2], const Unit& u, int wr, int wc, int fr, int fq) const {
        const int row0 = u.pm * BM + wr * 64 + fr, col0 = u.pn * BM + wc * 32 + 8 * fq;
#pragma unroll
        for (int ai = 0; ai < 2; ++ai)
#pragma unroll
            for (int m = 0; m < 4; ++m) { bf16_t* rowp = O + (size_t)(row0 + ai * HALF + m * 16) * ldc + col0;
#pragma unroll
                for (int bj = 0; bj < 2; ++bj) { f32x4 v0 = acc[ai][bj][m][0], v1 = acc[ai][bj][m][1];
                    if (ACT == 1) {
#pragma unroll
                        for (int j = 0; j < 4; ++j) { v0[j] = gelu_tanh_f(v0[j]); v1[j] = gelu_tanh_f(v1[j]); } }
                    u32x4 w; w.x = cvt_pk_bf16(v0[0], v0[1]); w.y = cvt_pk_bf16(v0[2], v0[3]); w.z = cvt_pk_bf16(v1[0], v1[1]); w.w = cvt_pk_bf16(v1[2], v1[3]);
                    *(u32x4*)(rowp + bj * HALF) = w; } }
    }
};
}

#define MFMA32S(a, b, c) __builtin_amdgcn_mfma_f32_32x32x16_bf16((a), (b), (c), 0, 0, 0)
template <int MODE, int KSTEPS>
__device__ __forceinline__ void sample_gemm(LAS unsigned char* lds, const bf16_t* A, int lda, const bf16_t* Bt, int ldb, int K, int N, bf16_t* O, int ldc, const int tid, float* Xs = nullptr, float rs = 0.f) {
    const int lane = tid & 63, wave = __builtin_amdgcn_readfirstlane(tid >> 6), hh = lane >> 5;
    const int ntiles = 8 * (N / 32), kw = K / 8;
    LAS float* red = (LAS float*)lds;
    for (int tile = blockIdx.x; tile < ntiles; tile += gridDim.x) {
        const int rt = tile & 7, ct = tile >> 3;
        const bf16_t* ap = A + (size_t)(32 * rt + (lane & 31)) * lda + wave * kw + 8 * hh;
        int brow = 32 * ct + (lane & 31);
        if (MODE == 2) { const int h0 = 32 * ct; brow = (h0 >> 7) * 256 + (h0 & 127) + (lane & 31); }
        const bf16_t* bp = Bt + (size_t)brow * ldb + wave * kw + 8 * hh;
        f32x16 c0, c1;
#pragma unroll
        for (int i = 0; i < 16; ++i) { c0[i] = 0.f; c1[i] = 0.f; }
        constexpr int CH = KSTEPS > 11 ? KSTEPS / 2 : KSTEPS;
#pragma unroll
        for (int cb = 0; cb < KSTEPS; cb += CH) {
            bf16x8 af[CH], bfr[CH], b2f[CH];
#pragma unroll
            for (int i = 0; i < CH; ++i) { af[i] = *(const bf16x8*)(ap + 16 * (cb + i)); bfr[i] = *(const bf16x8*)(bp + 16 * (cb + i));
                if (MODE == 2) b2f[i] = *(const bf16x8*)(bp + (size_t)128 * ldb + 16 * (cb + i)); }
#pragma unroll
            for (int i = 0; i < CH; ++i) { c0 = MFMA32S(af[i], bfr[i], c0); if (MODE == 2) c1 = MFMA32S(af[i], b2f[i], c1); }
        }
        __syncthreads();
#pragma unroll
        for (int i = 0; i < 16; ++i) { red[((wave * 2 + 0) * 16 + i) * 64 + lane] = c0[i]; if (MODE == 2) red[((wave * 2 + 1) * 16 + i) * 64 + lane] = c1[i]; }
        __syncthreads();
#pragma unroll
        for (int r = 0; r < 2; ++r) {
            const int e = tid + 512 * r, i = e >> 6, l = e & 63;
            float s0 = 0.f, s1 = 0.f;
#pragma unroll
            for (int w = 0; w < 8; ++w) { s0 += red[((w * 2 + 0) * 16 + i) * 64 + l]; if (MODE == 2) s1 += red[((w * 2 + 1) * 16 + i) * 64 + l]; }
            const int row = 32 * rt + (i & 3) + 8 * (i >> 2) + 4 * (l >> 5);
            int col = 32 * ct + (l & 31);
            if (MODE == 3) col = (((ct >> 3) * 4 + (ct & 3)) * 64 + 32 * ((ct >> 2) & 1)) + (l & 31);
            const float v = MODE == 2 ? silu_f(s0) * s1 : (MODE == 1 ? gelu_tanh_f(s0) : s0);
            if (MODE == 5) { bf16_t* xp = O + (size_t)row * ldc + col; *xp = (bf16_t)(cvt_pk_bf16(__uint_as_float((unsigned)*xp << 16) + rs * s0, 0.f) & 0xffffu); }
            else if (MODE == 4) Xs[(size_t)row * ldc + col] = __uint_as_float((unsigned)O[(size_t)row * ldc + col] << 16) + 0.5f * s0;
            else O[(size_t)row * ldc + col] = (bf16_t)(cvt_pk_bf16(v, 0.f) & 0xffffu);
        }
    }
    __syncthreads();
}

struct Params { const float* in[16]; float* out; unsigned char* ws; int ph_lo, ph_hi; };

__device__ __forceinline__ int dest_row32(int n0, bool swiglu, bool qkvperm) {
    if (swiglu) { const int up = n0 >= FF, nn = up ? n0 - FF : n0; return (nn >> 7) * 256 + (up ? 128 : 0) + (nn & 127); }
    if (qkvperm) { const int head = n0 >> 6, bj = (n0 >> 5) & 1; return (head >> 2) * 256 + bj * 128 + (head & 3) * 32; }
    return n0;
}
__device__ __forceinline__ void transpose_mat(const float* W, int K, int N, bf16_t* WT, int item, bool swiglu, LAS float* scr, int lane, int ldw = 0, bool qkvperm = false) {
    const int nblk = N / 64, kb = item / nblk, nb = item - kb * nblk, k0 = 32 * kb, n0 = 64 * nb;
    if (ldw == 0) ldw = K;
    const float* src = W + (size_t)(k0 + (lane >> 4)) * N + n0 + 4 * (lane & 15);
    f32x4 v[8];
#pragma unroll
    for (int i = 0; i < 8; ++i) v[i] = *(const f32x4*)(src + (size_t)(4 * i) * N);
#pragma unroll
    for (int i = 0; i < 8; ++i) *(LAS f32x4*)(scr + (4 * i + (lane >> 4)) * 68 + 4 * (lane & 15)) = v[i];
    asm volatile("s_waitcnt lgkmcnt(0)" ::: "memory");
    const int d0 = dest_row32(n0, swiglu, qkvperm), d1 = dest_row32(n0 + 32, swiglu, qkvperm);
    const int c = lane & 3;
#pragma unroll
    for (int j = 0; j < 4; ++j) { const int n = (lane >> 2) + 16 * j; const LAS float* sp = scr + (8 * c) * 68 + n;
        u32x4 o; o.x = cvt_pk_bf16(sp[0 * 68], sp[1 * 68]); o.y = cvt_pk_bf16(sp[2 * 68], sp[3 * 68]); o.z = cvt_pk_bf16(sp[4 * 68], sp[5 * 68]); o.w = cvt_pk_bf16(sp[6 * 68], sp[7 * 68]);
        const int drow = n < 32 ? d0 + n : d1 + n - 32;
        *(u32x4*)(WT + (size_t)drow * ldw + k0 + 8 * c) = o; }
    asm volatile("s_waitcnt lgkmcnt(0)" ::: "memory");
}
__constant__ double ROPE_INV[32] = {
    1.0, 0.7498942093324559, 0.5623413251903491, 0.4216965034285822, 0.31622776601683794, 0.23713737056616552, 0.1778279410038923, 0.1333521432163324,
    0.1, 0.07498942093324558, 0.05623413251903491, 0.042169650342858224, 0.03162277660168379, 0.023713737056616554, 0.01778279410038923, 0.01333521432163324,
    0.01, 0.007498942093324558, 0.005623413251903491, 0.004216965034285823, 0.0031622776601683794, 0.0023713737056616554, 0.0017782794100389228, 0.001333521432163324,
    0.001, 0.0007498942093324559, 0.0005623413251903491, 0.00042169650342858224, 0.00031622776601683794, 0.00023713737056616554, 0.00017782794100389227, 0.0001333521432163324};

__device__ __forceinline__ void norm_row0(const float* xrow, const float* g, bf16_t* orow, bf16_t* xb, int lane) {
    const f32x4* xr = (const f32x4*)xrow + lane;
    f32x4 v[4]; float ss = 0.f;
#pragma unroll
    for (int j = 0; j < 4; ++j) v[j] = xr[64 * j];
#pragma unroll
    for (int j = 0; j < 4; ++j) ss += (v[j].x * v[j].x + v[j].y * v[j].y) + (v[j].z * v[j].z + v[j].w * v[j].w);
    const float r = 1.0f / sqrtf(wave_sum(ss) * (1.0f / D) + EPS);
#pragma unroll
    for (int j = 0; j < 4; ++j) {
        const f32x4 gg = ((const f32x4*)g)[lane + 64 * j];
        u32x2 o; o.x = cvt_pk_bf16(v[j].x * r * gg.x, v[j].y * r * gg.y); o.y = cvt_pk_bf16(v[j].z * r * gg.z, v[j].w * r * gg.w);
        ((u32x2*)orow)[lane + 64 * j] = o;
        u32x2 xo; xo.x = cvt_pk_bf16(v[j].x, v[j].y); xo.y = cvt_pk_bf16(v[j].z, v[j].w);
        ((u32x2*)xb)[lane + 64 * j] = xo;
    }
}

__device__ __forceinline__ void phase_prologue(const Params& p, unsigned char* ws, float* out, LAS unsigned char* lds, const int tid) {
    const int lane = tid & 63, wave = tid >> 6;
    const int gw = blockIdx.x * 8 + wave, NGW = gridDim.x * 8;
    LAS float* scr = (LAS float*)(lds + wave * 8704);
    constexpr int I_IN = (D / 32) * (2 * FF / 64), I_OUT = (FF / 32) * (D / 64), I_QKV = (D / 32) * (NQKV / 64), I_OA = (AW / 32) * (D / 64), I_UV = (D / 32) * (NUV / 64), I_OB = (BW / 32) * (D / 64);
    constexpr int NITEMS = 4 * I_IN + 4 * I_OUT + I_QKV + I_OA + I_UV + I_OB;
    for (int it = gw; it < NITEMS; it += NGW) {
        int r = it;
        if (r < 4 * I_IN) { const int w = r / I_IN; transpose_mat(p.in[6] + (size_t)w * D * 2 * FF, D, 2 * FF, (bf16_t*)(ws + WS_WIN + w * SZ_WIN), r % I_IN, true, scr, lane); continue; } r -= 4 * I_IN;
        if (r < 4 * I_OUT) { const int w = r / I_OUT; transpose_mat(p.in[7] + (size_t)w * FF * D, FF, D, (bf16_t*)(ws + WS_WOUT + w * SZ_WOUT), r % I_OUT, false, scr, lane); continue; } r -= 4 * I_OUT;
        if (r < I_QKV) { transpose_mat(p.in[8], D, NQKV, (bf16_t*)(ws + WS_WQKV), r, false, scr, lane, 0, true); continue; } r -= I_QKV;
        if (r < I_OA) { transpose_mat(p.in[10], AW, D, (bf16_t*)(ws + WS_WOA), r, false, scr, lane); continue; } r -= I_OA;
        if (r < I_UV) { transpose_mat(p.in[11], D, NUV, (bf16_t*)(ws + WS_WUV), r, false, scr, lane); continue; } r -= I_UV;
        transpose_mat(p.in[15], BW, D, (bf16_t*)(ws + WS_WOB), r, false, scr, lane, LDU);
    }
    { bf16_t* wsp = (bf16_t*)(ws + WS_WSP); const float* src = p.in[13];
      for (int i = blockIdx.x * 512 + tid; i < 16 * 128 * 128 / 2; i += gridDim.x * 512) {
          const int e = 2 * i, s = e & 127, t = (e >> 7) & 127; const f32x2 v = *(const f32x2*)(src + e);
          ((unsigned*)wsp)[i] = cvt_pk_bf16(s <= t ? v.x : 0.f, (s + 1) <= t ? v.y : 0.f); } }
    { float* ct = (float*)(ws + WS_ROPE); float* st = ct + NPOS * 32;
      for (int i = blockIdx.x * 512 + tid; i < NPOS * 32; i += gridDim.x * 512) {
          const int pi = i >> 5, fi = i & 31; const double pos = (double)(pi < SEQ ? pi : PAST + (pi - SEQ));
          const double a = pos * ROPE_INV[fi]; const double n = __builtin_rint(a * 0.15915494309189535);
          const double r = (a - n * 6.283185307179586) - n * 2.4492935982947064e-16; const double r2 = r * r;
          double sn = 1.0, cs = 1.0;
#pragma unroll 1
          for (int k = 14; k >= 1; --k) { const double k2 = (double)(2 * k); sn = 1.0 - sn * r2 / (k2 * (k2 + 1.0)); cs = 1.0 - cs * r2 / ((k2 - 1.0) * k2); }
          ct[i] = (float)cs; st[i] = (float)(sn * r); } }
#ifdef NANFILL
    { u32x4* f = (u32x4*)(ws + WS_BIG); const size_t n = (WS_END - WS_BIG) / 16; const u32x4 q = {0xffffffffu, 0xffffffffu, 0xffffffffu, 0xffffffffu};
      for (size_t i = (size_t)blockIdx.x * 512 + tid; i < n; i += (size_t)gridDim.x * 512) f[i] = q;
      u32x4* fo = (u32x4*)(out + O_KP0); const size_t no = (O_VS + 524288 - O_KP0) / 4;
      for (size_t i = (size_t)blockIdx.x * 512 + tid; i < no; i += (size_t)gridDim.x * 512) fo[i] = q; }
#endif
    for (int m = gw; m < M; m += NGW) {
        const float* src = m < MP ? p.in[0] + (size_t)m * D : p.in[1] + (size_t)(m - MP) * D;
        norm_row0(src, p.in[5], (bf16_t*)(ws + WS_XN) + (size_t)m * D, (bf16_t*)(ws + WS_XB) + (size_t)m * D, lane);
    }
}

__device__ __forceinline__ void phase_norm(unsigned char* ws, float* out, const float* g, float sy, const int tid) {
    const int lane = tid & 63, wave = tid >> 6;
    const int gw = blockIdx.x * 8 + wave, NGW = gridDim.x * 8;
    bf16_t* XN = (bf16_t*)(ws + WS_XN); const bf16_t* XB = (const bf16_t*)(ws + WS_XB);
    for (int m0 = gw; m0 < M; m0 += 2 * NGW) {
        const int m1 = m0 + NGW; const bool two = m1 < M; const int mb = two ? m1 : m0;
        u32x2 xa[4], xb[4];
#pragma unroll
        for (int j = 0; j < 4; ++j) { xa[j] = ((const u32x2*)(XB + (size_t)m0 * D))[lane + 64 * j]; xb[j] = ((const u32x2*)(XB + (size_t)mb * D))[lane + 64 * j]; }
        f32x4 va[4], vb[4]; float sa = 0.f, sb = 0.f;
#pragma unroll
        for (int j = 0; j < 4; ++j) {
            va[j] = (f32x4){bf_lo(xa[j].x), bf_hi(xa[j].x), bf_lo(xa[j].y), bf_hi(xa[j].y)};
            vb[j] = (f32x4){bf_lo(xb[j].x), bf_hi(xb[j].x), bf_lo(xb[j].y), bf_hi(xb[j].y)};
            sa += (va[j].x * va[j].x + va[j].y * va[j].y) + (va[j].z * va[j].z + va[j].w * va[j].w);
            sb += (vb[j].x * vb[j].x + vb[j].y * vb[j].y) + (vb[j].z * vb[j].z + vb[j].w * vb[j].w);
        }
        const float ra = 1.0f / sqrtf(wave_sum(sa) * (1.0f / D) + EPS), rb = 1.0f / sqrtf(wave_sum(sb) * (1.0f / D) + EPS);
#pragma unroll
        for (int j = 0; j < 4; ++j) {
            const f32x4 gg = ((const f32x4*)g)[lane + 64 * j];
            u32x2 o; o.x = cvt_pk_bf16(va[j].x * ra * gg.x, va[j].y * ra * gg.y); o.y = cvt_pk_bf16(va[j].z * ra * gg.z, va[j].w * ra * gg.w);
            ((u32x2*)(XN + (size_t)m0 * D))[lane + 64 * j] = o;
            if (two) { u32x2 o2; o2.x = cvt_pk_bf16(vb[j].x * rb * gg.x, vb[j].y * rb * gg.y); o2.y = cvt_pk_bf16(vb[j].z * rb * gg.z, vb[j].w * rb * gg.w);
                ((u32x2*)(XN + (size_t)m1 * D))[lane + 64 * j] = o2; }
        }
    }
}

__device__ __forceinline__ void tail_store(float* out, int g, int h, int kv, int row, int i0, f32x4 a, f32x4 b) {
    float* dst;
    if (row < MP) {
        const int bb = row >> 11, t = row & 2047, keep = 128 << (2 * g), tt = t - (SEQ - keep);
        if (tt < 0) return;
        const size_t base = g == 0 ? O_KP0 : (g == 1 ? O_KP1 : O_KP2);
        dst = out + base + ((((size_t)bb * keep + tt) * 2 + kv) * 8 + h) * 64;
    } else {
        const int s = row - MP; const size_t base = g == 0 ? O_KS0 : (g == 1 ? O_KS1 : O_KS2);
        dst = out + base + (((size_t)s * 2 + kv) * 8 + h) * 64;
    }
    *(f32x4*)(dst + i0) = a; *(f32x4*)(dst + 32 + i0) = b;
}
__device__ __forceinline__ void phase_qknorm(const Params& p, unsigned char* ws, float* out, const int tid) {
    const int lane = tid & 63, wave = tid >> 6;
    const int gw = blockIdx.x * 8 + wave, NGW = gridDim.x * 8;
    bf16_t* QKV = (bf16_t*)(ws + WS_BIG);
    const float* ct = (const float*)(ws + WS_ROPE); const float* st = ct + NPOS * 32;
    const int sub = lane & 7, i0 = 4 * sub;
    for (int it = MP * 9 + gw; it < M * 9; it += NGW) {
        const int row = it / 9, s9 = it - row * 9;
        if (s9 < 6) {
            const int head = s9 * 8 + (lane >> 3), isk = head >= 24, gh = isk ? head - 24 : head, g = gh >> 3, h = gh & 7;
            bf16_t* ptr = QKV + (size_t)row * NQKV + head * 64;
            const u32x2 ra = *(const u32x2*)(ptr + i0), rb = *(const u32x2*)(ptr + 32 + i0);
            f32x4 x1 = {bf_lo(ra.x), bf_hi(ra.x), bf_lo(ra.y), bf_hi(ra.y)}, x2 = {bf_lo(rb.x), bf_hi(rb.x), bf_lo(rb.y), bf_hi(rb.y)};
            float ss = (x1.x * x1.x + x1.y * x1.y) + (x1.z * x1.z + x1.w * x1.w) + (x2.x * x2.x + x2.y * x2.y) + (x2.z * x2.z + x2.w * x2.w);
            ss += __shfl_xor(ss, 1); ss += __shfl_xor(ss, 2); ss += __shfl_xor(ss, 4);
            const float r = 1.0f / sqrtf(ss * (1.0f / 64) + EPS);
            const float* gain = p.in[9] + isk * 64;
            const f32x4 g1 = *(const f32x4*)(gain + i0), g2 = *(const f32x4*)(gain + 32 + i0);
            const int pi = row < MP ? (row & 2047) : SEQ + ((row - MP) & 7);
            const f32x4 c = *(const f32x4*)(ct + pi * 32 + i0), s = *(const f32x4*)(st + pi * 32 + i0);
            const f32x4 y1 = x1 * r * g1, y2 = x2 * r * g2;
            const f32x4 o1 = y1 * c - y2 * s, o2 = y2 * c + y1 * s;
            u32x2 wa, wb; wa.x = cvt_pk_bf16(o1.x, o1.y); wa.y = cvt_pk_bf16(o1.z, o1.w); wb.x = cvt_pk_bf16(o2.x, o2.y); wb.y = cvt_pk_bf16(o2.z, o2.w);
            *(u32x2*)(ptr + i0) = wa; *(u32x2*)(ptr + 32 + i0) = wb;
            if (isk) tail_store(out, g, h, 0, row, i0, o1, o2);
        } else {
            const int vh = (s9 - 6) * 8 + (lane >> 3), g = vh >> 3, h = vh & 7;
            const bf16_t* ptr = QKV + (size_t)row * NQKV + 3072 + vh * 64;
            const u32x2 ra = *(const u32x2*)(ptr + i0), rb = *(const u32x2*)(ptr + 32 + i0);
            const f32x4 x1 = {bf_lo(ra.x), bf_hi(ra.x), bf_lo(ra.y), bf_hi(ra.y)}, x2 = {bf_lo(rb.x), bf_hi(rb.x), bf_lo(rb.y), bf_hi(rb.y)};
            tail_store(out, g, h, 1, row, i0, x1, x2);
        }
    }
}

#define MFMA32(a, b, c) __builtin_amdgcn_mfma_f32_32x32x16_bf16((a), (b), (c), 0, 0, 0)
__device__ __forceinline__ s16x4 tr_read(unsigned lds_addr) { return __builtin_amdgcn_ds_read_tr16_b64_v4i16((LAS s16x4*)(uintptr_t)lds_addr); }
__device__ __forceinline__ bf16x8 pack8(const f32x16& x, int s) {
    u32x4 pk;
    pk.x = cvt_pk_bf16(x[8 * s + 0], x[8 * s + 1]); pk.y = cvt_pk_bf16(x[8 * s + 2], x[8 * s + 3]); pk.z = cvt_pk_bf16(x[8 * s + 4], x[8 * s + 5]); pk.w = cvt_pk_bf16(x[8 * s + 6], x[8 * s + 7]);
    return __builtin_bit_cast(bf16x8, pk);
}
__device__ __forceinline__ void attn_prompt_tile(const bf16_t* QKV, bf16_t* OG, float* LSE, LAS unsigned char* vl, int g, int b, int h, int w, int lane) {
    const int dsh = 2 * g, d = 1 << dsh;
    const int tpr_sh = 6 - dsh;
    const int r = w >> tpr_sh, jt = w & ((1 << tpr_sh) - 1), j0 = jt * 32;
    const int q = lane & 31, hh = lane >> 5;
    const size_t rowb = (size_t)b * SEQ;
    const int qcol = g * 512 + h * 64, kcol = 1536 + qcol, vcol = 3072 + qcol;
    const int tq = ((j0 + q) << dsh) + r;
    const bf16_t* qp = QKV + (rowb + tq) * NQKV + qcol + 8 * hh;
    bf16x8 qf[4];
#pragma unroll
    for (int s = 0; s < 4; ++s) qf[s] = *(const bf16x8*)(qp + 16 * s);
    const int kb0 = jt >= 4 ? 0 : 4 - jt;
    f32x16 S[5];
    float mx = -INFINITY;
    bf16x8 kfa[5][4];
#pragma unroll
    for (int kb = 0; kb < 5; ++kb) {
        int jk = j0 - 128 + kb * 32 + q; jk = jk < 0 ? 0 : jk;
        const bf16_t* kp = QKV + (rowb + (size_t)((jk << dsh) + r)) * NQKV + kcol + 8 * hh;
#pragma unroll
        for (int s = 0; s < 4; ++s) kfa[kb][s] = *(const bf16x8*)(kp + 16 * s);
    }
#pragma unroll
    for (int kb = 0; kb < 5; ++kb) {
        f32x16 c;
#pragma unroll
        for (int i = 0; i < 16; ++i) c[i] = 0.f;
#pragma unroll
        for (int s = 0; s < 4; ++s) c = MFMA32(kfa[kb][s], qf[s], c);
#pragma unroll
        for (int i = 0; i < 16; ++i) {
            const int ki = (i & 3) + 8 * (i >> 2) + 4 * hh;
            bool valid = kb >= kb0;
            if (kb == 0) valid = valid && (ki >= q);
            if (kb == 4) valid = valid && (ki <= q);
            const float sv = valid ? c[i] * 0.125f : -INFINITY;
            c[i] = sv; mx = fmaxf(mx, sv);
        }
        S[kb] = c;
    }
    bf16x8 vva[5][4];
#pragma unroll
    for (int kb = 0; kb < 5; ++kb)
#pragma unroll
        for (int c4 = 0; c4 < 4; ++c4) {
            const int i = c4 * 8 + (lane >> 3); int jk = j0 - 128 + kb * 32 + i; jk = jk < 0 ? 0 : jk;
            vva[kb][c4] = *(const bf16x8*)(QKV + (rowb + (size_t)((jk << dsh) + r)) * NQKV + vcol + (lane & 7) * 8);
        }
    mx = fmaxf(mx, __shfl_xor(mx, 32));
    float l = 0.f;
#pragma unroll
    for (int kb = 0; kb < 5; ++kb)
#pragma unroll
        for (int i = 0; i < 16; ++i) { const float e = __expf(S[kb][i] - mx); S[kb][i] = e; l += e; }
    l += __shfl_xor(l, 32);
    const float inv = 1.0f / l;
    f32x16 o0, o1;
#pragma unroll
    for (int i = 0; i < 16; ++i) { o0[i] = 0.f; o1[i] = 0.f; }
    const unsigned vbase = (unsigned)(uintptr_t)vl;
    const unsigned tr_off = (unsigned)((4 * hh + ((lane & 15) >> 2)) * 144 + ((lane >> 4) & 1) * 32 + 8 * (lane & 3));
#pragma unroll
    for (int kb = 0; kb < 5; ++kb) {
        {
#pragma unroll
            for (int c4 = 0; c4 < 4; ++c4) *(LAS bf16x8*)(vl + (c4 * 8 + (lane >> 3)) * 144 + (lane & 7) * 16) = vva[kb][c4];
#pragma unroll
            for (int s2 = 0; s2 < 2; ++s2) {
                f32x16 pn = S[kb];
#pragma unroll
                for (int i = 0; i < 16; ++i) pn[i] *= inv;
                const bf16x8 pb = pack8(pn, s2);
#pragma unroll
                for (int nb = 0; nb < 2; ++nb) {
                    const unsigned a0 = vbase + tr_off + (unsigned)(16 * s2 * 144 + nb * 64);
                    const s16x4 lo = tr_read(a0), hi = tr_read(a0 + 8 * 144);
                    const bf16x8 va = __builtin_shufflevector(lo, hi, 0, 1, 2, 3, 4, 5, 6, 7);
                    if (nb == 0) o0 = MFMA32(va, pb, o0); else o1 = MFMA32(va, pb, o1);
                }
            }
        }
    }
    const size_t orow = (size_t)g * M + rowb + tq;
    bf16_t* op = OG + orow * AW + h * 64 + 4 * hh;
#pragma unroll
    for (int g4 = 0; g4 < 4; ++g4) {
        u32x2 w0, w1;
        w0.x = cvt_pk_bf16(o0[4 * g4], o0[4 * g4 + 1]); w0.y = cvt_pk_bf16(o0[4 * g4 + 2], o0[4 * g4 + 3]);
        w1.x = cvt_pk_bf16(o1[4 * g4], o1[4 * g4 + 1]); w1.y = cvt_pk_bf16(o1[4 * g4 + 2], o1[4 * g4 + 3]);
        *(u32x2*)(op + 8 * g4) = w0; *(u32x2*)(op + 32 + 8 * g4) = w1;
    }
    if (hh == 0) LSE[orow * 8 + h] = mx + __logf(l);
}
__device__ __forceinline__ void attn_sample_item(const Params& p, unsigned char* ws, int item, LAS float* sc, int lane) {
    const int j = item & 7, h = (item >> 3) & 7, gb = item >> 6, g = gb % 3, b = gb / 3;
    const int dsh = 2 * g, L = 128 << dsh;
    const float* cache = (g == 0 ? p.in[2] : (g == 1 ? p.in[3] : p.in[4])) + (size_t)b * L * 1024;
    const bf16_t* QKV = (const bf16_t*)(ws + WS_BIG);
    const int row = MP + b * 8 + j;
    const int sub = lane & 15, ks = lane >> 4;
    const int qcol = g * 512 + h * 64 + 4 * sub;
    const u32x2 qr = *(const u32x2*)(QKV + (size_t)row * NQKV + qcol);
    const f32x4 qv = {bf_lo(qr.x), bf_hi(qr.x), bf_lo(qr.y), bf_hi(qr.y)};
#pragma unroll 11
    for (int it = 0; it < 33; ++it) {
        const int i = it * 4 + ks;
        float dot = 0.f;
        if (i <= 128) {
            const int idx = L + j - (i << dsh);
            f32x4 kv;
            if (idx >= L) { const u32x2 kr = *(const u32x2*)(QKV + (size_t)(MP + b * 8 + (idx - L)) * NQKV + 1536 + qcol); kv = (f32x4){bf_lo(kr.x), bf_hi(kr.x), bf_lo(kr.y), bf_hi(kr.y)}; }
            else kv = *(const f32x4*)(cache + (size_t)idx * 1024 + h * 64 + 4 * sub);
            dot = (qv.x * kv.x + qv.y * kv.y) + (qv.z * kv.z + qv.w * kv.w);
        }
        dot += __shfl_xor(dot, 1); dot += __shfl_xor(dot, 2); dot += __shfl_xor(dot, 4); dot += __shfl_xor(dot, 8);
        if (sub == 0 && i <= 128) sc[i] = dot * 0.125f;
    }
    asm volatile("s_waitcnt lgkmcnt(0)" ::: "memory");
    float mx = fmaxf(sc[lane], sc[lane + 64]); if (lane == 0) mx = fmaxf(mx, sc[128]);
    mx = wave_max(mx);
    float l = __expf(sc[lane] - mx) + __expf(sc[lane + 64] - mx); if (lane == 0) l += __expf(sc[128] - mx);
    l = wave_sum(l);
    const float inv = 1.0f / l;
    f32x4 acc = {0.f, 0.f, 0.f, 0.f};
#pragma unroll 11
    for (int it = 0; it < 33; ++it) {
        const int i = it * 4 + ks;
        if (i <= 128) {
            const float pw = __expf(sc[i] - mx) * inv;
            const int idx = L + j - (i << dsh);
            f32x4 vv;
            if (idx >= L) { const u32x2 vr = *(const u32x2*)(QKV + (size_t)(MP + b * 8 + (idx - L)) * NQKV + 3072 + qcol); vv = (f32x4){bf_lo(vr.x), bf_hi(vr.x), bf_lo(vr.y), bf_hi(vr.y)}; }
            else vv = *(const f32x4*)(cache + (size_t)idx * 1024 + 512 + h * 64 + 4 * sub);
            acc += vv * pw;
        }
    }
#pragma unroll
    for (int k = 0; k < 4; ++k) { acc[k] += __shfl_xor(acc[k], 16); acc[k] += __shfl_xor(acc[k], 32); }
    const size_t orow = (size_t)g * M + row;
    if (ks == 0) { u32x2 w; w.x = cvt_pk_bf16(acc.x, acc.y); w.y = cvt_pk_bf16(acc.z, acc.w); *(u32x2*)((bf16_t*)(ws + WS_OG) + orow * AW + h * 64 + 4 * sub) = w; }
    if (lane == 0) ((float*)(ws + WS_LSE))[orow * 8 + h] = mx + __logf(l);
    asm volatile("s_waitcnt lgkmcnt(0)" ::: "memory");
}
__device__ __forceinline__ void attn_prompt_block(const bf16_t* QKV, bf16_t* OG, float* LSE, LAS unsigned char* lds, int g, int b, int h, int w8, const int tid) {
    const int lane = tid & 63, wave = __builtin_amdgcn_readfirstlane(tid >> 6);
    const int dsh = 2 * g, tpr_sh = 6 - dsh;
    const size_t rowb = (size_t)b * SEQ;
    const int qcol = g * 512 + h * 64, kcol = 1536 + qcol, vcol = 3072 + qcol;
    LAS unsigned char* Kl = lds; LAS unsigned char* Vl = lds + 55296;
    const int w = w8 * 8 + wave, r = w >> tpr_sh, jt = w & ((1 << tpr_sh) - 1), j0 = jt * 32;
    const int q = lane & 31, hh = lane >> 5;
    const int tq = ((j0 + q) << dsh) + r;
    const bf16_t* qp = QKV + (rowb + tq) * NQKV + qcol + 8 * hh;
    bf16x8 qf[4];
#pragma unroll
    for (int s = 0; s < 4; ++s) qf[s] = *(const bf16x8*)(qp + 16 * s);
    __syncthreads();
    {
        bf16x8 kr[6], vr[6];
#pragma unroll
        for (int i = 0; i < 6; ++i) {
            const int p = tid + 512 * i, sl = p >> 3, c = p & 7;
            int j, rr; bool valid;
            if (g == 2) { valid = sl < 256; j = sl & 127; rr = 2 * w8 + (sl >> 7); }
            else if (g == 1) { j = 256 * (w8 & 1) - 128 + sl; rr = w8 >> 1; valid = j >= 0; }
            else { j = 256 * w8 - 128 + sl; rr = 0; valid = j >= 0; }
            j = valid ? j : 0;
            const bf16_t* src = QKV + (rowb + (size_t)((j << dsh) + rr)) * NQKV + c * 8;
            kr[i] = *(const bf16x8*)(src + kcol); vr[i] = *(const bf16x8*)(src + vcol);
        }
#pragma unroll
        for (int i = 0; i < 6; ++i) {
            const int p = tid + 512 * i, sl = p >> 3, c = p & 7;
            *(LAS bf16x8*)(Kl + sl * 144 + c * 16) = kr[i]; *(LAS bf16x8*)(Vl + sl * 144 + c * 16) = vr[i];
        }
    }
    __syncthreads();
    const int jstart = g == 2 ? -128 * (wave >> 2) : (g == 1 ? 256 * (w8 & 1) - 128 : 256 * w8 - 128);
    const int kb0 = jt >= 4 ? 0 : 4 - jt;
    f32x16 S[5];
    float mx = -INFINITY;
#pragma unroll
    for (int kb = 0; kb < 5; ++kb) {
        f32x16 c;
#pragma unroll
        for (int i = 0; i < 16; ++i) c[i] = 0.f;
        const int jb = j0 - 128 + kb * 32;
        const int slot = jb < 0 ? -jstart : jb - jstart + q;
        bf16x8 kf[4];
#pragma unroll
        for (int s = 0; s < 4; ++s) kf[s] = *(const LAS bf16x8*)(Kl + slot * 144 + s * 32 + hh * 16);
#pragma unroll
        for (int s = 0; s < 4; ++s) c = MFMA32(kf[s], qf[s], c);
#pragma unroll
        for (int i = 0; i < 16; ++i) {
            const int ki = (i & 3) + 8 * (i >> 2) + 4 * hh;
            bool valid = kb >= kb0;
            if (kb == 0) valid = valid && (ki >= q);
            if (kb == 4) valid = valid && (ki <= q);
            const float sv = valid ? c[i] * 0.125f : -INFINITY;
            c[i] = sv; mx = fmaxf(mx, sv);
        }
        S[kb] = c;
    }
    mx = fmaxf(mx, __shfl_xor(mx, 32));
    float l = 0.f;
#pragma unroll
    for (int kb = 0; kb < 5; ++kb)
#pragma unroll
        for (int i = 0; i < 16; ++i) { const float e = __expf(S[kb][i] - mx); S[kb][i] = e; l += e; }
    l += __shfl_xor(l, 32);
    const float inv = 1.0f / l;
    f32x16 o0, o1;
#pragma unroll
    for (int i = 0; i < 16; ++i) { o0[i] = 0.f; o1[i] = 0.f; }
    const unsigned vbase = (unsigned)(uintptr_t)Vl;
    const int trrow = 4 * hh + ((lane & 15) >> 2);
    const unsigned trcol = (unsigned)(((lane >> 4) & 1) * 32 + 8 * (lane & 3));
#pragma unroll
    for (int kb = 0; kb < 5; ++kb) {
        const int jb = j0 - 128 + kb * 32;
        const int sbase = jb < 0 ? -jstart : jb - jstart, sstr = jb < 0 ? 0 : 144;
#pragma unroll
        for (int s2 = 0; s2 < 2; ++s2) {
            f32x16 pn = S[kb];
#pragma unroll
            for (int i = 0; i < 16; ++i) pn[i] *= inv;
            const bf16x8 pb = pack8(pn, s2);
#pragma unroll
            for (int nb = 0; nb < 2; ++nb) {
                const unsigned a0 = vbase + (unsigned)(sbase * 144 + (16 * s2 + trrow) * sstr) + trcol + (unsigned)(nb * 64);
                const s16x4 lo = tr_read(a0), hi = tr_read(a0 + (unsigned)(8 * sstr));
                const bf16x8 va = __builtin_shufflevector(lo, hi, 0, 1, 2, 3, 4, 5, 6, 7);
                if (nb == 0) o0 = MFMA32(va, pb, o0); else o1 = MFMA32(va, pb, o1);
            }
        }
    }
    const size_t orow = (size_t)g * M + rowb + tq;
    bf16_t* op = OG + orow * AW + h * 64 + 4 * hh;
#pragma unroll
    for (int g4 = 0; g4 < 4; ++g4) {
        u32x2 w0, w1;
        w0.x = cvt_pk_bf16(o0[4 * g4], o0[4 * g4 + 1]); w0.y = cvt_pk_bf16(o0[4 * g4 + 2], o0[4 * g4 + 3]);
        w1.x = cvt_pk_bf16(o1[4 * g4], o1[4 * g4 + 1]); w1.y = cvt_pk_bf16(o1[4 * g4 + 2], o1[4 * g4 + 3]);
        *(u32x2*)(op + 8 * g4) = w0; *(u32x2*)(op + 32 + 8 * g4) = w1;
    }
    if (hh == 0) LSE[orow * 8 + h] = mx + __logf(l);
}
__device__ __forceinline__ void phase_attn(const Params& p, unsigned char* ws, LAS unsigned char* lds, const int tid) {
    const int lane = tid & 63, wave = __builtin_amdgcn_readfirstlane(tid >> 6);
    LAS unsigned char* vl = lds + wave * 4608;
    constexpr int NS = 768, NP = 3072;
    for (int bi = blockIdx.x; bi < NS; bi += gridDim.x) attn_sample_item(p, ws, bi * 8 + wave, (LAS float*)vl, lane);
    for (int x = blockIdx.x; x < NP; x += gridDim.x) {
        const int w8 = x & 7, h = (x >> 3) & 7, b = (x >> 6) & 15, g = x >> 10;
        attn_prompt_block((const bf16_t*)(ws + WS_BIG), (bf16_t*)(ws + WS_OG), (float*)(ws + WS_LSE), lds, g, b, h, w8, tid);
    }
    __syncthreads();
}
__device__ __forceinline__ void phase_merge(unsigned char* ws, const int tid) {
    const bf16_t* OG = (const bf16_t*)(ws + WS_OG); const float* LSE = (const float*)(ws + WS_LSE); bf16_t* AO = (bf16_t*)(ws + WS_AO);
    for (int e = blockIdx.x * 512 + tid; e < M * 64; e += gridDim.x * 512) {
        const int rh = e >> 3, c8 = e & 7;
        const float l0 = LSE[rh], l1 = LSE[(size_t)M * 8 + rh], l2 = LSE[(size_t)2 * M * 8 + rh];
        const float mx = fmaxf(l0, fmaxf(l1, l2));
        float w0 = __expf(l0 - mx), w1 = __expf(l1 - mx), w2 = __expf(l2 - mx); const float inv = 1.0f / (w0 + w1 + w2); w0 *= inv; w1 *= inv; w2 *= inv;
        const size_t off = (size_t)rh * 64 + c8 * 8;
        const u32x4 a = *(const u32x4*)(OG + off), b = *(const u32x4*)(OG + (size_t)M * AW + off), c = *(const u32x4*)(OG + (size_t)2 * M * AW + off);
        u32x4 o;
#pragma unroll
        for (int k = 0; k < 4; ++k) o[k] = cvt_pk_bf16(w0 * bf_lo(a[k]) + w1 * bf_lo(b[k]) + w2 * bf_lo(c[k]), w0 * bf_hi(a[k]) + w1 * bf_hi(b[k]) + w2 * bf_hi(c[k]));
        *(u32x4*)(AO + off) = o;
    }
}

__device__ __forceinline__ void phase_vnorm(const Params& p, unsigned char* ws, float* out, const int tid) {
    const int lane = tid & 63, wave = tid >> 6;
    const int gw = blockIdx.x * 8 + wave, NGW = gridDim.x * 8;
    const bf16_t* UV = (const bf16_t*)(ws + WS_BIG); float* RV = (float*)(ws + WS_RV);
    for (int m = gw; m < M; m += NGW) {
        const u32x4* vr = (const u32x4*)(UV + (size_t)m * NUV + BW) + lane;
        u32x4 v[4]; float ss = 0.f;
#pragma unroll
        for (int j = 0; j < 4; ++j) { v[j] = vr[64 * j];
#pragma unroll
            for (int k = 0; k < 4; ++k) { const float a = bf_lo(v[j][k]), b = bf_hi(v[j][k]); ss += a * a + b * b; } }
        const float r = 1.0f / sqrtf(wave_sum(ss) * (1.0f / BW) + EPS);
        if (lane == 0) RV[m] = r;
        if (m >= MP) {
            float* dst = out + O_VS + (size_t)(m - MP) * BW;
#pragma unroll
            for (int j = 0; j < 4; ++j) { const int c0 = 8 * (lane + 64 * j); const f32x4 ga = *(const f32x4*)(p.in[12] + c0), gb = *(const f32x4*)(p.in[12] + c0 + 4);
                *(f32x4*)(dst + c0) = (f32x4){bf_lo(v[j][0]) * r * ga.x, bf_hi(v[j][0]) * r * ga.y, bf_lo(v[j][1]) * r * ga.z, bf_hi(v[j][1]) * r * ga.w};
                *(f32x4*)(dst + c0 + 4) = (f32x4){bf_lo(v[j][2]) * r * gb.x, bf_hi(v[j][2]) * r * gb.y, bf_lo(v[j][3]) * r * gb.z, bf_hi(v[j][3]) * r * gb.w}; }
        }
    }
}
__device__ __forceinline__ void spatial_item(const Params& p, unsigned char* ws, LAS unsigned char* lds, int chunk, int gi, const int tid) {
    const bf16_t* UV = (const bf16_t*)(ws + WS_BIG); const float* RV = (const float*)(ws + WS_RV); bf16_t* UM = (bf16_t*)(ws + WS_UM);
    const bf16_t* WSP = (const bf16_t*)(ws + WS_WSP);
    constexpr int PITCH = 272;
    const int lane = tid & 63, wave = __builtin_amdgcn_readfirstlane(tid >> 6), tb = wave & 3, ch = wave >> 2, hh = lane >> 5;
    const int t = 32 * tb + (lane & 31);
    const bf16_t* wp = WSP + ((size_t)gi * 128 + t) * 128 + 8 * hh;
    bf16x8 wfa[8];
#pragma unroll
    for (int ks = 0; ks < 8; ++ks) wfa[ks] = *(const bf16x8*)(wp + 16 * ks);
    const size_t row = (size_t)chunk * 128 + t;
    const int colb = gi * 128 + 64 * ch;
    const bf16_t* up = UV + row * NUV + colb + 4 * hh;
    u32x2 ur[8];
#pragma unroll
    for (int k = 0; k < 8; ++k) ur[k] = *(const u32x2*)(up + 32 * (k >> 2) + 8 * (k & 3));
    const float bias = p.in[14][gi * 128 + t];
    __syncthreads();
#pragma unroll
    for (int k = 0; k < 4; ++k) {
        const int pc = tid + 512 * k, sr = pc >> 4, c16 = pc & 15;
        const u32x4 raw = *(const u32x4*)(UV + (size_t)(chunk * 128 + sr) * NUV + BW + gi * 128 + c16 * 8);
        const float rv = RV[chunk * 128 + sr];
        const f32x4 ga = *(const f32x4*)(p.in[12] + gi * 128 + c16 * 8), gb = *(const f32x4*)(p.in[12] + gi * 128 + c16 * 8 + 4);
        u32x4 o;
        o.x = cvt_pk_bf16(bf_lo(raw.x) * rv * ga.x, bf_hi(raw.x) * rv * ga.y); o.y = cvt_pk_bf16(bf_lo(raw.y) * rv * ga.z, bf_hi(raw.y) * rv * ga.w);
        o.z = cvt_pk_bf16(bf_lo(raw.z) * rv * gb.x, bf_hi(raw.z) * rv * gb.y); o.w = cvt_pk_bf16(bf_lo(raw.w) * rv * gb.z, bf_hi(raw.w) * rv * gb.w);
        *(LAS u32x4*)(lds + sr * PITCH + c16 * 16) = o;
    }
    __syncthreads();
    f32x16 a0, a1;
#pragma unroll
    for (int i = 0; i < 16; ++i) { a0[i] = 0.f; a1[i] = 0.f; }
    const unsigned lbase = (unsigned)(uintptr_t)lds;
    const unsigned tr_off = (unsigned)((8 * hh + ((lane & 15) >> 2)) * PITCH + (64 * ch + 16 * ((lane >> 4) & 1)) * 2 + 8 * (lane & 3));
#pragma unroll
    for (int ks = 0; ks < 8; ++ks) {
        if (ks < 2 * (tb + 1)) {
#pragma unroll
            for (int cb = 0; cb < 2; ++cb) {
                const unsigned a = lbase + tr_off + (unsigned)(16 * ks * PITCH + cb * 64);
                const s16x4 lo = tr_read(a), hi = tr_read(a + 4 * PITCH);
                const bf16x8 va = __builtin_shufflevector(lo, hi, 0, 1, 2, 3, 4, 5, 6, 7);
                if (cb == 0) a0 = MFMA32(va, wfa[ks], a0); else a1 = MFMA32(va, wfa[ks], a1);
            }
        }
    }
    bf16_t* op = UM + row * LDU + colb + 4 * hh;
#pragma unroll
    for (int cb = 0; cb < 2; ++cb)
#pragma unroll
        for (int g4 = 0; g4 < 4; ++g4) {
            const u32x2 uu = ur[cb * 4 + g4];
            const f32x16& a = cb == 0 ? a0 : a1;
            u32x2 w;
            w.x = cvt_pk_bf16(bf_lo(uu.x) * (a[4 * g4] + bias), bf_hi(uu.x) * (a[4 * g4 + 1] + bias));
            w.y = cvt_pk_bf16(bf_lo(uu.y) * (a[4 * g4 + 2] + bias), bf_hi(uu.y) * (a[4 * g4 + 3] + bias));
            *(u32x2*)(op + 32 * cb + 8 * g4) = w;
        }
}
__device__ __forceinline__ void phase_spatial(const Params& p, unsigned char* ws, LAS unsigned char* lds, const int tid) {
    const int lane = tid & 63, wave = __builtin_amdgcn_readfirstlane(tid >> 6);
    const bf16_t* UV = (const bf16_t*)(ws + WS_BIG); const float* RV = (const float*)(ws + WS_RV); bf16_t* UM = (bf16_t*)(ws + WS_UM);
    const float* vgain = p.in[12]; const float* bsp = p.in[14];
    constexpr int NPI = 256 * 16, NSI = 256;
    LAS unsigned char* vl = lds + wave * 4608;
    for (int it = blockIdx.x; it < NPI + NSI; it += gridDim.x) {
        if (it < NPI) spatial_item(p, ws, lds, it >> 4, it & 15, tid);
        else {
            const int e = (it - NPI) * 512 + tid;
            const int c4 = e & 511, bt = e >> 9, t = bt & 7, b = bt >> 3, c0 = 4 * c4, gi = c0 >> 7;
            f32x4 acc = {0.f, 0.f, 0.f, 0.f};
            const f32x4 vg = *(const f32x4*)(vgain + c0);
            for (int s = 0; s <= t; ++s) {
                const size_t r = (size_t)MP + b * 8 + s;
                const u32x2 vr = *(const u32x2*)(UV + r * NUV + BW + c0);
                const float wv = p.in[13][((size_t)gi * 128 + t) * 128 + s] * RV[r];
                acc += (f32x4){bf_lo(vr.x), bf_hi(vr.x), bf_lo(vr.y), bf_hi(vr.y)} * wv;
            }
            const float bias = bsp[gi * 128 + t];
            const size_t r = (size_t)MP + b * 8 + t;
            const u32x2 ur = *(const u32x2*)(UV + r * NUV + c0);
            u32x2 w;
            w.x = cvt_pk_bf16(bf_lo(ur.x) * (acc.x * vg.x + bias), bf_hi(ur.x) * (acc.y * vg.y + bias));
            w.y = cvt_pk_bf16(bf_lo(ur.y) * (acc.z * vg.z + bias), bf_hi(ur.y) * (acc.w * vg.w + bias));
            *(u32x2*)(UM + r * LDU + c0) = w;
        }
    }
}

constexpr int BAR_WORDS = 64 * 18;
__device__ __forceinline__ void grid_barrier(unsigned* bar, const int tid, volatile LAS unsigned* ctl) {
    asm volatile("s_waitcnt vmcnt(0) lgkmcnt(0)" ::: "memory");
    __syncthreads();
    if (tid == 0) {
        const unsigned x = (unsigned)__builtin_amdgcn_s_getreg((3 << 11) | 20) & 7u, nloc = ctl[0], nx = ctl[1];
        if (__hip_atomic_fetch_add(bar + 64 * x, 1u, __ATOMIC_RELAXED, __HIP_MEMORY_SCOPE_AGENT) == nloc - 1u) {
            __builtin_amdgcn_fence(__ATOMIC_RELEASE, "agent");
            asm volatile("s_waitcnt vmcnt(0)" ::: "memory");
            if (__hip_atomic_fetch_add(bar + 64 * 8, 1u, __ATOMIC_RELAXED, __HIP_MEMORY_SCOPE_AGENT) == nx - 1u) __hip_atomic_store(bar + 64 * 9, 1u, __ATOMIC_RELAXED, __HIP_MEMORY_SCOPE_AGENT);
            else while (__hip_atomic_load(bar + 64 * 9, __ATOMIC_RELAXED, __HIP_MEMORY_SCOPE_AGENT) == 0u) __builtin_amdgcn_s_sleep(1);
            __builtin_amdgcn_fence(__ATOMIC_ACQUIRE, "agent");
            __hip_atomic_store(bar + 64 * (10 + x), 1u, __ATOMIC_RELAXED, __HIP_MEMORY_SCOPE_AGENT);
            asm volatile("s_waitcnt vmcnt(0)" ::: "memory");
        } else {
            while (__hip_atomic_load(bar + 64 * (10 + x), __ATOMIC_RELAXED, __HIP_MEMORY_SCOPE_AGENT) == 0u) __builtin_amdgcn_s_sleep(1);
            __builtin_amdgcn_fence(__ATOMIC_ACQUIRE, "agent");
            asm volatile("s_waitcnt vmcnt(0)" ::: "memory");
        }
    }
    __syncthreads();
}

__global__ void __launch_bounds__(512, 2) mega(Params p) {
    extern __shared__ __attribute__((aligned(16))) unsigned char lds_raw[];
    LAS unsigned char* lds = (LAS unsigned char*)lds_raw;
    for (int pi = p.ph_lo; pi < p.ph_hi; ++pi) {
        int ph = pi;
        if (DUPMASK) { int q = 0, r = 0; for (; q < NPHASE; ++q) { if (r == pi) break; ++r; if ((DUPMASK >> q) & 1u) { if (r == pi) break; ++r; } } ph = q; }
        int tid = threadIdx.x; asm volatile("" : "+v"(tid));
        unsigned z; asm volatile("s_mov_b32 %0, 0" : "=s"(z));
        unsigned char* ws = p.ws + z; float* out = p.out + z;
        bf16_t* XN = (bf16_t*)(ws + WS_XN); bf16_t* BIG = (bf16_t*)(ws + WS_BIG);
        bf16_t* YB = (bf16_t*)(ws + WS_YB);
        int fi = -1, fo = -1, ni = -1; float sy = 0.5f;
        switch (ph) {
            case 1: fi = 0; break; case 10: fi = 1; break; case 13: fi = 2; break; case 21: fi = 3; break;
            case 2: fo = 0; break; case 11: fo = 1; break; case 14: fo = 2; break; case 22: fo = 3; break;
            case 3: ni = 1; break; case 9: ni = 2; sy = 1.0f; break; case 12: ni = 3; break; case 15: ni = 4; break; case 20: ni = 5; sy = 1.0f; break; case 23: ni = 6; break;
            default: break;
        }
#ifndef PMASK
#define PMASK 0xFFFF
#endif
        if ((PMASK & 1) && ph == 0) phase_prologue(p, ws, out, lds, tid);
        else if ((PMASK & 2) && fi >= 0) { const bf16_t* W = (const bf16_t*)(ws + WS_WIN + fi * SZ_WIN); sample_gemm<2, 8>(lds, XN + (size_t)MP * D, D, W, D, D, FF, BIG + (size_t)MP * FF, FF, tid);
            pg8::EpiSwiglu E{BIG}; pg8::gemm_phase(lds, XN, W, MP, 2 * FF, D, E, tid); }
        else if (ph == 22) {
            const bf16_t* B = (const bf16_t*)(ws + WS_WOUT + 3 * SZ_WOUT);
            sample_gemm<4, 22>(lds, BIG + (size_t)MP * FF, FF, B, FF, FF, D, (bf16_t*)(ws + WS_XB) + (size_t)MP * D, D, tid, out + (size_t)MP * D);
            pg8::EpiFinal E{out, (const bf16_t*)(ws + WS_XB), 0.5f}; pg8::gemm_phase(lds, BIG, B, MP, D, FF, E, tid); }
        else if ((PMASK & 4) && (fo >= 0 || ph == 8 || ph == 19)) {
            const bf16_t* A = BIG; const bf16_t* B = (const bf16_t*)(ws + WS_WOUT + (fo < 0 ? 0 : fo) * SZ_WOUT); int K = FF, ld = FF;
            if (ph == 8) { A = (const bf16_t*)(ws + WS_AO); B = (const bf16_t*)(ws + WS_WOA); K = AW; ld = AW; }
            if (ph == 19) { A = (const bf16_t*)(ws + WS_UM); B = (const bf16_t*)(ws + WS_WOB); K = BW; ld = LDU; }
            bf16_t* XBp = (bf16_t*)(ws + WS_XB); const float rs = fo >= 0 ? 0.5f : 1.0f;
            if (K == FF) sample_gemm<5, 22>(lds, A + (size_t)MP * ld, ld, B, ld, K, D, XBp + (size_t)MP * D, D, tid, nullptr, rs);
            else if (K == AW) sample_gemm<5, 4>(lds, A + (size_t)MP * ld, ld, B, ld, K, D, XBp + (size_t)MP * D, D, tid, nullptr, rs);
            else sample_gemm<5, 16>(lds, A + (size_t)MP * ld, ld, B, ld, K, D, XBp + (size_t)MP * D, D, tid, nullptr, rs);
            pg8::EpiResidB E{XBp, rs}; pg8::gemm_phase(lds, A, B, MP, D, K, E, tid, ld, ld); }
#ifdef DUMPSEL
        else if (ph == 20) {
            const bf16_t* wsp = (const bf16_t*)(ws + WS_WSP); const float* rvp = (const float*)(ws + WS_RV);
            for (size_t e = (size_t)blockIdx.x * 512 + tid; e < (size_t)M * D; e += (size_t)gridDim.x * 512) { const size_t r = e / D, c = e % D;
                out[e] = (DUMPSEL == 10) ? p.in[12][(c + r) % 2048] * p.in[14][(c * 3 + r) % 2048] * (1.0f + p.in[13][(r * 1024 + c) % 262144]) : (DUMPSEL == 2) ? (r >= (size_t)MP ? 0.f : 1.f) * __uint_as_float((unsigned)((const bf16_t*)(ws + WS_UM))[r * LDU + c] << 16) : (DUMPSEL == 8) ? (r < 256 ? __uint_as_float((unsigned)wsp[r * 1024 + c] << 16) : 0.f) : rvp[r]; }
        }
#endif
        else if ((PMASK & 8) && ni >= 0) phase_norm(ws, out, ni < 6 ? p.in[5] + ni * D : nullptr, sy, tid);
        else if ((PMASK & 16) && ph == 4) { sample_gemm<3, 8>(lds, XN + (size_t)MP * D, D, (const bf16_t*)(ws + WS_WQKV), D, D, NQKV, BIG + (size_t)MP * NQKV, NQKV, tid);
            const float* ctab = (const float*)(ws + WS_ROPE);
            pg8::EpiQKV E{BIG, ctab, ctab + NPOS * 32, p.in[9], out}; pg8::gemm_phase(lds, XN, (const bf16_t*)(ws + WS_WQKV), MP, NQKV, D, E, tid); }
        else if ((PMASK & 32) && ph == 5) phase_qknorm(p, ws, out, tid);
        else if ((PMASK & 64) && ph == 6) phase_attn(p, ws, lds, tid);
        else if ((PMASK & 128) && ph == 7) phase_merge(ws, tid);
        else if ((PMASK & 512) && ph == 16) { sample_gemm<1, 8>(lds, XN + (size_t)MP * D, D, (const bf16_t*)(ws + WS_WUV), D, D, NUV, BIG + (size_t)MP * NUV, NUV, tid);
            pg8::EpiBf16<1> E{BIG, NUV}; pg8::gemm_phase(lds, XN, (const bf16_t*)(ws + WS_WUV), MP, NUV, D, E, tid); }
        else if ((PMASK & 1024) && ph == 17) phase_vnorm(p, ws, out, tid);
        else if ((PMASK & 2048) && ph == 18) phase_spatial(p, ws, lds, tid);
        if (pi + 1 < p.ph_hi) {
            volatile LAS unsigned* ctl = (volatile LAS unsigned*)(lds + 135168);
            if (pi == 0) {
                const unsigned x = (unsigned)__builtin_amdgcn_s_getreg((3 << 11) | 20) & 7u;
                if (tid == 0) __hip_atomic_fetch_add((unsigned*)p.ws + 64 * x, 1u, __ATOMIC_RELAXED, __HIP_MEMORY_SCOPE_AGENT);
                __syncthreads(); cg::this_grid().sync();
                if (tid == 0) { unsigned nx = 0;
                    for (int j = 0; j < 8; ++j) nx += __hip_atomic_load((unsigned*)p.ws + 64 * j, __ATOMIC_RELAXED, __HIP_MEMORY_SCOPE_AGENT) != 0u;
                    ctl[0] = __hip_atomic_load((unsigned*)p.ws + 64 * x, __ATOMIC_RELAXED, __HIP_MEMORY_SCOPE_AGENT); ctl[1] = nx; }
                __syncthreads();
            }
            else grid_barrier((unsigned*)p.ws + (size_t)BAR_WORDS * pi, tid, ctl);
        }
    }
}

extern "C" void kernel_launch(void* const* d_in, const int* in_sizes, int n_in, void* d_out, int out_size, void* d_ws, size_t ws_size, hipStream_t stream) {
    static int grid = 0;
    if (grid == 0) {
        if (n_in != 16 || ws_size < WS_END) { fprintf(stderr, "kernel_launch: unexpected inputs (n_in %d, ws %zu < %zu)\n", n_in, ws_size, (size_t)WS_END); grid = -1; return; }
        int dev = 0, cus = 0, per_cu = 0;
        (void)hipGetDevice(&dev);
        (void)hipDeviceGetAttribute(&cus, hipDeviceAttributeMultiprocessorCount, dev);
        if (hipFuncSetAttribute((const void*)mega, hipFuncAttributeMaxDynamicSharedMemorySize, LDS_BYTES) != hipSuccess) { fprintf(stderr, "kernel_launch: hipFuncSetAttribute failed\n"); grid = -1; return; }
        if (hipOccupancyMaxActiveBlocksPerMultiprocessor(&per_cu, (const void*)mega, 512, LDS_BYTES) != hipSuccess || per_cu < 1) { fprintf(stderr, "kernel_launch: occupancy query says %d\n", per_cu); per_cu = 1; }
        (void)hipGetLastError();
        grid = cus * 1;
    }
    if (grid < 0) return;
    if (hipMemsetAsync(d_ws, 0, 262144, stream) != hipSuccess) { fprintf(stderr, "kernel_launch: memset failed\n"); return; }
    Params p{};
    for (int i = 0; i < 16; ++i) p.in[i] = (const float*)d_in[i];
    p.out = (float*)d_out; p.ws = (unsigned char*)d_ws;
#if ONE_LAUNCH
    p.ph_lo = 0; p.ph_hi = NPHASE + __builtin_popcount(DUPMASK);
    void* args[] = {&p};
    hipError_t e = hipLaunchCooperativeKernel((const void*)mega, dim3(grid), dim3(512), args, LDS_BYTES, stream);
    if (e != hipSuccess) fprintf(stderr, "cooperative launch failed: %s (grid %d)\n", hipGetErrorString(e), grid);
#else
    for (int ph = 0; ph < NPHASE; ++ph) {
        p.ph_lo = ph; p.ph_hi = ph + 1;
        hipLaunchKernelGGL(mega, dim3(grid), dim3(512), LDS_BYTES, stream, p);
    }
#endif
}
```
